# Optimizing an MI355X kernel written in HIP

```python
import math
import numpy as np
import jax
import jax.numpy as jnp
from jax import lax

D_MODEL = 1024
BATCH = 1
SEQ = 16384
DEPTH = 1

NSA_HEADS = 8
NSA_KV_GROUPS = 2
NSA_HPG = NSA_HEADS // NSA_KV_GROUPS
NSA_HEAD_DIM = 64
CMP_LEN = 32
CMP_STRIDE = 16
CMP_HIDDEN = 256
SEL_BLOCK = 64
SEL_TOP_N = 16
N_LOCAL_SEL = 2
WINDOW = 512
Q_BLOCK = 128
RET_HEADS = 4
RET_QK_DIM = 128
RET_V_DIM = 256
RET_CHUNK = 128
ROPE_BASE = 10000.0
REL_BUCKETS = 32
REL_MAX_DIST = 128
N_GROUPS = 4
EXPERTS_PER_GROUP = 8
N_EXPERTS = N_GROUPS * EXPERTS_PER_GROUP
EXPERT_TOP_K = 2
EXPERT_FF = 256
EPS = 1e-6

NSA_Q_W = NSA_HEADS * NSA_HEAD_DIM
NSA_KV_W = NSA_KV_GROUPS * NSA_HEAD_DIM
RET_QK_W = RET_HEADS * RET_QK_DIM
RET_V_W = RET_HEADS * RET_V_DIM
SPLITS = (NSA_Q_W, 6 * NSA_KV_W, 3 * NSA_HEADS, RET_QK_W, RET_QK_W, RET_V_W, RET_V_W, D_MODEL, D_MODEL)
IN_PROJ_W = NSA_Q_W + 6 * NSA_KV_W + 3 * NSA_HEADS + 2 * RET_QK_W + 2 * RET_V_W + 2 * D_MODEL

kernel_name = 'hybrid_nsa_retention_hmoe_block'


def rmsnorm(x, w):
    xf = x.astype(jnp.float32)
    y = xf * lax.rsqrt(jnp.mean(xf * xf, axis=-1, keepdims=True) + EPS)
    return (y * w.astype(jnp.float32)).astype(x.dtype)


def t5_bucket(dist):
    dist = jnp.maximum(dist, 0)
    max_exact = REL_BUCKETS // 2
    d_f = jnp.maximum(dist, 1).astype(jnp.float32)
    large = max_exact + (jnp.log(d_f / max_exact) / math.log(REL_MAX_DIST / max_exact)
                         * (REL_BUCKETS - max_exact)).astype(jnp.int32)
    large = jnp.minimum(large, REL_BUCKETS - 1)
    return jnp.where(dist < max_exact, dist, large)


def masked_softmax(s, mask, axis):
    s = jnp.where(mask, s, -1e30)
    m = jnp.max(s, axis=axis, keepdims=True)
    e = jnp.where(mask, jnp.exp(s - m), 0.0)
    return e / jnp.maximum(jnp.sum(e, axis=axis, keepdims=True), 1e-30)


def compress_tokens(kv, pos_emb, w1, w2):
    B, S, G, d = kv.shape
    n_cmp = (S - CMP_LEN) // CMP_STRIDE + 1
    idx = np.arange(n_cmp)[:, None] * CMP_STRIDE + np.arange(CMP_LEN)[None, :]
    blocks = kv[:, idx] + pos_emb[None, None, :, None, :]
    blocks = jnp.moveaxis(blocks, 3, 2).reshape(B, n_cmp, G, CMP_LEN * d)
    return jax.nn.gelu(blocks @ w1) @ w2


def nsa_attention(q, kv, gates, rel_bias, pos_k, k_w1, k_w2, pos_v, v_w1, v_w2):
    B, S = q.shape[0], q.shape[1]
    G, HPG, Dh = NSA_KV_GROUPS, NSA_HPG, NSA_HEAD_DIM
    f32 = jnp.float32
    scale = Dh ** -0.5
    k_cmp, v_cmp, k_sel, v_sel, k_win, v_win = [kv[:, :, j] for j in range(6)]
    kc = compress_tokens(k_cmp, pos_k, k_w1, k_w2)
    vc = compress_tokens(v_cmp, pos_v, v_w1, v_w2)
    n_cmp = kc.shape[1]
    cmp_end = jnp.arange(n_cmp) * CMP_STRIDE + (CMP_LEN - 1)
    n_sel = S // SEL_BLOCK
    top_n = min(SEL_TOP_N, n_sel)
    c_start = np.arange(n_cmp) * CMP_STRIDE
    b_start = np.arange(n_sel) * SEL_BLOCK
    overlap = jnp.asarray((c_start[:, None] <= b_start[None, :] + SEL_BLOCK - 1)
                          & (c_start[:, None] + CMP_LEN - 1 >= b_start[None, :]), dtype=f32)
    ks_blk = jnp.moveaxis(k_sel.reshape(B, n_sel, SEL_BLOCK, G, Dh), 3, 1)
    vs_blk = jnp.moveaxis(v_sel.reshape(B, n_sel, SEL_BLOCK, G, Dh), 3, 1)
    kw = jnp.pad(k_win, ((0, 0), (WINDOW, 0), (0, 0), (0, 0)))
    vw = jnp.pad(v_win, ((0, 0), (WINDOW, 0), (0, 0), (0, 0)))
    bias_g = rel_bias.reshape(REL_BUCKETS, G, HPG)
    b_ix = jnp.arange(B)[:, None, None, None]
    g_ix = jnp.arange(G)[None, None, :, None]
    blk_ids = jnp.arange(n_sel)
    n_qb = S // Q_BLOCK
    qb = jnp.moveaxis(q.reshape(B, n_qb, Q_BLOCK, G, HPG, Dh), 1, 0)
    gb = jnp.moveaxis(gates.reshape(B, n_qb, Q_BLOCK, 3, NSA_HEADS), 1, 0)

    def block(args):
        i, qi, gi = args
        start = i * Q_BLOCK
        t = start + jnp.arange(Q_BLOCK)
        s_c = jnp.einsum('bqgjd,bcgd->bqgjc', qi, kc).astype(f32) * scale
        dist_c = t[:, None] - cmp_end[None, :]
        s_c = s_c + jnp.transpose(bias_g[t5_bucket(dist_c)], (0, 2, 3, 1))[None]
        p_c = masked_softmax(s_c, (dist_c >= 0)[None, :, None, None, :], -1)
        o_c = jnp.einsum('bqgjc,bcgd->bqgjd', p_c.astype(vc.dtype), vc)
        imp = jnp.einsum('bqgc,cn->bqgn', p_c.sum(3), overlap)
        cur = t // SEL_BLOCK
        back = cur[:, None] - blk_ids[None, :]
        valid = back >= 0
        forced = (blk_ids[None, :] == 0) | (valid & (back < N_LOCAL_SEL))
        imp = jnp.where(forced[None, :, None, :], 1e9, jnp.where(valid[None, :, None, :], imp, -1e9))
        _, sel = lax.top_k(imp, top_n)
        k_g = ks_blk[b_ix, g_ix, sel]
        v_g = vs_blk[b_ix, g_ix, sel]
        pos_s = sel[..., None] * SEL_BLOCK + jnp.arange(SEL_BLOCK)
        dist_s = t[None, :, None, None, None] - pos_s
        s_s = jnp.einsum('bqgjd,bqgnkd->bqgjnk', qi, k_g).astype(f32) * scale
        bias_s = jnp.moveaxis(bias_g[t5_bucket(dist_s), g_ix[..., None]], -1, 3)
        p_s = masked_softmax(s_s + bias_s, (dist_s >= 0)[:, :, :, None], (-2, -1))
        o_s = jnp.einsum('bqgjnk,bqgnkd->bqgjd', p_s.astype(v_g.dtype), v_g)
        kw_i = lax.dynamic_slice_in_dim(kw, start, WINDOW + Q_BLOCK, axis=1)
        vw_i = lax.dynamic_slice_in_dim(vw, start, WINDOW + Q_BLOCK, axis=1)
        pos_w = start - WINDOW + jnp.arange(WINDOW + Q_BLOCK)
        dist_w = t[:, None] - pos_w[None, :]
        mask_w = (dist_w >= 0) & (dist_w < WINDOW) & (pos_w[None, :] >= 0)
        s_w = jnp.einsum('bqgjd,bkgd->bqgjk', qi, kw_i).astype(f32) * scale
        s_w = s_w + jnp.transpose(bias_g[t5_bucket(dist_w)], (0, 2, 3, 1))[None]
        p_w = masked_softmax(s_w, mask_w[None, :, None, None, :], -1)
        o_w = jnp.einsum('bqgjk,bkgd->bqgjd', p_w.astype(vw_i.dtype), vw_i)
        gi = gi.reshape(B, Q_BLOCK, 3, G, HPG)[..., None]
        o = gi[:, :, 0] * o_c + gi[:, :, 1] * o_s + gi[:, :, 2] * o_w
        return o.reshape(B, Q_BLOCK, NSA_HEADS * Dh)

    out = lax.map(block, (jnp.arange(n_qb), qb, gb))
    return jnp.moveaxis(out, 0, 1).reshape(B, S, NSA_HEADS * Dh)


def rotary(x, pos):
    half = x.shape[-1] // 2
    inv = ROPE_BASE ** (-jnp.arange(half, dtype=jnp.float32) / half)
    ang = pos[:, None].astype(jnp.float32) * inv[None, :]
    cos = jnp.cos(ang)[None, :, None, :]
    sin = jnp.sin(ang)[None, :, None, :]
    x1 = x[..., :half].astype(jnp.float32)
    x2 = x[..., half:].astype(jnp.float32)
    return jnp.concatenate([x1 * cos - x2 * sin, x1 * sin + x2 * cos], axis=-1).astype(x.dtype)


def retention(q, k, v, g, norm_w):
    B, S, H, dk = q.shape
    dv = v.shape[-1]
    C = RET_CHUNK
    nc = S // C
    f32 = jnp.float32
    pos = jnp.arange(S)
    q = rotary(q, pos)
    k = rotary(k, pos) * (dk ** -0.5)
    log_gamma = jnp.log(1.0 - 2.0 ** (-5.0 - jnp.arange(H, dtype=f32)))
    idx = jnp.arange(C, dtype=f32)
    diff = idx[:, None] - idx[None, :]
    decay_mask = jnp.where(diff >= 0, jnp.exp(jnp.maximum(diff, 0.0)[None] * log_gamma[:, None, None]), 0.0)
    q_decay = jnp.exp((idx + 1.0)[None, :] * log_gamma[:, None])[None, :, :, None]
    k_decay = jnp.exp((C - 1.0 - idx)[None, :] * log_gamma[:, None])[None, :, :, None]
    chunk_decay = jnp.exp(C * log_gamma)[None, :, None, None]

    def to_chunks(a):
        return a.reshape(B, nc, C, H, a.shape[-1]).transpose(1, 0, 3, 2, 4).astype(f32)

    def step(R, inp):
        qc, kc, vc = inp
        inner = jnp.einsum('bhid,bhjd->bhij', qc, kc) * decay_mask[None]
        y = jnp.einsum('bhij,bhjv->bhiv', inner, vc) + jnp.einsum('bhid,bhdv->bhiv', qc, R) * q_decay
        R = R * chunk_decay + jnp.einsum('bhjd,bhjv->bhdv', kc * k_decay, vc)
        return R, y

    R0 = jnp.zeros((B, H, dk, dv), f32)
    _, ys = lax.scan(step, R0, (to_chunks(q), to_chunks(k), to_chunks(v)))
    y = ys.transpose(1, 0, 3, 2, 4).reshape(B, S, H, dv)
    mu = jnp.mean(y, axis=-1, keepdims=True)
    var = jnp.mean(jnp.square(y - mu), axis=-1, keepdims=True)
    y = ((y - mu) * lax.rsqrt(var + EPS)).reshape(B, S, H * dv) * norm_w.astype(f32)
    return (jax.nn.silu(g.astype(f32)) * y).astype(g.dtype)


def hierarchical_moe(h, w_rg, b_rg, w_re, b_re, w_gate, w_up, w_down):
    B, S, _ = h.shape
    f32 = jnp.float32
    lg = (h @ w_rg).astype(f32) + b_rg.astype(f32)
    pg = jax.nn.softmax(lg, axis=-1)
    p_grp, grp = lax.top_k(pg, 1)
    le = ((h @ w_re).astype(f32) + b_re.astype(f32)).reshape(B, S, N_GROUPS, EXPERTS_PER_GROUP)
    le_g = jnp.take_along_axis(le, grp[..., None], axis=2)[:, :, 0]
    top_l, top_i = lax.top_k(le_g, EXPERT_TOP_K)
    w_sel = jax.nn.softmax(top_l, axis=-1) * p_grp
    e_idx = grp * EXPERTS_PER_GROUP + top_i
    combine = jnp.sum(jax.nn.one_hot(e_idx, N_EXPERTS, dtype=f32) * w_sel[..., None], axis=-2)

    def expert(acc, inp):
        wg, wu, wd, c = inp
        hid = jax.nn.silu(h @ wg) * (h @ wu)
        return acc + (hid @ wd) * c[..., None].astype(h.dtype), None

    out, _ = lax.scan(expert, jnp.zeros_like(h), (w_gate, w_up, w_down, jnp.moveaxis(combine, -1, 0)))
    return out


def setup_inputs(seed: int = 0) -> dict:
    key = jax.random.key(seed)
    ks = jax.random.split(key, 24)
    f32 = jnp.float32

    def nrm(k, shape, scale):
        return jax.random.normal(k, shape, f32) * scale

    D = D_MODEL
    return {
        'x': nrm(ks[0], (BATCH, SEQ, D), 1.0),
        'rel_bias': nrm(ks[1], (REL_BUCKETS, NSA_HEADS), 0.5),
        'norm_mix': 1.0 + nrm(ks[2], (DEPTH, D), 0.01),
        'w_in': nrm(ks[3], (DEPTH, D, IN_PROJ_W), D ** -0.5),
        'cmp_pos_k': nrm(ks[4], (DEPTH, CMP_LEN, NSA_HEAD_DIM), 0.1),
        'cmp_k_w1': nrm(ks[5], (DEPTH, CMP_LEN * NSA_HEAD_DIM, CMP_HIDDEN), (CMP_LEN * NSA_HEAD_DIM) ** -0.5),
        'cmp_k_w2': nrm(ks[6], (DEPTH, CMP_HIDDEN, NSA_HEAD_DIM), CMP_HIDDEN ** -0.5),
        'cmp_pos_v': nrm(ks[7], (DEPTH, CMP_LEN, NSA_HEAD_DIM), 0.1),
        'cmp_v_w1': nrm(ks[8], (DEPTH, CMP_LEN * NSA_HEAD_DIM, CMP_HIDDEN), (CMP_LEN * NSA_HEAD_DIM) ** -0.5),
        'cmp_v_w2': nrm(ks[9], (DEPTH, CMP_HIDDEN, NSA_HEAD_DIM), CMP_HIDDEN ** -0.5),
        'ret_norm': 1.0 + nrm(ks[10], (DEPTH, RET_V_W), 0.01),
        'w_nsa_up': nrm(ks[11], (DEPTH, NSA_Q_W, D), NSA_Q_W ** -0.5),
        'w_ret_up': nrm(ks[12], (DEPTH, RET_V_W, D), RET_V_W ** -0.5),
        'w_out': nrm(ks[13], (DEPTH, D, D), D ** -0.5),
        'norm_ffn': 1.0 + nrm(ks[14], (DEPTH, D), 0.01),
        'w_router_group': nrm(ks[15], (DEPTH, D, N_GROUPS), D ** -0.5),
        'b_router_group': nrm(ks[16], (DEPTH, N_GROUPS), 0.01),
        'w_router_expert': nrm(ks[17], (DEPTH, D, N_EXPERTS), D ** -0.5),
        'b_router_expert': nrm(ks[18], (DEPTH, N_EXPERTS), 0.01),
        'moe_w_gate': nrm(ks[19], (DEPTH, N_EXPERTS, D, EXPERT_FF), D ** -0.5),
        'moe_w_up': nrm(ks[20], (DEPTH, N_EXPERTS, D, EXPERT_FF), D ** -0.5),
        'moe_w_down': nrm(ks[21], (DEPTH, N_EXPERTS, EXPERT_FF, D), EXPERT_FF ** -0.5),
        'norm_final': 1.0 + nrm(ks[22], (D,), 0.01),
    }


def reference(x, rel_bias, norm_mix, w_in, cmp_pos_k, cmp_k_w1, cmp_k_w2, cmp_pos_v, cmp_v_w1, cmp_v_w2,
              ret_norm, w_nsa_up, w_ret_up, w_out, norm_ffn, w_router_group, b_router_group,
              w_router_expert, b_router_expert, moe_w_gate, moe_w_up, moe_w_down, norm_final):
    B, S, _ = x.shape
    split_idx = np.cumsum(SPLITS)[:-1].tolist()
    for l in range(DEPTH):
        h = rmsnorm(x, norm_mix[l])
        proj = h @ w_in[l]
        q_a, kv_a, g_a, q_r, k_r, v_r, g_r, gate_a, gate_r = jnp.split(proj, split_idx, axis=-1)
        y_a = nsa_attention(q_a.reshape(B, S, NSA_HEADS, NSA_HEAD_DIM),
                            kv_a.reshape(B, S, 6, NSA_KV_GROUPS, NSA_HEAD_DIM),
                            jax.nn.sigmoid(g_a.reshape(B, S, 3, NSA_HEADS)),
                            rel_bias, cmp_pos_k[l], cmp_k_w1[l], cmp_k_w2[l],
                            cmp_pos_v[l], cmp_v_w1[l], cmp_v_w2[l])
        y_r = retention(q_r.reshape(B, S, RET_HEADS, RET_QK_DIM),
                        k_r.reshape(B, S, RET_HEADS, RET_QK_DIM),
                        v_r.reshape(B, S, RET_HEADS, RET_V_DIM), g_r, ret_norm[l])
        merged = jax.nn.sigmoid(gate_a) * (y_a @ w_nsa_up[l]) + jax.nn.sigmoid(gate_r) * (y_r @ w_ret_up[l])
        x = x + merged @ w_out[l]
        h = rmsnorm(x, norm_ffn[l])
        x = x + hierarchical_moe(h, w_router_group[l], b_router_group[l], w_router_expert[l],
                                 b_router_expert[l], moe_w_gate[l], moe_w_up[l], moe_w_down[l])
    return rmsnorm(x, norm_final)
```

```cpp
#include <hip/hip_runtime.h>
#include <cstdio>
#include <cstdint>
namespace pg8 {
#define PG8_LAS __attribute__((address_space(3)))
typedef unsigned short bf16_t;
typedef short bf16x8 __attribute__((ext_vector_type(8)));
typedef float f32x4 __attribute__((ext_vector_type(4)));
typedef unsigned u32x4 __attribute__((ext_vector_type(4)));
constexpr int BM = 256, BK = 64, HALF = 128, HTB = HALF * BK * 2  , STAGE_BYTES = 8 * HTB, NXCD = 8, WGM = 8;

__host__ __device__ __forceinline__ int lds_byte(int r, int c) { const int st = (r >> 4) * 2 + (c >> 5), rr = r & 15, cc = c & 31, ob = rr * 64 + cc * 2; return st * 1024 + (ob ^ (((ob >> 9) & 1) << 5)); }
__host__ __device__ __forceinline__ void stage_rc(int b, int& R, int& C) { const int st = b / 1024, sb = b % 1024, swz = sb ^ (((sb >> 9) & 1) << 5); R = (st >> 1) * 16 + swz / 64; C = (st & 1) * 32 + (swz % 64) / 2; }
__host__ __device__ __forceinline__ int perm32(int rho) { const int n = rho >> 4, i = rho & 15; return 8 * (i >> 2) + 4 * n + (i & 3); }

struct Unit { int pm, pn; };
struct Gemm { const bf16_t* A; const bf16_t* Bt; int M, N, K; };

struct StaticOrder {
    int nM, nN, nwg, G, c;
    __host__ __device__ void init(int M, int N, int G_, int c_) { nM = M / BM; nN = N / BM; nwg = nM * nN; G = G_; c = c_; }
    __host__ __device__ bool next(int i, Unit& u) const {
        const long L = (long)i * G + c; if (L >= nwg) return false;
        int wgid = (int)L; { const int q = nwg / NXCD, r = nwg % NXCD, xcd = wgid % NXCD, off = wgid / NXCD; wgid = (xcd < r ? xcd * (q + 1) : r * (q + 1) + (xcd - r) * q) + off; }
        const int nig = WGM * nN, gid = wgid / nig, fm = gid * WGM, gsz = (nM - fm) < WGM ? (nM - fm) : WGM;
        u.pm = fm + ((wgid % nig) % gsz); u.pn = (wgid % nig) / gsz; return true;
    }
    __device__ __forceinline__ void a_ready(const Unit&) const {}
    __device__ __forceinline__ void done(const Unit&) const {}
};

__device__ __forceinline__ unsigned cvt_pk_bf16(float lo, float hi) { unsigned r; asm volatile("v_cvt_pk_bf16_f32 %0, %1, %2" : "=v"(r) : "v"(lo), "v"(hi)); return r; }

template <class Epi, class Sched, bool ALIGN_EPI = false, bool SP2 = false>
__device__ __forceinline__ void gemm_phase(PG8_LAS unsigned char* lds, const Gemm g, const Sched& S, const Epi& E) {
    const int tid = threadIdx.x, wid = __builtin_amdgcn_readfirstlane(tid >> 6), lane = tid & 63, wr = wid >> 2, wc = wid & 3, fr = lane & 15, fq = lane >> 4;
    const int K = g.K, nt = K / BK;
    unsigned voffA[2], voffB[2];
#pragma unroll
    for (int i = 0; i < 2; ++i) { int R, C; stage_rc(tid * 16 + i * 8192, R, C); const int Rb = Epi::PERM ? ((R & ~31) + perm32(R & 31)) : R;
        voffA[i] = (unsigned)(R * K + C) * 2u; voffB[i] = (unsigned)(Rb * K + C) * 2u; }
    const size_t kstep = (size_t)(BK * 2);
    const size_t hstep = (size_t)HALF * K * 2;
    const size_t tstep = 2 * hstep;
    const unsigned ldsw = (unsigned)wid * 1024u;
    const int aoff = lds_byte(wr * 64 + fr, fq * 8), boff = lds_byte(wc * 32 + fr, fq * 8);
#define PG8_SA(b, h) (((b) * 2 + (h)) * HTB)
#define PG8_SB(b, h) ((4 + (b) * 2 + (h)) * HTB)
#define PG8_STAGE(bufoff, gbase, voff) do { _Pragma("unroll") for (int _i = 0; _i < 2; ++_i) \
        __builtin_amdgcn_global_load_lds((const unsigned*)((const char*)(gbase) + (voff)[_i]), (PG8_LAS unsigned*)(lds + (bufoff) + ldsw + _i * 8192), 16, 0, 0); } while (0)
#define PG8_LDA(dst, b, h) do { _Pragma("unroll") for (int m = 0; m < 4; ++m) _Pragma("unroll") for (int k = 0; k < 2; ++k) dst[m][k] = *(const PG8_LAS bf16x8*)(lds + PG8_SA(b, h) + aoff + m * 2048 + k * 1024); } while (0)
#define PG8_LDB(dst, b, h) do { _Pragma("unroll") for (int n = 0; n < 2; ++n) _Pragma("unroll") for (int k = 0; k < 2; ++k) dst[n][k] = *(const PG8_LAS bf16x8*)(lds + PG8_SB(b, h) + boff + n * 2048 + k * 1024); } while (0)
#define PG8_MMA(ai, bj, At, Bt) do { __builtin_amdgcn_s_setprio(1); _Pragma("unroll") for (int m = 0; m < 4; ++m) _Pragma("unroll") for (int n = 0; n < 2; ++n) _Pragma("unroll") for (int k = 0; k < 2; ++k) \
        acc[ai][bj][m][n] = __builtin_amdgcn_mfma_f32_16x16x32_bf16(Bt[n][k], At[m][k], acc[ai][bj][m][n], 0, 0, 0); __builtin_amdgcn_s_setprio(0); } while (0)
#define PG8_WAIT_V(n) asm volatile("s_waitcnt vmcnt(" #n ")" ::: "memory")
#define PG8_WAIT_L(n) asm volatile("s_waitcnt lgkmcnt(" #n ")" ::: "memory")
#define PG8_BAR __builtin_amdgcn_s_barrier()
#define PG8_SCHED __builtin_amdgcn_sched_barrier(0)
    Unit cur, nxt; int ui = 0;
    if (!S.next(0, cur)) return;
    f32x4 acc[2][2][4][2];
#pragma unroll
    for (int a = 0; a < 2; ++a)
#pragma unroll
        for (int b = 0; b < 2; ++b)
#pragma unroll
            for (int m = 0; m < 4; ++m)
#pragma unroll
                for (int n = 0; n < 2; ++n) acc[a][b][m][n] = (f32x4){0.f, 0.f, 0.f, 0.f};
    bf16x8 At[4][2], B0[2][2], B1[2][2];
    const char* cA = (const char*)g.A + (size_t)cur.pm * tstep; const char* cB = (const char*)g.Bt + (size_t)cur.pn * tstep;
    S.a_ready(cur);
    if constexpr (SP2) {
        PG8_STAGE(PG8_SB(0, 0), cB, voffB); PG8_STAGE(PG8_SB(0, 1), cB + hstep, voffB); PG8_STAGE(PG8_SA(0, 0), cA, voffA); PG8_STAGE(PG8_SA(0, 1), cA + hstep, voffA);
        if (wr == 1) PG8_BAR;
        PG8_WAIT_V(2); PG8_BAR;
        PG8_STAGE(PG8_SB(1, 0), cB + kstep, voffB); PG8_STAGE(PG8_SA(1, 0), cA + kstep, voffA); PG8_STAGE(PG8_SB(1, 1), cB + hstep + kstep, voffB);
        PG8_WAIT_V(6); PG8_BAR;
    } else {
        PG8_STAGE(PG8_SB(0, 0), cB, voffB); PG8_STAGE(PG8_SA(0, 0), cA, voffA); PG8_STAGE(PG8_SB(0, 1), cB + hstep, voffB); PG8_STAGE(PG8_SA(0, 1), cA + hstep, voffA);
        if (wr == 1) PG8_BAR;
        PG8_WAIT_V(4); PG8_BAR;
        PG8_STAGE(PG8_SB(1, 0), cB + kstep, voffB); PG8_STAGE(PG8_SA(1, 0), cA + kstep, voffA); PG8_STAGE(PG8_SB(1, 1), cB + hstep + kstep, voffB);
        PG8_WAIT_V(6); PG8_BAR;
    }
    for (;;) {
        const bool has_next = S.next(ui + 1, nxt);
        const char* nA = has_next ? (const char*)g.A + (size_t)nxt.pm * tstep : cA; const char* nB = has_next ? (const char*)g.Bt + (size_t)nxt.pn * tstep : cB;
#pragma nounroll
        for (int t = 0; t < nt; t += 2) {
            const bool last = (t == nt - 2);
            const char* a1 = cA + (size_t)(t + 1) * kstep;
            const char* a2 = last ? nA : cA + (size_t)(t + 2) * kstep; const char* b2 = last ? nB : cB + (size_t)(t + 2) * kstep;
            const char* a3 = a2 + kstep; const char* b3 = b2 + kstep;
            if (last && has_next) S.a_ready(nxt);
            if constexpr (SP2) {
            PG8_LDB(B0, 0, 0); PG8_LDB(B1, 0, 1); PG8_SCHED; PG8_LDA(At, 0, 0); PG8_STAGE(PG8_SA(1, 1), a1 + hstep, voffA);
            PG8_WAIT_V(8); PG8_WAIT_L(0); PG8_BAR; PG8_MMA(0, 0, At, B0); PG8_MMA(0, 1, At, B1); PG8_BAR; PG8_SCHED;
            PG8_LDA(At, 0, 1); PG8_STAGE(PG8_SB(0, 0), b2, voffB); PG8_STAGE(PG8_SB(0, 1), b2 + hstep, voffB); PG8_STAGE(PG8_SA(0, 0), a2, voffA);
            PG8_WAIT_V(8); PG8_WAIT_L(0); PG8_BAR; PG8_MMA(1, 0, At, B0); PG8_MMA(1, 1, At, B1); PG8_BAR; PG8_SCHED;
            PG8_LDB(B0, 1, 0); PG8_LDB(B1, 1, 1); PG8_SCHED; PG8_LDA(At, 1, 0); PG8_STAGE(PG8_SA(0, 1), a2 + hstep, voffA);
            PG8_WAIT_V(8); PG8_WAIT_L(0); PG8_BAR; PG8_MMA(0, 0, At, B0); PG8_MMA(0, 1, At, B1); PG8_BAR; PG8_SCHED;
            PG8_LDA(At, 1, 1); PG8_STAGE(PG8_SB(1, 0), b3, voffB); PG8_STAGE(PG8_SB(1, 1), b3 + hstep, voffB); PG8_STAGE(PG8_SA(1, 0), a3, voffA);
            PG8_WAIT_V(8); PG8_WAIT_L(0); PG8_BAR; PG8_MMA(1, 0, At, B0); PG8_MMA(1, 1, At, B1); PG8_BAR; PG8_SCHED;
            } else {
            PG8_LDB(B0, 0, 0); PG8_SCHED; PG8_LDA(At, 0, 0); PG8_STAGE(PG8_SA(1, 1), a1 + hstep, voffA);
            PG8_WAIT_L(8); PG8_BAR; PG8_WAIT_L(0); PG8_MMA(0, 0, At, B0); PG8_BAR; PG8_SCHED;
            PG8_LDB(B1, 0, 1); PG8_STAGE(PG8_SB(0, 0), b2, voffB);
            PG8_BAR; PG8_WAIT_L(0); PG8_MMA(0, 1, At, B1); PG8_BAR;
            PG8_LDA(At, 0, 1); PG8_STAGE(PG8_SA(0, 0), a2, voffA);
            PG8_BAR; PG8_WAIT_L(0); PG8_MMA(1, 0, At, B0); PG8_BAR; PG8_SCHED;
            PG8_STAGE(PG8_SB(0, 1), b2 + hstep, voffB);
            PG8_WAIT_V(6); PG8_BAR; PG8_MMA(1, 1, At, B1); PG8_BAR;
            PG8_LDB(B0, 1, 0); PG8_SCHED; PG8_LDA(At, 1, 0); PG8_STAGE(PG8_SA(0, 1), a2 + hstep, voffA);
            PG8_WAIT_L(8); PG8_BAR; PG8_WAIT_L(0); PG8_MMA(0, 0, At, B0); PG8_BAR; PG8_SCHED;
            PG8_LDB(B1, 1, 1); PG8_STAGE(PG8_SB(1, 0), b3, voffB);
            PG8_BAR; PG8_WAIT_L(0); PG8_MMA(0, 1, At, B1); PG8_BAR;
            PG8_LDA(At, 1, 1); PG8_STAGE(PG8_SA(1, 0), a3, voffA);
            PG8_BAR; PG8_WAIT_L(0); PG8_MMA(1, 0, At, B0); PG8_BAR; PG8_SCHED;
            PG8_STAGE(PG8_SB(1, 1), b3 + hstep, voffB);
            PG8_WAIT_V(6); PG8_BAR; PG8_MMA(1, 1, At, B1); PG8_BAR;
            }
        }
        if constexpr (ALIGN_EPI) { if (wr == 0) PG8_BAR; }
        if constexpr (!Epi::AFTER_DRAIN) { E(acc, cur, wr, wc, fr, fq); S.done(cur); }
        if (!has_next) break;
#pragma unroll
        for (int a = 0; a < 2; ++a)
#pragma unroll
            for (int b = 0; b < 2; ++b)
#pragma unroll
                for (int m = 0; m < 4; ++m)
#pragma unroll
                    for (int n = 0; n < 2; ++n) acc[a][b][m][n] = (f32x4){0.f, 0.f, 0.f, 0.f};
        cur = nxt; cA = nA; cB = nB; ++ui;
        if constexpr (ALIGN_EPI) { if (wr == 1) PG8_BAR; }
    }
    PG8_WAIT_V(0);
    if constexpr (!ALIGN_EPI) { if (wr == 0) PG8_BAR; }
    PG8_BAR;
    if constexpr (Epi::AFTER_DRAIN) { E.fused(acc, cur, wr, wc, fr, fq, lds, wid, lane); S.done(cur); }
#undef PG8_SA
#undef PG8_SB
#undef PG8_STAGE
#undef PG8_LDA
#undef PG8_LDB
#undef PG8_MMA
#undef PG8_WAIT_V
#undef PG8_WAIT_L
#undef PG8_BAR
#undef PG8_SCHED
}
}

#define GAS __attribute__((address_space(1)))
#define LAS __attribute__((address_space(3)))
#define DI __device__ __forceinline__
typedef unsigned short bf16;
typedef unsigned v4u __attribute__((ext_vector_type(4)));
typedef unsigned v2u __attribute__((ext_vector_type(2)));
typedef float f32x4 __attribute__((ext_vector_type(4)));
typedef short bf16x8 __attribute__((ext_vector_type(8)));
typedef float f32x2_t __attribute__((ext_vector_type(2)));
typedef __bf16 bf16x2_t __attribute__((ext_vector_type(2)));
#define LDS_WAIT() asm volatile("s_waitcnt lgkmcnt(0)" ::: "memory")
#define VM_WAIT() asm volatile("s_waitcnt vmcnt(0)" ::: "memory")
DI unsigned pk2(float lo, float hi) { f32x2_t v = {lo, hi}; bf16x2_t b = __builtin_convertvector(v, bf16x2_t); return __builtin_bit_cast(unsigned, b); }
DI float bflo(unsigned u) { return __uint_as_float(u << 16); }
DI float bfhi(unsigned u) { return __uint_as_float(u & 0xffff0000u); }
DI float bf1(bf16 b) { return __uint_as_float(((unsigned)b) << 16); }
DI f32x4 mfma16(bf16x8 a, bf16x8 b, f32x4 c) { return __builtin_amdgcn_mfma_f32_16x16x32_bf16(a, b, c, 0, 0, 0); }
DI bf16x8 ld16(const bf16* p) { return *(const bf16x8*)p; }
DI bf16x8 ld8x2(const bf16* p, int off2) { const v2u a = *(const v2u*)p, b = *(const v2u*)(p + off2); v4u r = {a.x, a.y, b.x, b.y}; return __builtin_bit_cast(bf16x8, r); }
DI bf16x8 pack8(f32x4 a, f32x4 b) { v4u r = {pk2(a[0], a[1]), pk2(a[2], a[3]), pk2(b[0], b[1]), pk2(b[2], b[3])}; return __builtin_bit_cast(bf16x8, r); }
DI v2u pack4(f32x4 a) { v2u r = {pk2(a[0], a[1]), pk2(a[2], a[3])}; return r; }
DI float wave_sum(float v) {
#pragma unroll
    for (int o = 1; o < 64; o <<= 1) v += __shfl_xor(v, o);
    return v;
}
DI float quad_sum(float v) { v += __shfl_xor(v, 16); v += __shfl_xor(v, 32); return v; }
DI float quad_max(float v) { v = fmaxf(v, __shfl_xor(v, 16)); v = fmaxf(v, __shfl_xor(v, 32)); return v; }
DI unsigned wave_max_u32(unsigned v) {
#pragma unroll
    for (int o = 1; o < 64; o <<= 1) { const unsigned w = (unsigned)__shfl_xor((int)v, o); v = w > v ? w : v; }
    return v;
}
DI float sigmoidf_(float x) { return __builtin_amdgcn_rcpf(1.0f + __builtin_amdgcn_exp2f(-x * 1.4426950408889634f)); }
DI float siluf_(float x) { return x * sigmoidf_(x); }
DI float gelu_tanh(float v) { const float z = 0.7978845608028654f * (v + 0.044715f * v * v * v); const float e = __builtin_amdgcn_exp2f(2.0f * 1.4426950408889634f * z); return 0.5f * v * (2.0f - 2.0f * __builtin_amdgcn_rcpf(e + 1.0f)); }

constexpr int S = 16384, D = 1024;
constexpr int NWAVES = 8, NTHR = 512;
constexpr float EPS = 1e-6f, LOG2E = 1.4426950408889634f, QSCALE = 0.125f * 1.4426950408889634f;
constexpr size_t MiB = 1u << 20;
constexpr size_t WS_CTL = 0, CTL_ZERO_BYTES = MiB;
constexpr size_t WS_MISC = 1 * MiB;
constexpr size_t WS_WR = 2 * MiB;
constexpr size_t WS_H = WS_WR + 3328 * 2048;
constexpr size_t WS_WT = WS_H + 32 * MiB;
constexpr size_t WS_WG = 44 * MiB;
constexpr size_t WS_WC1 = 48 * MiB;
constexpr size_t WS_WUA = 50 * MiB, WS_WUB = 51 * MiB, WS_WO = 53 * MiB;
constexpr size_t WS_SM = 55 * MiB;
constexpr size_t SM_W2T = 0, SM_B1 = 64 * 1024, SM_WRT = 128 * 1024, SM_KC = 512 * 1024, SM_VCT = 768 * 1024;
constexpr size_t WS_QA = 56 * MiB, WS_GR = 72 * MiB, WS_GA = 104 * MiB, WS_KCV = 105 * MiB, WS_QR = 121 * MiB, WS_KR = 137 * MiB, WS_TOUT = 153 * MiB, WS_UR = 209 * MiB, WS_HIDC = 241 * MiB;
constexpr size_t WS_G = 105 * MiB, WS_MG = 169 * MiB;
constexpr size_t WS_MOEW = 56 * MiB;
constexpr size_t WS_HID = 104 * MiB, WS_XS = 124 * MiB, WS_Y = 124 * MiB, WS_END = 256 * MiB;
static_assert(WS_WT + 1792 * 2048 <= WS_WG && WS_HIDC + 2 * MiB <= WS_END && WS_XS + 40960ull * 2048 <= WS_END && WS_Y + 64 * MiB <= WS_END, "ws map");
constexpr int CW_BAR = 4096, CW_KMAX = 8192, CW_CNT = 8256;
constexpr int XS_ROWS = 40960;
constexpr int WAVE_LDS = 16960;
constexpr int BIAS_OFF = 135680;
constexpr int MOET_OFF = 139840;
constexpr int MISC_OFF = 140032;
constexpr int LDS_BYTES = 147456;
#define XB_TMO      128
#define XB_XCNT(j)  (256  + 64 * (j))
#define XB_XSUB(j)  (1280 + 64 * (j))
#define XB_XGEN(j)  (2304 + 64 * (j))
#define XB_TOP      3328
#define XB_TOPGEN   3392
#define XCD_BAR_WORDS 3456
#define XB_SPIN_CAP (1u << 18)

__device__ __forceinline__ unsigned xb_ld(unsigned* p)              { return __hip_atomic_load(p, __ATOMIC_RELAXED, __HIP_MEMORY_SCOPE_AGENT); }
__device__ __forceinline__ unsigned xb_add(unsigned* p, unsigned v) { return __hip_atomic_fetch_add(p, v, __ATOMIC_RELAXED, __HIP_MEMORY_SCOPE_AGENT); }
__device__ __forceinline__ unsigned xb_xcc_id() { return (unsigned)__builtin_amdgcn_s_getreg((3 << 11) | 20) & 0xFu; }
#define XB_SPIN(cond, bar) do { unsigned _sp = 0; while (cond) { __builtin_amdgcn_s_sleep(1); \
    if ((++_sp & 255u) == 0u) { if (xb_ld(&(bar)[XB_TMO])) break; if (_sp > XB_SPIN_CAP) { atomicAdd(&(bar)[XB_TMO], 1u); break; } } } } while (0)

struct XcdBarrier {
    unsigned* bar; unsigned x;
    volatile LAS unsigned* st;
};

__device__ __forceinline__ XcdBarrier xcd_barrier_post(unsigned* bar, volatile LAS unsigned* st) {
    XcdBarrier b; b.bar = bar; b.x = xb_xcc_id(); b.st = st;
    if (threadIdx.x == 0) (void)xb_add(&bar[XB_XCNT(b.x)], 1u);
    return b;
}
__device__ __forceinline__ void xcd_barrier_complete(unsigned* bar, unsigned x, unsigned& nloc, unsigned& nx) {
    const unsigned G = gridDim.x * gridDim.y * gridDim.z;
    unsigned sum, cnt, mine, sp = 0u;
    for (;;) {
        sum = 0u; cnt = 0u; mine = 0u;
#pragma unroll
        for (unsigned j = 0; j < 16; ++j) { const unsigned c = xb_ld(&bar[XB_XCNT(j)]); sum += c; cnt += (c > 0u) ? 1u : 0u; mine = (j == x) ? c : mine; }
        if (sum == G) break;
        __builtin_amdgcn_s_sleep(1);
        if ((++sp & 255u) == 0u) { if (xb_ld(&bar[XB_TMO])) break; if (sp > XB_SPIN_CAP) { atomicAdd(&bar[XB_TMO], 1u); break; } }
    }
    nloc = mine > 0u ? mine : 1u; nx = cnt > 0u ? cnt : 1u;
}

__device__ __forceinline__ void xcd_barrier(const XcdBarrier& b) {
    asm volatile("s_waitcnt vmcnt(0)" ::: "memory");
    __syncthreads();
    if (threadIdx.x == 0) {
        unsigned* bar = b.bar;
        __builtin_amdgcn_s_waitcnt(0);
        unsigned nloc = b.st[0], nx = b.st[1];
        if (nloc == 0u) { xcd_barrier_complete(bar, b.x, nloc, nx); b.st[0] = nloc; b.st[1] = nx; }
        const unsigned old = xb_add(&bar[XB_XSUB(b.x)], 1u);
        const unsigned gen = old / nloc;
        if (old + 1u == (gen + 1u) * nloc) {
            __builtin_amdgcn_fence(__ATOMIC_RELEASE, "agent");
            asm volatile("s_waitcnt vmcnt(0)" ::: "memory");
            const unsigned og = xb_add(&bar[XB_TOP], 1u);
            const unsigned tg = og / nx;
            if (og + 1u == (tg + 1u) * nx) xb_add(&bar[XB_TOPGEN], 1u);
            else XB_SPIN(xb_ld(&bar[XB_TOPGEN]) == tg, bar);
            __builtin_amdgcn_fence(__ATOMIC_ACQUIRE, "agent");
            xb_add(&bar[XB_XGEN(b.x)], 1u);
            asm volatile("s_waitcnt vmcnt(0)" ::: "memory");
        } else {
            XB_SPIN(xb_ld(&bar[XB_XGEN(b.x)]) == gen, bar);
            __builtin_amdgcn_fence(__ATOMIC_ACQUIRE, "agent");
            asm volatile("s_waitcnt vmcnt(0)" ::: "memory");
        }
    }
    __syncthreads();
}

DI void tile_map(int L, int nwg, int nM, int nN, int& pm, int& pn) {
    int wgid = L; { const int q = nwg / 8, r = nwg % 8, xcd = wgid % 8, off = wgid / 8; wgid = (xcd < r ? xcd * (q + 1) : r * (q + 1) + (xcd - r) * q) + off; }
    const int nig = 8 * nN, gid = wgid / nig, fm = gid * 8, gsz = (nM - fm) < 8 ? (nM - fm) : 8;
    pm = fm + ((wgid % nig) % gsz); pn = (wgid % nig) / gsz;
}
struct ProjOrder {
    int G, c;
    DI bool next(int i, pg8::Unit& u) const {
        const int L = i * G + c; if (L >= 1280) return false;
        if (L < 832) tile_map(L, 832, 64, 13, u.pm, u.pn);
        else { tile_map(L - 832, 448, 7, 64, u.pm, u.pn); u.pm += 64; u.pn += 13; }
        return true;
    }
    DI void a_ready(const pg8::Unit&) const {}
    DI void done(const pg8::Unit&) const {}
};
template <int NJ> struct MoeOrder {
    int G, c; const LAS int* tp;
    DI bool next(int i, pg8::Unit& u) const {
        const int L = i * G + c, tau = L / NJ, j = L % NJ; const int nt = __builtin_amdgcn_readfirstlane(tp[32]);
        if (tau >= nt) return false;
        int e = 0;
        for (int k = 1; k < 32; ++k) e += (tau >= __builtin_amdgcn_readfirstlane(tp[k])) ? 1 : 0;
        u.pm = tau; u.pn = e * NJ + j; return true;
    }
    DI void a_ready(const pg8::Unit&) const {}
    DI void done(const pg8::Unit&) const {}
};

struct EpiProj {
    static constexpr bool PERM = true, AFTER_DRAIN = false;
    bf16 *QA, *KCV, *QR, *KR, *GR, *GA, *TOUT;
    DI void operator()(const f32x4 (&acc)[2][2][4][2], const pg8::Unit& u, int wr, int wc, int fr_, int fq_) const {
        int fr = fr_, fq = fq_; asm volatile("" : "+v"(fr), "+v"(fq));
        const float L2B = 13.287712379549449f / 64.0f;
        const float INV2PI = 0.15915494309189535f;
        if (u.pm < 64) {
            const int pn = u.pn, row0 = u.pm * 256 + wr * 64 + fr;
            if (pn >= 4 && pn < 8) {
                bf16* base = pn < 6 ? QR : KR; const float sc = pn < 6 ? 1.0f : 0.08838834764831845f; const int hd0 = 2 * (pn & 1), d0 = 16 * wc + 4 * fq;
                float invr[4];
#pragma unroll
                for (int i = 0; i < 4; ++i) invr[i] = __builtin_amdgcn_exp2f(-(float)(d0 + i) * L2B) * INV2PI;
#pragma unroll
                for (int ai = 0; ai < 2; ++ai)
#pragma unroll
                    for (int m = 0; m < 4; ++m) {
                        const int tok = row0 + ai * 128 + m * 16; float cs[4], sn[4];
#pragma unroll
                        for (int i = 0; i < 4; ++i) { float rev = (float)tok * invr[i]; rev -= floorf(rev); sn[i] = __builtin_amdgcn_sinf(rev) * sc; cs[i] = __builtin_amdgcn_cosf(rev) * sc; }
#pragma unroll
                        for (int bj = 0; bj < 2; ++bj) {
                            const f32x4 x1 = acc[ai][bj][m][0], x2 = acc[ai][bj][m][1]; f32x4 o1, o2;
#pragma unroll
                            for (int i = 0; i < 4; ++i) { o1[i] = x1[i] * cs[i] - x2[i] * sn[i]; o2[i] = x1[i] * sn[i] + x2[i] * cs[i]; }
                            bf16* p = base + (size_t)tok * 512 + (hd0 + bj) * 128 + d0;
                            *(v2u*)p = pack4(o1); *(v2u*)(p + 64) = pack4(o2);
                        }
                    }
            } else if (pn == 12) {
                if (wc == 0) {
#pragma unroll
                    for (int ai = 0; ai < 2; ++ai)
#pragma unroll
                        for (int m = 0; m < 4; ++m) {
                            const int tok = row0 + ai * 128 + m * 16; f32x4 a = acc[ai][0][m][0], b = acc[ai][0][m][1];
#pragma unroll
                            for (int i = 0; i < 4; ++i) { a[i] = sigmoidf_(a[i]); b[i] = sigmoidf_(b[i]); }
                            *(bf16x8*)(GA + (size_t)tok * 32 + 8 * fq) = pack8(a, b);
                        }
                }
            } else {
                bf16* dst; int ldc, colt; float sc = 1.0f;
                if (pn < 2) { dst = QA; ldc = 512; colt = 256 * pn; sc = QSCALE; }
                else if (pn < 4) { dst = KCV; ldc = 512; colt = 256 * (pn - 2); }
                else { dst = GR; ldc = 1024; colt = 256 * (pn - 8); }
                const int col0 = colt + wc * 32 + 8 * fq;
#pragma unroll
                for (int ai = 0; ai < 2; ++ai)
#pragma unroll
                    for (int m = 0; m < 4; ++m) {
                        bf16* rowp = dst + (size_t)(row0 + ai * 128 + m * 16) * ldc + col0;
#pragma unroll
                        for (int bj = 0; bj < 2; ++bj) *(bf16x8*)(rowp + bj * 128) = pack8(acc[ai][bj][m][0] * sc, acc[ai][bj][m][1] * sc);
                    }
            }
        } else {
            const int pmp = u.pm - 64, tok0 = (u.pn - 13) * 256 + wc * 32 + 8 * fq;
            if (pmp == 1 || pmp == 2) {
                const float sc = 0.08838834764831845f;
#pragma unroll
                for (int ai = 0; ai < 2; ++ai) {
                    const int head = 2 * (pmp - 1) + ai;
#pragma unroll
                    for (int m = 0; m < 2; ++m) {
                        const int d = 32 * wr + 16 * m + fr; const float invr = __builtin_amdgcn_exp2f(-(float)d * L2B) * INV2PI;
                        bf16* p1 = TOUT + (size_t)(256 + head * 128 + d) * S;
#pragma unroll
                        for (int bj = 0; bj < 2; ++bj) {
                            f32x4 o1[2], o2[2];
#pragma unroll
                            for (int n = 0; n < 2; ++n)
#pragma unroll
                                for (int i = 0; i < 4; ++i) {
                                    const int tok = tok0 + bj * 128 + 4 * n + i; float rev = (float)tok * invr; rev -= floorf(rev);
                                    const float sn = __builtin_amdgcn_sinf(rev) * sc, cs = __builtin_amdgcn_cosf(rev) * sc;
                                    const float x1 = acc[ai][bj][m][n][i], x2 = acc[ai][bj][m + 2][n][i];
                                    o1[n][i] = x1 * cs - x2 * sn; o2[n][i] = x1 * sn + x2 * cs;
                                }
                            *(bf16x8*)(p1 + tok0 + bj * 128) = pack8(o1[0], o1[1]);
                            *(bf16x8*)(p1 + (size_t)64 * S + tok0 + bj * 128) = pack8(o2[0], o2[1]);
                        }
                    }
                }
            } else {
#pragma unroll
                for (int ai = 0; ai < 2; ++ai)
#pragma unroll
                    for (int m = 0; m < 4; ++m) {
                        bf16* rowp = TOUT + (size_t)(pmp * 256 + ai * 128 + wr * 64 + m * 16 + fr) * S + tok0;
#pragma unroll
                        for (int bj = 0; bj < 2; ++bj) *(bf16x8*)(rowp + bj * 128) = pack8(acc[ai][bj][m][0], acc[ai][bj][m][1]);
                    }
            }
        }
    }
};
struct EpiGate {
    static constexpr bool PERM = true, AFTER_DRAIN = false;
    bf16* G;
    DI void operator()(const f32x4 (&acc)[2][2][4][2], const pg8::Unit& u, int wr, int wc, int fr, int fq) const {
        const int row0 = u.pm * 256 + wr * 64 + fr, col0 = u.pn * 256 + wc * 32 + 8 * fq;
#pragma unroll
        for (int ai = 0; ai < 2; ++ai)
#pragma unroll
            for (int m = 0; m < 4; ++m) {
                bf16* rowp = G + (size_t)(row0 + ai * 128 + m * 16) * 2048 + col0;
#pragma unroll
                for (int bj = 0; bj < 2; ++bj) { f32x4 a = acc[ai][bj][m][0], b = acc[ai][bj][m][1];
#pragma unroll
                    for (int i = 0; i < 4; ++i) { a[i] = sigmoidf_(a[i]); b[i] = sigmoidf_(b[i]); }
                    *(bf16x8*)(rowp + bj * 128) = pack8(a, b); }
            }
    }
};
template <bool ADD> struct EpiUp {
    static constexpr bool PERM = true, AFTER_DRAIN = false;
    const bf16* G; bf16* MG; int goff;
    DI void operator()(const f32x4 (&acc)[2][2][4][2], const pg8::Unit& u, int wr, int wc, int fr, int fq) const {
        const int row0 = u.pm * 256 + wr * 64 + fr, col0 = u.pn * 256 + wc * 32 + 8 * fq;
#pragma unroll
        for (int ai = 0; ai < 2; ++ai)
#pragma unroll
            for (int m = 0; m < 4; ++m) {
                const size_t r = (size_t)(row0 + ai * 128 + m * 16);
#pragma unroll
                for (int bj = 0; bj < 2; ++bj) {
                    const v4u g = *(const v4u*)(G + r * 2048 + goff + col0 + bj * 128);
                    f32x4 a = acc[ai][bj][m][0], b = acc[ai][bj][m][1];
                    a[0] *= bflo(g.x); a[1] *= bfhi(g.x); a[2] *= bflo(g.y); a[3] *= bfhi(g.y); b[0] *= bflo(g.z); b[1] *= bfhi(g.z); b[2] *= bflo(g.w); b[3] *= bfhi(g.w);
                    bf16* op = MG + r * 1024 + col0 + bj * 128;
                    if (ADD) { const v4u o = *(const v4u*)op;
                        a[0] += bflo(o.x); a[1] += bfhi(o.x); a[2] += bflo(o.y); a[3] += bfhi(o.y); b[0] += bflo(o.z); b[1] += bfhi(o.z); b[2] += bflo(o.w); b[3] += bfhi(o.w); }
                    *(bf16x8*)op = pack8(a, b);
                }
            }
    }
};
struct EpiOut {
    static constexpr bool PERM = false, AFTER_DRAIN = false;
    const float* X; float* O;
    DI void operator()(const f32x4 (&acc)[2][2][4][2], const pg8::Unit& u, int wr, int wc, int fr, int fq) const {
        const int row0 = u.pm * 256 + wr * 64 + fr, col0 = u.pn * 256 + wc * 32 + 4 * fq;
#pragma unroll
        for (int ai = 0; ai < 2; ++ai)
#pragma unroll
            for (int m = 0; m < 4; ++m) {
                const size_t off = (size_t)(row0 + ai * 128 + m * 16) * 1024 + col0;
#pragma unroll
                for (int bj = 0; bj < 2; ++bj)
#pragma unroll
                    for (int n = 0; n < 2; ++n) { const size_t o = off + bj * 128 + n * 16; *(f32x4*)(O + o) = *(const f32x4*)(X + o) + acc[ai][bj][m][n]; }
            }
    }
};
struct EpiMoe1 {
    static constexpr bool PERM = false, AFTER_DRAIN = false;
    bf16* HID;
    DI void operator()(const f32x4 (&acc)[2][2][4][2], const pg8::Unit& u, int wr, int wc, int fr, int fq) const {
        const int row0 = u.pm * 256 + wr * 64 + fr, f0 = (u.pn & 1) * 128 + 16 * wc + 4 * fq;
#pragma unroll
        for (int ai = 0; ai < 2; ++ai)
#pragma unroll
            for (int m = 0; m < 4; ++m) {
                bf16* rowp = HID + (size_t)(row0 + ai * 128 + m * 16) * 256 + f0;
#pragma unroll
                for (int bj = 0; bj < 2; ++bj) { const f32x4 g = acc[ai][bj][m][0], up = acc[ai][bj][m][1]; f32x4 h;
#pragma unroll
                    for (int i = 0; i < 4; ++i) h[i] = siluf_(g[i]) * up[i];
                    *(v2u*)(rowp + bj * 64) = pack4(h); }
            }
    }
};
struct EpiMoe2 {
    static constexpr bool PERM = true, AFTER_DRAIN = false;
    const v2u* RI; bf16* Y;
    DI void operator()(const f32x4 (&acc)[2][2][4][2], const pg8::Unit& u, int wr, int wc, int fr, int fq) const {
        const int row0 = u.pm * 256 + wr * 64 + fr, col0 = (u.pn & 3) * 256 + wc * 32 + 8 * fq;
#pragma unroll
        for (int ai = 0; ai < 2; ++ai)
#pragma unroll
            for (int m = 0; m < 4; ++m) {
                const v2u ri = RI[row0 + ai * 128 + m * 16]; const float w = __uint_as_float(ri.y);
                if (ri.x != 0xffffffffu) {
                    bf16* rowp = Y + ri.x + col0;
#pragma unroll
                    for (int bj = 0; bj < 2; ++bj) *(bf16x8*)(rowp + bj * 128) = pack8(acc[ai][bj][m][0] * w, acc[ai][bj][m][1] * w);
                }
                asm volatile("" ::: "memory");
            }
    }
};

struct Args { const float* in[23]; float* out; unsigned char* ws; int ph_lo, ph_hi; };
struct Frame {
    LAS unsigned char* lds;
    unsigned* ctl;
    int tid, lane, wave, G, gw, ngw;
    const Args* A; float* out; unsigned char* ws;
};
#define WSP(T, off) ((T*)(F.ws + (off)))

template <class DestFn>
DI void tr_item(const float* W, int ldw, int ncols, int k0, int n0, LAS float* scr, int lane, DestFn dest) {
    const int nn = n0 + (lane & 31);
#pragma unroll 8
    for (int i = 0; i < 32; ++i) { const int kk = 2 * i + (lane >> 5); scr[kk * 33 + (lane & 31)] = nn < ncols ? W[(size_t)(k0 + kk) * ldw + nn] : 0.0f; }
    LDS_WAIT(); asm volatile("" ::: "memory");
    const int c = lane & 7;
#pragma unroll
    for (int j = 0; j < 4; ++j) {
        const int nl = (lane >> 3) + 8 * j, n = n0 + nl;
        if (n < ncols) {
            const LAS float* s = scr + (8 * c) * 33 + nl;
            v4u o; o.x = pk2(s[0 * 33], s[1 * 33]); o.y = pk2(s[2 * 33], s[3 * 33]); o.z = pk2(s[4 * 33], s[5 * 33]); o.w = pk2(s[6 * 33], s[7 * 33]);
            bf16* r0 = dest(n, 0); if (r0) *(v4u*)(r0 + k0 + 8 * c) = o;
            bf16* r1 = dest(n, 1); if (r1) *(v4u*)(r1 + k0 + 8 * c) = o;
        }
    }
    LDS_WAIT(); asm volatile("" ::: "memory");
}
DI int rot_row_R(int d) { const int n = d >> 6, dd = d & 63; return 32 * (dd >> 4) + 8 * ((dd >> 2) & 3) + 4 * n + (dd & 3); }
DI int rot_row_T(int d) { const int x2 = d >> 6, dd = d & 63; return 64 * (dd >> 5) + 16 * (((dd >> 4) & 1) + 2 * x2) + (dd & 15); }
DI bf16* win_dest(unsigned char* ws, int s, int which) {
    bf16* WR = (bf16*)(ws + WS_WR); bf16* WT = (bf16*)(ws + WS_WT); bf16* WG = (bf16*)(ws + WS_WG);
    int r = -1, t = -1, g = -1;
    if (s < 512) r = s;
    else if (s < 1280) { const int sp = s - 512, j6 = sp >> 7, gd = sp & 127;
        if (j6 == 0) r = 512 + gd; else if (j6 == 1) r = 512 + 128 + gd; else if (j6 == 2) r = 512 + 256 + gd; else if (j6 == 4) r = 512 + 384 + gd;
        else if (j6 == 3) t = gd; else t = 128 + gd; }
    else if (s < 1304) r = 12 * 256 + (s - 1280);
    else if (s < 1816) { const int f = s - 1304, hh = f >> 7, d = f & 127; r = (4 + (hh >> 1)) * 256 + (hh & 1) * 128 + rot_row_R(d); }
    else if (s < 2328) { const int f = s - 1816, hh = f >> 7, d = f & 127; r = (6 + (hh >> 1)) * 256 + (hh & 1) * 128 + rot_row_R(d); t = (1 + (hh >> 1)) * 256 + (hh & 1) * 128 + rot_row_T(d); }
    else if (s < 3352) t = 768 + (s - 2328);
    else if (s < 4376) r = 8 * 256 + (s - 3352);
    else g = s - 4376;
    if (which == 0) { if (r >= 0) return WR + (size_t)r * 1024; if (t >= 0) return WT + (size_t)t * 1024; return WG + (size_t)g * 1024; }
    return (r >= 0 && t >= 0) ? WT + (size_t)t * 1024 : nullptr;
}
DI void load_row(const float* p, int lane, f32x4 (&v)[4]) {
#pragma unroll
    for (int j = 0; j < 4; ++j) v[j] = *(const f32x4*)(p + 4 * lane + 256 * j);
}
DI float row_rstd(const f32x4 (&v)[4]) {
    float s = 0.f;
#pragma unroll
    for (int j = 0; j < 4; ++j) s += (v[j][0] * v[j][0] + v[j][1] * v[j][1]) + (v[j][2] * v[j][2] + v[j][3] * v[j][3]);
    return 1.0f / sqrtf(wave_sum(s) * (1.0f / 1024.0f) + EPS);
}

DI void p0_prologue(Frame& F) {
    LAS float* scr = (LAS float*)(F.lds + F.wave * WAVE_LDS);
    const float* w_in = F.A->in[3];
    constexpr int I_IN = 16 * 201, I_C1 = 512, I_C2 = 16, I_UA = 256, I_UB = 512, I_WO = 512, NIT = I_IN + I_C1 + I_C2 + I_UA + I_UB + I_WO;
    unsigned char* ws = F.ws;
    for (int it = F.gw; it < NIT; it += F.ngw) {
        int r = it;
        if (r < I_IN) { const int kb = r / 201, nb = r % 201; tr_item(w_in, 6424, 6424, 64 * kb, 32 * nb, scr, F.lane, [ws](int n, int which) { return win_dest(ws, n, which); }); continue; } r -= I_IN;
        if (r < I_C1) { const int kind = r >> 8, q = r & 255, kb = q >> 3, nb = q & 7; bf16* dstb = (bf16*)(ws + WS_WC1) + (size_t)kind * 256 * 2048;
            tr_item(F.A->in[kind ? 8 : 5], 256, 256, 64 * kb, 32 * nb, scr, F.lane, [dstb](int n, int which) { return which ? (bf16*)nullptr : dstb + (size_t)n * 2048; }); continue; } r -= I_C1;
        if (r < I_C2) { const int kind = r >> 3, q = r & 7, kb = q >> 1, nb = q & 1; bf16* dstb = (bf16*)(ws + WS_SM + SM_W2T) + (size_t)kind * 64 * 256;
            tr_item(F.A->in[kind ? 9 : 6], 64, 64, 64 * kb, 32 * nb, scr, F.lane, [dstb](int n, int which) { return which ? (bf16*)nullptr : dstb + (size_t)n * 256; }); continue; } r -= I_C2;
        if (r < I_UA) { const int kb = r >> 5, nb = r & 31; bf16* dstb = (bf16*)(ws + WS_WUA);
            tr_item(F.A->in[11], 1024, 1024, 64 * kb, 32 * nb, scr, F.lane, [dstb](int n, int which) { return which ? (bf16*)nullptr : dstb + (size_t)n * 512; }); continue; } r -= I_UA;
        if (r < I_UB) { const int kb = r >> 5, nb = r & 31; bf16* dstb = (bf16*)(ws + WS_WUB);
            tr_item(F.A->in[12], 1024, 1024, 64 * kb, 32 * nb, scr, F.lane, [dstb](int n, int which) { return which ? (bf16*)nullptr : dstb + (size_t)n * 1024; }); continue; } r -= I_UB;
        { const int kb = r >> 5, nb = r & 31; bf16* dstb = (bf16*)(ws + WS_WO);
            tr_item(F.A->in[13], 1024, 1024, 64 * kb, 32 * nb, scr, F.lane, [dstb](int n, int which) { return which ? (bf16*)nullptr : dstb + (size_t)n * 1024; }); }
    }
    for (int o = F.gw; o < 512; o += F.ngw) {
        const int kind = o >> 8, n = o & 255; const float* pos = F.A->in[kind ? 7 : 4]; const float* w1 = F.A->in[kind ? 8 : 5]; float s = 0.f;
        for (int kk = F.lane; kk < 2048; kk += 64) s += pos[kk] * w1[(size_t)kk * 256 + n];
        s = wave_sum(s); if (F.lane == 0) ((float*)(ws + WS_SM + SM_B1))[o] = s;
    }
    { float* wrt = (float*)(ws + WS_SM + SM_WRT);
      for (int i = F.gw * 64 + F.lane; i < 36 * 1024; i += F.ngw * 64) { const int o = i >> 10, k = i & 1023; wrt[i] = o < 4 ? F.A->in[15][k * 4 + o] : F.A->in[17][k * 32 + (o - 4)]; } }
    { f32x4 w[4]; load_row(F.A->in[2], F.lane, w); bf16* H = (bf16*)(ws + WS_H);
      for (int m = F.gw; m < S; m += F.ngw) { f32x4 v[4]; load_row(F.A->in[0] + (size_t)m * 1024, F.lane, v); const float rs = row_rstd(v);
#pragma unroll
        for (int j = 0; j < 4; ++j) { const f32x4 o = v[j] * rs * w[j]; *(v2u*)(H + (size_t)m * 1024 + 4 * F.lane + 256 * j) = pack4(o); } } }
}

DI void p2_ret_state(Frame& F, int u) {
    const int c = u >> 5, h = (u >> 3) & 3, dkt = u & 7, col = F.lane & 15, kq = F.lane >> 4;
    const float l2g = log2f(1.0f - __builtin_amdgcn_exp2f((float)(-5 - h)));
    const bf16* TOUT = WSP(const bf16, WS_TOUT);
    const bf16* krow = TOUT + (size_t)(256 + h * 128 + dkt * 16 + col) * S + c * 128 + kq * 8;
    const bf16* vrow = TOUT + (size_t)(768 + h * 256 + col) * S + c * 128 + kq * 8;
    f32x4 acc[16];
#pragma unroll
    for (int i = 0; i < 16; ++i) acc[i] = (f32x4){0.f, 0.f, 0.f, 0.f};
#pragma unroll
    for (int ks = 0; ks < 4; ++ks) {
        const v4u kr = *(const v4u*)(krow + ks * 32); float kv[8] = {bflo(kr.x), bfhi(kr.x), bflo(kr.y), bfhi(kr.y), bflo(kr.z), bfhi(kr.z), bflo(kr.w), bfhi(kr.w)};
#pragma unroll
        for (int e = 0; e < 8; ++e) kv[e] *= __builtin_amdgcn_exp2f((float)(127 - (ks * 32 + kq * 8 + e)) * l2g);
        v4u ks4 = {pk2(kv[0], kv[1]), pk2(kv[2], kv[3]), pk2(kv[4], kv[5]), pk2(kv[6], kv[7])}; const bf16x8 kf = __builtin_bit_cast(bf16x8, ks4);
#pragma unroll
        for (int dvt = 0; dvt < 16; ++dvt) { const bf16x8 vf = ld16(vrow + (size_t)dvt * 16 * S + ks * 32); acc[dvt] = mfma16(kf, vf, acc[dvt]); }
    }
    bf16* UR = WSP(bf16, WS_UR) + ((size_t)(c * 4 + h) * 256) * 128;
#pragma unroll
    for (int dvt = 0; dvt < 16; ++dvt) *(v2u*)(UR + (size_t)(dvt * 16 + col) * 128 + dkt * 16 + 4 * kq) = pack4(acc[dvt]);
}
DI void p2_cmp_hidden(Frame& F, int u) {
    const int combo = u >> 6, kind = combo >> 1, g = combo & 1, rt = (u >> 1) & 31, nh = u & 1, col = F.lane & 15, kq = F.lane >> 4;
    const bf16* W1 = WSP(const bf16, WS_WC1) + (size_t)kind * 256 * 2048 + (size_t)(nh * 128 + col) * 2048 + kq * 8;
    const bf16* KCV = WSP(const bf16, WS_KCV) + kind * 128 + g * 64 + kq * 8;
    int tokb[2];
#pragma unroll
    for (int ct = 0; ct < 2; ++ct) tokb[ct] = 16 * (rt * 32 + ct * 16 + col);
    f32x4 acc[8][2];
#pragma unroll
    for (int i = 0; i < 8; ++i) { acc[i][0] = (f32x4){0.f, 0.f, 0.f, 0.f}; acc[i][1] = (f32x4){0.f, 0.f, 0.f, 0.f}; }
    for (int st = 0; st < 64; ++st) {
        const int l = st >> 1, d0 = (st & 1) * 32; bf16x8 bfr[2];
#pragma unroll
        for (int ct = 0; ct < 2; ++ct) { int tok = tokb[ct] + l; tok = tok < S ? tok : S - 1; bfr[ct] = ld16(KCV + (size_t)tok * 512 + d0); }
#pragma unroll
        for (int nt = 0; nt < 8; ++nt) { const bf16x8 af = ld16(W1 + (size_t)nt * 16 * 2048 + st * 32);
            acc[nt][0] = mfma16(af, bfr[0], acc[nt][0]); acc[nt][1] = mfma16(af, bfr[1], acc[nt][1]); }
    }
    const float* b1 = WSP(const float, WS_SM + SM_B1) + kind * 256; bf16* HC = WSP(bf16, WS_HIDC) + (size_t)combo * 1024 * 256;
#pragma unroll
    for (int nt = 0; nt < 8; ++nt) { const int n0 = nh * 128 + nt * 16 + 4 * kq; const f32x4 bb = *(const f32x4*)(b1 + n0);
#pragma unroll
        for (int ct = 0; ct < 2; ++ct) { f32x4 v = acc[nt][ct] + bb;
#pragma unroll
            for (int i = 0; i < 4; ++i) v[i] = gelu_tanh(v[i]);
            *(v2u*)(HC + (size_t)(rt * 32 + ct * 16 + col) * 256 + n0) = pack4(v); } }
}
DI void p2_kmax(Frame& F, int u) {
    const int tok = u * 64 + F.lane; const bf16* KCV = WSP(const bf16, WS_KCV) + (size_t)tok * 512 + 256;
#pragma unroll
    for (int q = 0; q < 4; ++q) { float s = 0.f;
#pragma unroll
        for (int j = 0; j < 8; ++j) { const v4u k = *(const v4u*)(KCV + q * 64 + j * 8);
            const float a0 = bflo(k.x), a1 = bfhi(k.x), a2 = bflo(k.y), a3 = bfhi(k.y), a4 = bflo(k.z), a5 = bfhi(k.z), a6 = bflo(k.w), a7 = bfhi(k.w);
            s += (a0 * a0 + a1 * a1) + (a2 * a2 + a3 * a3) + (a4 * a4 + a5 * a5) + (a6 * a6 + a7 * a7); }
        const unsigned m = wave_max_u32(__float_as_uint(s));
        if (F.lane == 0) atomicMax(F.ctl + CW_KMAX + q, m); }
}
DI void p3_scan(Frame& F) {
    const int idx = blockIdx.x * NTHR + F.tid;
    if (idx < 65536) {
        const int h = idx >> 14; const float cd = __builtin_amdgcn_exp2f(128.0f * log2f(1.0f - __builtin_amdgcn_exp2f((float)(-5 - h))));
        unsigned* UR = WSP(unsigned, WS_UR) + idx; float r0 = 0.f, r1 = 0.f;
#pragma unroll 8
        for (int c = 0; c < 128; ++c) { const unsigned u = UR[(size_t)c * 65536]; UR[(size_t)c * 65536] = pk2(r0, r1); r0 = r0 * cd + bflo(u); r1 = r1 * cd + bfhi(u); }
    }
}
DI void p3_kcvc(Frame& F, int u) {
    const int combo = u >> 6, kind = combo >> 1, g = combo & 1, rt = u & 63, col = F.lane & 15, kq = F.lane >> 4;
    const bf16* HC = WSP(const bf16, WS_HIDC) + (size_t)combo * 1024 * 256 + (size_t)(rt * 16 + col) * 256 + kq * 8;
    const bf16* W2 = WSP(const bf16, WS_SM + SM_W2T) + (size_t)kind * 64 * 256 + (size_t)col * 256 + kq * 8;
    f32x4 acc[4];
#pragma unroll
    for (int i = 0; i < 4; ++i) acc[i] = (f32x4){0.f, 0.f, 0.f, 0.f};
#pragma unroll
    for (int ks = 0; ks < 8; ++ks) { const bf16x8 hf = ld16(HC + ks * 32);
#pragma unroll
        for (int dt = 0; dt < 4; ++dt) { const bf16x8 wf = ld16(W2 + (size_t)dt * 16 * 256 + ks * 32); acc[dt] = kind ? mfma16(hf, wf, acc[dt]) : mfma16(wf, hf, acc[dt]); } }
    if (kind == 0) { bf16* KC = WSP(bf16, WS_SM + SM_KC) + (size_t)g * 1024 * 64;
#pragma unroll
        for (int dt = 0; dt < 4; ++dt) *(v2u*)(KC + (size_t)(rt * 16 + col) * 64 + dt * 16 + 4 * kq) = pack4(acc[dt]); }
    else { bf16* VCT = WSP(bf16, WS_SM + SM_VCT) + (size_t)g * 64 * 1024;
#pragma unroll
        for (int dt = 0; dt < 4; ++dt) *(v2u*)(VCT + (size_t)(dt * 16 + col) * 1024 + rt * 16 + 4 * kq) = pack4(acc[dt]); }
}

DI void p4_bias_table(Frame& F) {
    LAS float* bt = (LAS float*)(F.lds + BIAS_OFF); const float* rb = F.A->in[1];
    for (int i = F.tid; i < 129 * 8; i += NTHR) { const int dist = i >> 3, hd = i & 7; int b = dist;
        if (dist >= 16) { b = 16 + (int)(logf((float)dist / 16.0f) / 2.0794415416798357f * 16.0f); b = b < 31 ? b : 31; }
        bt[i] = rb[b * 8 + hd] * LOG2E; }
    __syncthreads();
    if (F.tid < 64) { float m = 0.f; for (int i = F.tid; i < 129 * 8; i += 64) m = fmaxf(m, fabsf(bt[i]));
#pragma unroll
        for (int o = 1; o < 64; o <<= 1) m = fmaxf(m, __shfl_xor(m, o));
        if (F.tid == 0) bt[129 * 8] = m; }
    __syncthreads();
}
DI void p4_nsa_unit(Frame& F, int qt, int g) {
    const int lane = F.lane, col = lane & 15, rq = lane >> 4, t0 = qt * 16, tq = t0 + col;
    LAS float* wl = (LAS float*)(F.lds + F.wave * WAVE_LDS);
    LAS unsigned char* sel = (LAS unsigned char*)(F.lds + F.wave * WAVE_LDS + 16640);
    const LAS float* bt = (const LAS float*)(F.lds + BIAS_OFF);
    const float bmax = bt[129 * 8];
    const bf16* QA = WSP(const bf16, WS_QA); const bf16* KCV = WSP(const bf16, WS_KCV); const bf16* TOUT = WSP(const bf16, WS_TOUT); const bf16* GA = WSP(const bf16, WS_GA);
    const bf16* KC = WSP(const bf16, WS_SM + SM_KC) + (size_t)g * 1024 * 64; const bf16* VCT = WSP(const bf16, WS_SM + SM_VCT) + (size_t)g * 64 * 1024;
    const float kmax_sel = sqrtf(__uint_as_float(F.ctl[CW_KMAX + g])), kmax_win = sqrtf(__uint_as_float(F.ctl[CW_KMAX + 2 + g]));
    bf16x8 qf[4][2]; float qn[4], gcmp[4], gwin[4];
#pragma unroll
    for (int j = 0; j < 4; ++j) { float s = 0.f;
#pragma unroll
        for (int ks = 0; ks < 2; ++ks) { const v4u q = *(const v4u*)(QA + (size_t)tq * 512 + (g * 4 + j) * 64 + ks * 32 + rq * 8); qf[j][ks] = __builtin_bit_cast(bf16x8, q);
            const float a0 = bflo(q.x), a1 = bfhi(q.x), a2 = bflo(q.y), a3 = bfhi(q.y), a4 = bflo(q.z), a5 = bfhi(q.z), a6 = bflo(q.w), a7 = bfhi(q.w);
            s += (a0 * a0 + a1 * a1) + (a2 * a2 + a3 * a3) + (a4 * a4 + a5 * a5) + (a6 * a6 + a7 * a7); }
        qn[j] = sqrtf(quad_sum(s)); gcmp[j] = bf1(GA[(size_t)tq * 32 + g * 4 + j]); gwin[j] = bf1(GA[(size_t)tq * 32 + 16 + g * 4 + j]); }
    const f32x4 z4 = {0.f, 0.f, 0.f, 0.f};
    const int nkc = qt < 1023 ? qt : 1023, nst = (nkc + 31) >> 5;
    float m1[4], l1[4];
#pragma unroll
    for (int j = 0; j < 4; ++j) { m1[j] = -1e30f; l1[j] = 0.f; }
    for (int st = 0; st < nst; ++st) {
        bf16x8 kf[2][2];
#pragma unroll
        for (int kt = 0; kt < 2; ++kt)
#pragma unroll
            for (int ks = 0; ks < 2; ++ks) kf[kt][ks] = ld16(KC + (size_t)(st * 32 + kt * 16 + col) * 64 + ks * 32 + rq * 8);
#pragma unroll
        for (int j = 0; j < 4; ++j) {
            float sv[8]; float tm = -1e30f;
#pragma unroll
            for (int kt = 0; kt < 2; ++kt) { f32x4 s = mfma16(kf[kt][0], qf[j][0], z4); s = mfma16(kf[kt][1], qf[j][1], s);
#pragma unroll
                for (int e = 0; e < 4; ++e) { const int ci = st * 32 + kt * 16 + 4 * rq + e, dist = tq - (16 * ci + 31); const int dc = dist < 0 ? 0 : (dist > 128 ? 128 : dist);
                    const float v = dist >= 0 ? s[e] + bt[dc * 8 + g * 4 + j] : -1e30f; sv[kt * 4 + e] = v; tm = fmaxf(tm, v); } }
            const float mn = fmaxf(m1[j], tm); float ls = 0.f;
#pragma unroll
            for (int e = 0; e < 8; ++e) ls += sv[e] > -1e29f ? __builtin_amdgcn_exp2f(sv[e] - mn) : 0.f;
            l1[j] = l1[j] * __builtin_amdgcn_exp2f(m1[j] - mn) + ls; m1[j] = mn;
        }
    }
    float mc[4], ilc[4];
#pragma unroll
    for (int j = 0; j < 4; ++j) { const float M = quad_max(m1[j]); const float l = quad_sum(l1[j] * __builtin_amdgcn_exp2f(m1[j] - M)); mc[j] = M; ilc[j] = l > 0.f ? 1.0f / l : 0.f; }
    f32x4 ACC[4][4];
#pragma unroll
    for (int j = 0; j < 4; ++j)
#pragma unroll
        for (int dt = 0; dt < 4; ++dt) ACC[j][dt] = z4;
    {
        float lw[4], bw[4];
#pragma unroll
        for (int j = 0; j < 4; ++j) { lw[j] = 0.f; bw[j] = qn[j] * kmax_win + bmax; }
        int pstart = (t0 - 511) & ~31; pstart = pstart < 0 ? 0 : pstart;
        for (int p0 = pstart; p0 <= t0 + 15; p0 += 32) {
            bf16x8 kf[2][2], vf[4];
#pragma unroll
            for (int kt = 0; kt < 2; ++kt)
#pragma unroll
                for (int ks = 0; ks < 2; ++ks) kf[kt][ks] = ld16(KCV + (size_t)(p0 + kt * 16 + col) * 512 + 384 + g * 64 + ks * 32 + rq * 8);
#pragma unroll
            for (int dt = 0; dt < 4; ++dt) vf[dt] = ld8x2(TOUT + (size_t)(128 + g * 64 + dt * 16 + col) * S + p0 + 4 * rq, 16);
#pragma unroll
            for (int j = 0; j < 4; ++j) {
                f32x4 p[2];
#pragma unroll
                for (int kt = 0; kt < 2; ++kt) { f32x4 s = mfma16(kf[kt][0], qf[j][0], z4); s = mfma16(kf[kt][1], qf[j][1], s);
#pragma unroll
                    for (int e = 0; e < 4; ++e) { const int dist = tq - (p0 + kt * 16 + 4 * rq + e); const int dc = dist < 0 ? 0 : (dist > 128 ? 128 : dist);
                        const float v = (dist >= 0 && dist < 512) ? __builtin_amdgcn_exp2f(s[e] + bt[dc * 8 + g * 4 + j] - bw[j]) : 0.f; p[kt][e] = v; lw[j] += v; } }
                const bf16x8 pb = pack8(p[0], p[1]);
#pragma unroll
                for (int dt = 0; dt < 4; ++dt) ACC[j][dt] = mfma16(vf[dt], pb, ACC[j][dt]);
            }
        }
#pragma unroll
        for (int j = 0; j < 4; ++j) { const float sc = gwin[j] / quad_sum(lw[j]);
#pragma unroll
            for (int dt = 0; dt < 4; ++dt) ACC[j][dt] = ACC[j][dt] * sc; }
    }
    {
        float xprev = 0.f;
        for (int st = 0; st < nst; ++st) {
            bf16x8 kf[2][2], vf[4];
#pragma unroll
            for (int kt = 0; kt < 2; ++kt)
#pragma unroll
                for (int ks = 0; ks < 2; ++ks) kf[kt][ks] = ld16(KC + (size_t)(st * 32 + kt * 16 + col) * 64 + ks * 32 + rq * 8);
#pragma unroll
            for (int dt = 0; dt < 4; ++dt) vf[dt] = ld8x2(VCT + (size_t)(dt * 16 + col) * 1024 + st * 32 + 4 * rq, 16);
            f32x4 ps[2] = {z4, z4};
#pragma unroll
            for (int j = 0; j < 4; ++j) {
                f32x4 p[2];
#pragma unroll
                for (int kt = 0; kt < 2; ++kt) { f32x4 s = mfma16(kf[kt][0], qf[j][0], z4); s = mfma16(kf[kt][1], qf[j][1], s);
#pragma unroll
                    for (int e = 0; e < 4; ++e) { const int ci = st * 32 + kt * 16 + 4 * rq + e, dist = tq - (16 * ci + 31); const int dc = dist < 0 ? 0 : (dist > 128 ? 128 : dist);
                        const float v = dist >= 0 ? __builtin_amdgcn_exp2f(s[e] + bt[dc * 8 + g * 4 + j] - mc[j]) * ilc[j] : 0.f; ps[kt][e] += v; p[kt][e] = v * gcmp[j]; } }
                const bf16x8 pb = pack8(p[0], p[1]);
#pragma unroll
                for (int dt = 0; dt < 4; ++dt) ACC[j][dt] = mfma16(vf[dt], pb, ACC[j][dt]);
            }
#pragma unroll
            for (int kt = 0; kt < 2; ++kt) {
                const float Gs = (ps[kt][0] + ps[kt][1]) + (ps[kt][2] + ps[kt][3]), X = ps[kt][3];
                const float xa = __shfl(X, (lane + 48) & 63), xb = __shfl(xprev, (lane + 48) & 63);
                const float xin = rq > 0 ? xa : xb;
                wl[col * 257 + st * 8 + kt * 4 + rq] = Gs + xin; xprev = X;
            }
        }
    }
    LDS_WAIT();
    for (int i = 0; i < 16; ++i) {
        const int cur = (t0 + i) >> 6; unsigned k[4];
#pragma unroll
        for (int e = 0; e < 4; ++e) { const int n = lane * 4 + e; const float v = wl[i * 257 + n];
            k[e] = (n == 0 || (n <= cur && n + 2 > cur)) ? 0x7F000000u : (n <= cur ? __float_as_uint(v) + 1u : 0u); }
        int cnt = 0;
        for (int r = 0; r < 16; ++r) {
            const unsigned a = k[0] > k[1] ? k[0] : k[1], b = k[2] > k[3] ? k[2] : k[3], lm = a > b ? a : b; const unsigned wm = wave_max_u32(lm);
            if (wm == 0u) break;
            const unsigned long long bal = __ballot(lm == wm); const int L = __ffsll((long long)bal) - 1;
            if (lane == L) { const int e = k[0] == wm ? 0 : (k[1] == wm ? 1 : (k[2] == wm ? 2 : 3)); sel[i * 16 + cnt] = (unsigned char)(lane * 4 + e);
                if (e == 0) k[0] = 0u; else if (e == 1) k[1] = 0u; else if (e == 2) k[2] = 0u; else k[3] = 0u; }
            ++cnt;
        }
        if (lane == 0) sel[256 + i] = (unsigned char)cnt;
    }
    LDS_WAIT();
#pragma unroll
    for (int j = 0; j < 4; ++j)
#pragma unroll
        for (int dt = 0; dt < 4; ++dt) *(LAS f32x4*)(wl + col * 260 + j * 64 + dt * 16 + 4 * rq) = ACC[j][dt];
    LDS_WAIT();
    const int hj = col & 3;
    for (int i = 0; i < 16; ++i) {
        const int t = t0 + i; const int ns = __builtin_amdgcn_readfirstlane((int)sel[256 + i]);
        bf16x8 qb[2]; float s2 = 0.f;
#pragma unroll
        for (int ks = 0; ks < 2; ++ks) { v4u q = *(const v4u*)(QA + (size_t)t * 512 + (g * 4 + hj) * 64 + ks * 32 + rq * 8); if (col >= 4) q = (v4u){0u, 0u, 0u, 0u}; qb[ks] = __builtin_bit_cast(bf16x8, q);
            const float a0 = bflo(q.x), a1 = bfhi(q.x), a2 = bflo(q.y), a3 = bfhi(q.y), a4 = bflo(q.z), a5 = bfhi(q.z), a6 = bflo(q.w), a7 = bfhi(q.w);
            s2 += (a0 * a0 + a1 * a1) + (a2 * a2 + a3 * a3) + (a4 * a4 + a5 * a5) + (a6 * a6 + a7 * a7); }
        const float bs = sqrtf(quad_sum(s2)) * kmax_sel + bmax;
        f32x4 O[4] = {z4, z4, z4, z4}; float ls = 0.f;
        for (int b = 0; b < ns; ++b) {
            const int blk = __builtin_amdgcn_readfirstlane((int)sel[i * 16 + b]);
            for (int half = 0; half < 2; ++half) {
                const int p0 = blk * 64 + half * 32; if (p0 > t) break;
                bf16x8 kf[2][2], vf[4];
#pragma unroll
                for (int kt = 0; kt < 2; ++kt)
#pragma unroll
                    for (int ks = 0; ks < 2; ++ks) kf[kt][ks] = ld16(KCV + (size_t)(p0 + kt * 16 + col) * 512 + 256 + g * 64 + ks * 32 + rq * 8);
#pragma unroll
                for (int dt = 0; dt < 4; ++dt) vf[dt] = ld8x2(TOUT + (size_t)(g * 64 + dt * 16 + col) * S + p0 + 4 * rq, 16);
                f32x4 p[2];
#pragma unroll
                for (int kt = 0; kt < 2; ++kt) { f32x4 s = mfma16(kf[kt][0], qb[0], z4); s = mfma16(kf[kt][1], qb[1], s);
#pragma unroll
                    for (int e = 0; e < 4; ++e) { const int dist = t - (p0 + kt * 16 + 4 * rq + e); const int dc = dist < 0 ? 0 : (dist > 128 ? 128 : dist);
                        const float v = dist >= 0 ? __builtin_amdgcn_exp2f(s[e] + bt[dc * 8 + g * 4 + hj] - bs) : 0.f; p[kt][e] = v; ls += v; } }
                const bf16x8 pb = pack8(p[0], p[1]);
#pragma unroll
                for (int dt = 0; dt < 4; ++dt) O[dt] = mfma16(vf[dt], pb, O[dt]);
            }
        }
        const float sc = bf1(GA[(size_t)t * 32 + 8 + g * 4 + hj]) / quad_sum(ls);
        if (col < 4) {
#pragma unroll
            for (int dt = 0; dt < 4; ++dt) { const f32x4 a = *(const LAS f32x4*)(wl + i * 260 + col * 64 + dt * 16 + 4 * rq); const f32x4 o = a + O[dt] * sc;
                *(v2u*)(WSP(bf16, WS_QA) + (size_t)t * 512 + (g * 4 + col) * 64 + dt * 16 + 4 * rq) = pack4(o); }
        }
    }
    LDS_WAIT();
}
DI void p4_ret_unit(Frame& F, int u) {
    const int c = u >> 5, h = (u >> 3) & 3, q8 = u & 7, lane = F.lane, col = lane & 15, rq = lane >> 4;
    const int il = q8 * 16 + col, tq = c * 128 + il;
    const float l2g = log2f(1.0f - __builtin_amdgcn_exp2f((float)(-5 - h)));
    const bf16* QR = WSP(const bf16, WS_QR); const bf16* KR = WSP(const bf16, WS_KR); const bf16* TOUT = WSP(const bf16, WS_TOUT);
    const bf16* RT = WSP(const bf16, WS_UR) + ((size_t)(c * 4 + h) * 256) * 128;
    bf16x8 qf[4];
#pragma unroll
    for (int ks = 0; ks < 4; ++ks) qf[ks] = ld16(QR + (size_t)tq * 512 + h * 128 + ks * 32 + rq * 8);
    f32x4 ACC[16]; const f32x4 z4 = {0.f, 0.f, 0.f, 0.f};
#pragma unroll
    for (int i = 0; i < 16; ++i) ACC[i] = z4;
#pragma unroll
    for (int ks = 0; ks < 4; ++ks)
#pragma unroll
        for (int dvt = 0; dvt < 16; ++dvt) { const bf16x8 rf = ld16(RT + (size_t)(dvt * 16 + col) * 128 + ks * 32 + rq * 8); ACC[dvt] = mfma16(rf, qf[ks], ACC[dvt]); }
    { const float qd = __builtin_amdgcn_exp2f((float)(il + 1) * l2g);
#pragma unroll
      for (int i = 0; i < 16; ++i) ACC[i] = ACC[i] * qd; }
    const int nkp = (q8 * 16 + 16 + 31) >> 5;
    for (int kp = 0; kp < nkp; ++kp) {
        f32x4 p[2];
#pragma unroll
        for (int kt = 0; kt < 2; ++kt) { f32x4 s = z4;
#pragma unroll
            for (int ks = 0; ks < 4; ++ks) { const bf16x8 kf = ld16(KR + (size_t)(c * 128 + kp * 32 + kt * 16 + col) * 512 + h * 128 + ks * 32 + rq * 8); s = mfma16(kf, qf[ks], s); }
#pragma unroll
            for (int e = 0; e < 4; ++e) { const int dj = il - (kp * 32 + kt * 16 + 4 * rq + e); p[kt][e] = dj >= 0 ? s[e] * __builtin_amdgcn_exp2f((float)dj * l2g) : 0.f; } }
        const bf16x8 pb = pack8(p[0], p[1]);
#pragma unroll
        for (int dvt = 0; dvt < 16; ++dvt) { const bf16x8 vf = ld8x2(TOUT + (size_t)(768 + h * 256 + dvt * 16 + col) * S + c * 128 + kp * 32 + 4 * rq, 16); ACC[dvt] = mfma16(vf, pb, ACC[dvt]); }
    }
    float s1 = 0.f;
#pragma unroll
    for (int i = 0; i < 16; ++i) s1 += (ACC[i][0] + ACC[i][1]) + (ACC[i][2] + ACC[i][3]);
    const float mu = quad_sum(s1) * (1.0f / 256.0f); float s2 = 0.f;
#pragma unroll
    for (int i = 0; i < 16; ++i) { ACC[i] = ACC[i] - mu; s2 += (ACC[i][0] * ACC[i][0] + ACC[i][1] * ACC[i][1]) + (ACC[i][2] * ACC[i][2] + ACC[i][3] * ACC[i][3]); }
    const float rs = 1.0f / sqrtf(quad_sum(s2) * (1.0f / 256.0f) + EPS);
    bf16* GR = WSP(bf16, WS_GR) + (size_t)tq * 1024 + h * 256; const float* rn = F.A->in[10] + h * 256;
#pragma unroll
    for (int dvt = 0; dvt < 16; ++dvt) { const int d0 = dvt * 16 + 4 * rq; const v2u gv = *(const v2u*)(GR + d0); const f32x4 w = *(const f32x4*)(rn + d0);
        f32x4 o; o[0] = siluf_(bflo(gv.x)) * ACC[dvt][0] * rs * w[0]; o[1] = siluf_(bfhi(gv.x)) * ACC[dvt][1] * rs * w[1]; o[2] = siluf_(bflo(gv.y)) * ACC[dvt][2] * rs * w[2]; o[3] = siluf_(bfhi(gv.y)) * ACC[dvt][3] * rs * w[3];
        *(v2u*)(GR + d0) = pack4(o); }
}

DI int moe_row(int f) { const int fp = f & 127; return (f >> 7) * 256 + 128 * (fp >> 6) + 32 * ((fp >> 4) & 3) + 4 * ((fp >> 2) & 3) + (fp & 3); }
DI void p8_route_item(Frame& F, int item) {
    const int lane = F.lane, m0 = item * 8; const float* x1 = F.out; bf16* H2 = WSP(bf16, WS_H);
    LAS float* lg = (LAS float*)(F.lds + F.wave * WAVE_LDS);
    f32x4 hv[8][4];
    { f32x4 w[4]; load_row(F.A->in[14], lane, w);
#pragma unroll
      for (int r = 0; r < 8; ++r) { load_row(x1 + (size_t)(m0 + r) * 1024, lane, hv[r]); const float rs = row_rstd(hv[r]);
#pragma unroll
        for (int j = 0; j < 4; ++j) { hv[r][j] = hv[r][j] * rs * w[j]; *(v2u*)(H2 + (size_t)(m0 + r) * 1024 + 4 * lane + 256 * j) = pack4(hv[r][j]); } } }
    const float* WRT = WSP(const float, WS_SM + SM_WRT);
    for (int o = 0; o < 36; ++o) {
        f32x4 wv[4]; load_row(WRT + (size_t)o * 1024, lane, wv); const float bo = o < 4 ? F.A->in[16][o] : F.A->in[18][o - 4];
#pragma unroll
        for (int r = 0; r < 8; ++r) { float s = 0.f;
#pragma unroll
            for (int j = 0; j < 4; ++j) s += (hv[r][j][0] * wv[j][0] + hv[r][j][1] * wv[j][1]) + (hv[r][j][2] * wv[j][2] + hv[r][j][3] * wv[j][3]);
            s = wave_sum(s); if (lane == 0) lg[r * 36 + o] = s + bo; }
    }
    LDS_WAIT();
    if (lane < 8) {
        const LAS float* l = lg + lane * 36; const int t = m0 + lane;
        int grp = 0; float mg = l[0];
#pragma unroll
        for (int i = 1; i < 4; ++i) if (l[i] > mg) { mg = l[i]; grp = i; }
        float Z = 0.f;
#pragma unroll
        for (int i = 0; i < 4; ++i) Z += expf(l[i] - mg);
        const float pg = 1.0f / Z;
        const LAS float* le = l + 4 + grp * 8; int i1 = 0; float v1 = le[0];
#pragma unroll
        for (int i = 1; i < 8; ++i) if (le[i] > v1) { v1 = le[i]; i1 = i; }
        int i2 = -1; float v2 = -3.0e38f;
#pragma unroll
        for (int i = 0; i < 8; ++i) if (i != i1 && le[i] > v2) { v2 = le[i]; i2 = i; }
        const float e2 = expf(v2 - v1), w1 = pg / (1.0f + e2), w2 = pg * e2 / (1.0f + e2);
        const int ex1 = grp * 8 + i1, ex2 = grp * 8 + i2;
        const unsigned r1 = atomicAdd(F.ctl + CW_CNT + ex1, 1u), r2 = atomicAdd(F.ctl + CW_CNT + ex2, 1u);
        v2u* TOKR = WSP(v2u, WS_MISC);
        TOKR[t * 2 + 0] = (v2u){((unsigned)ex1 << 16) | r1, __float_as_uint(w1)};
        TOKR[t * 2 + 1] = (v2u){((unsigned)ex2 << 16) | r2, __float_as_uint(w2)};
    }
    LDS_WAIT();
}
DI void p8_moe_weights(Frame& F) {
    LAS float* scr = (LAS float*)(F.lds + F.wave * WAVE_LDS + 2048);
    bf16* WGU = WSP(bf16, WS_MOEW); bf16* WD = WGU + (size_t)32 * 512 * 1024;
    for (int it = F.gw; it < 3 * 4096; it += F.ngw) {
        const int which = it >> 12, r = it & 4095;
        if (which < 2) { const int e = r >> 7, q = r & 127, kb = q >> 3, nb = q & 7; bf16* dstb = WGU + (size_t)e * 512 * 1024 + (which ? 16 * 1024 : 0);
            tr_item((which ? F.A->in[20] : F.A->in[19]) + (size_t)e * 1024 * 256, 256, 256, 64 * kb, 32 * nb, scr, F.lane, [dstb](int n, int w2) { return w2 ? (bf16*)nullptr : dstb + (size_t)moe_row(n) * 1024; }); }
        else { const int e = r >> 7, q = r & 127, kb = q >> 5, nb = q & 31; bf16* dstb = WD + (size_t)e * 1024 * 256;
            tr_item(F.A->in[21] + (size_t)e * 256 * 1024, 1024, 1024, 64 * kb, 32 * nb, scr, F.lane, [dstb](int n, int w2) { return w2 ? (bf16*)nullptr : dstb + (size_t)n * 256; }); }
    }
}
DI void moe_tile_prefix(Frame& F) {
    LAS int* tp = (LAS int*)(F.lds + MOET_OFF);
    if (F.tid == 0) { int a = 0; for (int e = 0; e < 32; ++e) { tp[e] = a; a += (int)((__hip_atomic_load(F.ctl + CW_CNT + e, __ATOMIC_RELAXED, __HIP_MEMORY_SCOPE_AGENT) + 255u) >> 8); } tp[32] = a; }
    __syncthreads();
}
DI void p9_sort(Frame& F) {
    const LAS int* tp = (const LAS int*)(F.lds + MOET_OFF);
    const v2u* TOKR = WSP(const v2u, WS_MISC); v2u* RI = WSP(v2u, WS_MISC + 256 * 1024); const bf16* H2 = WSP(const bf16, WS_H); bf16* XS = WSP(bf16, WS_XS);
    for (int i = F.gw; i < 2 * S; i += F.ngw) {
        const v2u tr = TOKR[i]; const int e = (int)(tr.x >> 16), rank = (int)(tr.x & 0xffffu), pos = tp[e] * 256 + rank, t = i >> 1;
        const v4u* src = (const v4u*)(H2 + (size_t)t * 1024); v4u* dst = (v4u*)(XS + (size_t)pos * 1024);
        const v4u a = src[F.lane], b = src[F.lane + 64]; dst[F.lane] = a; dst[F.lane + 64] = b;
        if (F.lane == 0) RI[pos] = (v2u){(unsigned)(((i & 1) * S + t) * 1024), tr.y};
    }
    for (int idx = blockIdx.x * NTHR + F.tid; idx < 32 * 256; idx += F.G * NTHR) {
        const int e = idx >> 8, r = idx & 255; const int cnt = (int)F.ctl[CW_CNT + e]; const int pos = tp[e] * 256 + cnt + r;
        if (pos < tp[e + 1] * 256) RI[pos] = (v2u){0xffffffffu, 0u};
    }
}
DI void p12_final(Frame& F) {
    f32x4 w[4]; load_row(F.A->in[22], F.lane, w); const bf16* Y = WSP(const bf16, WS_Y);
    for (int m = F.gw; m < S; m += F.ngw) {
        f32x4 v[4]; load_row(F.out + (size_t)m * 1024, F.lane, v);
#pragma unroll
        for (int j = 0; j < 4; ++j) { const v2u a = *(const v2u*)(Y + (size_t)m * 1024 + 4 * F.lane + 256 * j), b = *(const v2u*)(Y + ((size_t)S + m) * 1024 + 4 * F.lane + 256 * j);
            v[j][0] += bflo(a.x) + bflo(b.x); v[j][1] += bfhi(a.x) + bfhi(b.x); v[j][2] += bflo(a.y) + bflo(b.y); v[j][3] += bfhi(a.y) + bfhi(b.y); }
        const float rs = row_rstd(v);
#pragma unroll
        for (int j = 0; j < 4; ++j) *(f32x4*)(F.out + (size_t)m * 1024 + 4 * F.lane + 256 * j) = v[j] * rs * w[j];
    }
}

#ifndef MK_PER_PHASE
#define MK_PER_PHASE 0
#endif
constexpr int NPH = 13;
__global__ void __launch_bounds__(NTHR, 2) mk_fwd(Args args) {
    extern __shared__ __attribute__((aligned(16))) unsigned char lds[];
    Frame F;
    F.lds = (LAS unsigned char*)lds;
    F.tid = threadIdx.x; F.lane = F.tid & 63; F.wave = __builtin_amdgcn_readfirstlane(F.tid >> 6);
    F.G = gridDim.x; F.gw = blockIdx.x * NWAVES + F.wave; F.ngw = F.G * NWAVES;
    F.ws = args.ws; F.ctl = (unsigned*)(args.ws + WS_CTL); F.out = args.out;
    F.A = &args;
    for (int u = F.tid; u < (LDS_BYTES - MISC_OFF) / 4; u += NTHR) ((LAS unsigned*)(F.lds + MISC_OFF))[u] = 0u;
    __syncthreads();
    XcdBarrier bar; bar.bar = F.ctl + CW_BAR; bar.x = 0; bar.st = nullptr;
    if (!MK_PER_PHASE) bar = xcd_barrier_post(F.ctl + CW_BAR, (volatile LAS unsigned*)(F.lds + MISC_OFF) + 8);
    const int lo = args.ph_lo, hi = args.ph_hi;
#define IN(k) (lo <= (k) && (k) < hi)
#define SEAM(k) do { if (IN(k) && IN((k) + 1)) xcd_barrier(bar); } while (0)
    LAS unsigned char* ring = F.lds;

    if (IN(0)) { p0_prologue(F); }
    SEAM(0);
    if (IN(1)) {
        pg8::Gemm g{WSP(const bf16, WS_H), WSP(const bf16, WS_WR), 0, 0, 1024}; ProjOrder O{F.G, (int)blockIdx.x};
        EpiProj E{WSP(bf16, WS_QA), WSP(bf16, WS_KCV), WSP(bf16, WS_QR), WSP(bf16, WS_KR), WSP(bf16, WS_GR), WSP(bf16, WS_GA), WSP(bf16, WS_TOUT)};
        pg8::gemm_phase<EpiProj, ProjOrder, true, true>(ring, g, O, E);
    }
    SEAM(1);
    if (IN(2)) {
        for (int u = F.gw; u < 256 + 256 + 4096; u += F.ngw) { if (u < 256) p2_cmp_hidden(F, u); else if (u < 512) p2_kmax(F, u - 256); else p2_ret_state(F, u - 512); }
    }
    SEAM(2);
    if (IN(3)) {
        p3_scan(F);
        for (int u = F.gw; u < 256; u += F.ngw) p3_kcvc(F, u);
    }
    SEAM(3);
    if (IN(4)) {
        p4_bias_table(F);
        for (int u = F.gw; u < 2048; u += F.ngw) { const int b = u >> 3, w = u & 7; p4_nsa_unit(F, w * 128 + (b >> 1), b & 1); }
        for (int u = F.gw; u < 4096; u += F.ngw) p4_ret_unit(F, u);
        __syncthreads();
    }
    SEAM(4);
    if (IN(5)) {
        pg8::Gemm g{WSP(const bf16, WS_H), WSP(const bf16, WS_WG), S, 2048, 1024}; pg8::StaticOrder O; O.init(S, 2048, F.G, (int)blockIdx.x);
        EpiGate E{WSP(bf16, WS_G)};
        pg8::gemm_phase<EpiGate, pg8::StaticOrder, true, true>(ring, g, O, E);
    }
    SEAM(5);
    if (IN(6)) {
        { pg8::Gemm g{WSP(const bf16, WS_QA), WSP(const bf16, WS_WUA), S, 1024, 512}; pg8::StaticOrder O; O.init(S, 1024, F.G, (int)blockIdx.x);
          EpiUp<false> E{WSP(const bf16, WS_G), WSP(bf16, WS_MG), 0};
          pg8::gemm_phase<EpiUp<false>, pg8::StaticOrder, true, true>(ring, g, O, E); }
        if (F.G != 256 && !MK_PER_PHASE) xcd_barrier(bar); else { VM_WAIT(); __syncthreads(); }
        { pg8::Gemm g{WSP(const bf16, WS_GR), WSP(const bf16, WS_WUB), S, 1024, 1024}; pg8::StaticOrder O; O.init(S, 1024, F.G, (int)blockIdx.x);
          EpiUp<true> E{WSP(const bf16, WS_G), WSP(bf16, WS_MG), 1024};
          pg8::gemm_phase<EpiUp<true>, pg8::StaticOrder, true, true>(ring, g, O, E); }
    }
    SEAM(6);
    if (IN(7)) {
        pg8::Gemm g{WSP(const bf16, WS_MG), WSP(const bf16, WS_WO), S, 1024, 1024}; pg8::StaticOrder O; O.init(S, 1024, F.G, (int)blockIdx.x);
        EpiOut E{F.A->in[0], F.out};
        pg8::gemm_phase<EpiOut, pg8::StaticOrder, true, true>(ring, g, O, E);
    }
    SEAM(7);
    if (IN(8)) {
        for (int it = F.gw; it < S / 8; it += F.ngw) p8_route_item(F, it);
        p8_moe_weights(F);
    }
    SEAM(8);
    if (IN(9)) { moe_tile_prefix(F); p9_sort(F); }
    SEAM(9);
    if (IN(10)) {
        moe_tile_prefix(F);
        pg8::Gemm g{WSP(const bf16, WS_XS), WSP(const bf16, WS_MOEW), 0, 0, 1024}; MoeOrder<2> O{F.G, (int)blockIdx.x, (const LAS int*)(F.lds + MOET_OFF)};
        EpiMoe1 E{WSP(bf16, WS_HID)};
        pg8::gemm_phase<EpiMoe1, MoeOrder<2>, true, true>(ring, g, O, E);
    }
    SEAM(10);
    if (IN(11)) {
        moe_tile_prefix(F);
        pg8::Gemm g{WSP(const bf16, WS_HID), WSP(const bf16, WS_MOEW) + (size_t)32 * 512 * 1024, 0, 0, 256}; MoeOrder<4> O{F.G, (int)blockIdx.x, (const LAS int*)(F.lds + MOET_OFF)};
        EpiMoe2 E{WSP(const v2u, WS_MISC + 256 * 1024), WSP(bf16, WS_Y)};
        pg8::gemm_phase<EpiMoe2, MoeOrder<4>, true, true>(ring, g, O, E);
    }
    SEAM(11);
    if (IN(12)) p12_final(F);
#undef IN
#undef SEAM
}

extern "C" void kernel_launch(void* const* d_in, const int* in_sizes, int n_in, void* d_out, int out_size, void* d_ws, size_t ws_size, hipStream_t stream) {
    static int grid = 0;
    if (grid == 0) {
        if (n_in != 23 || out_size != S * D || ws_size < WS_END) { fprintf(stderr, "kernel_launch: unexpected problem (n_in %d, out %d, ws %zu)\n", n_in, out_size, ws_size); grid = -1; return; }
        int dev = 0, cus = 0;
        if (hipGetDevice(&dev) != hipSuccess || hipDeviceGetAttribute(&cus, hipDeviceAttributeMultiprocessorCount, dev) != hipSuccess) { grid = -1; return; }
        if (hipFuncSetAttribute((const void*)mk_fwd, hipFuncAttributeMaxDynamicSharedMemorySize, LDS_BYTES) != hipSuccess) { fprintf(stderr, "kernel_launch: hipFuncSetAttribute failed\n"); grid = -1; return; }
        int per_cu = 0;
        if (hipOccupancyMaxActiveBlocksPerMultiprocessor(&per_cu, (const void*)mk_fwd, NTHR, LDS_BYTES) != hipSuccess || per_cu < 1) { fprintf(stderr, "kernel_launch: occupancy query says %d\n", per_cu); }
        (void)hipGetLastError();
        grid = cus > 0 ? cus : 256;
    }
    if (grid < 0) return;
    if (hipMemsetAsync((char*)d_ws + WS_CTL, 0, CTL_ZERO_BYTES, stream) != hipSuccess) return;
    Args a{};
    for (int i = 0; i < 23; ++i) a.in[i] = (const float*)d_in[i];
    a.out = (float*)d_out; a.ws = (unsigned char*)d_ws;
#if MK_PER_PHASE
    for (int p = 0; p < NPH; ++p) { a.ph_lo = p; a.ph_hi = p + 1; hipLaunchKernelGGL(mk_fwd, dim3(grid), dim3(NTHR), LDS_BYTES, stream, a); }
#else
    a.ph_lo = 0; a.ph_hi = NPH;
    hipLaunchKernelGGL(mk_fwd, dim3(grid), dim3(NTHR), LDS_BYTES, stream, a);
#endif
}
```

```cpp
#include <hip/hip_runtime.h>
#include <cstdio>
#include <cstdint>
namespace pg8 {
#define PG8_LAS __attribute__((address_space(3)))
typedef unsigned short bf16_t;
typedef short bf16x8 __attribute__((ext_vector_type(8)));
typedef float f32x4 __attribute__((ext_vector_type(4)));
typedef unsigned u32x4 __attribute__((ext_vector_type(4)));
constexpr int BM = 256, BK = 64, HALF = 128, HTB = HALF * BK * 2  , STAGE_BYTES = 8 * HTB, NXCD = 8, WGM = 8;

__host__ __device__ __forceinline__ int lds_byte(int r, int c) { const int st = (r >> 4) * 2 + (c >> 5), rr = r & 15, cc = c & 31, ob = rr * 64 + cc * 2; return st * 1024 + (ob ^ (((ob >> 9) & 1) << 5)); }
__host__ __device__ __forceinline__ void stage_rc(int b, int& R, int& C) { const int st = b / 1024, sb = b % 1024, swz = sb ^ (((sb >> 9) & 1) << 5); R = (st >> 1) * 16 + swz / 64; C = (st & 1) * 32 + (swz % 64) / 2; }
__host__ __device__ __forceinline__ int perm32(int rho) { const int n = rho >> 4, i = rho & 15; return 8 * (i >> 2) + 4 * n + (i & 3); }

struct Unit { int pm, pn; };
struct Gemm { const bf16_t* A; const bf16_t* Bt; int M, N, K; };

struct StaticOrder {
    int nM, nN, nwg, G, c;
    __host__ __device__ void init(int M, int N, int G_, int c_) { nM = M / BM; nN = N / BM; nwg = nM * nN; G = G_; c = c_; }
    __host__ __device__ bool next(int i, Unit& u) const {
        const long L = (long)i * G + c; if (L >= nwg) return false;
        int wgid = (int)L; { const int q = nwg / NXCD, r = nwg % NXCD, xcd = wgid % NXCD, off = wgid / NXCD; wgid = (xcd < r ? xcd * (q + 1) : r * (q + 1) + (xcd - r) * q) + off; }
        const int nig = WGM * nN, gid = wgid / nig, fm = gid * WGM, gsz = (nM - fm) < WGM ? (nM - fm) : WGM;
        u.pm = fm + ((wgid % nig) % gsz); u.pn = (wgid % nig) / gsz; return true;
    }
    __device__ __forceinline__ void a_ready(const Unit&) const {}
    __device__ __forceinline__ void done(const Unit&) const {}
};

__device__ __forceinline__ unsigned cvt_pk_bf16(float lo, float hi) { unsigned r; asm volatile("v_cvt_pk_bf16_f32 %0, %1, %2" : "=v"(r) : "v"(lo), "v"(hi)); return r; }

template <class Epi, class Sched, bool ALIGN_EPI = false, bool SP2 = false>
__device__ __forceinline__ void gemm_phase(PG8_LAS unsigned char* lds, const Gemm g, const Sched& S, const Epi& E) {
    const int tid = threadIdx.x, wid = __builtin_amdgcn_readfirstlane(tid >> 6), lane = tid & 63, wr = wid >> 2, wc = wid & 3, fr = lane & 15, fq = lane >> 4;
    const int K = g.K, nt = K / BK;
    unsigned voffA[2], voffB[2];
#pragma unroll
    for (int i = 0; i < 2; ++i) { int R, C; stage_rc(tid * 16 + i * 8192, R, C); const int Rb = Epi::PERM ? ((R & ~31) + perm32(R & 31)) : R;
        voffA[i] = (unsigned)(R * K + C) * 2u; voffB[i] = (unsigned)(Rb * K + C) * 2u; }
    const size_t kstep = (size_t)(BK * 2);
    const size_t hstep = (size_t)HALF * K * 2;
    const size_t tstep = 2 * hstep;
    const unsigned ldsw = (unsigned)wid * 1024u;
    const int aoff = lds_byte(wr * 64 + fr, fq * 8), boff = lds_byte(wc * 32 + fr, fq * 8);
#define PG8_SA(b, h) (((b) * 2 + (h)) * HTB)
#define PG8_SB(b, h) ((4 + (b) * 2 + (h)) * HTB)
#define PG8_STAGE(bufoff, gbase, voff) do { _Pragma("unroll") for (int _i = 0; _i < 2; ++_i) \
        __builtin_amdgcn_global_load_lds((const unsigned*)((const char*)(gbase) + (voff)[_i]), (PG8_LAS unsigned*)(lds + (bufoff) + ldsw + _i * 8192), 16, 0, 0); } while (0)
#define PG8_LDA(dst, b, h) do { _Pragma("unroll") for (int m = 0; m < 4; ++m) _Pragma("unroll") for (int k = 0; k < 2; ++k) dst[m][k] = *(const PG8_LAS bf16x8*)(lds + PG8_SA(b, h) + aoff + m * 2048 + k * 1024); } while (0)
#define PG8_LDB(dst, b, h) do { _Pragma("unroll") for (int n = 0; n < 2; ++n) _Pragma("unroll") for (int k = 0; k < 2; ++k) dst[n][k] = *(const PG8_LAS bf16x8*)(lds + PG8_SB(b, h) + boff + n * 2048 + k * 1024); } while (0)
#define PG8_MMA(ai, bj, At, Bt) do { __builtin_amdgcn_s_setprio(1); _Pragma("unroll") for (int m = 0; m < 4; ++m) _Pragma("unroll") for (int n = 0; n < 2; ++n) _Pragma("unroll") for (int k = 0; k < 2; ++k) \
        acc[ai][bj][m][n] = __builtin_amdgcn_mfma_f32_16x16x32_bf16(Bt[n][k], At[m][k], acc[ai][bj][m][n], 0, 0, 0); __builtin_amdgcn_s_setprio(0); } while (0)
#define PG8_WAIT_V(n) asm volatile("s_waitcnt vmcnt(" #n ")" ::: "memory")
#define PG8_WAIT_L(n) asm volatile("s_waitcnt lgkmcnt(" #n ")" ::: "memory")
#define PG8_BAR __builtin_amdgcn_s_barrier()
#define PG8_SCHED __builtin_amdgcn_sched_barrier(0)
    Unit cur, nxt; int ui = 0;
    if (!S.next(0, cur)) return;
    f32x4 acc[2][2][4][2];
#pragma unroll
    for (int a = 0; a < 2; ++a)
#pragma unroll
        for (int b = 0; b < 2; ++b)
#pragma unroll
            for (int m = 0; m < 4; ++m)
#pragma unroll
                for (int n = 0; n < 2; ++n) acc[a][b][m][n] = (f32x4){0.f, 0.f, 0.f, 0.f};
    bf16x8 At[4][2], B0[2][2], B1[2][2];
    const char* cA = (const char*)g.A + (size_t)cur.pm * tstep; const char* cB = (const char*)g.Bt + (size_t)cur.pn * tstep;
    S.a_ready(cur);
    if constexpr (SP2) {
        PG8_STAGE(PG8_SB(0, 0), cB, voffB); PG8_STAGE(PG8_SB(0, 1), cB + hstep, voffB); PG8_STAGE(PG8_SA(0, 0), cA, voffA); PG8_STAGE(PG8_SA(0, 1), cA + hstep, voffA);
        if (wr == 1) PG8_BAR;
        PG8_WAIT_V(2); PG8_BAR;
        PG8_STAGE(PG8_SB(1, 0), cB + kstep, voffB); PG8_STAGE(PG8_SA(1, 0), cA + kstep, voffA); PG8_STAGE(PG8_SB(1, 1), cB + hstep + kstep, voffB);
        PG8_WAIT_V(6); PG8_BAR;
    } else {
        PG8_STAGE(PG8_SB(0, 0), cB, voffB); PG8_STAGE(PG8_SA(0, 0), cA, voffA); PG8_STAGE(PG8_SB(0, 1), cB + hstep, voffB); PG8_STAGE(PG8_SA(0, 1), cA + hstep, voffA);
        if (wr == 1) PG8_BAR;
        PG8_WAIT_V(4); PG8_BAR;
        PG8_STAGE(PG8_SB(1, 0), cB + kstep, voffB); PG8_STAGE(PG8_SA(1, 0), cA + kstep, voffA); PG8_STAGE(PG8_SB(1, 1), cB + hstep + kstep, voffB);
        PG8_WAIT_V(6); PG8_BAR;
    }
    for (;;) {
        const bool has_next = S.next(ui + 1, nxt);
        const char* nA = has_next ? (const char*)g.A + (size_t)nxt.pm * tstep : cA; const char* nB = has_next ? (const char*)g.Bt + (size_t)nxt.pn * tstep : cB;
#pragma nounroll
        for (int t = 0; t < nt; t += 2) {
            const bool last = (t == nt - 2);
            const char* a1 = cA + (size_t)(t + 1) * kstep;
            const char* a2 = last ? nA : cA + (size_t)(t + 2) * kstep; const char* b2 = last ? nB : cB + (size_t)(t + 2) * kstep;
            const char* a3 = a2 + kstep; const char* b3 = b2 + kstep;
            if (last && has_next) S.a_ready(nxt);
            if constexpr (SP2) {
            PG8_LDB(B0, 0, 0); PG8_LDB(B1, 0, 1); PG8_SCHED; PG8_LDA(At, 0, 0); PG8_STAGE(PG8_SA(1, 1), a1 + hstep, voffA);
            PG8_WAIT_V(8); PG8_WAIT_L(0); PG8_BAR; PG8_MMA(0, 0, At, B0); PG8_MMA(0, 1, At, B1); PG8_BAR; PG8_SCHED;
            PG8_LDA(At, 0, 1); PG8_STAGE(PG8_SB(0, 0), b2, voffB); PG8_STAGE(PG8_SB(0, 1), b2 + hstep, voffB); PG8_STAGE(PG8_SA(0, 0), a2, voffA);
            PG8_WAIT_V(8); PG8_WAIT_L(0); PG8_BAR; PG8_MMA(1, 0, At, B0); PG8_MMA(1, 1, At, B1); PG8_BAR; PG8_SCHED;
            PG8_LDB(B0, 1, 0); PG8_LDB(B1, 1, 1); PG8_SCHED; PG8_LDA(At, 1, 0); PG8_STAGE(PG8_SA(0, 1), a2 + hstep, voffA);
            PG8_WAIT_V(8); PG8_WAIT_L(0); PG8_BAR; PG8_MMA(0, 0, At, B0); PG8_MMA(0, 1, At, B1); PG8_BAR; PG8_SCHED;
            PG8_LDA(At, 1, 1); PG8_STAGE(PG8_SB(1, 0), b3, voffB); PG8_STAGE(PG8_SB(1, 1), b3 + hstep, voffB); PG8_STAGE(PG8_SA(1, 0), a3, voffA);
            PG8_WAIT_V(8); PG8_WAIT_L(0); PG8_BAR; PG8_MMA(1, 0, At, B0); PG8_MMA(1, 1, At, B1); PG8_BAR; PG8_SCHED;
            } else {
            PG8_LDB(B0, 0, 0); PG8_SCHED; PG8_LDA(At, 0, 0); PG8_STAGE(PG8_SA(1, 1), a1 + hstep, voffA);
            PG8_WAIT_L(8); PG8_BAR; PG8_WAIT_L(0); PG8_MMA(0, 0, At, B0); PG8_BAR; PG8_SCHED;
            PG8_LDB(B1, 0, 1); PG8_STAGE(PG8_SB(0, 0), b2, voffB);
            PG8_BAR; PG8_WAIT_L(0); PG8_MMA(0, 1, At, B1); PG8_BAR;
            PG8_LDA(At, 0, 1); PG8_STAGE(PG8_SA(0, 0), a2, voffA);
            PG8_BAR; PG8_WAIT_L(0); PG8_MMA(1, 0, At, B0); PG8_BAR; PG8_SCHED;
            PG8_STAGE(PG8_SB(0, 1), b2 + hstep, voffB);
            PG8_WAIT_V(6); PG8_BAR; PG8_MMA(1, 1, At, B1); PG8_BAR;
            PG8_LDB(B0, 1, 0); PG8_SCHED; PG8_LDA(At, 1, 0); PG8_STAGE(PG8_SA(0, 1), a2 + hstep, voffA);
            PG8_WAIT_L(8); PG8_BAR; PG8_WAIT_L(0); PG8_MMA(0, 0, At, B0); PG8_BAR; PG8_SCHED;
            PG8_LDB(B1, 1, 1); PG8_STAGE(PG8_SB(1, 0), b3, voffB);
            PG8_BAR; PG8_WAIT_L(0); PG8_MMA(0, 1, At, B1); PG8_BAR;
            PG8_LDA(At, 1, 1); PG8_STAGE(PG8_SA(1, 0), a3, voffA);
            PG8_BAR; PG8_WAIT_L(0); PG8_MMA(1, 0, At, B0); PG8_BAR; PG8_SCHED;
            PG8_STAGE(PG8_SB(1, 1), b3 + hstep, voffB);
            PG8_WAIT_V(6); PG8_BAR; PG8_MMA(1, 1, At, B1); PG8_BAR;
            }
        }
        if constexpr (ALIGN_EPI) { if (wr == 0) PG8_BAR; }
        if constexpr (!Epi::AFTER_DRAIN) { E(acc, cur, wr, wc, fr, fq); S.done(cur); }
        if (!has_next) break;
#pragma unroll
        for (int a = 0; a < 2; ++a)
#pragma unroll
            for (int b = 0; b < 2; ++b)
#pragma unroll
                for (int m = 0; m < 4; ++m)
#pragma unroll
                    for (int n = 0; n < 2; ++n) acc[a][b][m][n] = (f32x4){0.f, 0.f, 0.f, 0.f};
        cur = nxt; cA = nA; cB = nB; ++ui;
        if constexpr (ALIGN_EPI) { if (wr == 1) PG8_BAR; }
    }
    PG8_WAIT_V(0);
    if constexpr (!ALIGN_EPI) { if (wr == 0) PG8_BAR; }
    PG8_BAR;
    if constexpr (Epi::AFTER_DRAIN) { E.fused(acc, cur, wr, wc, fr, fq, lds, wid, lane); S.done(cur); }
#undef PG8_SA
#undef PG8_SB
#undef PG8_STAGE
#undef PG8_LDA
#undef PG8_LDB
#undef PG8_MMA
#undef PG8_WAIT_V
#undef PG8_WAIT_L
#undef PG8_BAR
#undef PG8_SCHED
}
}

#define GAS __attribute__((address_space(1)))
#define LAS __attribute__((address_space(3)))
#define DI __device__ __forceinline__
typedef unsigned short bf16;
typedef unsigned v4u __attribute__((ext_vector_type(4)));
typedef unsigned v2u __attribute__((ext_vector_type(2)));
typedef float f32x4 __attribute__((ext_vector_type(4)));
typedef short bf16x8 __attribute__((ext_vector_type(8)));
typedef float f32x2_t __attribute__((ext_vector_type(2)));
typedef __bf16 bf16x2_t __attribute__((ext_vector_type(2)));
#define LDS_WAIT() asm volatile("s_waitcnt lgkmcnt(0)" ::: "memory")
#define VM_WAIT() asm volatile("s_waitcnt vmcnt(0)" ::: "memory")
DI unsigned pk2(float lo, float hi) { f32x2_t v = {lo, hi}; bf16x2_t b = __builtin_convertvector(v, bf16x2_t); return __builtin_bit_cast(unsigned, b); }
DI float bflo(unsigned u) { return __uint_as_float(u << 16); }
DI float bfhi(unsigned u) { return __uint_as_float(u & 0xffff0000u); }
DI float bf1(bf16 b) { return __uint_as_float(((unsigned)b) << 16); }
DI f32x4 mfma16(bf16x8 a, bf16x8 b, f32x4 c) { return __builtin_amdgcn_mfma_f32_16x16x32_bf16(a, b, c, 0, 0, 0); }
DI bf16x8 ld16(const bf16* p) { return *(const bf16x8*)p; }
DI bf16x8 ld8x2(const bf16* p, int off2) { const v2u a = *(const v2u*)p, b = *(const v2u*)(p + off2); v4u r = {a.x, a.y, b.x, b.y}; return __builtin_bit_cast(bf16x8, r); }
DI bf16x8 pack8(f32x4 a, f32x4 b) { v4u r = {pk2(a[0], a[1]), pk2(a[2], a[3]), pk2(b[0], b[1]), pk2(b[2], b[3])}; return __builtin_bit_cast(bf16x8, r); }
DI v2u pack4(f32x4 a) { v2u r = {pk2(a[0], a[1]), pk2(a[2], a[3])}; return r; }
DI float wave_sum(float v) {
#pragma unroll
    for (int o = 1; o < 64; o <<= 1) v += __shfl_xor(v, o);
    return v;
}
DI float quad_sum(float v) { v += __shfl_xor(v, 16); v += __shfl_xor(v, 32); return v; }
DI float quad_max(float v) { v = fmaxf(v, __shfl_xor(v, 16)); v = fmaxf(v, __shfl_xor(v, 32)); return v; }
DI unsigned wave_max_u32(unsigned v) {
#pragma unroll
    for (int o = 1; o < 64; o <<= 1) { const unsigned w = (unsigned)__shfl_xor((int)v, o); v = w > v ? w : v; }
    return v;
}
DI float sigmoidf_(float x) { return __builtin_amdgcn_rcpf(1.0f + __builtin_amdgcn_exp2f(-x * 1.4426950408889634f)); }
DI float siluf_(float x) { return x * sigmoidf_(x); }
DI float gelu_tanh(float v) { const float z = 0.7978845608028654f * (v + 0.044715f * v * v * v); const float e = __builtin_amdgcn_exp2f(2.0f * 1.4426950408889634f * z); return 0.5f * v * (2.0f - 2.0f * __builtin_amdgcn_rcpf(e + 1.0f)); }

constexpr int S = 16384, D = 1024;
constexpr int NWAVES = 8, NTHR = 512;
constexpr float EPS = 1e-6f, LOG2E = 1.4426950408889634f, QSCALE = 0.125f * 1.4426950408889634f;
constexpr size_t MiB = 1u << 20;
constexpr size_t WS_CTL = 0, CTL_ZERO_BYTES = MiB;
constexpr size_t WS_MISC = 1 * MiB;
constexpr size_t WS_WR = 2 * MiB;
constexpr size_t WS_H = WS_WR + 3328 * 2048;
constexpr size_t WS_WT = WS_H + 32 * MiB;
constexpr size_t WS_WG = 44 * MiB;
constexpr size_t WS_WC1 = 48 * MiB;
constexpr size_t WS_WUA = 50 * MiB, WS_WUB = 51 * MiB, WS_WO = 53 * MiB;
constexpr size_t WS_SM = 55 * MiB;
constexpr size_t SM_W2T = 0, SM_B1 = 64 * 1024, SM_WRT = 128 * 1024, SM_KC = 512 * 1024, SM_VCT = 768 * 1024;
constexpr size_t WS_QA = 56 * MiB, WS_GR = 72 * MiB, WS_GA = 104 * MiB, WS_KCV = 105 * MiB, WS_QR = 121 * MiB, WS_KR = 137 * MiB, WS_TOUT = 153 * MiB, WS_UR = 209 * MiB, WS_HIDC = 241 * MiB;
constexpr size_t WS_G = 105 * MiB, WS_MG = 169 * MiB;
constexpr size_t WS_MOEW = 56 * MiB;
constexpr size_t WS_HID = 104 * MiB, WS_XS = 124 * MiB, WS_Y = 124 * MiB, WS_END = 256 * MiB;
static_assert(WS_WT + 1792 * 2048 <= WS_WG && WS_HIDC + 2 * MiB <= WS_END && WS_XS + 40960ull * 2048 <= WS_END && WS_Y + 64 * MiB <= WS_END, "ws map");
constexpr int CW_BAR = 4096, CW_KMAX = 16384, CW_CNT = 16448;
constexpr int XS_ROWS = 40960;
constexpr int WAVE_LDS = 16960;
constexpr int BIAS_OFF = 157184;
constexpr int MOET_OFF = 161344;
constexpr int MISC_OFF = 161536;
constexpr int LDS_BYTES = 163840;
#define XB_TMO      128
#define XB_XCNT(j)  (256  + 64 * (j))
#define XB_XSUB(j)  (1280 + 64 * (j))
#define XB_XGEN(j)  (2304 + 64 * (j))
#define XB_TOP      3328
#define XB_TOPGEN   3392
#define XCD_BAR_WORDS 3456
#define XB_SPIN_CAP (1u << 18)

__device__ __forceinline__ unsigned xb_ld(unsigned* p)              { return __hip_atomic_load(p, __ATOMIC_RELAXED, __HIP_MEMORY_SCOPE_AGENT); }
__device__ __forceinline__ unsigned xb_add(unsigned* p, unsigned v) { return __hip_atomic_fetch_add(p, v, __ATOMIC_RELAXED, __HIP_MEMORY_SCOPE_AGENT); }
__device__ __forceinline__ unsigned xb_xcc_id() { return (unsigned)__builtin_amdgcn_s_getreg((3 << 11) | 20) & 0xFu; }
#define XB_SPIN(cond, bar) do { unsigned _sp = 0; while (cond) { __builtin_amdgcn_s_sleep(1); \
    if ((++_sp & 255u) == 0u) { if (xb_ld(&(bar)[XB_TMO])) break; if (_sp > XB_SPIN_CAP) { atomicAdd(&(bar)[XB_TMO], 1u); break; } } } } while (0)

struct XcdBarrier {
    unsigned* bar; unsigned x;
    volatile LAS unsigned* st;
};

__device__ __forceinline__ XcdBarrier xcd_barrier_post(unsigned* bar, volatile LAS unsigned* st) {
    XcdBarrier b; b.bar = bar; b.x = xb_xcc_id(); b.st = st;
    if (threadIdx.x == 0) (void)xb_add(&bar[XB_XCNT(b.x)], 1u);
    return b;
}
__device__ __forceinline__ void xcd_barrier_complete(unsigned* bar, unsigned x, unsigned& nloc, unsigned& nx) {
    const unsigned G = gridDim.x * gridDim.y * gridDim.z;
    unsigned sum, cnt, mine, sp = 0u;
    for (;;) {
        sum = 0u; cnt = 0u; mine = 0u;
#pragma unroll
        for (unsigned j = 0; j < 16; ++j) { const unsigned c = xb_ld(&bar[XB_XCNT(j)]); sum += c; cnt += (c > 0u) ? 1u : 0u; mine = (j == x) ? c : mine; }
        if (sum == G) break;
        __builtin_amdgcn_s_sleep(1);
        if ((++sp & 255u) == 0u) { if (xb_ld(&bar[XB_TMO])) break; if (sp > XB_SPIN_CAP) { atomicAdd(&bar[XB_TMO], 1u); break; } }
    }
    nloc = mine > 0u ? mine : 1u; nx = cnt > 0u ? cnt : 1u;
}

__device__ __forceinline__ void xcd_barrier(const XcdBarrier& b) {
    asm volatile("s_waitcnt vmcnt(0)" ::: "memory");
    __syncthreads();
    if (threadIdx.x == 0) {
        unsigned* bar = b.bar;
        __builtin_amdgcn_s_waitcnt(0);
        unsigned nloc = b.st[0], nx = b.st[1];
        if (nloc == 0u) { xcd_barrier_complete(bar, b.x, nloc, nx); b.st[0] = nloc; b.st[1] = nx; }
        const unsigned old = xb_add(&bar[XB_XSUB(b.x)], 1u);
        const unsigned gen = old / nloc;
        if (old + 1u == (gen + 1u) * nloc) {
            __builtin_amdgcn_fence(__ATOMIC_RELEASE, "agent");
            asm volatile("s_waitcnt vmcnt(0)" ::: "memory");
            const unsigned og = xb_add(&bar[XB_TOP], 1u);
            const unsigned tg = og / nx;
            if (og + 1u == (tg + 1u) * nx) xb_add(&bar[XB_TOPGEN], 1u);
            else XB_SPIN(xb_ld(&bar[XB_TOPGEN]) == tg, bar);
            __builtin_amdgcn_fence(__ATOMIC_ACQUIRE, "agent");
            xb_add(&bar[XB_XGEN(b.x)], 1u);
            asm volatile("s_waitcnt vmcnt(0)" ::: "memory");
        } else {
            XB_SPIN(xb_ld(&bar[XB_XGEN(b.x)]) == gen, bar);
            __builtin_amdgcn_fence(__ATOMIC_ACQUIRE, "agent");
            asm volatile("s_waitcnt vmcnt(0)" ::: "memory");
        }
    }
    __syncthreads();
}

DI void tile_map(int L, int nwg, int nM, int nN, int& pm, int& pn) {
    int wgid = L; { const int q = nwg / 8, r = nwg % 8, xcd = wgid % 8, off = wgid / 8; wgid = (xcd < r ? xcd * (q + 1) : r * (q + 1) + (xcd - r) * q) + off; }
    const int nig = 8 * nN, gid = wgid / nig, fm = gid * 8, gsz = (nM - fm) < 8 ? (nM - fm) : 8;
    pm = fm + ((wgid % nig) % gsz); pn = (wgid % nig) / gsz;
}
struct ProjOrder {
    int G, c;
    DI bool next(int i, pg8::Unit& u) const {
        const int L = i * G + c; if (L >= 1280) return false;
        if (L < 832) tile_map(L, 832, 64, 13, u.pm, u.pn);
        else { tile_map(L - 832, 448, 7, 64, u.pm, u.pn); u.pm += 64; u.pn += 13; }
        return true;
    }
    DI void a_ready(const pg8::Unit&) const {}
    DI void done(const pg8::Unit&) const {}
};
template <int NJ> struct MoeOrder {
    int G, c; const LAS int* tp;
    DI bool next(int i, pg8::Unit& u) const {
        const int L = i * G + c, tau = L / NJ, j = L % NJ; const int nt = __builtin_amdgcn_readfirstlane(tp[32]);
        if (tau >= nt) return false;
        int e = 0;
        for (int k = 1; k < 32; ++k) e += (tau >= __builtin_amdgcn_readfirstlane(tp[k])) ? 1 : 0;
        u.pm = tau; u.pn = e * NJ + j; return true;
    }
    DI void a_ready(const pg8::Unit&) const {}
    DI void done(const pg8::Unit&) const {}
};

struct EpiProj {
    static constexpr bool PERM = true, AFTER_DRAIN = false;
    bf16 *QA, *KCV, *QR, *KR, *GR, *GA, *TOUT;
    DI void operator()(const f32x4 (&acc)[2][2][4][2], const pg8::Unit& u, int wr, int wc, int fr_, int fq_) const {
        int fr = fr_, fq = fq_; asm volatile("" : "+v"(fr), "+v"(fq));
        const float L2B = 13.287712379549449f / 64.0f;
        const float INV2PI = 0.15915494309189535f;
        if (u.pm < 64) {
            const int pn = u.pn, row0 = u.pm * 256 + wr * 64 + fr;
            if (pn >= 4 && pn < 8) {
                bf16* base = pn < 6 ? QR : KR; const float sc = pn < 6 ? 1.0f : 0.08838834764831845f; const int hd0 = 2 * (pn & 1), d0 = 16 * wc + 4 * fq;
                float invr[4];
#pragma unroll
                for (int i = 0; i < 4; ++i) invr[i] = __builtin_amdgcn_exp2f(-(float)(d0 + i) * L2B) * INV2PI;
#pragma unroll
                for (int ai = 0; ai < 2; ++ai)
#pragma unroll
                    for (int m = 0; m < 4; ++m) {
                        const int tok = row0 + ai * 128 + m * 16; float cs[4], sn[4];
#pragma unroll
                        for (int i = 0; i < 4; ++i) { float rev = (float)tok * invr[i]; rev -= floorf(rev); sn[i] = __builtin_amdgcn_sinf(rev) * sc; cs[i] = __builtin_amdgcn_cosf(rev) * sc; }
#pragma unroll
                        for (int bj = 0; bj < 2; ++bj) {
                            const f32x4 x1 = acc[ai][bj][m][0], x2 = acc[ai][bj][m][1]; f32x4 o1, o2;
#pragma unroll
                            for (int i = 0; i < 4; ++i) { o1[i] = x1[i] * cs[i] - x2[i] * sn[i]; o2[i] = x1[i] * sn[i] + x2[i] * cs[i]; }
                            bf16* p = base + (size_t)tok * 512 + (hd0 + bj) * 128 + d0;
                            *(v2u*)p = pack4(o1); *(v2u*)(p + 64) = pack4(o2);
                        }
                    }
            } else if (pn == 12) {
                if (wc == 0) {
#pragma unroll
                    for (int ai = 0; ai < 2; ++ai)
#pragma unroll
                        for (int m = 0; m < 4; ++m) {
                            const int tok = row0 + ai * 128 + m * 16; f32x4 a = acc[ai][0][m][0], b = acc[ai][0][m][1];
#pragma unroll
                            for (int i = 0; i < 4; ++i) { a[i] = sigmoidf_(a[i]); b[i] = sigmoidf_(b[i]); }
                            *(bf16x8*)(GA + (size_t)tok * 32 + 8 * fq) = pack8(a, b);
                        }
                }
            } else {
                bf16* dst; int ldc, colt; float sc = 1.0f;
                if (pn < 2) { dst = QA; ldc = 512; colt = 256 * pn; sc = QSCALE; }
                else if (pn < 4) { dst = KCV; ldc = 512; colt = 256 * (pn - 2); }
                else { dst = GR; ldc = 1024; colt = 256 * (pn - 8); }
                const int col0 = colt + wc * 32 + 8 * fq;
#pragma unroll
                for (int ai = 0; ai < 2; ++ai)
#pragma unroll
                    for (int m = 0; m < 4; ++m) {
                        bf16* rowp = dst + (size_t)(row0 + ai * 128 + m * 16) * ldc + col0;
#pragma unroll
                        for (int bj = 0; bj < 2; ++bj) *(bf16x8*)(rowp + bj * 128) = pack8(acc[ai][bj][m][0] * sc, acc[ai][bj][m][1] * sc);
                    }
            }
        } else {
            const int pmp = u.pm - 64, tok0 = (u.pn - 13) * 256 + wc * 32 + 8 * fq;
            if (pmp == 1 || pmp == 2) {
                const float sc = 0.08838834764831845f;
#pragma unroll
                for (int ai = 0; ai < 2; ++ai) {
                    const int head = 2 * (pmp - 1) + ai;
#pragma unroll
                    for (int m = 0; m < 2; ++m) {
                        const int d = 32 * wr + 16 * m + fr; const float invr = __builtin_amdgcn_exp2f(-(float)d * L2B) * INV2PI;
                        bf16* p1 = TOUT + (size_t)(256 + head * 128 + d) * S;
#pragma unroll
                        for (int bj = 0; bj < 2; ++bj) {
                            f32x4 o1[2], o2[2];
#pragma unroll
                            for (int n = 0; n < 2; ++n)
#pragma unroll
                                for (int i = 0; i < 4; ++i) {
                                    const int tok = tok0 + bj * 128 + 4 * n + i; float rev = (float)tok * invr; rev -= floorf(rev);
                                    const float sn = __builtin_amdgcn_sinf(rev) * sc, cs = __builtin_amdgcn_cosf(rev) * sc;
                                    const float x1 = acc[ai][bj][m][n][i], x2 = acc[ai][bj][m + 2][n][i];
                                    o1[n][i] = x1 * cs - x2 * sn; o2[n][i] = x1 * sn + x2 * cs;
                                }
                            *(bf16x8*)(p1 + tok0 + bj * 128) = pack8(o1[0], o1[1]);
                            *(bf16x8*)(p1 + (size_t)64 * S + tok0 + bj * 128) = pack8(o2[0], o2[1]);
                        }
                    }
                }
            } else {
#pragma unroll
                for (int ai = 0; ai < 2; ++ai)
#pragma unroll
                    for (int m = 0; m < 4; ++m) {
                        bf16* rowp = TOUT + (size_t)(pmp * 256 + ai * 128 + wr * 64 + m * 16 + fr) * S + tok0;
#pragma unroll
                        for (int bj = 0; bj < 2; ++bj) *(bf16x8*)(rowp + bj * 128) = pack8(acc[ai][bj][m][0], acc[ai][bj][m][1]);
                    }
            }
        }
    }
};
struct EpiGate {
    static constexpr bool PERM = true, AFTER_DRAIN = false;
    bf16* G;
    DI void operator()(const f32x4 (&acc)[2][2][4][2], const pg8::Unit& u, int wr, int wc, int fr, int fq) const {
        const int row0 = u.pm * 256 + wr * 64 + fr, col0 = u.pn * 256 + wc * 32 + 8 * fq;
#pragma unroll
        for (int ai = 0; ai < 2; ++ai)
#pragma unroll
            for (int m = 0; m < 4; ++m) {
                bf16* rowp = G + (size_t)(row0 + ai * 128 + m * 16) * 2048 + col0;
#pragma unroll
                for (int bj = 0; bj < 2; ++bj) { f32x4 a = acc[ai][bj][m][0], b = acc[ai][bj][m][1];
#pragma unroll
                    for (int i = 0; i < 4; ++i) { a[i] = sigmoidf_(a[i]); b[i] = sigmoidf_(b[i]); }
                    *(bf16x8*)(rowp + bj * 128) = pack8(a, b); }
            }
    }
};
template <bool ADD> struct EpiUp {
    static constexpr bool PERM = true, AFTER_DRAIN = false;
    const bf16* G; bf16* MG; int goff;
    DI void operator()(const f32x4 (&acc)[2][2][4][2], const pg8::Unit& u, int wr, int wc, int fr, int fq) const {
        const int row0 = u.pm * 256 + wr * 64 + fr, col0 = u.pn * 256 + wc * 32 + 8 * fq;
#pragma unroll
        for (int ai = 0; ai < 2; ++ai)
#pragma unroll
            for (int m = 0; m < 4; ++m) {
                const size_t r = (size_t)(row0 + ai * 128 + m * 16);
#pragma unroll
                for (int bj = 0; bj < 2; ++bj) {
                    const v4u g = *(const v4u*)(G + r * 2048 + goff + col0 + bj * 128);
                    f32x4 a = acc[ai][bj][m][0], b = acc[ai][bj][m][1];
                    a[0] *= bflo(g.x); a[1] *= bfhi(g.x); a[2] *= bflo(g.y); a[3] *= bfhi(g.y); b[0] *= bflo(g.z); b[1] *= bfhi(g.z); b[2] *= bflo(g.w); b[3] *= bfhi(g.w);
                    bf16* op = MG + r * 1024 + col0 + bj * 128;
                    if (ADD) { const v4u o = *(const v4u*)op;
                        a[0] += bflo(o.x); a[1] += bfhi(o.x); a[2] += bflo(o.y); a[3] += bfhi(o.y); b[0] += bflo(o.z); b[1] += bfhi(o.z); b[2] += bflo(o.w); b[3] += bfhi(o.w); }
                    *(bf16x8*)op = pack8(a, b);
                }
            }
    }
};
struct EpiOut {
    static constexpr bool PERM = false, AFTER_DRAIN = false;
    const float* X; float* O;
    DI void operator()(const f32x4 (&acc)[2][2][4][2], const pg8::Unit& u, int wr, int wc, int fr, int fq) const {
        const int row0 = u.pm * 256 + wr * 64 + fr, col0 = u.pn * 256 + wc * 32 + 4 * fq;
#pragma unroll
        for (int ai = 0; ai < 2; ++ai)
#pragma unroll
            for (int m = 0; m < 4; ++m) {
                const size_t off = (size_t)(row0 + ai * 128 + m * 16) * 1024 + col0;
#pragma unroll
                for (int bj = 0; bj < 2; ++bj)
#pragma unroll
                    for (int n = 0; n < 2; ++n) { const size_t o = off + bj * 128 + n * 16; *(f32x4*)(O + o) = *(const f32x4*)(X + o) + acc[ai][bj][m][n]; }
            }
    }
};
struct EpiMoe1 {
    static constexpr bool PERM = false, AFTER_DRAIN = false;
    bf16* HID;
    DI void operator()(const f32x4 (&acc)[2][2][4][2], const pg8::Unit& u, int wr, int wc, int fr, int fq) const {
        const int row0 = u.pm * 256 + wr * 64 + fr, f0 = (u.pn & 1) * 128 + 16 * wc + 4 * fq;
#pragma unroll
        for (int ai = 0; ai < 2; ++ai)
#pragma unroll
            for (int m = 0; m < 4; ++m) {
                bf16* rowp = HID + (size_t)(row0 + ai * 128 + m * 16) * 256 + f0;
#pragma unroll
                for (int bj = 0; bj < 2; ++bj) { const f32x4 g = acc[ai][bj][m][0], up = acc[ai][bj][m][1]; f32x4 h;
#pragma unroll
                    for (int i = 0; i < 4; ++i) h[i] = siluf_(g[i]) * up[i];
                    *(v2u*)(rowp + bj * 64) = pack4(h); }
            }
    }
};
struct EpiMoe2 {
    static constexpr bool PERM = true, AFTER_DRAIN = false;
    const v2u* RI; bf16* Y;
    DI void operator()(const f32x4 (&acc)[2][2][4][2], const pg8::Unit& u, int wr, int wc, int fr, int fq) const {
        const int row0 = u.pm * 256 + wr * 64 + fr, col0 = (u.pn & 3) * 256 + wc * 32 + 8 * fq;
#pragma unroll
        for (int ai = 0; ai < 2; ++ai)
#pragma unroll
            for (int m = 0; m < 4; ++m) {
                const v2u ri = RI[row0 + ai * 128 + m * 16]; const float w = __uint_as_float(ri.y);
                if (ri.x != 0xffffffffu) {
                    bf16* rowp = Y + ri.x + col0;
#pragma unroll
                    for (int bj = 0; bj < 2; ++bj) *(bf16x8*)(rowp + bj * 128) = pack8(acc[ai][bj][m][0] * w, acc[ai][bj][m][1] * w);
                }
                asm volatile("" ::: "memory");
            }
    }
};

struct Args { const float* in[23]; float* out; unsigned char* ws; int ph_lo, ph_hi, li, pad; };
struct Frame {
    LAS unsigned char* lds;
    unsigned* ctl;
    int tid, lane, wave, G, gw, ngw;
    const Args* A; float* out; unsigned char* ws;
};
#define WSP(T, off) ((T*)(F.ws + (off)))

template <class DestFn>
DI void tr_item(const float* W, int ldw, int ncols, int k0, int n0, LAS float* scr, int lane, DestFn dest) {
    const int nn = n0 + (lane & 31);
#pragma unroll 8
    for (int i = 0; i < 32; ++i) { const int kk = 2 * i + (lane >> 5); scr[kk * 33 + (lane & 31)] = nn < ncols ? W[(size_t)(k0 + kk) * ldw + nn] : 0.0f; }
    LDS_WAIT(); asm volatile("" ::: "memory");
    const int c = lane & 7;
#pragma unroll
    for (int j = 0; j < 4; ++j) {
        const int nl = (lane >> 3) + 8 * j, n = n0 + nl;
        if (n < ncols) {
            const LAS float* s = scr + (8 * c) * 33 + nl;
            v4u o; o.x = pk2(s[0 * 33], s[1 * 33]); o.y = pk2(s[2 * 33], s[3 * 33]); o.z = pk2(s[4 * 33], s[5 * 33]); o.w = pk2(s[6 * 33], s[7 * 33]);
            bf16* r0 = dest(n, 0); if (r0) *(v4u*)(r0 + k0 + 8 * c) = o;
            bf16* r1 = dest(n, 1); if (r1) *(v4u*)(r1 + k0 + 8 * c) = o;
        }
    }
    LDS_WAIT(); asm volatile("" ::: "memory");
}
DI int rot_row_R(int d) { const int n = d >> 6, dd = d & 63; return 32 * (dd >> 4) + 8 * ((dd >> 2) & 3) + 4 * n + (dd & 3); }
DI int rot_row_T(int d) { const int x2 = d >> 6, dd = d & 63; return 64 * (dd >> 5) + 16 * (((dd >> 4) & 1) + 2 * x2) + (dd & 15); }
DI bf16* win_dest(unsigned char* ws, int s, int which) {
    bf16* WR = (bf16*)(ws + WS_WR); bf16* WT = (bf16*)(ws + WS_WT); bf16* WG = (bf16*)(ws + WS_WG);
    int r = -1, t = -1, g = -1;
    if (s < 512) r = s;
    else if (s < 1280) { const int sp = s - 512, j6 = sp >> 7, gd = sp & 127;
        if (j6 == 0) r = 512 + gd; else if (j6 == 1) r = 512 + 128 + gd; else if (j6 == 2) r = 512 + 256 + gd; else if (j6 == 4) r = 512 + 384 + gd;
        else if (j6 == 3) t = gd; else t = 128 + gd; }
    else if (s < 1304) r = 12 * 256 + (s - 1280);
    else if (s < 1816) { const int f = s - 1304, hh = f >> 7, d = f & 127; r = (4 + (hh >> 1)) * 256 + (hh & 1) * 128 + rot_row_R(d); }
    else if (s < 2328) { const int f = s - 1816, hh = f >> 7, d = f & 127; r = (6 + (hh >> 1)) * 256 + (hh & 1) * 128 + rot_row_R(d); t = (1 + (hh >> 1)) * 256 + (hh & 1) * 128 + rot_row_T(d); }
    else if (s < 3352) t = 768 + (s - 2328);
    else if (s < 4376) r = 8 * 256 + (s - 3352);
    else g = s - 4376;
    if (which == 0) { if (r >= 0) return WR + (size_t)r * 1024; if (t >= 0) return WT + (size_t)t * 1024; return WG + (size_t)g * 1024; }
    return (r >= 0 && t >= 0) ? WT + (size_t)t * 1024 : nullptr;
}
DI void load_row(const float* p, int lane, f32x4 (&v)[4]) {
#pragma unroll
    for (int j = 0; j < 4; ++j) v[j] = *(const f32x4*)(p + 4 * lane + 256 * j);
}
DI float row_rstd(const f32x4 (&v)[4]) {
    float s = 0.f;
#pragma unroll
    for (int j = 0; j < 4; ++j) s += (v[j][0] * v[j][0] + v[j][1] * v[j][1]) + (v[j][2] * v[j][2] + v[j][3] * v[j][3]);
    return 1.0f / sqrtf(wave_sum(s) * (1.0f / 1024.0f) + EPS);
}

DI void p0_prologue(Frame& F) {
    LAS float* scr = (LAS float*)(F.lds + F.wave * WAVE_LDS);
    const float* w_in = F.A->in[3];
    constexpr int I_IN = 16 * 201, I_C1 = 512, I_C2 = 16, I_UA = 256, I_UB = 512, I_WO = 512, NIT = I_IN + I_C1 + I_C2 + I_UA + I_UB + I_WO;
    unsigned char* ws = F.ws;
    for (int it = F.gw; it < NIT; it += F.ngw) {
        int r = it;
        if (r < I_IN) { const int kb = r / 201, nb = r % 201; tr_item(w_in, 6424, 6424, 64 * kb, 32 * nb, scr, F.lane, [ws](int n, int which) { return win_dest(ws, n, which); }); continue; } r -= I_IN;
        if (r < I_C1) { const int kind = r >> 8, q = r & 255, kb = q >> 3, nb = q & 7; bf16* dstb = (bf16*)(ws + WS_WC1) + (size_t)kind * 256 * 2048;
            tr_item(F.A->in[kind ? 8 : 5], 256, 256, 64 * kb, 32 * nb, scr, F.lane, [dstb](int n, int which) { return which ? (bf16*)nullptr : dstb + (size_t)n * 2048; }); continue; } r -= I_C1;
        if (r < I_C2) { const int kind = r >> 3, q = r & 7, kb = q >> 1, nb = q & 1; bf16* dstb = (bf16*)(ws + WS_SM + SM_W2T) + (size_t)kind * 64 * 256;
            tr_item(F.A->in[kind ? 9 : 6], 64, 64, 64 * kb, 32 * nb, scr, F.lane, [dstb](int n, int which) { return which ? (bf16*)nullptr : dstb + (size_t)n * 256; }); continue; } r -= I_C2;
        if (r < I_UA) { const int kb = r >> 5, nb = r & 31; bf16* dstb = (bf16*)(ws + WS_WUA);
            tr_item(F.A->in[11], 1024, 1024, 64 * kb, 32 * nb, scr, F.lane, [dstb](int n, int which) { return which ? (bf16*)nullptr : dstb + (size_t)n * 512; }); continue; } r -= I_UA;
        if (r < I_UB) { const int kb = r >> 5, nb = r & 31; bf16* dstb = (bf16*)(ws + WS_WUB);
            tr_item(F.A->in[12], 1024, 1024, 64 * kb, 32 * nb, scr, F.lane, [dstb](int n, int which) { return which ? (bf16*)nullptr : dstb + (size_t)n * 1024; }); continue; } r -= I_UB;
        { const int kb = r >> 5, nb = r & 31; bf16* dstb = (bf16*)(ws + WS_WO);
            tr_item(F.A->in[13], 1024, 1024, 64 * kb, 32 * nb, scr, F.lane, [dstb](int n, int which) { return which ? (bf16*)nullptr : dstb + (size_t)n * 1024; }); }
    }
    for (int o = F.gw; o < 512; o += F.ngw) {
        const int kind = o >> 8, n = o & 255; const float* pos = F.A->in[kind ? 7 : 4]; const float* w1 = F.A->in[kind ? 8 : 5]; float s = 0.f;
        for (int kk = F.lane; kk < 2048; kk += 64) s += pos[kk] * w1[(size_t)kk * 256 + n];
        s = wave_sum(s); if (F.lane == 0) ((float*)(ws + WS_SM + SM_B1))[o] = s;
    }
    { float* wrt = (float*)(ws + WS_SM + SM_WRT);
      for (int i = F.gw * 64 + F.lane; i < 36 * 1024; i += F.ngw * 64) { const int o = i >> 10, k = i & 1023; wrt[i] = o < 4 ? F.A->in[15][k * 4 + o] : F.A->in[17][k * 32 + (o - 4)]; } }
    { f32x4 w[4]; load_row(F.A->in[2], F.lane, w); bf16* H = (bf16*)(ws + WS_H);
      for (int m = F.gw; m < S; m += F.ngw) { f32x4 v[4]; load_row(F.A->in[0] + (size_t)m * 1024, F.lane, v); const float rs = row_rstd(v);
#pragma unroll
        for (int j = 0; j < 4; ++j) { const f32x4 o = v[j] * rs * w[j]; *(v2u*)(H + (size_t)m * 1024 + 4 * F.lane + 256 * j) = pack4(o); } } }
}

DI void p2_ret_state(Frame& F, int u) {
    const int c = u >> 5, h = (u >> 3) & 3, dkt = u & 7, col = F.lane & 15, kq = F.lane >> 4;
    const float l2g = log2f(1.0f - __builtin_amdgcn_exp2f((float)(-5 - h)));
    const bf16* TOUT = WSP(const bf16, WS_TOUT);
    const bf16* krow = TOUT + (size_t)(256 + h * 128 + dkt * 16 + col) * S + c * 128 + kq * 8;
    const bf16* vrow = TOUT + (size_t)(768 + h * 256 + col) * S + c * 128 + kq * 8;
    f32x4 acc[16];
#pragma unroll
    for (int i = 0; i < 16; ++i) acc[i] = (f32x4){0.f, 0.f, 0.f, 0.f};
#pragma unroll
    for (int ks = 0; ks < 4; ++ks) {
        const v4u kr = *(const v4u*)(krow + ks * 32); float kv[8] = {bflo(kr.x), bfhi(kr.x), bflo(kr.y), bfhi(kr.y), bflo(kr.z), bfhi(kr.z), bflo(kr.w), bfhi(kr.w)};
#pragma unroll
        for (int e = 0; e < 8; ++e) kv[e] *= __builtin_amdgcn_exp2f((float)(127 - (ks * 32 + kq * 8 + e)) * l2g);
        v4u ks4 = {pk2(kv[0], kv[1]), pk2(kv[2], kv[3]), pk2(kv[4], kv[5]), pk2(kv[6], kv[7])}; const bf16x8 kf = __builtin_bit_cast(bf16x8, ks4);
#pragma unroll
        for (int dvt = 0; dvt < 16; ++dvt) { const bf16x8 vf = ld16(vrow + (size_t)dvt * 16 * S + ks * 32); acc[dvt] = mfma16(kf, vf, acc[dvt]); }
    }
    bf16* UR = WSP(bf16, WS_UR) + ((size_t)(c * 4 + h) * 256) * 128;
#pragma unroll
    for (int dvt = 0; dvt < 16; ++dvt) *(v2u*)(UR + (size_t)(dvt * 16 + col) * 128 + dkt * 16 + 4 * kq) = pack4(acc[dvt]);
}
DI void p2_cmp_hidden(Frame& F, int u) {
    const int combo = u >> 6, kind = combo >> 1, g = combo & 1, rt = (u >> 1) & 31, nh = u & 1, col = F.lane & 15, kq = F.lane >> 4;
    const bf16* W1 = WSP(const bf16, WS_WC1) + (size_t)kind * 256 * 2048 + (size_t)(nh * 128 + col) * 2048 + kq * 8;
    const bf16* KCV = WSP(const bf16, WS_KCV) + kind * 128 + g * 64 + kq * 8;
    int tokb[2];
#pragma unroll
    for (int ct = 0; ct < 2; ++ct) tokb[ct] = 16 * (rt * 32 + ct * 16 + col);
    f32x4 acc[8][2];
#pragma unroll
    for (int i = 0; i < 8; ++i) { acc[i][0] = (f32x4){0.f, 0.f, 0.f, 0.f}; acc[i][1] = (f32x4){0.f, 0.f, 0.f, 0.f}; }
    for (int st = 0; st < 64; ++st) {
        const int l = st >> 1, d0 = (st & 1) * 32; bf16x8 bfr[2];
#pragma unroll
        for (int ct = 0; ct < 2; ++ct) { int tok = tokb[ct] + l; tok = tok < S ? tok : S - 1; bfr[ct] = ld16(KCV + (size_t)tok * 512 + d0); }
#pragma unroll
        for (int nt = 0; nt < 8; ++nt) { const bf16x8 af = ld16(W1 + (size_t)nt * 16 * 2048 + st * 32);
            acc[nt][0] = mfma16(af, bfr[0], acc[nt][0]); acc[nt][1] = mfma16(af, bfr[1], acc[nt][1]); }
    }
    const float* b1 = WSP(const float, WS_SM + SM_B1) + kind * 256; bf16* HC = WSP(bf16, WS_HIDC) + (size_t)combo * 1024 * 256;
#pragma unroll
    for (int nt = 0; nt < 8; ++nt) { const int n0 = nh * 128 + nt * 16 + 4 * kq; const f32x4 bb = *(const f32x4*)(b1 + n0);
#pragma unroll
        for (int ct = 0; ct < 2; ++ct) { f32x4 v = acc[nt][ct] + bb;
#pragma unroll
            for (int i = 0; i < 4; ++i) v[i] = gelu_tanh(v[i]);
            *(v2u*)(HC + (size_t)(rt * 32 + ct * 16 + col) * 256 + n0) = pack4(v); } }
}
DI void p2_kmax(Frame& F, int u) {
    const int tok = u * 64 + F.lane; const bf16* KCV = WSP(const bf16, WS_KCV) + (size_t)tok * 512 + 256;
#pragma unroll
    for (int q = 0; q < 4; ++q) { float s = 0.f;
#pragma unroll
        for (int j = 0; j < 8; ++j) { const v4u k = *(const v4u*)(KCV + q * 64 + j * 8);
            const float a0 = bflo(k.x), a1 = bfhi(k.x), a2 = bflo(k.y), a3 = bfhi(k.y), a4 = bflo(k.z), a5 = bfhi(k.z), a6 = bflo(k.w), a7 = bfhi(k.w);
            s += (a0 * a0 + a1 * a1) + (a2 * a2 + a3 * a3) + (a4 * a4 + a5 * a5) + (a6 * a6 + a7 * a7); }
        const unsigned m = wave_max_u32(__float_as_uint(s));
        if (F.lane == 0) atomicMax(F.ctl + CW_KMAX + q, m); }
}
DI void p3_scan(Frame& F) {
    const int idx = blockIdx.x * NTHR + F.tid;
    if (idx < 65536) {
        const int h = idx >> 14; const float cd = __builtin_amdgcn_exp2f(128.0f * log2f(1.0f - __builtin_amdgcn_exp2f((float)(-5 - h))));
        unsigned* UR = WSP(unsigned, WS_UR) + idx; float r0 = 0.f, r1 = 0.f;
#pragma unroll 8
        for (int c = 0; c < 128; ++c) { const unsigned u = UR[(size_t)c * 65536]; UR[(size_t)c * 65536] = pk2(r0, r1); r0 = r0 * cd + bflo(u); r1 = r1 * cd + bfhi(u); }
    }
}
DI void p3_kcvc(Frame& F, int u) {
    const int combo = u >> 6, kind = combo >> 1, g = combo & 1, rt = u & 63, col = F.lane & 15, kq = F.lane >> 4;
    const bf16* HC = WSP(const bf16, WS_HIDC) + (size_t)combo * 1024 * 256 + (size_t)(rt * 16 + col) * 256 + kq * 8;
    const bf16* W2 = WSP(const bf16, WS_SM + SM_W2T) + (size_t)kind * 64 * 256 + (size_t)col * 256 + kq * 8;
    f32x4 acc[4];
#pragma unroll
    for (int i = 0; i < 4; ++i) acc[i] = (f32x4){0.f, 0.f, 0.f, 0.f};
#pragma unroll
    for (int ks = 0; ks < 8; ++ks) { const bf16x8 hf = ld16(HC + ks * 32);
#pragma unroll
        for (int dt = 0; dt < 4; ++dt) { const bf16x8 wf = ld16(W2 + (size_t)dt * 16 * 256 + ks * 32); acc[dt] = kind ? mfma16(hf, wf, acc[dt]) : mfma16(wf, hf, acc[dt]); } }
    if (kind == 0) { bf16* KC = WSP(bf16, WS_SM + SM_KC) + (size_t)g * 1024 * 64;
#pragma unroll
        for (int dt = 0; dt < 4; ++dt) *(v2u*)(KC + (size_t)(rt * 16 + col) * 64 + dt * 16 + 4 * kq) = pack4(acc[dt]); }
    else { bf16* VCT = WSP(bf16, WS_SM + SM_VCT) + (size_t)g * 64 * 1024;
#pragma unroll
        for (int dt = 0; dt < 4; ++dt) *(v2u*)(VCT + (size_t)(dt * 16 + col) * 1024 + rt * 16 + 4 * kq) = pack4(acc[dt]); }
}

DI void p4_bias_table(Frame& F) {
    LAS float* bt = (LAS float*)(F.lds + BIAS_OFF); const float* rb = F.A->in[1];
    for (int i = F.tid; i < 129 * 8; i += NTHR) { const int dist = i >> 3, hd = i & 7; int b = dist;
        if (dist >= 16) { b = 16 + (int)(logf((float)dist / 16.0f) / 2.0794415416798357f * 16.0f); b = b < 31 ? b : 31; }
        bt[i] = rb[b * 8 + hd] * LOG2E; }
    __syncthreads();
    if (F.tid < 64) { float m = 0.f; for (int i = F.tid; i < 129 * 8; i += 64) m = fmaxf(m, fabsf(bt[i]));
#pragma unroll
        for (int o = 1; o < 64; o <<= 1) m = fmaxf(m, __shfl_xor(m, o));
        if (F.tid == 0) bt[129 * 8] = m; }
    __syncthreads();
}
DI void p4a_unit(Frame& F, int qt, int g) {
    const int lane = F.lane, col = lane & 15, rq = lane >> 4, t0 = qt * 16, tq = t0 + col;
    LAS float* wl = (LAS float*)(F.lds + F.wave * WAVE_LDS);
    const LAS float* bt = (const LAS float*)(F.lds + BIAS_OFF);
    const float bmax = bt[129 * 8];
    const bf16* QA = WSP(const bf16, WS_QA); const bf16* KCV = WSP(const bf16, WS_KCV); const bf16* TOUT = WSP(const bf16, WS_TOUT); const bf16* GA = WSP(const bf16, WS_GA);
    const bf16* KC = WSP(const bf16, WS_SM + SM_KC) + (size_t)g * 1024 * 64; const bf16* VCT = WSP(const bf16, WS_SM + SM_VCT) + (size_t)g * 64 * 1024;
    const float kmax_sel = sqrtf(__uint_as_float(F.ctl[CW_KMAX + g])), kmax_win = sqrtf(__uint_as_float(F.ctl[CW_KMAX + 2 + g]));
    bf16x8 qf[4][2]; float qn[4];
#pragma unroll
    for (int j = 0; j < 4; ++j) { float s = 0.f;
#pragma unroll
        for (int ks = 0; ks < 2; ++ks) { const v4u q = *(const v4u*)(QA + (size_t)tq * 512 + (g * 4 + j) * 64 + ks * 32 + rq * 8); qf[j][ks] = __builtin_bit_cast(bf16x8, q);
            const float a0 = bflo(q.x), a1 = bfhi(q.x), a2 = bflo(q.y), a3 = bfhi(q.y), a4 = bflo(q.z), a5 = bfhi(q.z), a6 = bflo(q.w), a7 = bfhi(q.w);
            s += (a0 * a0 + a1 * a1) + (a2 * a2 + a3 * a3) + (a4 * a4 + a5 * a5) + (a6 * a6 + a7 * a7); }
        qn[j] = sqrtf(quad_sum(s)); }
    const f32x4 z4 = {0.f, 0.f, 0.f, 0.f};
    f32x4 ACC[4][4];
#pragma unroll
    for (int j = 0; j < 4; ++j)
#pragma unroll
        for (int dt = 0; dt < 4; ++dt) ACC[j][dt] = z4;
    {
        float lw[4], bw[4];
#pragma unroll
        for (int j = 0; j < 4; ++j) { lw[j] = 0.f; bw[j] = qn[j] * kmax_win + bmax; }
        int pstart = (t0 - 511) & ~31; pstart = pstart < 0 ? 0 : pstart;
        for (int p0 = pstart; p0 <= t0 + 15; p0 += 32) {
            bf16x8 kf[2][2], vf[4];
#pragma unroll
            for (int kt = 0; kt < 2; ++kt)
#pragma unroll
                for (int ks = 0; ks < 2; ++ks) kf[kt][ks] = ld16(KCV + (size_t)(p0 + kt * 16 + col) * 512 + 384 + g * 64 + ks * 32 + rq * 8);
#pragma unroll
            for (int dt = 0; dt < 4; ++dt) vf[dt] = ld8x2(TOUT + (size_t)(128 + g * 64 + dt * 16 + col) * S + p0 + 4 * rq, 16);
#pragma unroll
            for (int j = 0; j < 4; ++j) {
                f32x4 p[2];
#pragma unroll
                for (int kt = 0; kt < 2; ++kt) { f32x4 s = mfma16(kf[kt][0], qf[j][0], z4); s = mfma16(kf[kt][1], qf[j][1], s);
#pragma unroll
                    for (int e = 0; e < 4; ++e) { const int dist = tq - (p0 + kt * 16 + 4 * rq + e); const int dc = dist < 0 ? 0 : (dist > 128 ? 128 : dist);
                        const float v = (dist >= 0 && dist < 512) ? __builtin_amdgcn_exp2f(s[e] + bt[dc * 8 + g * 4 + j] - bw[j]) : 0.f; p[kt][e] = v; lw[j] += v; } }
                const bf16x8 pb = pack8(p[0], p[1]);
#pragma unroll
                for (int dt = 0; dt < 4; ++dt) ACC[j][dt] = mfma16(vf[dt], pb, ACC[j][dt]);
            }
        }
#pragma unroll
        for (int j = 0; j < 4; ++j) { const float sc = bf1(GA[(size_t)tq * 32 + 16 + g * 4 + j]) / quad_sum(lw[j]);
#pragma unroll
            for (int dt = 0; dt < 4; ++dt) ACC[j][dt] = ACC[j][dt] * sc; }
    }
    const int nkc = qt < 1023 ? qt : 1023, nst = (nkc + 31) >> 5;
    float m1[4], l1[4];
#pragma unroll
    for (int j = 0; j < 4; ++j) { m1[j] = -1e30f; l1[j] = 0.f; }
    for (int st = 0; st < nst; ++st) {
        bf16x8 kf[2][2];
#pragma unroll
        for (int kt = 0; kt < 2; ++kt)
#pragma unroll
            for (int ks = 0; ks < 2; ++ks) kf[kt][ks] = ld16(KC + (size_t)(st * 32 + kt * 16 + col) * 64 + ks * 32 + rq * 8);
#pragma unroll
        for (int j = 0; j < 4; ++j) {
            float sv[8]; float tm = -1e30f;
#pragma unroll
            for (int kt = 0; kt < 2; ++kt) { f32x4 s = mfma16(kf[kt][0], qf[j][0], z4); s = mfma16(kf[kt][1], qf[j][1], s);
#pragma unroll
                for (int e = 0; e < 4; ++e) { const int ci = st * 32 + kt * 16 + 4 * rq + e, dist = tq - (16 * ci + 31); const int dc = dist < 0 ? 0 : (dist > 128 ? 128 : dist);
                    const float v = dist >= 0 ? s[e] + bt[dc * 8 + g * 4 + j] : -1e30f; sv[kt * 4 + e] = v; tm = fmaxf(tm, v); } }
            const float mn = fmaxf(m1[j], tm); float ls = 0.f;
#pragma unroll
            for (int e = 0; e < 8; ++e) ls += sv[e] > -1e29f ? __builtin_amdgcn_exp2f(sv[e] - mn) : 0.f;
            l1[j] = l1[j] * __builtin_amdgcn_exp2f(m1[j] - mn) + ls; m1[j] = mn;
        }
    }
    float mc[4], ilc[4];
#pragma unroll
    for (int j = 0; j < 4; ++j) { const float M = quad_max(m1[j]); const float l = quad_sum(l1[j] * __builtin_amdgcn_exp2f(m1[j] - M)); mc[j] = M; ilc[j] = l > 0.f ? 1.0f / l : 0.f; }
    {
        float gcmp[4];
#pragma unroll
        for (int j = 0; j < 4; ++j) gcmp[j] = bf1(GA[(size_t)tq * 32 + g * 4 + j]);
        float xprev = 0.f;
        for (int st = 0; st < nst; ++st) {
            bf16x8 kf[2][2], vf[4];
#pragma unroll
            for (int kt = 0; kt < 2; ++kt)
#pragma unroll
                for (int ks = 0; ks < 2; ++ks) kf[kt][ks] = ld16(KC + (size_t)(st * 32 + kt * 16 + col) * 64 + ks * 32 + rq * 8);
#pragma unroll
            for (int dt = 0; dt < 4; ++dt) vf[dt] = ld8x2(VCT + (size_t)(dt * 16 + col) * 1024 + st * 32 + 4 * rq, 16);
            f32x4 ps[2] = {z4, z4};
#pragma unroll
            for (int j = 0; j < 4; ++j) {
                f32x4 p[2];
#pragma unroll
                for (int kt = 0; kt < 2; ++kt) { f32x4 s = mfma16(kf[kt][0], qf[j][0], z4); s = mfma16(kf[kt][1], qf[j][1], s);
#pragma unroll
                    for (int e = 0; e < 4; ++e) { const int ci = st * 32 + kt * 16 + 4 * rq + e, dist = tq - (16 * ci + 31); const int dc = dist < 0 ? 0 : (dist > 128 ? 128 : dist);
                        const float v = dist >= 0 ? __builtin_amdgcn_exp2f(s[e] + bt[dc * 8 + g * 4 + j] - mc[j]) * ilc[j] : 0.f; ps[kt][e] += v; p[kt][e] = v * gcmp[j]; } }
                const bf16x8 pb = pack8(p[0], p[1]);
#pragma unroll
                for (int dt = 0; dt < 4; ++dt) ACC[j][dt] = mfma16(vf[dt], pb, ACC[j][dt]);
            }
#pragma unroll
            for (int kt = 0; kt < 2; ++kt) {
                const float Gs = (ps[kt][0] + ps[kt][1]) + (ps[kt][2] + ps[kt][3]), X = ps[kt][3];
                const float xa = __shfl(X, (lane + 48) & 63), xb = __shfl(xprev, (lane + 48) & 63);
                const float xin = rq > 0 ? xa : xb;
                wl[col * 257 + st * 8 + kt * 4 + rq] = Gs + xin; xprev = X;
            }
        }
    }
    float* PART = F.out + (size_t)tq * 512 + g * 256;
#pragma unroll
    for (int j = 0; j < 4; ++j)
#pragma unroll
        for (int dt = 0; dt < 4; ++dt) *(f32x4*)(PART + j * 64 + dt * 16 + 4 * rq) = ACC[j][dt];
    LDS_WAIT();
    unsigned long long* SELM = (unsigned long long*)((unsigned char*)F.out + (size_t)32 * MiB);
    for (int i = 0; i < 16; ++i) {
        const int cur = (t0 + i) >> 6; unsigned k[4];
#pragma unroll
        for (int e = 0; e < 4; ++e) { const int n = lane * 4 + e; const float v = wl[i * 257 + n];
            k[e] = (n == 0 || (n <= cur && n + 2 > cur)) ? 0x7F000000u : (n <= cur ? __float_as_uint(v) + 1u : 0u); }
        unsigned T = 0u;
#pragma unroll 1
        for (int bit = 30; bit >= 0; --bit) { const unsigned c = T | (1u << bit);
            const int cnt = __popcll(__ballot(k[0] >= c)) + __popcll(__ballot(k[1] >= c)) + __popcll(__ballot(k[2] >= c)) + __popcll(__ballot(k[3] >= c));
            if (cnt >= 16) T = c; }
        unsigned long long bsel[4]; int ngt = 0;
#pragma unroll
        for (int e = 0; e < 4; ++e) { bsel[e] = __ballot(k[e] > T && k[e] != 0u); ngt += __popcll(bsel[e]); }
        if (T != 0u) {
            int need = 16 - ngt;
            unsigned long long beq[4];
#pragma unroll
            for (int e = 0; e < 4; ++e) beq[e] = __ballot(k[e] == T);
            while (need > 0) {
                int bestn = 1 << 30, be = 0;
#pragma unroll
                for (int e = 0; e < 4; ++e) if (beq[e]) { const int n = 4 * (__ffsll((long long)beq[e]) - 1) + e; if (n < bestn) { bestn = n; be = e; } }
                if (bestn == (1 << 30)) break;
                const unsigned long long bitm = 1ull << (bestn >> 2);
                if (be == 0) { bsel[0] |= bitm; beq[0] &= ~bitm; } else if (be == 1) { bsel[1] |= bitm; beq[1] &= ~bitm; } else if (be == 2) { bsel[2] |= bitm; beq[2] &= ~bitm; } else { bsel[3] |= bitm; beq[3] &= ~bitm; }
                --need;
            }
        }
        if (lane < 4) SELM[((size_t)(t0 + i) * 2 + g) * 4 + lane] = lane == 0 ? bsel[0] : (lane == 1 ? bsel[1] : (lane == 2 ? bsel[2] : bsel[3]));
    }
    LDS_WAIT();
}
constexpr int B_NSLOT = 9;
DI void p4b_pass(LAS unsigned char* ldsb, unsigned char* ws, float* outp, int tile, int g) {
    Frame F; F.lds = ldsb; F.ws = ws; F.out = outp; F.ctl = (unsigned*)(ws + WS_CTL); F.tid = threadIdx.x; F.lane = F.tid & 63; F.wave = __builtin_amdgcn_readfirstlane(F.tid >> 6); F.G = gridDim.x; F.gw = 0; F.ngw = 0; F.A = nullptr;
    const int lane = F.lane, w = F.wave, col = lane & 15, rq = lane >> 4, T0 = tile * 64, cur = tile, hj = col & 3;
    LAS unsigned char* L = F.lds;
    const LAS float* bt = (const LAS float*)(L + BIAS_OFF); const float bmax = bt[129 * 8];
    const bf16* QA = WSP(const bf16, WS_QA); const bf16* KCV = WSP(const bf16, WS_KCV); const bf16* TOUT = WSP(const bf16, WS_TOUT); const bf16* GA = WSP(const bf16, WS_GA);
    const float kmax_sel = sqrtf(__uint_as_float(F.ctl[CW_KMAX + g]));
    const unsigned long long* SELM = (const unsigned long long*)((const unsigned char*)F.out + (size_t)32 * MiB);
    bf16x8 qb[2][2]; float bnd[2]; unsigned long long pk[2][4]; int tq[2];
#pragma unroll
    for (int ct = 0; ct < 2; ++ct) { const int t = T0 + w * 8 + ct * 4 + (col >> 2); tq[ct] = t; float s = 0.f;
#pragma unroll
        for (int ks = 0; ks < 2; ++ks) { const v4u q = *(const v4u*)(QA + (size_t)t * 512 + (g * 4 + hj) * 64 + ks * 32 + rq * 8); qb[ct][ks] = __builtin_bit_cast(bf16x8, q);
            const float a0 = bflo(q.x), a1 = bfhi(q.x), a2 = bflo(q.y), a3 = bfhi(q.y), a4 = bflo(q.z), a5 = bfhi(q.z), a6 = bflo(q.w), a7 = bfhi(q.w);
            s += (a0 * a0 + a1 * a1) + (a2 * a2 + a3 * a3) + (a4 * a4 + a5 * a5) + (a6 * a6 + a7 * a7); }
        bnd[ct] = sqrtf(quad_sum(s)) * kmax_sel + bmax;
#pragma unroll
        for (int e = 0; e < 4; ++e) pk[ct][e] = SELM[((size_t)t * 2 + g) * 4 + e]; }
    const f32x4 z4 = {0.f, 0.f, 0.f, 0.f};
    f32x4 O[2][4]; float ls[2] = {0.f, 0.f};
#pragma unroll
    for (int ct = 0; ct < 2; ++ct)
#pragma unroll
        for (int dt = 0; dt < 4; ++dt) O[ct][dt] = z4;
    const float bfar = bt[128 * 8 + g * 4 + hj];
    const int dr = lane >> 3, dc = (lane & 7) ^ dr, nb = cur + 1;
    const bf16* kbase = KCV + (size_t)(w * 8 + dr) * 512 + 256 + g * 64 + dc * 8;
    const bf16* vbase = TOUT + (size_t)(g * 64 + w * 8 + dr) * S + dc * 8;
#define P4B_ISSUE(blk_, slot) do { \
        __builtin_amdgcn_global_load_lds((const unsigned*)(kbase + (size_t)(blk_) * 64 * 512), (LAS unsigned*)(L + (slot) * 16384 + w * 1024), 16, 0, 0); \
        __builtin_amdgcn_global_load_lds((const unsigned*)(vbase + (size_t)(blk_) * 64), (LAS unsigned*)(L + (slot) * 16384 + 8192 + w * 1024), 16, 0, 0); } while (0)
    asm volatile("s_waitcnt vmcnt(0)" ::: "memory");
    __builtin_amdgcn_s_barrier();
#pragma unroll 1
    for (int i = 0; i < B_NSLOT - 1 && i < nb; ++i) P4B_ISSUE(i, i);
#pragma unroll 1
    for (int i = 0; i < nb; ++i) {
        const int rem = nb - 1 - i;
        if (rem >= 7) asm volatile("s_waitcnt vmcnt(14)" ::: "memory"); else if (rem == 6) asm volatile("s_waitcnt vmcnt(12)" ::: "memory"); else if (rem == 5) asm volatile("s_waitcnt vmcnt(10)" ::: "memory");
        else if (rem == 4) asm volatile("s_waitcnt vmcnt(8)" ::: "memory"); else if (rem == 3) asm volatile("s_waitcnt vmcnt(6)" ::: "memory"); else if (rem == 2) asm volatile("s_waitcnt vmcnt(4)" ::: "memory");
        else if (rem == 1) asm volatile("s_waitcnt vmcnt(2)" ::: "memory"); else asm volatile("s_waitcnt vmcnt(0)" ::: "memory");
        asm volatile("s_waitcnt lgkmcnt(0)" ::: "memory"); __builtin_amdgcn_s_barrier(); asm volatile("" ::: "memory");
        if (i + B_NSLOT - 1 < nb) P4B_ISSUE(i + B_NSLOT - 1, (i + B_NSLOT - 1) % B_NSLOT);
        const int blk = i; const LAS unsigned char* ring = L + (i % B_NSLOT) * 16384;
        const int eb = blk & 3, Lb = blk >> 2;
#pragma unroll
        for (int ct = 0; ct < 2; ++ct) {
            const unsigned long long word = eb == 0 ? pk[ct][0] : (eb == 1 ? pk[ct][1] : (eb == 2 ? pk[ct][2] : pk[ct][3]));
            const bool pick = (word >> Lb) & 1ull;
            if (__ballot(pick) == 0ull) continue;
            f32x4 sacc[4];
#pragma unroll
            for (int kt = 0; kt < 4; ++kt) { const int key = kt * 16 + col;
                const bf16x8 k0 = *(const LAS bf16x8*)(ring + key * 128 + ((rq ^ (key & 7)) * 16)), k1 = *(const LAS bf16x8*)(ring + key * 128 + (((4 + rq) ^ (key & 7)) * 16));
                sacc[kt] = mfma16(k0, qb[ct][0], z4); sacc[kt] = mfma16(k1, qb[ct][1], sacc[kt]); }
            float lsum = 0.f;
            if (blk + 3 <= cur) {
                const float bb = bfar - bnd[ct];
#pragma unroll
                for (int kt = 0; kt < 4; ++kt)
#pragma unroll
                    for (int e = 0; e < 4; ++e) { const float v = pick ? __builtin_amdgcn_exp2f(sacc[kt][e] + bb) : 0.f; sacc[kt][e] = v; lsum += v; }
            } else {
#pragma unroll
                for (int kt = 0; kt < 4; ++kt)
#pragma unroll
                    for (int e = 0; e < 4; ++e) { const int dist = tq[ct] - (blk * 64 + kt * 16 + 4 * rq + e); const int dcl = dist < 0 ? 0 : (dist > 128 ? 128 : dist);
                        const float v = (pick && dist >= 0) ? __builtin_amdgcn_exp2f(sacc[kt][e] + bt[dcl * 8 + g * 4 + hj] - bnd[ct]) : 0.f; sacc[kt][e] = v; lsum += v; }
            }
            ls[ct] += lsum;
            const bf16x8 pb0 = pack8(sacc[0], sacc[1]), pb1 = pack8(sacc[2], sacc[3]);
#pragma unroll
            for (int dt = 0; dt < 4; ++dt) { const int d = dt * 16 + col; const LAS unsigned char* vr = ring + 8192 + d * 128 + (rq & 1) * 8; const int sw = d & 7, c0 = rq >> 1;
                const v2u a0 = *(const LAS v2u*)(vr + ((c0 ^ sw) * 16)), a1 = *(const LAS v2u*)(vr + (((c0 + 2) ^ sw) * 16)), a2 = *(const LAS v2u*)(vr + (((c0 + 4) ^ sw) * 16)), a3 = *(const LAS v2u*)(vr + (((c0 + 6) ^ sw) * 16));
                v4u v0 = {a0.x, a0.y, a1.x, a1.y}, v1 = {a2.x, a2.y, a3.x, a3.y};
                O[ct][dt] = mfma16(__builtin_bit_cast(bf16x8, v0), pb0, O[ct][dt]); O[ct][dt] = mfma16(__builtin_bit_cast(bf16x8, v1), pb1, O[ct][dt]); }
        }
    }
#pragma unroll
    for (int ct = 0; ct < 2; ++ct) { const int t = tq[ct]; const float sc = bf1(GA[(size_t)t * 32 + 8 + g * 4 + hj]) / quad_sum(ls[ct]);
        const float* part = F.out + (size_t)t * 512 + g * 256 + hj * 64; bf16* ya = WSP(bf16, WS_QA) + (size_t)t * 512 + (g * 4 + hj) * 64;
#pragma unroll
        for (int dt = 0; dt < 4; ++dt) { const f32x4 p = *(const f32x4*)(part + dt * 16 + 4 * rq); const f32x4 o = p + O[ct][dt] * sc; *(v2u*)(ya + dt * 16 + 4 * rq) = pack4(o); } }
    asm volatile("s_waitcnt vmcnt(0) lgkmcnt(0)" ::: "memory");
#undef P4B_ISSUE
}
DI void p4_ret_unit(Frame& F, int u) {
    const int c = u >> 5, h = (u >> 3) & 3, q8 = u & 7, lane = F.lane, col = lane & 15, rq = lane >> 4;
    const int il = q8 * 16 + col, tq = c * 128 + il;
    const float l2g = log2f(1.0f - __builtin_amdgcn_exp2f((float)(-5 - h)));
    const bf16* QR = WSP(const bf16, WS_QR); const bf16* KR = WSP(const bf16, WS_KR); const bf16* TOUT = WSP(const bf16, WS_TOUT);
    const bf16* RT = WSP(const bf16, WS_UR) + ((size_t)(c * 4 + h) * 256) * 128;
    bf16x8 qf[4];
#pragma unroll
    for (int ks = 0; ks < 4; ++ks) qf[ks] = ld16(QR + (size_t)tq * 512 + h * 128 + ks * 32 + rq * 8);
    f32x4 ACC[16]; const f32x4 z4 = {0.f, 0.f, 0.f, 0.f};
#pragma unroll
    for (int i = 0; i < 16; ++i) ACC[i] = z4;
#pragma unroll
    for (int ks = 0; ks < 4; ++ks)
#pragma unroll
        for (int dvt = 0; dvt < 16; ++dvt) { const bf16x8 rf = ld16(RT + (size_t)(dvt * 16 + col) * 128 + ks * 32 + rq * 8); ACC[dvt] = mfma16(rf, qf[ks], ACC[dvt]); }
    { const float qd = __builtin_amdgcn_exp2f((float)(il + 1) * l2g);
#pragma unroll
      for (int i = 0; i < 16; ++i) ACC[i] = ACC[i] * qd; }
    const int nkp = (q8 * 16 + 16 + 31) >> 5;
    for (int kp = 0; kp < nkp; ++kp) {
        f32x4 p[2];
#pragma unroll
        for (int kt = 0; kt < 2; ++kt) { f32x4 s = z4;
#pragma unroll
            for (int ks = 0; ks < 4; ++ks) { const bf16x8 kf = ld16(KR + (size_t)(c * 128 + kp * 32 + kt * 16 + col) * 512 + h * 128 + ks * 32 + rq * 8); s = mfma16(kf, qf[ks], s); }
#pragma unroll
            for (int e = 0; e < 4; ++e) { const int dj = il - (kp * 32 + kt * 16 + 4 * rq + e); p[kt][e] = dj >= 0 ? s[e] * __builtin_amdgcn_exp2f((float)dj * l2g) : 0.f; } }
        const bf16x8 pb = pack8(p[0], p[1]);
#pragma unroll
        for (int dvt = 0; dvt < 16; ++dvt) { const bf16x8 vf = ld8x2(TOUT + (size_t)(768 + h * 256 + dvt * 16 + col) * S + c * 128 + kp * 32 + 4 * rq, 16); ACC[dvt] = mfma16(vf, pb, ACC[dvt]); }
    }
    float s1 = 0.f;
#pragma unroll
    for (int i = 0; i < 16; ++i) s1 += (ACC[i][0] + ACC[i][1]) + (ACC[i][2] + ACC[i][3]);
    const float mu = quad_sum(s1) * (1.0f / 256.0f); float s2 = 0.f;
#pragma unroll
    for (int i = 0; i < 16; ++i) { ACC[i] = ACC[i] - mu; s2 += (ACC[i][0] * ACC[i][0] + ACC[i][1] * ACC[i][1]) + (ACC[i][2] * ACC[i][2] + ACC[i][3] * ACC[i][3]); }
    const float rs = 1.0f / sqrtf(quad_sum(s2) * (1.0f / 256.0f) + EPS);
    bf16* GR = WSP(bf16, WS_GR) + (size_t)tq * 1024 + h * 256; const float* rn = F.A->in[10] + h * 256;
#pragma unroll
    for (int dvt = 0; dvt < 16; ++dvt) { const int d0 = dvt * 16 + 4 * rq; const v2u gv = *(const v2u*)(GR + d0); const f32x4 w = *(const f32x4*)(rn + d0);
        f32x4 o; o[0] = siluf_(bflo(gv.x)) * ACC[dvt][0] * rs * w[0]; o[1] = siluf_(bfhi(gv.x)) * ACC[dvt][1] * rs * w[1]; o[2] = siluf_(bflo(gv.y)) * ACC[dvt][2] * rs * w[2]; o[3] = siluf_(bfhi(gv.y)) * ACC[dvt][3] * rs * w[3];
        *(v2u*)(GR + d0) = pack4(o); }
}

DI int moe_row(int f) { const int fp = f & 127; return (f >> 7) * 256 + 128 * (fp >> 6) + 32 * ((fp >> 4) & 3) + 4 * ((fp >> 2) & 3) + (fp & 3); }
DI void p8_route_item(Frame& F, int item) {
    const int lane = F.lane, m0 = item * 8; const float* x1 = F.out; bf16* H2 = WSP(bf16, WS_H);
    LAS float* lg = (LAS float*)(F.lds + F.wave * WAVE_LDS);
    f32x4 hv[8][4];
    { f32x4 w[4]; load_row(F.A->in[14], lane, w);
#pragma unroll
      for (int r = 0; r < 8; ++r) { load_row(x1 + (size_t)(m0 + r) * 1024, lane, hv[r]); const float rs = row_rstd(hv[r]);
#pragma unroll
        for (int j = 0; j < 4; ++j) { hv[r][j] = hv[r][j] * rs * w[j]; *(v2u*)(H2 + (size_t)(m0 + r) * 1024 + 4 * lane + 256 * j) = pack4(hv[r][j]); } } }
    const float* WRT = WSP(const float, WS_SM + SM_WRT);
    for (int o = 0; o < 36; ++o) {
        f32x4 wv[4]; load_row(WRT + (size_t)o * 1024, lane, wv); const float bo = o < 4 ? F.A->in[16][o] : F.A->in[18][o - 4];
#pragma unroll
        for (int r = 0; r < 8; ++r) { float s = 0.f;
#pragma unroll
            for (int j = 0; j < 4; ++j) s += (hv[r][j][0] * wv[j][0] + hv[r][j][1] * wv[j][1]) + (hv[r][j][2] * wv[j][2] + hv[r][j][3] * wv[j][3]);
            s = wave_sum(s); if (lane == 0) lg[r * 36 + o] = s + bo; }
    }
    LDS_WAIT();
    if (lane < 8) {
        const LAS float* l = lg + lane * 36; const int t = m0 + lane;
        int grp = 0; float mg = l[0];
#pragma unroll
        for (int i = 1; i < 4; ++i) if (l[i] > mg) { mg = l[i]; grp = i; }
        float Z = 0.f;
#pragma unroll
        for (int i = 0; i < 4; ++i) Z += expf(l[i] - mg);
        const float pg = 1.0f / Z;
        const LAS float* le = l + 4 + grp * 8; int i1 = 0; float v1 = le[0];
#pragma unroll
        for (int i = 1; i < 8; ++i) if (le[i] > v1) { v1 = le[i]; i1 = i; }
        int i2 = -1; float v2 = -3.0e38f;
#pragma unroll
        for (int i = 0; i < 8; ++i) if (i != i1 && le[i] > v2) { v2 = le[i]; i2 = i; }
        const float e2 = expf(v2 - v1), w1 = pg / (1.0f + e2), w2 = pg * e2 / (1.0f + e2);
        const int ex1 = grp * 8 + i1, ex2 = grp * 8 + i2;
        const unsigned r1 = atomicAdd(F.ctl + CW_CNT + ex1, 1u), r2 = atomicAdd(F.ctl + CW_CNT + ex2, 1u);
        v2u* TOKR = WSP(v2u, WS_MISC);
        TOKR[t * 2 + 0] = (v2u){((unsigned)ex1 << 16) | r1, __float_as_uint(w1)};
        TOKR[t * 2 + 1] = (v2u){((unsigned)ex2 << 16) | r2, __float_as_uint(w2)};
    }
    LDS_WAIT();
}
DI void p8_moe_weights(Frame& F) {
    LAS float* scr = (LAS float*)(F.lds + F.wave * WAVE_LDS + 2048);
    bf16* WGU = WSP(bf16, WS_MOEW); bf16* WD = WGU + (size_t)32 * 512 * 1024;
    for (int it = F.gw; it < 3 * 4096; it += F.ngw) {
        const int which = it >> 12, r = it & 4095;
        if (which < 2) { const int e = r >> 7, q = r & 127, kb = q >> 3, nb = q & 7; bf16* dstb = WGU + (size_t)e * 512 * 1024 + (which ? 16 * 1024 : 0);
            tr_item((which ? F.A->in[20] : F.A->in[19]) + (size_t)e * 1024 * 256, 256, 256, 64 * kb, 32 * nb, scr, F.lane, [dstb](int n, int w2) { return w2 ? (bf16*)nullptr : dstb + (size_t)moe_row(n) * 1024; }); }
        else { const int e = r >> 7, q = r & 127, kb = q >> 5, nb = q & 31; bf16* dstb = WD + (size_t)e * 1024 * 256;
            tr_item(F.A->in[21] + (size_t)e * 256 * 1024, 1024, 1024, 64 * kb, 32 * nb, scr, F.lane, [dstb](int n, int w2) { return w2 ? (bf16*)nullptr : dstb + (size_t)n * 256; }); }
    }
}
DI void moe_tile_prefix(Frame& F) {
    LAS int* tp = (LAS int*)(F.lds + MOET_OFF);
    if (F.tid == 0) { int a = 0; for (int e = 0; e < 32; ++e) { tp[e] = a; a += (int)((__hip_atomic_load(F.ctl + CW_CNT + e, __ATOMIC_RELAXED, __HIP_MEMORY_SCOPE_AGENT) + 255u) >> 8); } tp[32] = a; }
    __syncthreads();
}
DI void p9_sort(Frame& F) {
    const LAS int* tp = (const LAS int*)(F.lds + MOET_OFF);
    const v2u* TOKR = WSP(const v2u, WS_MISC); v2u* RI = WSP(v2u, WS_MISC + 256 * 1024); const bf16* H2 = WSP(const bf16, WS_H); bf16* XS = WSP(bf16, WS_XS);
    for (int i = F.gw; i < 2 * S; i += F.ngw) {
        const v2u tr = TOKR[i]; const int e = (int)(tr.x >> 16), rank = (int)(tr.x & 0xffffu), pos = tp[e] * 256 + rank, t = i >> 1;
        const v4u* src = (const v4u*)(H2 + (size_t)t * 1024); v4u* dst = (v4u*)(XS + (size_t)pos * 1024);
        const v4u a = src[F.lane], b = src[F.lane + 64]; dst[F.lane] = a; dst[F.lane + 64] = b;
        if (F.lane == 0) RI[pos] = (v2u){(unsigned)(((i & 1) * S + t) * 1024), tr.y};
    }
    for (int idx = blockIdx.x * NTHR + F.tid; idx < 32 * 256; idx += F.G * NTHR) {
        const int e = idx >> 8, r = idx & 255; const int cnt = (int)F.ctl[CW_CNT + e]; const int pos = tp[e] * 256 + cnt + r;
        if (pos < tp[e + 1] * 256) RI[pos] = (v2u){0xffffffffu, 0u};
    }
}
DI void p12_final(Frame& F) {
    f32x4 w[4]; load_row(F.A->in[22], F.lane, w); const bf16* Y = WSP(const bf16, WS_Y);
    for (int m = F.gw; m < S; m += F.ngw) {
        f32x4 v[4]; load_row(F.out + (size_t)m * 1024, F.lane, v);
#pragma unroll
        for (int j = 0; j < 4; ++j) { const v2u a = *(const v2u*)(Y + (size_t)m * 1024 + 4 * F.lane + 256 * j), b = *(const v2u*)(Y + ((size_t)S + m) * 1024 + 4 * F.lane + 256 * j);
            v[j][0] += bflo(a.x) + bflo(b.x); v[j][1] += bfhi(a.x) + bfhi(b.x); v[j][2] += bflo(a.y) + bflo(b.y); v[j][3] += bfhi(a.y) + bfhi(b.y); }
        const float rs = row_rstd(v);
#pragma unroll
        for (int j = 0; j < 4; ++j) *(f32x4*)(F.out + (size_t)m * 1024 + 4 * F.lane + 256 * j) = v[j] * rs * w[j];
    }
}

#ifndef MK_PER_PHASE
#define MK_PER_PHASE 0
#endif
constexpr int NPH = 13;
__global__ void __launch_bounds__(NTHR, 2) mk_fwd(Args args) {
    extern __shared__ __attribute__((aligned(16))) unsigned char lds[];
    Frame F;
    F.lds = (LAS unsigned char*)lds;
    F.tid = threadIdx.x; F.lane = F.tid & 63; F.wave = __builtin_amdgcn_readfirstlane(F.tid >> 6);
    F.G = gridDim.x; F.gw = blockIdx.x * NWAVES + F.wave; F.ngw = F.G * NWAVES;
    F.ws = args.ws; F.ctl = (unsigned*)(args.ws + WS_CTL); F.out = args.out;
    F.A = &args;
    for (int u = F.tid; u < (LDS_BYTES - MISC_OFF) / 4; u += NTHR) ((LAS unsigned*)(F.lds + MISC_OFF))[u] = 0u;
    __syncthreads();
    XcdBarrier bar; bar.bar = F.ctl + CW_BAR + args.li * XCD_BAR_WORDS; bar.x = 0; bar.st = nullptr;
    if (!MK_PER_PHASE) bar = xcd_barrier_post(F.ctl + CW_BAR + args.li * XCD_BAR_WORDS, (volatile LAS unsigned*)(F.lds + MISC_OFF) + 8);
    const int lo = args.ph_lo, hi = args.ph_hi;
#define IN(k) (lo <= (k) && (k) < hi)
#define SEAM(k) do { if (IN(k) && IN((k) + 1)) xcd_barrier(bar); } while (0)
    LAS unsigned char* ring = F.lds;

    if (IN(0)) { p0_prologue(F); }
    SEAM(0);
    if (IN(1)) {
        pg8::Gemm g{WSP(const bf16, WS_H), WSP(const bf16, WS_WR), 0, 0, 1024}; ProjOrder O{F.G, (int)blockIdx.x};
        EpiProj E{WSP(bf16, WS_QA), WSP(bf16, WS_KCV), WSP(bf16, WS_QR), WSP(bf16, WS_KR), WSP(bf16, WS_GR), WSP(bf16, WS_GA), WSP(bf16, WS_TOUT)};
        pg8::gemm_phase<EpiProj, ProjOrder, true, true>(ring, g, O, E);
    }
    SEAM(1);
    if (IN(2)) {
        for (int u = F.gw; u < 256 + 256 + 4096; u += F.ngw) { if (u < 256) p2_cmp_hidden(F, u); else if (u < 512) p2_kmax(F, u - 256); else p2_ret_state(F, u - 512); }
    }
    SEAM(2);
    if (IN(3)) {
        p3_scan(F);
        for (int u = F.gw; u < 256; u += F.ngw) p3_kcvc(F, u);
    }
    SEAM(3);
    if (IN(4)) {
        p4_bias_table(F);
        const int sub = args.pad ? args.pad : 7;
        for (int pp = blockIdx.x; pp < 256; pp += F.G) {
            const int g = pp & 1, c = pp >> 1;
            if (sub & 1) p4a_unit(F, (F.wave < 4 ? c : 255 - c) * 4 + (F.wave & 3), g);
            VM_WAIT(); __syncthreads();
            if (sub & 2) {
#pragma unroll 1
                for (int hh = 0; hh < 2; ++hh) p4b_pass(F.lds, F.ws, F.out, hh ? 255 - c : c, g); }
        }
        if (sub & 4) for (int u = F.gw; u < 4096; u += F.ngw) p4_ret_unit(F, u);
        __syncthreads();
    }
    SEAM(4);
    if (IN(5)) {
        pg8::Gemm g{WSP(const bf16, WS_H), WSP(const bf16, WS_WG), S, 2048, 1024}; pg8::StaticOrder O; O.init(S, 2048, F.G, (int)blockIdx.x);
        EpiGate E{WSP(bf16, WS_G)};
        pg8::gemm_phase<EpiGate, pg8::StaticOrder, true, true>(ring, g, O, E);
    }
    SEAM(5);
    if (IN(6)) {
        { pg8::Gemm g{WSP(const bf16, WS_QA), WSP(const bf16, WS_WUA), S, 1024, 512}; pg8::StaticOrder O; O.init(S, 1024, F.G, (int)blockIdx.x);
          EpiUp<false> E{WSP(const bf16, WS_G), WSP(bf16, WS_MG), 0};
          pg8::gemm_phase<EpiUp<false>, pg8::StaticOrder, true, true>(ring, g, O, E); }
        if (F.G != 256 && !MK_PER_PHASE) xcd_barrier(bar); else { VM_WAIT(); __syncthreads(); }
        { pg8::Gemm g{WSP(const bf16, WS_GR), WSP(const bf16, WS_WUB), S, 1024, 1024}; pg8::StaticOrder O; O.init(S, 1024, F.G, (int)blockIdx.x);
          EpiUp<true> E{WSP(const bf16, WS_G), WSP(bf16, WS_MG), 1024};
          pg8::gemm_phase<EpiUp<true>, pg8::StaticOrder, true, true>(ring, g, O, E); }
    }
    SEAM(6);
    if (IN(7)) {
        pg8::Gemm g{WSP(const bf16, WS_MG), WSP(const bf16, WS_WO), S, 1024, 1024}; pg8::StaticOrder O; O.init(S, 1024, F.G, (int)blockIdx.x);
        EpiOut E{F.A->in[0], F.out};
        pg8::gemm_phase<EpiOut, pg8::StaticOrder, true, true>(ring, g, O, E);
    }
    SEAM(7);
    if (IN(8)) {
        for (int it = F.gw; it < S / 8; it += F.ngw) p8_route_item(F, it);
        p8_moe_weights(F);
    }
    SEAM(8);
    if (IN(9)) { moe_tile_prefix(F); p9_sort(F); }
    SEAM(9);
    if (IN(10)) {
        moe_tile_prefix(F);
        pg8::Gemm g{WSP(const bf16, WS_XS), WSP(const bf16, WS_MOEW), 0, 0, 1024}; MoeOrder<2> O{F.G, (int)blockIdx.x, (const LAS int*)(F.lds + MOET_OFF)};
        EpiMoe1 E{WSP(bf16, WS_HID)};
        pg8::gemm_phase<EpiMoe1, MoeOrder<2>, true, true>(ring, g, O, E);
    }
    SEAM(10);
    if (IN(11)) {
        moe_tile_prefix(F);
        pg8::Gemm g{WSP(const bf16, WS_HID), WSP(const bf16, WS_MOEW) + (size_t)32 * 512 * 1024, 0, 0, 256}; MoeOrder<4> O{F.G, (int)blockIdx.x, (const LAS int*)(F.lds + MOET_OFF)};
        EpiMoe2 E{WSP(const v2u, WS_MISC + 256 * 1024), WSP(bf16, WS_Y)};
        pg8::gemm_phase<EpiMoe2, MoeOrder<4>, true, true>(ring, g, O, E);
    }
    SEAM(11);
    if (IN(12)) p12_final(F);
#undef IN
#undef SEAM
}

extern "C" void kernel_launch(void* const* d_in, const int* in_sizes, int n_in, void* d_out, int out_size, void* d_ws, size_t ws_size, hipStream_t stream) {
    static int grid = 0;
    if (grid == 0) {
        if (n_in != 23 || out_size != S * D || ws_size < WS_END) { fprintf(stderr, "kernel_launch: unexpected problem (n_in %d, out %d, ws %zu)\n", n_in, out_size, ws_size); grid = -1; return; }
        int dev = 0, cus = 0;
        if (hipGetDevice(&dev) != hipSuccess || hipDeviceGetAttribute(&cus, hipDeviceAttributeMultiprocessorCount, dev) != hipSuccess) { grid = -1; return; }
        if (hipFuncSetAttribute((const void*)mk_fwd, hipFuncAttributeMaxDynamicSharedMemorySize, LDS_BYTES) != hipSuccess) { fprintf(stderr, "kernel_launch: hipFuncSetAttribute failed\n"); grid = -1; return; }
        int per_cu = 0;
        if (hipOccupancyMaxActiveBlocksPerMultiprocessor(&per_cu, (const void*)mk_fwd, NTHR, LDS_BYTES) != hipSuccess || per_cu < 1) { fprintf(stderr, "kernel_launch: occupancy query says %d\n", per_cu); }
        (void)hipGetLastError();
        grid = cus > 0 ? cus : 256;
    }
    if (grid < 0) return;
    if (hipMemsetAsync((char*)d_ws + WS_CTL, 0, CTL_ZERO_BYTES, stream) != hipSuccess) return;
    Args a{};
    for (int i = 0; i < 23; ++i) a.in[i] = (const float*)d_in[i];
    a.out = (float*)d_out; a.ws = (unsigned char*)d_ws;
#if MK_PER_PHASE
    for (int p = 0; p < NPH; ++p) { a.ph_lo = p; a.ph_hi = p + 1; hipLaunchKernelGGL(mk_fwd, dim3(grid), dim3(NTHR), LDS_BYTES, stream, a); }
#elif defined(MK_PREFIX_HI)
    a.ph_lo = 0; a.ph_hi = MK_PREFIX_HI; a.li = 0; a.pad = MK_PREFIX_SUB; hipLaunchKernelGGL(mk_fwd, dim3(grid), dim3(NTHR), LDS_BYTES, stream, a);
    a.ph_lo = 0; a.ph_hi = NPH; a.li = 1; a.pad = 0; hipLaunchKernelGGL(mk_fwd, dim3(grid), dim3(NTHR), LDS_BYTES, stream, a);
#elif defined(MK_DUP_LO)
    a.ph_lo = 0; a.ph_hi = MK_DUP_HI + 1; a.li = 0; hipLaunchKernelGGL(mk_fwd, dim3(grid), dim3(NTHR), LDS_BYTES, stream, a);
    a.ph_lo = MK_DUP_LO; a.ph_hi = NPH; a.li = 1; hipLaunchKernelGGL(mk_fwd, dim3(grid), dim3(NTHR), LDS_BYTES, stream, a);
#else
    a.ph_lo = 0; a.ph_hi = NPH;
    hipLaunchKernelGGL(mk_fwd, dim3(grid), dim3(NTHR), LDS_BYTES, stream, a);
#endif
}
```

```cpp
#include <hip/hip_runtime.h>
#include <cstdio>
#include <cstdint>
namespace pg8 {
#define PG8_LAS __attribute__((address_space(3)))
typedef unsigned short bf16_t;
typedef short bf16x8 __attribute__((ext_vector_type(8)));
typedef float f32x4 __attribute__((ext_vector_type(4)));
typedef unsigned u32x4 __attribute__((ext_vector_type(4)));
constexpr int BM = 256, BK = 64, HALF = 128, HTB = HALF * BK * 2  , STAGE_BYTES = 8 * HTB, NXCD = 8, WGM = 8;

__host__ __device__ __forceinline__ int lds_byte(int r, int c) { const int st = (r >> 4) * 2 + (c >> 5), rr = r & 15, cc = c & 31, ob = rr * 64 + cc * 2; return st * 1024 + (ob ^ (((ob >> 9) & 1) << 5)); }
__host__ __device__ __forceinline__ void stage_rc(int b, int& R, int& C) { const int st = b / 1024, sb = b % 1024, swz = sb ^ (((sb >> 9) & 1) << 5); R = (st >> 1) * 16 + swz / 64; C = (st & 1) * 32 + (swz % 64) / 2; }
__host__ __device__ __forceinline__ int perm32(int rho) { const int n = rho >> 4, i = rho & 15; return 8 * (i >> 2) + 4 * n + (i & 3); }

struct Unit { int pm, pn; };
struct Gemm { const bf16_t* A; const bf16_t* Bt; int M, N, K; };

struct StaticOrder {
    int nM, nN, nwg, G, c;
    __host__ __device__ void init(int M, int N, int G_, int c_) { nM = M / BM; nN = N / BM; nwg = nM * nN; G = G_; c = c_; }
    __host__ __device__ bool next(int i, Unit& u) const {
        const long L = (long)i * G + c; if (L >= nwg) return false;
        int wgid = (int)L; { const int q = nwg / NXCD, r = nwg % NXCD, xcd = wgid % NXCD, off = wgid / NXCD; wgid = (xcd < r ? xcd * (q + 1) : r * (q + 1) + (xcd - r) * q) + off; }
        const int nig = WGM * nN, gid = wgid / nig, fm = gid * WGM, gsz = (nM - fm) < WGM ? (nM - fm) : WGM;
        u.pm = fm + ((wgid % nig) % gsz); u.pn = (wgid % nig) / gsz; return true;
    }
    __device__ __forceinline__ void a_ready(const Unit&) const {}
    __device__ __forceinline__ void done(const Unit&) const {}
};

__device__ __forceinline__ unsigned cvt_pk_bf16(float lo, float hi) { unsigned r; asm volatile("v_cvt_pk_bf16_f32 %0, %1, %2" : "=v"(r) : "v"(lo), "v"(hi)); return r; }

template <class Epi, class Sched, bool ALIGN_EPI = false, bool SP2 = false>
__device__ __forceinline__ void gemm_phase(PG8_LAS unsigned char* lds, const Gemm g, const Sched& S, const Epi& E) {
    const int tid = threadIdx.x, wid = __builtin_amdgcn_readfirstlane(tid >> 6), lane = tid & 63, wr = wid >> 2, wc = wid & 3, fr = lane & 15, fq = lane >> 4;
    const int K = g.K, nt = K / BK;
    unsigned voffA[2], voffB[2];
#pragma unroll
    for (int i = 0; i < 2; ++i) { int R, C; stage_rc(tid * 16 + i * 8192, R, C); const int Rb = Epi::PERM ? ((R & ~31) + perm32(R & 31)) : R;
        voffA[i] = (unsigned)(R * K + C) * 2u; voffB[i] = (unsigned)(Rb * K + C) * 2u; }
    const size_t kstep = (size_t)(BK * 2);
    const size_t hstep = (size_t)HALF * K * 2;
    const size_t tstep = 2 * hstep;
    const unsigned ldsw = (unsigned)wid * 1024u;
    const int aoff = lds_byte(wr * 64 + fr, fq * 8), boff = lds_byte(wc * 32 + fr, fq * 8);
#define PG8_SA(b, h) (((b) * 2 + (h)) * HTB)
#define PG8_SB(b, h) ((4 + (b) * 2 + (h)) * HTB)
#define PG8_STAGE(bufoff, gbase, voff) do { _Pragma("unroll") for (int _i = 0; _i < 2; ++_i) \
        __builtin_amdgcn_global_load_lds((const unsigned*)((const char*)(gbase) + (voff)[_i]), (PG8_LAS unsigned*)(lds + (bufoff) + ldsw + _i * 8192), 16, 0, 0); } while (0)
#define PG8_LDA(dst, b, h) do { _Pragma("unroll") for (int m = 0; m < 4; ++m) _Pragma("unroll") for (int k = 0; k < 2; ++k) dst[m][k] = *(const PG8_LAS bf16x8*)(lds + PG8_SA(b, h) + aoff + m * 2048 + k * 1024); } while (0)
#define PG8_LDB(dst, b, h) do { _Pragma("unroll") for (int n = 0; n < 2; ++n) _Pragma("unroll") for (int k = 0; k < 2; ++k) dst[n][k] = *(const PG8_LAS bf16x8*)(lds + PG8_SB(b, h) + boff + n * 2048 + k * 1024); } while (0)
#define PG8_MMA(ai, bj, At, Bt) do { __builtin_amdgcn_s_setprio(1); _Pragma("unroll") for (int m = 0; m < 4; ++m) _Pragma("unroll") for (int n = 0; n < 2; ++n) _Pragma("unroll") for (int k = 0; k < 2; ++k) \
        acc[ai][bj][m][n] = __builtin_amdgcn_mfma_f32_16x16x32_bf16(Bt[n][k], At[m][k], acc[ai][bj][m][n], 0, 0, 0); __builtin_amdgcn_s_setprio(0); } while (0)
#define PG8_WAIT_V(n) asm volatile("s_waitcnt vmcnt(" #n ")" ::: "memory")
#define PG8_WAIT_L(n) asm volatile("s_waitcnt lgkmcnt(" #n ")" ::: "memory")
#define PG8_BAR __builtin_amdgcn_s_barrier()
#define PG8_SCHED __builtin_amdgcn_sched_barrier(0)
    Unit cur, nxt; int ui = 0;
    if (!S.next(0, cur)) return;
    f32x4 acc[2][2][4][2];
#pragma unroll
    for (int a = 0; a < 2; ++a)
#pragma unroll
        for (int b = 0; b < 2; ++b)
#pragma unroll
            for (int m = 0; m < 4; ++m)
#pragma unroll
                for (int n = 0; n < 2; ++n) acc[a][b][m][n] = (f32x4){0.f, 0.f, 0.f, 0.f};
    bf16x8 At[4][2], B0[2][2], B1[2][2];
    const char* cA = (const char*)g.A + (size_t)cur.pm * tstep; const char* cB = (const char*)g.Bt + (size_t)cur.pn * tstep;
    S.a_ready(cur);
    if constexpr (SP2) {
        PG8_STAGE(PG8_SB(0, 0), cB, voffB); PG8_STAGE(PG8_SB(0, 1), cB + hstep, voffB); PG8_STAGE(PG8_SA(0, 0), cA, voffA); PG8_STAGE(PG8_SA(0, 1), cA + hstep, voffA);
        if (wr == 1) PG8_BAR;
        PG8_WAIT_V(2); PG8_BAR;
        PG8_STAGE(PG8_SB(1, 0), cB + kstep, voffB); PG8_STAGE(PG8_SA(1, 0), cA + kstep, voffA); PG8_STAGE(PG8_SB(1, 1), cB + hstep + kstep, voffB);
        PG8_WAIT_V(6); PG8_BAR;
    } else {
        PG8_STAGE(PG8_SB(0, 0), cB, voffB); PG8_STAGE(PG8_SA(0, 0), cA, voffA); PG8_STAGE(PG8_SB(0, 1), cB + hstep, voffB); PG8_STAGE(PG8_SA(0, 1), cA + hstep, voffA);
        if (wr == 1) PG8_BAR;
        PG8_WAIT_V(4); PG8_BAR;
        PG8_STAGE(PG8_SB(1, 0), cB + kstep, voffB); PG8_STAGE(PG8_SA(1, 0), cA + kstep, voffA); PG8_STAGE(PG8_SB(1, 1), cB + hstep + kstep, voffB);
        PG8_WAIT_V(6); PG8_BAR;
    }
    for (;;) {
        const bool has_next = S.next(ui + 1, nxt);
        const char* nA = has_next ? (const char*)g.A + (size_t)nxt.pm * tstep : cA; const char* nB = has_next ? (const char*)g.Bt + (size_t)nxt.pn * tstep : cB;
#pragma nounroll
        for (int t = 0; t < nt; t += 2) {
            const bool last = (t == nt - 2);
            const char* a1 = cA + (size_t)(t + 1) * kstep;
            const char* a2 = last ? nA : cA + (size_t)(t + 2) * kstep; const char* b2 = last ? nB : cB + (size_t)(t + 2) * kstep;
            const char* a3 = a2 + kstep; const char* b3 = b2 + kstep;
            if (last && has_next) S.a_ready(nxt);
            if constexpr (SP2) {
            PG8_LDB(B0, 0, 0); PG8_LDB(B1, 0, 1); PG8_SCHED; PG8_LDA(At, 0, 0); PG8_STAGE(PG8_SA(1, 1), a1 + hstep, voffA);
            PG8_WAIT_V(8); PG8_WAIT_L(0); PG8_BAR; PG8_MMA(0, 0, At, B0); PG8_MMA(0, 1, At, B1); PG8_BAR; PG8_SCHED;
            PG8_LDA(At, 0, 1); PG8_STAGE(PG8_SB(0, 0), b2, voffB); PG8_STAGE(PG8_SB(0, 1), b2 + hstep, voffB); PG8_STAGE(PG8_SA(0, 0), a2, voffA);
            PG8_WAIT_V(8); PG8_WAIT_L(0); PG8_BAR; PG8_MMA(1, 0, At, B0); PG8_MMA(1, 1, At, B1); PG8_BAR; PG8_SCHED;
            PG8_LDB(B0, 1, 0); PG8_LDB(B1, 1, 1); PG8_SCHED; PG8_LDA(At, 1, 0); PG8_STAGE(PG8_SA(0, 1), a2 + hstep, voffA);
            PG8_WAIT_V(8); PG8_WAIT_L(0); PG8_BAR; PG8_MMA(0, 0, At, B0); PG8_MMA(0, 1, At, B1); PG8_BAR; PG8_SCHED;
            PG8_LDA(At, 1, 1); PG8_STAGE(PG8_SB(1, 0), b3, voffB); PG8_STAGE(PG8_SB(1, 1), b3 + hstep, voffB); PG8_STAGE(PG8_SA(1, 0), a3, voffA);
            PG8_WAIT_V(8); PG8_WAIT_L(0); PG8_BAR; PG8_MMA(1, 0, At, B0); PG8_MMA(1, 1, At, B1); PG8_BAR; PG8_SCHED;
            } else {
            PG8_LDB(B0, 0, 0); PG8_SCHED; PG8_LDA(At, 0, 0); PG8_STAGE(PG8_SA(1, 1), a1 + hstep, voffA);
            PG8_WAIT_L(8); PG8_BAR; PG8_WAIT_L(0); PG8_MMA(0, 0, At, B0); PG8_BAR; PG8_SCHED;
            PG8_LDB(B1, 0, 1); PG8_STAGE(PG8_SB(0, 0), b2, voffB);
            PG8_BAR; PG8_WAIT_L(0); PG8_MMA(0, 1, At, B1); PG8_BAR;
            PG8_LDA(At, 0, 1); PG8_STAGE(PG8_SA(0, 0), a2, voffA);
            PG8_BAR; PG8_WAIT_L(0); PG8_MMA(1, 0, At, B0); PG8_BAR; PG8_SCHED;
            PG8_STAGE(PG8_SB(0, 1), b2 + hstep, voffB);
            PG8_WAIT_V(6); PG8_BAR; PG8_MMA(1, 1, At, B1); PG8_BAR;
            PG8_LDB(B0, 1, 0); PG8_SCHED; PG8_LDA(At, 1, 0); PG8_STAGE(PG8_SA(0, 1), a2 + hstep, voffA);
            PG8_WAIT_L(8); PG8_BAR; PG8_WAIT_L(0); PG8_MMA(0, 0, At, B0); PG8_BAR; PG8_SCHED;
            PG8_LDB(B1, 1, 1); PG8_STAGE(PG8_SB(1, 0), b3, voffB);
            PG8_BAR; PG8_WAIT_L(0); PG8_MMA(0, 1, At, B1); PG8_BAR;
            PG8_LDA(At, 1, 1); PG8_STAGE(PG8_SA(1, 0), a3, voffA);
            PG8_BAR; PG8_WAIT_L(0); PG8_MMA(1, 0, At, B0); PG8_BAR; PG8_SCHED;
            PG8_STAGE(PG8_SB(1, 1), b3 + hstep, voffB);
            PG8_WAIT_V(6); PG8_BAR; PG8_MMA(1, 1, At, B1); PG8_BAR;
            }
        }
        if constexpr (ALIGN_EPI) { if (wr == 0) PG8_BAR; }
        if constexpr (!Epi::AFTER_DRAIN) { E(acc, cur, wr, wc, fr, fq); S.done(cur); }
        if (!has_next) break;
#pragma unroll
        for (int a = 0; a < 2; ++a)
#pragma unroll
            for (int b = 0; b < 2; ++b)
#pragma unroll
                for (int m = 0; m < 4; ++m)
#pragma unroll
                    for (int n = 0; n < 2; ++n) acc[a][b][m][n] = (f32x4){0.f, 0.f, 0.f, 0.f};
        cur = nxt; cA = nA; cB = nB; ++ui;
        if constexpr (ALIGN_EPI) { if (wr == 1) PG8_BAR; }
    }
    PG8_WAIT_V(0);
    if constexpr (!ALIGN_EPI) { if (wr == 0) PG8_BAR; }
    PG8_BAR;
    if constexpr (Epi::AFTER_DRAIN) { E.fused(acc, cur, wr, wc, fr, fq, lds, wid, lane); S.done(cur); }
#undef PG8_SA
#undef PG8_SB
#undef PG8_STAGE
#undef PG8_LDA
#undef PG8_LDB
#undef PG8_MMA
#undef PG8_WAIT_V
#undef PG8_WAIT_L
#undef PG8_BAR
#undef PG8_SCHED
}
}

#define GAS __attribute__((address_space(1)))
#define LAS __attribute__((address_space(3)))
#define DI __device__ __forceinline__
typedef unsigned short bf16;
typedef unsigned v4u __attribute__((ext_vector_type(4)));
typedef unsigned v2u __attribute__((ext_vector_type(2)));
typedef float f32x4 __attribute__((ext_vector_type(4)));
typedef short bf16x8 __attribute__((ext_vector_type(8)));
typedef float f32x2_t __attribute__((ext_vector_type(2)));
typedef __bf16 bf16x2_t __attribute__((ext_vector_type(2)));
#define LDS_WAIT() asm volatile("s_waitcnt lgkmcnt(0)" ::: "memory")
#define VM_WAIT() asm volatile("s_waitcnt vmcnt(0)" ::: "memory")
DI unsigned pk2(float lo, float hi) { f32x2_t v = {lo, hi}; bf16x2_t b = __builtin_convertvector(v, bf16x2_t); return __builtin_bit_cast(unsigned, b); }
DI float bflo(unsigned u) { return __uint_as_float(u << 16); }
DI float bfhi(unsigned u) { return __uint_as_float(u & 0xffff0000u); }
DI float bf1(bf16 b) { return __uint_as_float(((unsigned)b) << 16); }
DI f32x4 mfma16(bf16x8 a, bf16x8 b, f32x4 c) { return __builtin_amdgcn_mfma_f32_16x16x32_bf16(a, b, c, 0, 0, 0); }
DI bf16x8 ld16(const bf16* p) { return *(const bf16x8*)p; }
DI bf16x8 ld8x2(const bf16* p, int off2) { const v2u a = *(const v2u*)p, b = *(const v2u*)(p + off2); v4u r = {a.x, a.y, b.x, b.y}; return __builtin_bit_cast(bf16x8, r); }
DI bf16x8 pack8(f32x4 a, f32x4 b) { v4u r = {pk2(a[0], a[1]), pk2(a[2], a[3]), pk2(b[0], b[1]), pk2(b[2], b[3])}; return __builtin_bit_cast(bf16x8, r); }
DI v2u pack4(f32x4 a) { v2u r = {pk2(a[0], a[1]), pk2(a[2], a[3])}; return r; }
DI float wave_sum(float v) {
#pragma unroll
    for (int o = 1; o < 64; o <<= 1) v += __shfl_xor(v, o);
    return v;
}
DI float quad_sum(float v) { v += __shfl_xor(v, 16); v += __shfl_xor(v, 32); return v; }
DI float quad_max(float v) { v = fmaxf(v, __shfl_xor(v, 16)); v = fmaxf(v, __shfl_xor(v, 32)); return v; }
DI unsigned wave_max_u32(unsigned v) {
#pragma unroll
    for (int o = 1; o < 64; o <<= 1) { const unsigned w = (unsigned)__shfl_xor((int)v, o); v = w > v ? w : v; }
    return v;
}
DI float sigmoidf_(float x) { return __builtin_amdgcn_rcpf(1.0f + __builtin_amdgcn_exp2f(-x * 1.4426950408889634f)); }
DI float siluf_(float x) { return x * sigmoidf_(x); }
DI float gelu_tanh(float v) { const float z = 0.7978845608028654f * (v + 0.044715f * v * v * v); const float e = __builtin_amdgcn_exp2f(2.0f * 1.4426950408889634f * z); return 0.5f * v * (2.0f - 2.0f * __builtin_amdgcn_rcpf(e + 1.0f)); }

constexpr int S = 16384, D = 1024;
constexpr int TP = S + 2048 + 128;
constexpr int NWAVES = 8, NTHR = 512;
constexpr float EPS = 1e-6f, LOG2E = 1.4426950408889634f, QSCALE = 0.125f * 1.4426950408889634f;
constexpr size_t MiB = 1u << 20;
constexpr size_t WS_CTL = 0, CTL_ZERO_BYTES = MiB;
constexpr size_t WS_MISC = 1 * MiB;
constexpr size_t WS_WR = 2 * MiB;
constexpr size_t WS_H = WS_WR + 3328 * 2048;
constexpr size_t WS_WT = WS_H + 32 * MiB;
constexpr size_t WS_WG = 44 * MiB;
constexpr size_t WS_WC1 = 48 * MiB;
constexpr size_t WS_WUA = 50 * MiB, WS_WUB = 51 * MiB, WS_WO = 53 * MiB;
constexpr size_t WS_SM = 55 * MiB;
constexpr size_t SM_W2T = 0, SM_B1 = 64 * 1024, SM_WRT = 128 * 1024, SM_KC = 512 * 1024, SM_VCT = 768 * 1024;
constexpr size_t WS_QA = 56 * MiB, WS_GR = 72 * MiB, WS_GA = 104 * MiB, WS_KCV = 105 * MiB, WS_QR = 121 * MiB, WS_KR = 137 * MiB, WS_TOUT = 153 * MiB, WS_UR = 217 * MiB, WS_HIDC = 249 * MiB;
constexpr size_t WS_G = 105 * MiB, WS_MG = 169 * MiB;
constexpr size_t WS_MOEW = 56 * MiB;
constexpr size_t WS_HID = 104 * MiB, WS_XS = 124 * MiB, WS_Y = 124 * MiB, WS_END = 256 * MiB;
static_assert(WS_TOUT + 1792ull * TP * 2 <= WS_UR && WS_WT + 1792 * 2048 <= WS_WG && WS_HIDC + 2 * MiB <= WS_END && WS_XS + 40960ull * 2048 <= WS_END && WS_Y + 64 * MiB <= WS_END, "ws map");
constexpr int CW_BAR = 4096, CW_KMAX = 16384, CW_CNT = 16448, CW_WQ = 16512;
constexpr int XS_ROWS = 40960;
constexpr int WAVE_LDS = 16960;
constexpr int BIAS_OFF = 157184;
constexpr int MOET_OFF = 161344;
constexpr int MISC_OFF = 161536;
constexpr int LDS_BYTES = 163840;
#define XB_TMO      128
#define XB_XCNT(j)  (256  + 64 * (j))
#define XB_XSUB(j)  (1280 + 64 * (j))
#define XB_XGEN(j)  (2304 + 64 * (j))
#define XB_TOP      3328
#define XB_TOPGEN   3392
#define XCD_BAR_WORDS 3456
#define XB_SPIN_CAP (1u << 18)

__device__ __forceinline__ unsigned xb_ld(unsigned* p)              { return __hip_atomic_load(p, __ATOMIC_RELAXED, __HIP_MEMORY_SCOPE_AGENT); }
__device__ __forceinline__ unsigned xb_add(unsigned* p, unsigned v) { return __hip_atomic_fetch_add(p, v, __ATOMIC_RELAXED, __HIP_MEMORY_SCOPE_AGENT); }
__device__ __forceinline__ unsigned xb_xcc_id() { return (unsigned)__builtin_amdgcn_s_getreg((3 << 11) | 20) & 0xFu; }
#define XB_SPIN(cond, bar) do { unsigned _sp = 0; while (cond) { __builtin_amdgcn_s_sleep(1); \
    if ((++_sp & 255u) == 0u) { if (xb_ld(&(bar)[XB_TMO])) break; if (_sp > XB_SPIN_CAP) { atomicAdd(&(bar)[XB_TMO], 1u); break; } } } } while (0)

struct XcdBarrier {
    unsigned* bar; unsigned x;
    volatile LAS unsigned* st;
};

__device__ __forceinline__ XcdBarrier xcd_barrier_post(unsigned* bar, volatile LAS unsigned* st) {
    XcdBarrier b; b.bar = bar; b.x = xb_xcc_id(); b.st = st;
    if (threadIdx.x == 0) (void)xb_add(&bar[XB_XCNT(b.x)], 1u);
    return b;
}
__device__ __forceinline__ void xcd_barrier_complete(unsigned* bar, unsigned x, unsigned& nloc, unsigned& nx) {
    const unsigned G = gridDim.x * gridDim.y * gridDim.z;
    unsigned sum, cnt, mine, sp = 0u;
    for (;;) {
        sum = 0u; cnt = 0u; mine = 0u;
#pragma unroll
        for (unsigned j = 0; j < 16; ++j) { const unsigned c = xb_ld(&bar[XB_XCNT(j)]); sum += c; cnt += (c > 0u) ? 1u : 0u; mine = (j == x) ? c : mine; }
        if (sum == G) break;
        __builtin_amdgcn_s_sleep(1);
        if ((++sp & 255u) == 0u) { if (xb_ld(&bar[XB_TMO])) break; if (sp > XB_SPIN_CAP) { atomicAdd(&bar[XB_TMO], 1u); break; } }
    }
    nloc = mine > 0u ? mine : 1u; nx = cnt > 0u ? cnt : 1u;
}

__device__ __forceinline__ void xcd_barrier(const XcdBarrier& b) {
    asm volatile("s_waitcnt vmcnt(0)" ::: "memory");
    __syncthreads();
    if (threadIdx.x == 0) {
        unsigned* bar = b.bar;
        __builtin_amdgcn_s_waitcnt(0);
        unsigned nloc = b.st[0], nx = b.st[1];
        if (nloc == 0u) { xcd_barrier_complete(bar, b.x, nloc, nx); b.st[0] = nloc; b.st[1] = nx; }
        const unsigned old = xb_add(&bar[XB_XSUB(b.x)], 1u);
        const unsigned gen = old / nloc;
        if (old + 1u == (gen + 1u) * nloc) {
            __builtin_amdgcn_fence(__ATOMIC_RELEASE, "agent");
            asm volatile("s_waitcnt vmcnt(0)" ::: "memory");
            const unsigned og = xb_add(&bar[XB_TOP], 1u);
            const unsigned tg = og / nx;
            if (og + 1u == (tg + 1u) * nx) xb_add(&bar[XB_TOPGEN], 1u);
            else XB_SPIN(xb_ld(&bar[XB_TOPGEN]) == tg, bar);
            __builtin_amdgcn_fence(__ATOMIC_ACQUIRE, "agent");
            xb_add(&bar[XB_XGEN(b.x)], 1u);
            asm volatile("s_waitcnt vmcnt(0)" ::: "memory");
        } else {
            XB_SPIN(xb_ld(&bar[XB_XGEN(b.x)]) == gen, bar);
            __builtin_amdgcn_fence(__ATOMIC_ACQUIRE, "agent");
            asm volatile("s_waitcnt vmcnt(0)" ::: "memory");
        }
    }
    __syncthreads();
}

DI void tile_map(int L, int nwg, int nM, int nN, int& pm, int& pn) {
    int wgid = L; { const int q = nwg / 8, r = nwg % 8, xcd = wgid % 8, off = wgid / 8; wgid = (xcd < r ? xcd * (q + 1) : r * (q + 1) + (xcd - r) * q) + off; }
    const int nig = 8 * nN, gid = wgid / nig, fm = gid * 8, gsz = (nM - fm) < 8 ? (nM - fm) : 8;
    pm = fm + ((wgid % nig) % gsz); pn = (wgid % nig) / gsz;
}
struct ProjOrder {
    int G, c;
    DI bool next(int i, pg8::Unit& u) const {
        const int L = i * G + c; if (L >= 1280) return false;
        if (L < 832) tile_map(L, 832, 64, 13, u.pm, u.pn);
        else { tile_map(L - 832, 448, 7, 64, u.pm, u.pn); u.pm += 64; u.pn += 13; }
        return true;
    }
    DI void a_ready(const pg8::Unit&) const {}
    DI void done(const pg8::Unit&) const {}
};
template <int NJ> struct MoeOrder {
    int G, c; const LAS int* tp;
    DI bool next(int i, pg8::Unit& u) const {
        const int L = i * G + c, tau = L / NJ, j = L % NJ; const int nt = __builtin_amdgcn_readfirstlane(tp[32]);
        if (tau >= nt) return false;
        int e = 0;
        for (int k = 1; k < 32; ++k) e += (tau >= __builtin_amdgcn_readfirstlane(tp[k])) ? 1 : 0;
        u.pm = tau; u.pn = e * NJ + j; return true;
    }
    DI void a_ready(const pg8::Unit&) const {}
    DI void done(const pg8::Unit&) const {}
};

struct EpiProj {
    static constexpr bool PERM = true, AFTER_DRAIN = false;
    bf16 *QA, *KCV, *QR, *KR, *GR, *GA, *TOUT;
    DI void operator()(const f32x4 (&acc)[2][2][4][2], const pg8::Unit& u, int wr, int wc, int fr_, int fq_) const {
        int fr = fr_, fq = fq_; asm volatile("" : "+v"(fr), "+v"(fq));
        const float L2B = 13.287712379549449f / 64.0f;
        const float INV2PI = 0.15915494309189535f;
        if (u.pm < 64) {
            const int pn = u.pn, row0 = u.pm * 256 + wr * 64 + fr;
            if (pn >= 4 && pn < 8) {
                bf16* base = pn < 6 ? QR : KR; const float sc = pn < 6 ? 1.0f : 0.08838834764831845f; const int hd0 = 2 * (pn & 1), d0 = 16 * wc + 4 * fq;
                float invr[4];
#pragma unroll
                for (int i = 0; i < 4; ++i) invr[i] = __builtin_amdgcn_exp2f(-(float)(d0 + i) * L2B) * INV2PI;
#pragma unroll
                for (int ai = 0; ai < 2; ++ai)
#pragma unroll
                    for (int m = 0; m < 4; ++m) {
                        const int tok = row0 + ai * 128 + m * 16; float cs[4], sn[4];
#pragma unroll
                        for (int i = 0; i < 4; ++i) { float rev = (float)tok * invr[i]; rev -= floorf(rev); sn[i] = __builtin_amdgcn_sinf(rev) * sc; cs[i] = __builtin_amdgcn_cosf(rev) * sc; }
#pragma unroll
                        for (int bj = 0; bj < 2; ++bj) {
                            const f32x4 x1 = acc[ai][bj][m][0], x2 = acc[ai][bj][m][1]; f32x4 o1, o2;
#pragma unroll
                            for (int i = 0; i < 4; ++i) { o1[i] = x1[i] * cs[i] - x2[i] * sn[i]; o2[i] = x1[i] * sn[i] + x2[i] * cs[i]; }
                            bf16* p = base + (size_t)tok * 512 + (hd0 + bj) * 128 + d0;
                            *(v2u*)p = pack4(o1); *(v2u*)(p + 64) = pack4(o2);
                        }
                    }
            } else if (pn == 12) {
                if (wc == 0) {
#pragma unroll
                    for (int ai = 0; ai < 2; ++ai)
#pragma unroll
                        for (int m = 0; m < 4; ++m) {
                            const int tok = row0 + ai * 128 + m * 16; f32x4 a = acc[ai][0][m][0], b = acc[ai][0][m][1];
#pragma unroll
                            for (int i = 0; i < 4; ++i) { a[i] = sigmoidf_(a[i]); b[i] = sigmoidf_(b[i]); }
                            *(bf16x8*)(GA + (size_t)tok * 32 + 8 * fq) = pack8(a, b);
                        }
                }
            } else {
                bf16* dst; int ldc, colt; float sc = 1.0f;
                if (pn < 2) { dst = QA; ldc = 512; colt = 256 * pn; sc = QSCALE; }
                else if (pn < 4) { dst = KCV; ldc = 512; colt = 256 * (pn - 2); }
                else { dst = GR; ldc = 1024; colt = 256 * (pn - 8); }
                const int col0 = colt + wc * 32 + 8 * fq;
#pragma unroll
                for (int ai = 0; ai < 2; ++ai)
#pragma unroll
                    for (int m = 0; m < 4; ++m) {
                        bf16* rowp = dst + (size_t)(row0 + ai * 128 + m * 16) * ldc + col0;
#pragma unroll
                        for (int bj = 0; bj < 2; ++bj) *(bf16x8*)(rowp + bj * 128) = pack8(acc[ai][bj][m][0] * sc, acc[ai][bj][m][1] * sc);
                    }
            }
        } else {
            const int pmp = u.pm - 64, tok0 = (u.pn - 13) * 256 + wc * 32 + 8 * fq;
            if (pmp == 1 || pmp == 2) {
                const float sc = 0.08838834764831845f;
#pragma unroll
                for (int ai = 0; ai < 2; ++ai) {
                    const int head = 2 * (pmp - 1) + ai;
#pragma unroll
                    for (int m = 0; m < 2; ++m) {
                        const int d = 32 * wr + 16 * m + fr; const float invr = __builtin_amdgcn_exp2f(-(float)d * L2B) * INV2PI;
                        bf16* p1 = TOUT + (size_t)(256 + head * 128 + d) * TP;
#pragma unroll
                        for (int bj = 0; bj < 2; ++bj) {
                            f32x4 o1[2], o2[2];
#pragma unroll
                            for (int n = 0; n < 2; ++n)
#pragma unroll
                                for (int i = 0; i < 4; ++i) {
                                    const int tok = tok0 + bj * 128 + 4 * n + i; float rev = (float)tok * invr; rev -= floorf(rev);
                                    const float sn = __builtin_amdgcn_sinf(rev) * sc, cs = __builtin_amdgcn_cosf(rev) * sc;
                                    const float x1 = acc[ai][bj][m][n][i], x2 = acc[ai][bj][m + 2][n][i];
                                    o1[n][i] = x1 * cs - x2 * sn; o2[n][i] = x1 * sn + x2 * cs;
                                }
                            *(bf16x8*)(p1 + tok0 + bj * 128) = pack8(o1[0], o1[1]);
                            *(bf16x8*)(p1 + (size_t)64 * TP + tok0 + bj * 128) = pack8(o2[0], o2[1]);
                        }
                    }
                }
            } else {
#pragma unroll
                for (int ai = 0; ai < 2; ++ai)
#pragma unroll
                    for (int m = 0; m < 4; ++m) {
                        bf16* rowp = TOUT + (size_t)(pmp * 256 + ai * 128 + wr * 64 + m * 16 + fr) * TP + tok0;
#pragma unroll
                        for (int bj = 0; bj < 2; ++bj) *(bf16x8*)(rowp + bj * 128) = pack8(acc[ai][bj][m][0], acc[ai][bj][m][1]);
                    }
            }
        }
    }
};
struct EpiGate {
    static constexpr bool PERM = true, AFTER_DRAIN = false;
    bf16* G;
    DI void operator()(const f32x4 (&acc)[2][2][4][2], const pg8::Unit& u, int wr, int wc, int fr, int fq) const {
        const int row0 = u.pm * 256 + wr * 64 + fr, col0 = u.pn * 256 + wc * 32 + 8 * fq;
#pragma unroll
        for (int ai = 0; ai < 2; ++ai)
#pragma unroll
            for (int m = 0; m < 4; ++m) {
                bf16* rowp = G + (size_t)(row0 + ai * 128 + m * 16) * 2048 + col0;
#pragma unroll
                for (int bj = 0; bj < 2; ++bj) { f32x4 a = acc[ai][bj][m][0], b = acc[ai][bj][m][1];
#pragma unroll
                    for (int i = 0; i < 4; ++i) { a[i] = sigmoidf_(a[i]); b[i] = sigmoidf_(b[i]); }
                    *(bf16x8*)(rowp + bj * 128) = pack8(a, b); }
            }
    }
};
template <bool ADD> struct EpiUp {
    static constexpr bool PERM = true, AFTER_DRAIN = false;
    const bf16* G; bf16* MG; int goff;
    DI void operator()(const f32x4 (&acc)[2][2][4][2], const pg8::Unit& u, int wr, int wc, int fr, int fq) const {
        const int row0 = u.pm * 256 + wr * 64 + fr, col0 = u.pn * 256 + wc * 32 + 8 * fq;
#pragma unroll
        for (int ai = 0; ai < 2; ++ai)
#pragma unroll
            for (int m = 0; m < 4; ++m) {
                const size_t r = (size_t)(row0 + ai * 128 + m * 16);
#pragma unroll
                for (int bj = 0; bj < 2; ++bj) {
                    const v4u g = *(const v4u*)(G + r * 2048 + goff + col0 + bj * 128);
                    f32x4 a = acc[ai][bj][m][0], b = acc[ai][bj][m][1];
                    a[0] *= bflo(g.x); a[1] *= bfhi(g.x); a[2] *= bflo(g.y); a[3] *= bfhi(g.y); b[0] *= bflo(g.z); b[1] *= bfhi(g.z); b[2] *= bflo(g.w); b[3] *= bfhi(g.w);
                    bf16* op = MG + r * 1024 + col0 + bj * 128;
                    if (ADD) { const v4u o = *(const v4u*)op;
                        a[0] += bflo(o.x); a[1] += bfhi(o.x); a[2] += bflo(o.y); a[3] += bfhi(o.y); b[0] += bflo(o.z); b[1] += bfhi(o.z); b[2] += bflo(o.w); b[3] += bfhi(o.w); }
                    *(bf16x8*)op = pack8(a, b);
                }
            }
    }
};
struct EpiOut {
    static constexpr bool PERM = false, AFTER_DRAIN = false;
    const float* X; float* O;
    DI void operator()(const f32x4 (&acc)[2][2][4][2], const pg8::Unit& u, int wr, int wc, int fr, int fq) const {
        const int row0 = u.pm * 256 + wr * 64 + fr, col0 = u.pn * 256 + wc * 32 + 4 * fq;
#pragma unroll
        for (int ai = 0; ai < 2; ++ai)
#pragma unroll
            for (int m = 0; m < 4; ++m) {
                const size_t off = (size_t)(row0 + ai * 128 + m * 16) * 1024 + col0;
#pragma unroll
                for (int bj = 0; bj < 2; ++bj)
#pragma unroll
                    for (int n = 0; n < 2; ++n) { const size_t o = off + bj * 128 + n * 16; *(f32x4*)(O + o) = *(const f32x4*)(X + o) + acc[ai][bj][m][n]; }
            }
    }
};
struct EpiMoe1 {
    static constexpr bool PERM = false, AFTER_DRAIN = false;
    bf16* HID;
    DI void operator()(const f32x4 (&acc)[2][2][4][2], const pg8::Unit& u, int wr, int wc, int fr, int fq) const {
        const int row0 = u.pm * 256 + wr * 64 + fr, f0 = (u.pn & 1) * 128 + 16 * wc + 4 * fq;
#pragma unroll
        for (int ai = 0; ai < 2; ++ai)
#pragma unroll
            for (int m = 0; m < 4; ++m) {
                bf16* rowp = HID + (size_t)(row0 + ai * 128 + m * 16) * 256 + f0;
#pragma unroll
                for (int bj = 0; bj < 2; ++bj) { const f32x4 g = acc[ai][bj][m][0], up = acc[ai][bj][m][1]; f32x4 h;
#pragma unroll
                    for (int i = 0; i < 4; ++i) h[i] = siluf_(g[i]) * up[i];
                    *(v2u*)(rowp + bj * 64) = pack4(h); }
            }
    }
};
struct EpiMoe2 {
    static constexpr bool PERM = true, AFTER_DRAIN = false;
    const v2u* RI; bf16* Y;
    DI void operator()(const f32x4 (&acc)[2][2][4][2], const pg8::Unit& u, int wr, int wc, int fr, int fq) const {
        const int row0 = u.pm * 256 + wr * 64 + fr, col0 = (u.pn & 3) * 256 + wc * 32 + 8 * fq;
#pragma unroll
        for (int ai = 0; ai < 2; ++ai)
#pragma unroll
            for (int m = 0; m < 4; ++m) {
                const v2u ri = RI[row0 + ai * 128 + m * 16]; const float w = __uint_as_float(ri.y);
                if (ri.x != 0xffffffffu) {
                    bf16* rowp = Y + ri.x + col0;
#pragma unroll
                    for (int bj = 0; bj < 2; ++bj) *(bf16x8*)(rowp + bj * 128) = pack8(acc[ai][bj][m][0] * w, acc[ai][bj][m][1] * w);
                }
                asm volatile("" ::: "memory");
            }
    }
};

struct Args { const float* in[23]; float* out; unsigned char* ws; int ph_lo, ph_hi, li, pad; };
struct Frame {
    LAS unsigned char* lds;
    unsigned* ctl;
    int tid, lane, wave, G, gw, ngw;
    const Args* A; float* out; unsigned char* ws;
};
#define WSP(T, off) ((T*)(F.ws + (off)))

template <class DestFn>
DI void tr_item(const float* W, int ldw, int ncols, int k0, int n0, LAS float* scr, int lane, DestFn dest) {
    const int lr = lane >> 3, lc = (lane & 7) * 4;
    if (n0 + 32 <= ncols && (ldw & 3) == 0) {
#pragma unroll
        for (int i = 0; i < 8; ++i) { const int kk = 8 * i + lr; const f32x4 v = *(const f32x4*)(W + (size_t)(k0 + kk) * ldw + n0 + lc); LAS float* d = scr + kk * 33 + lc; d[0] = v[0]; d[1] = v[1]; d[2] = v[2]; d[3] = v[3]; }
    } else {
#pragma unroll
        for (int i = 0; i < 8; ++i) { const int kk = 8 * i + lr;
#pragma unroll
            for (int j = 0; j < 4; ++j) scr[kk * 33 + lc + j] = (n0 + lc + j) < ncols ? W[(size_t)(k0 + kk) * ldw + n0 + lc + j] : 0.0f; }
    }
    LDS_WAIT(); asm volatile("" ::: "memory");
    const int c = lane & 7;
#pragma unroll
    for (int j = 0; j < 4; ++j) {
        const int nl = (lane >> 3) + 8 * j, n = n0 + nl;
        if (n < ncols) {
            const LAS float* s = scr + (8 * c) * 33 + nl;
            v4u o; o.x = pk2(s[0 * 33], s[1 * 33]); o.y = pk2(s[2 * 33], s[3 * 33]); o.z = pk2(s[4 * 33], s[5 * 33]); o.w = pk2(s[6 * 33], s[7 * 33]);
            bf16* r0 = dest(n, 0); if (r0) *(v4u*)(r0 + k0 + 8 * c) = o;
            bf16* r1 = dest(n, 1); if (r1) *(v4u*)(r1 + k0 + 8 * c) = o;
        }
    }
    LDS_WAIT(); asm volatile("" ::: "memory");
}
DI int rot_row_R(int d) { const int n = d >> 6, dd = d & 63; return 32 * (dd >> 4) + 8 * ((dd >> 2) & 3) + 4 * n + (dd & 3); }
DI int rot_row_T(int d) { const int x2 = d >> 6, dd = d & 63; return 64 * (dd >> 5) + 16 * (((dd >> 4) & 1) + 2 * x2) + (dd & 15); }
DI bf16* win_dest(unsigned char* ws, int s, int which) {
    bf16* WR = (bf16*)(ws + WS_WR); bf16* WT = (bf16*)(ws + WS_WT); bf16* WG = (bf16*)(ws + WS_WG);
    int r = -1, t = -1, g = -1;
    if (s < 512) r = s;
    else if (s < 1280) { const int sp = s - 512, j6 = sp >> 7, gd = sp & 127;
        if (j6 == 0) r = 512 + gd; else if (j6 == 1) r = 512 + 128 + gd; else if (j6 == 2) r = 512 + 256 + gd; else if (j6 == 4) r = 512 + 384 + gd;
        else if (j6 == 3) t = gd; else t = 128 + gd; }
    else if (s < 1304) r = 12 * 256 + (s - 1280);
    else if (s < 1816) { const int f = s - 1304, hh = f >> 7, d = f & 127; r = (4 + (hh >> 1)) * 256 + (hh & 1) * 128 + rot_row_R(d); }
    else if (s < 2328) { const int f = s - 1816, hh = f >> 7, d = f & 127; r = (6 + (hh >> 1)) * 256 + (hh & 1) * 128 + rot_row_R(d); t = (1 + (hh >> 1)) * 256 + (hh & 1) * 128 + rot_row_T(d); }
    else if (s < 3352) t = 768 + (s - 2328);
    else if (s < 4376) r = 8 * 256 + (s - 3352);
    else g = s - 4376;
    if (which == 0) { if (r >= 0) return WR + (size_t)r * 1024; if (t >= 0) return WT + (size_t)t * 1024; return WG + (size_t)g * 1024; }
    return (r >= 0 && t >= 0) ? WT + (size_t)t * 1024 : nullptr;
}
DI void load_row(const float* p, int lane, f32x4 (&v)[4]) {
#pragma unroll
    for (int j = 0; j < 4; ++j) v[j] = *(const f32x4*)(p + 4 * lane + 256 * j);
}
DI float row_rstd(const f32x4 (&v)[4]) {
    float s = 0.f;
#pragma unroll
    for (int j = 0; j < 4; ++j) s += (v[j][0] * v[j][0] + v[j][1] * v[j][1]) + (v[j][2] * v[j][2] + v[j][3] * v[j][3]);
    return 1.0f / sqrtf(wave_sum(s) * (1.0f / 1024.0f) + EPS);
}

DI void p0_prologue(Frame& F) {
    LAS float* scr = (LAS float*)(F.lds + F.wave * WAVE_LDS);
    const float* w_in = F.A->in[3];
    constexpr int I_IN = 16 * 201, I_C1 = 512, I_C2 = 16, I_UA = 256, I_UB = 512, I_WO = 512, NIT = I_IN + I_C1 + I_C2 + I_UA + I_UB + I_WO;
    unsigned char* ws = F.ws;
    for (int it = F.gw; it < NIT; it += F.ngw) {
        int r = it;
        if (r < I_IN) { const int kb = r / 201, nb = r % 201; tr_item(w_in, 6424, 6424, 64 * kb, 32 * nb, scr, F.lane, [ws](int n, int which) { return win_dest(ws, n, which); }); continue; } r -= I_IN;
        if (r < I_C1) { const int kind = r >> 8, q = r & 255, kb = q >> 3, nb = q & 7; bf16* dstb = (bf16*)(ws + WS_WC1) + (size_t)kind * 256 * 2048;
            tr_item(F.A->in[kind ? 8 : 5], 256, 256, 64 * kb, 32 * nb, scr, F.lane, [dstb](int n, int which) { return which ? (bf16*)nullptr : dstb + (size_t)n * 2048; }); continue; } r -= I_C1;
        if (r < I_C2) { const int kind = r >> 3, q = r & 7, kb = q >> 1, nb = q & 1; bf16* dstb = (bf16*)(ws + WS_SM + SM_W2T) + (size_t)kind * 64 * 256;
            tr_item(F.A->in[kind ? 9 : 6], 64, 64, 64 * kb, 32 * nb, scr, F.lane, [dstb](int n, int which) { return which ? (bf16*)nullptr : dstb + (size_t)n * 256; }); continue; } r -= I_C2;
        if (r < I_UA) { const int kb = r >> 5, nb = r & 31; bf16* dstb = (bf16*)(ws + WS_WUA);
            tr_item(F.A->in[11], 1024, 1024, 64 * kb, 32 * nb, scr, F.lane, [dstb](int n, int which) { return which ? (bf16*)nullptr : dstb + (size_t)n * 512; }); continue; } r -= I_UA;
        if (r < I_UB) { const int kb = r >> 5, nb = r & 31; bf16* dstb = (bf16*)(ws + WS_WUB);
            tr_item(F.A->in[12], 1024, 1024, 64 * kb, 32 * nb, scr, F.lane, [dstb](int n, int which) { return which ? (bf16*)nullptr : dstb + (size_t)n * 1024; }); continue; } r -= I_UB;
        { const int kb = r >> 5, nb = r & 31; bf16* dstb = (bf16*)(ws + WS_WO);
            tr_item(F.A->in[13], 1024, 1024, 64 * kb, 32 * nb, scr, F.lane, [dstb](int n, int which) { return which ? (bf16*)nullptr : dstb + (size_t)n * 1024; }); }
    }
    for (int o = F.gw; o < 512; o += F.ngw) {
        const int kind = o >> 8, n = o & 255; const float* pos = F.A->in[kind ? 7 : 4]; const float* w1 = F.A->in[kind ? 8 : 5]; float s = 0.f;
        for (int kk = F.lane; kk < 2048; kk += 64) s += pos[kk] * w1[(size_t)kk * 256 + n];
        s = wave_sum(s); if (F.lane == 0) ((float*)(ws + WS_SM + SM_B1))[o] = s;
    }
    { float* wrt = (float*)(ws + WS_SM + SM_WRT); const float* wn = F.A->in[14];
      for (int i = F.gw * 64 + F.lane; i < 48 * 1024; i += F.ngw * 64) { const int o = i >> 10, k = i & 1023; wrt[i] = o < 4 ? wn[k] * F.A->in[15][k * 4 + o] : (o < 36 ? wn[k] * F.A->in[17][k * 32 + (o - 4)] : 0.0f); } }
    { f32x4 w[4]; load_row(F.A->in[2], F.lane, w); bf16* H = (bf16*)(ws + WS_H);
      for (int m = F.gw; m < S; m += F.ngw) { f32x4 v[4]; load_row(F.A->in[0] + (size_t)m * 1024, F.lane, v); const float rs = row_rstd(v);
#pragma unroll
        for (int j = 0; j < 4; ++j) { const f32x4 o = v[j] * rs * w[j]; *(v2u*)(H + (size_t)m * 1024 + 4 * F.lane + 256 * j) = pack4(o); } } }
}

DI void dma_rows256(const bf16* src0, size_t pitch, int nrows, LAS unsigned char* dst, int w, int lane) {
    const int lr = lane >> 4, pc = lane & 15;
#pragma unroll 1
    for (int k = w; k < (nrows >> 2); k += 8) { const int r = k * 4 + lr; const int gc = pc ^ (r & 15);
        __builtin_amdgcn_global_load_lds((const unsigned*)(src0 + (size_t)r * pitch + gc * 8), (LAS unsigned*)(dst + k * 1024), 16, 0, 0); }
}
DI bf16x8 frag256(const LAS unsigned char* base, int row, int chunk) { return *(const LAS bf16x8*)(base + row * 256 + ((chunk ^ (row & 15)) * 16)); }
DI v2u frag256h(const LAS unsigned char* base, int row, int chunk, int half) { return *(const LAS v2u*)(base + row * 256 + ((chunk ^ (row & 15)) * 16) + half * 8); }
DI void p2_ret_state_wg(Frame& F, int u) {
    const int c = u >> 2, h = u & 3, w = F.wave, col = F.lane & 15, kq = F.lane >> 4;
    const float l2g = log2f(1.0f - __builtin_amdgcn_exp2f((float)(-5 - h)));
    const bf16* TOUT = WSP(const bf16, WS_TOUT); LAS unsigned char* L = F.lds;
    asm volatile("s_waitcnt vmcnt(0) lgkmcnt(0)" ::: "memory"); __builtin_amdgcn_s_barrier();
    dma_rows256(TOUT + (size_t)(768 + h * 256) * TP + c * 128, TP, 256, L, w, F.lane);
    dma_rows256(TOUT + (size_t)(256 + h * 128) * TP + c * 128, TP, 128, L + 65536, w, F.lane);
    asm volatile("s_waitcnt vmcnt(0)" ::: "memory"); __builtin_amdgcn_s_barrier(); asm volatile("" ::: "memory");
    f32x4 acc[16];
#pragma unroll
    for (int i = 0; i < 16; ++i) acc[i] = (f32x4){0.f, 0.f, 0.f, 0.f};
#pragma unroll
    for (int ks = 0; ks < 4; ++ks) {
        const v4u kr = __builtin_bit_cast(v4u, frag256(L + 65536, w * 16 + col, ks * 4 + kq)); float kv[8] = {bflo(kr.x), bfhi(kr.x), bflo(kr.y), bfhi(kr.y), bflo(kr.z), bfhi(kr.z), bflo(kr.w), bfhi(kr.w)};
#pragma unroll
        for (int e = 0; e < 8; ++e) kv[e] *= __builtin_amdgcn_exp2f((float)(127 - (ks * 32 + kq * 8 + e)) * l2g);
        v4u ks4 = {pk2(kv[0], kv[1]), pk2(kv[2], kv[3]), pk2(kv[4], kv[5]), pk2(kv[6], kv[7])}; const bf16x8 kf = __builtin_bit_cast(bf16x8, ks4);
#pragma unroll
        for (int dvt = 0; dvt < 16; ++dvt) acc[dvt] = mfma16(kf, frag256(L, dvt * 16 + col, ks * 4 + kq), acc[dvt]);
    }
    bf16* UR = WSP(bf16, WS_UR) + ((size_t)(c * 4 + h) * 256) * 128;
#pragma unroll
    for (int dvt = 0; dvt < 16; ++dvt) *(v2u*)(UR + (size_t)(dvt * 16 + col) * 128 + w * 16 + 4 * kq) = pack4(acc[dvt]);
}
DI void p2_cmp_hidden(Frame& F, int u) {
    const int combo = u >> 8, kind = combo >> 1, g = combo & 1, rt = (u >> 2) & 63, nq = u & 3, col = F.lane & 15, kq = F.lane >> 4;
    const bf16* W1 = WSP(const bf16, WS_WC1) + (size_t)kind * 256 * 2048 + (size_t)(nq * 64 + col) * 2048 + kq * 8;
    int tokb = 16 * (rt * 16 + col); tokb = tokb < S - 32 ? tokb : S - 32;
    const bf16* KCV = WSP(const bf16, WS_KCV) + (size_t)tokb * 512 + kind * 128 + g * 64 + kq * 8;
    f32x4 acc[4];
#pragma unroll
    for (int i = 0; i < 4; ++i) acc[i] = (f32x4){0.f, 0.f, 0.f, 0.f};
#pragma unroll 8
    for (int st = 0; st < 64; ++st) {
        const bf16x8 bfr = ld16(KCV + (size_t)(st >> 1) * 512 + (st & 1) * 32);
#pragma unroll
        for (int nt = 0; nt < 4; ++nt) { const bf16x8 af = ld16(W1 + (size_t)nt * 16 * 2048 + st * 32); acc[nt] = mfma16(af, bfr, acc[nt]); }
    }
    const float* b1 = WSP(const float, WS_SM + SM_B1) + kind * 256; bf16* HC = WSP(bf16, WS_HIDC) + (size_t)combo * 1024 * 256;
#pragma unroll
    for (int nt = 0; nt < 4; ++nt) { const int n0 = nq * 64 + nt * 16 + 4 * kq; const f32x4 bb = *(const f32x4*)(b1 + n0); f32x4 v = acc[nt] + bb;
#pragma unroll
        for (int i = 0; i < 4; ++i) v[i] = gelu_tanh(v[i]);
        *(v2u*)(HC + (size_t)(rt * 16 + col) * 256 + n0) = pack4(v); }
}
DI void p2_kmax(Frame& F, int u) {
    const int tok = u * 64 + F.lane; const bf16* KCV = WSP(const bf16, WS_KCV) + (size_t)tok * 512 + 256;
#pragma unroll
    for (int q = 0; q < 4; ++q) { float s = 0.f;
#pragma unroll
        for (int j = 0; j < 8; ++j) { const v4u k = *(const v4u*)(KCV + q * 64 + j * 8);
            const float a0 = bflo(k.x), a1 = bfhi(k.x), a2 = bflo(k.y), a3 = bfhi(k.y), a4 = bflo(k.z), a5 = bfhi(k.z), a6 = bflo(k.w), a7 = bfhi(k.w);
            s += (a0 * a0 + a1 * a1) + (a2 * a2 + a3 * a3) + (a4 * a4 + a5 * a5) + (a6 * a6 + a7 * a7); }
        const unsigned m = wave_max_u32(__float_as_uint(s));
        if (F.lane == 0) atomicMax(F.ctl + CW_KMAX + q, m); }
}
DI void p3_scan(Frame& F) {
    const int idx = blockIdx.x * NTHR + F.tid;
    if (idx < 65536) {
        const int h = idx >> 14; const float cd = __builtin_amdgcn_exp2f(128.0f * log2f(1.0f - __builtin_amdgcn_exp2f((float)(-5 - h))));
        unsigned* UR = WSP(unsigned, WS_UR) + idx; float r0 = 0.f, r1 = 0.f;
#pragma unroll 32
        for (int c = 0; c < 128; ++c) { const unsigned u = UR[(size_t)c * 65536]; UR[(size_t)c * 65536] = pk2(r0, r1); r0 = r0 * cd + bflo(u); r1 = r1 * cd + bfhi(u); }
    }
}
DI void p3_kcvc(Frame& F, int u) {
    const int combo = u >> 6, kind = combo >> 1, g = combo & 1, rt = u & 63, col = F.lane & 15, kq = F.lane >> 4;
    const bf16* HC = WSP(const bf16, WS_HIDC) + (size_t)combo * 1024 * 256 + (size_t)(rt * 16 + col) * 256 + kq * 8;
    const bf16* W2 = WSP(const bf16, WS_SM + SM_W2T) + (size_t)kind * 64 * 256 + (size_t)col * 256 + kq * 8;
    f32x4 acc[4];
#pragma unroll
    for (int i = 0; i < 4; ++i) acc[i] = (f32x4){0.f, 0.f, 0.f, 0.f};
#pragma unroll
    for (int ks = 0; ks < 8; ++ks) { const bf16x8 hf = ld16(HC + ks * 32);
#pragma unroll
        for (int dt = 0; dt < 4; ++dt) { const bf16x8 wf = ld16(W2 + (size_t)dt * 16 * 256 + ks * 32); acc[dt] = kind ? mfma16(hf, wf, acc[dt]) : mfma16(wf, hf, acc[dt]); } }
    if (kind == 0) { bf16* KC = WSP(bf16, WS_SM + SM_KC) + (size_t)g * 1024 * 64;
#pragma unroll
        for (int dt = 0; dt < 4; ++dt) *(v2u*)(KC + (size_t)(rt * 16 + col) * 64 + dt * 16 + 4 * kq) = pack4(acc[dt]); }
    else { bf16* VCT = WSP(bf16, WS_SM + SM_VCT) + (size_t)g * 64 * 1024;
#pragma unroll
        for (int dt = 0; dt < 4; ++dt) *(v2u*)(VCT + (size_t)(dt * 16 + col) * 1024 + rt * 16 + 4 * kq) = pack4(acc[dt]); }
}

DI void p4_bias_table(Frame& F) {
    LAS float* bt = (LAS float*)(F.lds + BIAS_OFF); const float* rb = F.A->in[1];
    for (int i = F.tid; i < 129 * 8; i += NTHR) { const int dist = i >> 3, hd = i & 7; int b = dist;
        if (dist >= 16) { b = 16 + (int)(logf((float)dist / 16.0f) / 2.0794415416798357f * 16.0f); b = b < 31 ? b : 31; }
        bt[i] = rb[b * 8 + hd] * LOG2E; }
    __syncthreads();
    if (F.tid < 64) { float m = 0.f; for (int i = F.tid; i < 129 * 8; i += 64) m = fmaxf(m, fabsf(bt[i]));
#pragma unroll
        for (int o = 1; o < 64; o <<= 1) m = fmaxf(m, __shfl_xor(m, o));
        if (F.tid == 0) bt[129 * 8] = m; }
    __syncthreads();
}
DI void p4a_unit(Frame& F, int qt, int g, int dbg) {
    const bool noval = dbg & 1024, noload = dbg & 2048;
    const int lane = F.lane, col = lane & 15, rq = lane >> 4, t0 = qt * 16, tq = t0 + col;
    LAS float* wl = (LAS float*)(F.lds + F.wave * WAVE_LDS);
    const LAS float* bt = (const LAS float*)(F.lds + BIAS_OFF);
    const float bmax = bt[129 * 8];
    const bf16* QA = WSP(const bf16, WS_QA); const bf16* KCV = WSP(const bf16, WS_KCV); const bf16* TOUT = WSP(const bf16, WS_TOUT); const bf16* GA = WSP(const bf16, WS_GA);
    const bf16* KC = WSP(const bf16, WS_SM + SM_KC) + (size_t)g * 1024 * 64; const bf16* VCT = WSP(const bf16, WS_SM + SM_VCT) + (size_t)g * 64 * 1024;
    const float kmax_sel = sqrtf(__uint_as_float(F.ctl[CW_KMAX + g])), kmax_win = sqrtf(__uint_as_float(F.ctl[CW_KMAX + 2 + g]));
    bf16x8 qf[4][2]; float qn[4];
#pragma unroll
    for (int j = 0; j < 4; ++j) { float s = 0.f;
#pragma unroll
        for (int ks = 0; ks < 2; ++ks) { const v4u q = *(const v4u*)(QA + (size_t)tq * 512 + (g * 4 + j) * 64 + ks * 32 + rq * 8); qf[j][ks] = __builtin_bit_cast(bf16x8, q);
            const float a0 = bflo(q.x), a1 = bfhi(q.x), a2 = bflo(q.y), a3 = bfhi(q.y), a4 = bflo(q.z), a5 = bfhi(q.z), a6 = bflo(q.w), a7 = bfhi(q.w);
            s += (a0 * a0 + a1 * a1) + (a2 * a2 + a3 * a3) + (a4 * a4 + a5 * a5) + (a6 * a6 + a7 * a7); }
        qn[j] = sqrtf(quad_sum(s)); }
    const f32x4 z4 = {0.f, 0.f, 0.f, 0.f};
    f32x4 ACC[4][4];
#pragma unroll
    for (int j = 0; j < 4; ++j)
#pragma unroll
        for (int dt = 0; dt < 4; ++dt) ACC[j][dt] = z4;
    {
        float lw[4], bw[4];
#pragma unroll
        for (int j = 0; j < 4; ++j) { lw[j] = 0.f; bw[j] = qn[j] * kmax_win + bmax; }
        int pstart = (t0 - 511) & ~31; pstart = pstart < 0 ? 0 : pstart;
        for (int p0 = pstart; p0 <= t0 + 15; p0 += 32) {
            const bool farw = noval || ((p0 + 31 <= t0 - 128) && (p0 > t0 + 15 - 512));
            bf16x8 kf[2][2], vf[4]; const int p0l = noload ? pstart : p0;
#pragma unroll
            for (int kt = 0; kt < 2; ++kt)
#pragma unroll
                for (int ks = 0; ks < 2; ++ks) kf[kt][ks] = ld16(KCV + (size_t)(p0l + kt * 16 + col) * 512 + 384 + g * 64 + ks * 32 + rq * 8);
#pragma unroll
            for (int dt = 0; dt < 4; ++dt) vf[dt] = ld8x2(TOUT + (size_t)(128 + g * 64 + dt * 16 + col) * TP + p0l + 4 * rq, 16);
#pragma unroll
            for (int j = 0; j < 4; ++j) {
                f32x4 p[2];
#pragma unroll
                for (int kt = 0; kt < 2; ++kt) { f32x4 s = mfma16(kf[kt][0], qf[j][0], z4); s = mfma16(kf[kt][1], qf[j][1], s);
                    if (farw) {
                        const float cf = bt[128 * 8 + g * 4 + j] - bw[j];
#pragma unroll
                        for (int e = 0; e < 4; ++e) { const float v = __builtin_amdgcn_exp2f(s[e] + cf); p[kt][e] = v; lw[j] += v; }
                    } else {
#pragma unroll
                    for (int e = 0; e < 4; ++e) { const int dist = tq - (p0 + kt * 16 + 4 * rq + e); const int dc = dist < 0 ? 0 : (dist > 128 ? 128 : dist);
                        const float v = (dist >= 0 && dist < 512) ? __builtin_amdgcn_exp2f(s[e] + bt[dc * 8 + g * 4 + j] - bw[j]) : 0.f; p[kt][e] = v; lw[j] += v; } } }
                const bf16x8 pb = pack8(p[0], p[1]);
#pragma unroll
                for (int dt = 0; dt < 4; ++dt) ACC[j][dt] = mfma16(vf[dt], pb, ACC[j][dt]);
            }
        }
#pragma unroll
        for (int j = 0; j < 4; ++j) { const float sc = bf1(GA[(size_t)tq * 32 + 16 + g * 4 + j]) / quad_sum(lw[j]);
#pragma unroll
            for (int dt = 0; dt < 4; ++dt) ACC[j][dt] = ACC[j][dt] * sc; }
    }
    const int nkc = qt < 1023 ? qt : 1023, nst = (nkc + 31) >> 5;
    float m1[4], l1[4];
#pragma unroll
    for (int j = 0; j < 4; ++j) { m1[j] = -1e30f; l1[j] = 0.f; }
    for (int st = 0; st < nst; ++st) {
        const bool farc = noval || 16 * (st * 32 + 31) + 31 <= t0 - 128;
        bf16x8 kf[2][2]; const int stl = noload ? 0 : st;
#pragma unroll
        for (int kt = 0; kt < 2; ++kt)
#pragma unroll
            for (int ks = 0; ks < 2; ++ks) kf[kt][ks] = ld16(KC + (size_t)(stl * 32 + kt * 16 + col) * 64 + ks * 32 + rq * 8);
#pragma unroll
        for (int j = 0; j < 4; ++j) {
            float sv[8]; float tm = -1e30f;
#pragma unroll
            for (int kt = 0; kt < 2; ++kt) { f32x4 s = mfma16(kf[kt][0], qf[j][0], z4); s = mfma16(kf[kt][1], qf[j][1], s);
                if (farc) { const float bf_ = bt[128 * 8 + g * 4 + j];
#pragma unroll
                    for (int e = 0; e < 4; ++e) { const float v = s[e] + bf_; sv[kt * 4 + e] = v; tm = fmaxf(tm, v); }
                } else {
#pragma unroll
                for (int e = 0; e < 4; ++e) { const int ci = st * 32 + kt * 16 + 4 * rq + e, dist = tq - (16 * ci + 31); const int dc = dist < 0 ? 0 : (dist > 128 ? 128 : dist);
                    const float v = dist >= 0 ? s[e] + bt[dc * 8 + g * 4 + j] : -1e30f; sv[kt * 4 + e] = v; tm = fmaxf(tm, v); } } }
            const float mn = fmaxf(m1[j], tm); float ls = 0.f;
#pragma unroll
            for (int e = 0; e < 8; ++e) ls += sv[e] > -1e29f ? __builtin_amdgcn_exp2f(sv[e] - mn) : 0.f;
            l1[j] = l1[j] * __builtin_amdgcn_exp2f(m1[j] - mn) + ls; m1[j] = mn;
        }
    }
    float mc[4], ilc[4];
#pragma unroll
    for (int j = 0; j < 4; ++j) { const float M = quad_max(m1[j]); const float l = quad_sum(l1[j] * __builtin_amdgcn_exp2f(m1[j] - M)); mc[j] = M; ilc[j] = l > 0.f ? 1.0f / l : 0.f; }
    {
        float gcmp[4];
#pragma unroll
        for (int j = 0; j < 4; ++j) gcmp[j] = bf1(GA[(size_t)tq * 32 + g * 4 + j]);
        float xprev = 0.f;
        for (int st = 0; st < nst; ++st) {
            const bool farc = noval || 16 * (st * 32 + 31) + 31 <= t0 - 128;
            bf16x8 kf[2][2], vf[4]; const int stl = noload ? 0 : st;
#pragma unroll
            for (int kt = 0; kt < 2; ++kt)
#pragma unroll
                for (int ks = 0; ks < 2; ++ks) kf[kt][ks] = ld16(KC + (size_t)(stl * 32 + kt * 16 + col) * 64 + ks * 32 + rq * 8);
#pragma unroll
            for (int dt = 0; dt < 4; ++dt) vf[dt] = ld8x2(VCT + (size_t)(dt * 16 + col) * 1024 + stl * 32 + 4 * rq, 16);
            f32x4 ps[2] = {z4, z4};
#pragma unroll
            for (int j = 0; j < 4; ++j) {
                f32x4 p[2];
#pragma unroll
                for (int kt = 0; kt < 2; ++kt) { f32x4 s = mfma16(kf[kt][0], qf[j][0], z4); s = mfma16(kf[kt][1], qf[j][1], s);
                    if (farc) { const float cf = bt[128 * 8 + g * 4 + j] - mc[j];
#pragma unroll
                        for (int e = 0; e < 4; ++e) { const float v = __builtin_amdgcn_exp2f(s[e] + cf) * ilc[j]; ps[kt][e] += v; p[kt][e] = v * gcmp[j]; }
                    } else {
#pragma unroll
                    for (int e = 0; e < 4; ++e) { const int ci = st * 32 + kt * 16 + 4 * rq + e, dist = tq - (16 * ci + 31); const int dc = dist < 0 ? 0 : (dist > 128 ? 128 : dist);
                        const float v = dist >= 0 ? __builtin_amdgcn_exp2f(s[e] + bt[dc * 8 + g * 4 + j] - mc[j]) * ilc[j] : 0.f; ps[kt][e] += v; p[kt][e] = v * gcmp[j]; } } }
                const bf16x8 pb = pack8(p[0], p[1]);
#pragma unroll
                for (int dt = 0; dt < 4; ++dt) ACC[j][dt] = mfma16(vf[dt], pb, ACC[j][dt]);
            }
#pragma unroll
            for (int kt = 0; kt < 2; ++kt) {
                const float Gs = (ps[kt][0] + ps[kt][1]) + (ps[kt][2] + ps[kt][3]), X = ps[kt][3];
                const float xa = __shfl(X, (lane + 48) & 63), xb = __shfl(xprev, (lane + 48) & 63);
                const float xin = rq > 0 ? xa : xb;
                wl[col * 257 + st * 8 + kt * 4 + rq] = Gs + xin; xprev = X;
            }
        }
    }
    float* PART = F.out + (size_t)tq * 512 + g * 256;
#pragma unroll
    for (int j = 0; j < 4; ++j)
#pragma unroll
        for (int dt = 0; dt < 4; ++dt) *(f32x4*)(PART + j * 64 + dt * 16 + 4 * rq) = ACC[j][dt];
    LDS_WAIT();
    unsigned long long* SELM = (unsigned long long*)((unsigned char*)F.out + (size_t)32 * MiB);
    for (int i = 0; i < 16; ++i) {
        const int cur = (t0 + i) >> 6; unsigned k[4];
#pragma unroll
        for (int e = 0; e < 4; ++e) { const int n = lane * 4 + e; const float v = wl[i * 257 + n];
            k[e] = (n == 0 || (n <= cur && n + 2 > cur)) ? 0x7F000000u : (n <= cur ? __float_as_uint(v) + 1u : 0u); }
        unsigned T = 0u;
#pragma unroll 1
        for (int bit = 30; bit >= 0; --bit) { const unsigned c = T | (1u << bit);
            const int cnt = __popcll(__ballot(k[0] >= c)) + __popcll(__ballot(k[1] >= c)) + __popcll(__ballot(k[2] >= c)) + __popcll(__ballot(k[3] >= c));
            if (cnt >= 16) T = c; }
        unsigned long long bsel[4]; int ngt = 0;
#pragma unroll
        for (int e = 0; e < 4; ++e) { bsel[e] = __ballot(k[e] > T && k[e] != 0u); ngt += __popcll(bsel[e]); }
        if (T != 0u) {
            int need = 16 - ngt;
            unsigned long long beq[4];
#pragma unroll
            for (int e = 0; e < 4; ++e) beq[e] = __ballot(k[e] == T);
            while (need > 0) {
                int bestn = 1 << 30, be = 0;
#pragma unroll
                for (int e = 0; e < 4; ++e) if (beq[e]) { const int n = 4 * (__ffsll((long long)beq[e]) - 1) + e; if (n < bestn) { bestn = n; be = e; } }
                if (bestn == (1 << 30)) break;
                const unsigned long long bitm = 1ull << (bestn >> 2);
                if (be == 0) { bsel[0] |= bitm; beq[0] &= ~bitm; } else if (be == 1) { bsel[1] |= bitm; beq[1] &= ~bitm; } else if (be == 2) { bsel[2] |= bitm; beq[2] &= ~bitm; } else { bsel[3] |= bitm; beq[3] &= ~bitm; }
                --need;
            }
        }
        if (lane < 4) SELM[((size_t)(t0 + i) * 2 + g) * 4 + lane] = lane == 0 ? bsel[0] : (lane == 1 ? bsel[1] : (lane == 2 ? bsel[2] : bsel[3]));
    }
    LDS_WAIT();
}
constexpr int B_NSLOT = 8;
DI void p4b_pass(LAS unsigned char* ldsb, unsigned char* ws, float* outp, int tile, int g) {
    Frame F; F.lds = ldsb; F.ws = ws; F.out = outp; F.ctl = (unsigned*)(ws + WS_CTL); F.tid = threadIdx.x; F.lane = F.tid & 63; F.wave = __builtin_amdgcn_readfirstlane(F.tid >> 6); F.G = gridDim.x; F.gw = 0; F.ngw = 0; F.A = nullptr;
    const int lane = F.lane, w = F.wave, col = lane & 15, rq = lane >> 4, T0 = tile * 64, cur = tile, hj = col & 3;
    LAS unsigned char* L = F.lds;
    const LAS float* bt = (const LAS float*)(L + BIAS_OFF); const float bmax = bt[129 * 8];
    const bf16* QA = WSP(const bf16, WS_QA); const bf16* KCV = WSP(const bf16, WS_KCV); const bf16* TOUT = WSP(const bf16, WS_TOUT); const bf16* GA = WSP(const bf16, WS_GA);
    const float kmax_sel = sqrtf(__uint_as_float(F.ctl[CW_KMAX + g]));
    const unsigned long long* SELM = (const unsigned long long*)((const unsigned char*)F.out + (size_t)32 * MiB);
    bf16x8 qb[2][2]; float bnd[2]; unsigned long long pk[2][4]; int tq[2];
#pragma unroll
    for (int ct = 0; ct < 2; ++ct) { const int t = T0 + w * 8 + ct * 4 + (col >> 2); tq[ct] = t; float s = 0.f;
#pragma unroll
        for (int ks = 0; ks < 2; ++ks) { const v4u q = *(const v4u*)(QA + (size_t)t * 512 + (g * 4 + hj) * 64 + ks * 32 + rq * 8); qb[ct][ks] = __builtin_bit_cast(bf16x8, q);
            const float a0 = bflo(q.x), a1 = bfhi(q.x), a2 = bflo(q.y), a3 = bfhi(q.y), a4 = bflo(q.z), a5 = bfhi(q.z), a6 = bflo(q.w), a7 = bfhi(q.w);
            s += (a0 * a0 + a1 * a1) + (a2 * a2 + a3 * a3) + (a4 * a4 + a5 * a5) + (a6 * a6 + a7 * a7); }
        bnd[ct] = sqrtf(quad_sum(s)) * kmax_sel + bmax;
#pragma unroll
        for (int e = 0; e < 4; ++e) pk[ct][e] = SELM[((size_t)t * 2 + g) * 4 + e]; }
    const f32x4 z4 = {0.f, 0.f, 0.f, 0.f};
    f32x4 O[2][4]; float ls[2] = {0.f, 0.f};
#pragma unroll
    for (int ct = 0; ct < 2; ++ct)
#pragma unroll
        for (int dt = 0; dt < 4; ++dt) O[ct][dt] = z4;
    const float bfar = bt[128 * 8 + g * 4 + hj];
    const int dr = lane >> 3, dc = (lane & 7) ^ dr, nb = cur + 1;
    const bf16* kbase = KCV + (size_t)(w * 8 + dr) * 512 + 256 + g * 64 + dc * 8;
    const bf16* vbase = TOUT + (size_t)(g * 64 + w * 8 + dr) * TP + dc * 8;
#define P4B_ISSUE(blk_, slot) do { \
        __builtin_amdgcn_global_load_lds((const unsigned*)(kbase + (size_t)(blk_) * 64 * 512), (LAS unsigned*)(L + (slot) * 16384 + w * 1024), 16, 0, 0); \
        __builtin_amdgcn_global_load_lds((const unsigned*)(vbase + (size_t)(blk_) * 64), (LAS unsigned*)(L + (slot) * 16384 + 8192 + w * 1024), 16, 0, 0); } while (0)
    asm volatile("s_waitcnt vmcnt(0)" ::: "memory");
    __builtin_amdgcn_s_barrier();
    const int ngrp = (nb + 3) >> 2;
#pragma unroll 1
    for (int b4 = 0; b4 < 4; ++b4) if (b4 < nb) P4B_ISSUE(b4, b4);
#pragma unroll 1
    for (int gi = 0; gi < ngrp; ++gi) {
        asm volatile("s_waitcnt vmcnt(0)" ::: "memory");
        asm volatile("s_waitcnt lgkmcnt(0)" ::: "memory"); __builtin_amdgcn_s_barrier(); asm volatile("" ::: "memory");
#pragma unroll 1
        for (int b4 = 0; b4 < 4; ++b4) { const int nblk = (gi + 1) * 4 + b4; if (nblk < nb) P4B_ISSUE(nblk, ((gi + 1) & 1) * 4 + b4); }
#pragma unroll 1
      for (int b4 = 0; b4 < 4; ++b4) {
        const int i = gi * 4 + b4; if (i >= nb) break;
        const int blk = i; const LAS unsigned char* ring = L + ((gi & 1) * 4 + b4) * 16384;
        const int eb = blk & 3, Lb = blk >> 2;
#pragma unroll
        for (int ct = 0; ct < 2; ++ct) {
            const unsigned long long word = eb == 0 ? pk[ct][0] : (eb == 1 ? pk[ct][1] : (eb == 2 ? pk[ct][2] : pk[ct][3]));
            const bool pick = (word >> Lb) & 1ull;
            if (__ballot(pick) == 0ull) continue;
            f32x4 sacc[4];
#pragma unroll
            for (int kt = 0; kt < 4; ++kt) { const int key = kt * 16 + col;
                const bf16x8 k0 = *(const LAS bf16x8*)(ring + key * 128 + ((rq ^ (key & 7)) * 16)), k1 = *(const LAS bf16x8*)(ring + key * 128 + (((4 + rq) ^ (key & 7)) * 16));
                sacc[kt] = mfma16(k0, qb[ct][0], z4); sacc[kt] = mfma16(k1, qb[ct][1], sacc[kt]); }
            float lsum = 0.f;
            if (blk + 3 <= cur) {
                const float bb = bfar - bnd[ct];
#pragma unroll
                for (int kt = 0; kt < 4; ++kt)
#pragma unroll
                    for (int e = 0; e < 4; ++e) { const float v = pick ? __builtin_amdgcn_exp2f(sacc[kt][e] + bb) : 0.f; sacc[kt][e] = v; lsum += v; }
            } else {
#pragma unroll
                for (int kt = 0; kt < 4; ++kt)
#pragma unroll
                    for (int e = 0; e < 4; ++e) { const int dist = tq[ct] - (blk * 64 + kt * 16 + 4 * rq + e); const int dcl = dist < 0 ? 0 : (dist > 128 ? 128 : dist);
                        const float v = (pick && dist >= 0) ? __builtin_amdgcn_exp2f(sacc[kt][e] + bt[dcl * 8 + g * 4 + hj] - bnd[ct]) : 0.f; sacc[kt][e] = v; lsum += v; }
            }
            ls[ct] += lsum;
            const bf16x8 pb0 = pack8(sacc[0], sacc[1]), pb1 = pack8(sacc[2], sacc[3]);
#pragma unroll
            for (int dt = 0; dt < 4; ++dt) { const int d = dt * 16 + col; const LAS unsigned char* vr = ring + 8192 + d * 128 + (rq & 1) * 8; const int sw = d & 7, c0 = rq >> 1;
                const v2u a0 = *(const LAS v2u*)(vr + ((c0 ^ sw) * 16)), a1 = *(const LAS v2u*)(vr + (((c0 + 2) ^ sw) * 16)), a2 = *(const LAS v2u*)(vr + (((c0 + 4) ^ sw) * 16)), a3 = *(const LAS v2u*)(vr + (((c0 + 6) ^ sw) * 16));
                v4u v0 = {a0.x, a0.y, a1.x, a1.y}, v1 = {a2.x, a2.y, a3.x, a3.y};
                O[ct][dt] = mfma16(__builtin_bit_cast(bf16x8, v0), pb0, O[ct][dt]); O[ct][dt] = mfma16(__builtin_bit_cast(bf16x8, v1), pb1, O[ct][dt]); }
        }
      }
    }
#pragma unroll
    for (int ct = 0; ct < 2; ++ct) { const int t = tq[ct]; const float sc = bf1(GA[(size_t)t * 32 + 8 + g * 4 + hj]) / quad_sum(ls[ct]);
        const float* part = F.out + (size_t)t * 512 + g * 256 + hj * 64; bf16* ya = WSP(bf16, WS_QA) + (size_t)t * 512 + (g * 4 + hj) * 64;
#pragma unroll
        for (int dt = 0; dt < 4; ++dt) { const f32x4 p = *(const f32x4*)(part + dt * 16 + 4 * rq); const f32x4 o = p + O[ct][dt] * sc; *(v2u*)(ya + dt * 16 + 4 * rq) = pack4(o); } }
    asm volatile("s_waitcnt vmcnt(0) lgkmcnt(0)" ::: "memory");
#undef P4B_ISSUE
}
DI void p4_ret_wg(Frame& F, int u) {
    const int c = u >> 2, h = u & 3, q8 = F.wave, lane = F.lane, col = lane & 15, rq = lane >> 4;
    const int il = q8 * 16 + col, tq = c * 128 + il;
    const float l2g = log2f(1.0f - __builtin_amdgcn_exp2f((float)(-5 - h)));
    const bf16* QR = WSP(const bf16, WS_QR); const bf16* KR = WSP(const bf16, WS_KR); const bf16* TOUT = WSP(const bf16, WS_TOUT); LAS unsigned char* L = F.lds;
    const bf16* RT = WSP(const bf16, WS_UR) + ((size_t)(c * 4 + h) * 256) * 128;
    asm volatile("s_waitcnt vmcnt(0) lgkmcnt(0)" ::: "memory"); __builtin_amdgcn_s_barrier();
    dma_rows256(RT, 128, 256, L, F.wave, lane);
    bf16x8 qf[4];
#pragma unroll
    for (int ks = 0; ks < 4; ++ks) qf[ks] = ld16(QR + (size_t)tq * 512 + h * 128 + ks * 32 + rq * 8);
    asm volatile("s_waitcnt vmcnt(0)" ::: "memory"); __builtin_amdgcn_s_barrier(); asm volatile("" ::: "memory");
    f32x4 ACC[16]; const f32x4 z4 = {0.f, 0.f, 0.f, 0.f};
#pragma unroll
    for (int i = 0; i < 16; ++i) ACC[i] = z4;
#pragma unroll
    for (int ks = 0; ks < 4; ++ks)
#pragma unroll
        for (int dvt = 0; dvt < 16; ++dvt) ACC[dvt] = mfma16(frag256(L, dvt * 16 + col, ks * 4 + rq), qf[ks], ACC[dvt]);
    { const float qd = __builtin_amdgcn_exp2f((float)(il + 1) * l2g);
#pragma unroll
      for (int i = 0; i < 16; ++i) ACC[i] = ACC[i] * qd; }
    asm volatile("s_waitcnt lgkmcnt(0)" ::: "memory"); __builtin_amdgcn_s_barrier(); asm volatile("" ::: "memory");
    dma_rows256(TOUT + (size_t)(768 + h * 256) * TP + c * 128, TP, 256, L, F.wave, lane);
    dma_rows256(KR + (size_t)(c * 128) * 512 + h * 128, 512, 128, L + 65536, F.wave, lane);
    asm volatile("s_waitcnt vmcnt(0)" ::: "memory"); __builtin_amdgcn_s_barrier(); asm volatile("" ::: "memory");
    const int nkp = (q8 * 16 + 16 + 31) >> 5;
    for (int kp = 0; kp < nkp; ++kp) {
        f32x4 p[2];
#pragma unroll
        for (int kt = 0; kt < 2; ++kt) { f32x4 s = z4;
#pragma unroll
            for (int ks = 0; ks < 4; ++ks) s = mfma16(frag256(L + 65536, kp * 32 + kt * 16 + col, ks * 4 + rq), qf[ks], s);
#pragma unroll
            for (int e = 0; e < 4; ++e) { const int dj = il - (kp * 32 + kt * 16 + 4 * rq + e); p[kt][e] = dj >= 0 ? s[e] * __builtin_amdgcn_exp2f((float)dj * l2g) : 0.f; } }
        const bf16x8 pb = pack8(p[0], p[1]);
#pragma unroll
        for (int dvt = 0; dvt < 16; ++dvt) { const v2u lo = frag256h(L, dvt * 16 + col, kp * 4 + (rq >> 1), rq & 1), hi = frag256h(L, dvt * 16 + col, kp * 4 + 2 + (rq >> 1), rq & 1);
            v4u v = {lo.x, lo.y, hi.x, hi.y}; ACC[dvt] = mfma16(__builtin_bit_cast(bf16x8, v), pb, ACC[dvt]); }
    }
    float s1 = 0.f;
#pragma unroll
    for (int i = 0; i < 16; ++i) s1 += (ACC[i][0] + ACC[i][1]) + (ACC[i][2] + ACC[i][3]);
    const float mu = quad_sum(s1) * (1.0f / 256.0f); float s2 = 0.f;
#pragma unroll
    for (int i = 0; i < 16; ++i) { ACC[i] = ACC[i] - mu; s2 += (ACC[i][0] * ACC[i][0] + ACC[i][1] * ACC[i][1]) + (ACC[i][2] * ACC[i][2] + ACC[i][3] * ACC[i][3]); }
    const float rs = 1.0f / sqrtf(quad_sum(s2) * (1.0f / 256.0f) + EPS);
    bf16* GR = WSP(bf16, WS_GR) + (size_t)tq * 1024 + h * 256; const float* rn = F.A->in[10] + h * 256;
#pragma unroll
    for (int dvt = 0; dvt < 16; ++dvt) { const int d0 = dvt * 16 + 4 * rq; const v2u gv = *(const v2u*)(GR + d0); const f32x4 w = *(const f32x4*)(rn + d0);
        f32x4 o; o[0] = siluf_(bflo(gv.x)) * ACC[dvt][0] * rs * w[0]; o[1] = siluf_(bfhi(gv.x)) * ACC[dvt][1] * rs * w[1]; o[2] = siluf_(bflo(gv.y)) * ACC[dvt][2] * rs * w[2]; o[3] = siluf_(bfhi(gv.y)) * ACC[dvt][3] * rs * w[3];
        *(v2u*)(GR + d0) = pack4(o); }
}

DI int moe_row(int f) { const int fp = f & 127; return (f >> 7) * 256 + 128 * (fp >> 6) + 32 * ((fp >> 4) & 3) + 4 * ((fp >> 2) & 3) + (fp & 3); }
DI void p8_route_item(Frame& F, int item) {
    const int lane = F.lane, row = lane & 15, kq = lane >> 4, m0 = item * 16, slot = F.wave & 3, hh = F.wave >> 2; const float* x1 = F.out; bf16* H2 = WSP(bf16, WS_H);
    LAS float* lg = (LAS float*)(F.lds + slot * WAVE_LDS);
    LAS float* ex = (LAS float*)(F.lds + slot * WAVE_LDS + 3200);
    const float* WRT = WSP(const float, WS_SM + SM_WRT);
    const float* xr = x1 + (size_t)(m0 + row) * 1024 + 4 * kq + hh * 512; const float* wr = WRT + (size_t)row * 1024 + 4 * kq + hh * 512;
    f32x4 acc[3]; float ss = 0.f;
#pragma unroll
    for (int ct = 0; ct < 3; ++ct) acc[ct] = (f32x4){0.f, 0.f, 0.f, 0.f};
#pragma unroll 8
    for (int c = 0; c < 32; ++c) {
        const f32x4 xa = *(const f32x4*)(xr + 16 * c); ss += (xa[0] * xa[0] + xa[1] * xa[1]) + (xa[2] * xa[2] + xa[3] * xa[3]);
#pragma unroll
        for (int ct = 0; ct < 3; ++ct) { const f32x4 wb = *(const f32x4*)(wr + (size_t)ct * 16 * 1024 + 16 * c);
#pragma unroll
            for (int j = 0; j < 4; ++j) acc[ct] = __builtin_amdgcn_mfma_f32_16x16x4f32(xa[j], wb[j], acc[ct], 0, 0, 0); }
    }
    if (hh == 1) {
#pragma unroll
        for (int ct = 0; ct < 3; ++ct)
#pragma unroll
            for (int j = 0; j < 4; ++j) ex[(ct * 4 + j) * 64 + lane] = acc[ct][j];
        ex[12 * 64 + lane] = ss;
    }
    LDS_WAIT(); __syncthreads();
    if (hh == 0) {
#pragma unroll
        for (int ct = 0; ct < 3; ++ct)
#pragma unroll
            for (int j = 0; j < 4; ++j) acc[ct][j] += ex[(ct * 4 + j) * 64 + lane];
        ss += ex[12 * 64 + lane];
        const float rs = 1.0f / sqrtf(quad_sum(ss) * (1.0f / 1024.0f) + EPS);
        if (kq == 0) lg[16 * 48 + row] = rs;
#pragma unroll
        for (int ct = 0; ct < 3; ++ct)
#pragma unroll
            for (int j = 0; j < 4; ++j) lg[(4 * kq + j) * 48 + ct * 16 + row] = acc[ct][j];
        LDS_WAIT();
        if (lane < 16) {
            const int t = m0 + lane; const float rst = lg[16 * 48 + lane]; float l[36];
#pragma unroll
            for (int o = 0; o < 36; ++o) l[o] = lg[lane * 48 + o] * rst + (o < 4 ? F.A->in[16][o] : F.A->in[18][o - 4]);
            int grp = 0; float mg = l[0];
#pragma unroll
            for (int i = 1; i < 4; ++i) if (l[i] > mg) { mg = l[i]; grp = i; }
            float Z = 0.f;
#pragma unroll
            for (int i = 0; i < 4; ++i) Z += expf(l[i] - mg);
            const float pg = 1.0f / Z;
            float le[8];
#pragma unroll
            for (int i = 0; i < 8; ++i) le[i] = grp == 0 ? l[4 + i] : (grp == 1 ? l[12 + i] : (grp == 2 ? l[20 + i] : l[28 + i]));
            int i1 = 0; float v1 = le[0];
#pragma unroll
            for (int i = 1; i < 8; ++i) if (le[i] > v1) { v1 = le[i]; i1 = i; }
            int i2 = -1; float v2 = -3.0e38f;
#pragma unroll
            for (int i = 0; i < 8; ++i) if (i != i1 && le[i] > v2) { v2 = le[i]; i2 = i; }
            const float e2 = expf(v2 - v1), w1 = pg / (1.0f + e2), w2 = pg * e2 / (1.0f + e2);
            const int ex1 = grp * 8 + i1, ex2 = grp * 8 + i2;
            const unsigned r1 = atomicAdd(F.ctl + CW_CNT + ex1, 1u), r2 = atomicAdd(F.ctl + CW_CNT + ex2, 1u);
            v2u* TOKR = WSP(v2u, WS_MISC);
            TOKR[t * 2 + 0] = (v2u){((unsigned)ex1 << 16) | r1, __float_as_uint(w1)};
            TOKR[t * 2 + 1] = (v2u){((unsigned)ex2 << 16) | r2, __float_as_uint(w2)};
        }
    }
    LDS_WAIT(); __syncthreads();
    { f32x4 w[4]; load_row(F.A->in[14], lane, w);
#pragma unroll 4
      for (int r8 = 0; r8 < 8; ++r8) { const int r = hh * 8 + r8; f32x4 v[4]; load_row(x1 + (size_t)(m0 + r) * 1024, lane, v); const float rst = lg[16 * 48 + r];
#pragma unroll
        for (int j = 0; j < 4; ++j) *(v2u*)(H2 + (size_t)(m0 + r) * 1024 + 4 * lane + 256 * j) = pack4(v[j] * rst * w[j]); } }
    LDS_WAIT(); __syncthreads();
}
DI void p8_moe_weights(Frame& F) {
    LAS float* scr = (LAS float*)(F.lds + F.wave * WAVE_LDS + 4096);
    bf16* WGU = WSP(bf16, WS_MOEW); bf16* WD = WGU + (size_t)32 * 512 * 1024;
    for (int it = F.gw; it < 3 * 4096; it += F.ngw) {
        const int which = it >> 12, r = it & 4095;
        if (which < 2) { const int e = r >> 7, q = r & 127, kb = q >> 3, nb = q & 7; bf16* dstb = WGU + (size_t)e * 512 * 1024 + (which ? 16 * 1024 : 0);
            tr_item((which ? F.A->in[20] : F.A->in[19]) + (size_t)e * 1024 * 256, 256, 256, 64 * kb, 32 * nb, scr, F.lane, [dstb](int n, int w2) { return w2 ? (bf16*)nullptr : dstb + (size_t)moe_row(n) * 1024; }); }
        else { const int e = r >> 7, q = r & 127, kb = q >> 5, nb = q & 31; bf16* dstb = WD + (size_t)e * 1024 * 256;
            tr_item(F.A->in[21] + (size_t)e * 256 * 1024, 1024, 1024, 64 * kb, 32 * nb, scr, F.lane, [dstb](int n, int w2) { return w2 ? (bf16*)nullptr : dstb + (size_t)n * 256; }); }
    }
}
DI void moe_tile_prefix(Frame& F) {
    LAS int* tp = (LAS int*)(F.lds + MOET_OFF);
    if (F.tid == 0) { int a = 0; for (int e = 0; e < 32; ++e) { tp[e] = a; a += (int)((__hip_atomic_load(F.ctl + CW_CNT + e, __ATOMIC_RELAXED, __HIP_MEMORY_SCOPE_AGENT) + 255u) >> 8); } tp[32] = a; }
    __syncthreads();
}
DI void p9_sort(Frame& F) {
    const LAS int* tp = (const LAS int*)(F.lds + MOET_OFF);
    const v2u* TOKR = WSP(const v2u, WS_MISC); v2u* RI = WSP(v2u, WS_MISC + 256 * 1024); const bf16* H2 = WSP(const bf16, WS_H); bf16* XS = WSP(bf16, WS_XS);
#pragma unroll 4
    for (int i = F.gw; i < 2 * S; i += F.ngw) {
        const v2u tr = TOKR[i]; const int e = (int)(tr.x >> 16), rank = (int)(tr.x & 0xffffu), pos = tp[e] * 256 + rank, t = i >> 1;
        const v4u* src = (const v4u*)(H2 + (size_t)t * 1024); v4u* dst = (v4u*)(XS + (size_t)pos * 1024);
        const v4u a = src[F.lane], b = src[F.lane + 64]; dst[F.lane] = a; dst[F.lane + 64] = b;
        if (F.lane == 0) RI[pos] = (v2u){(unsigned)(((i & 1) * S + t) * 1024), tr.y};
    }
    for (int idx = blockIdx.x * NTHR + F.tid; idx < 32 * 256; idx += F.G * NTHR) {
        const int e = idx >> 8, r = idx & 255; const int cnt = (int)F.ctl[CW_CNT + e]; const int pos = tp[e] * 256 + cnt + r;
        if (pos < tp[e + 1] * 256) RI[pos] = (v2u){0xffffffffu, 0u};
    }
}
DI void p12_final(Frame& F) {
    f32x4 w[4]; load_row(F.A->in[22], F.lane, w); const bf16* Y = WSP(const bf16, WS_Y);
#pragma unroll 2
    for (int m = F.gw; m < S; m += F.ngw) {
        f32x4 v[4]; load_row(F.out + (size_t)m * 1024, F.lane, v);
#pragma unroll
        for (int j = 0; j < 4; ++j) { const v2u a = *(const v2u*)(Y + (size_t)m * 1024 + 4 * F.lane + 256 * j), b = *(const v2u*)(Y + ((size_t)S + m) * 1024 + 4 * F.lane + 256 * j);
            v[j][0] += bflo(a.x) + bflo(b.x); v[j][1] += bfhi(a.x) + bfhi(b.x); v[j][2] += bflo(a.y) + bflo(b.y); v[j][3] += bfhi(a.y) + bfhi(b.y); }
        const float rs = row_rstd(v);
#pragma unroll
        for (int j = 0; j < 4; ++j) *(f32x4*)(F.out + (size_t)m * 1024 + 4 * F.lane + 256 * j) = v[j] * rs * w[j];
    }
}

#ifndef MK_PER_PHASE
#define MK_PER_PHASE 0
#endif
constexpr int NPH = 13;
__global__ void __launch_bounds__(NTHR, 2) mk_fwd(Args args) {
    extern __shared__ __attribute__((aligned(16))) unsigned char lds[];
    Frame F;
    F.lds = (LAS unsigned char*)lds;
    F.tid = threadIdx.x; F.lane = F.tid & 63; F.wave = __builtin_amdgcn_readfirstlane(F.tid >> 6);
    F.G = gridDim.x; F.gw = blockIdx.x * NWAVES + F.wave; F.ngw = F.G * NWAVES;
    F.ws = args.ws; F.ctl = (unsigned*)(args.ws + WS_CTL); F.out = args.out;
    F.A = &args;
    for (int u = F.tid; u < (LDS_BYTES - MISC_OFF) / 4; u += NTHR) ((LAS unsigned*)(F.lds + MISC_OFF))[u] = 0u;
    __syncthreads();
    XcdBarrier bar; bar.bar = F.ctl + CW_BAR + args.li * XCD_BAR_WORDS; bar.x = 0; bar.st = nullptr;
    if (!MK_PER_PHASE) bar = xcd_barrier_post(F.ctl + CW_BAR + args.li * XCD_BAR_WORDS, (volatile LAS unsigned*)(F.lds + MISC_OFF) + 8);
    const int lo = args.ph_lo, hi = args.ph_hi;
    const int sub = args.pad ? args.pad : 0xFFFF;
#define IN(k) (lo <= (k) && (k) < hi)
#define SEAM(k) do { if (IN(k) && IN((k) + 1)) xcd_barrier(bar); } while (0)
    LAS unsigned char* ring = F.lds;

    if (IN(0)) { p0_prologue(F); }
    SEAM(0);
    if (IN(1)) {
        pg8::Gemm g{WSP(const bf16, WS_H), WSP(const bf16, WS_WR), 0, 0, 1024}; ProjOrder O{F.G, (int)blockIdx.x};
        EpiProj E{WSP(bf16, WS_QA), WSP(bf16, WS_KCV), WSP(bf16, WS_QR), WSP(bf16, WS_KR), WSP(bf16, WS_GR), WSP(bf16, WS_GA), WSP(bf16, WS_TOUT)};
        pg8::gemm_phase<EpiProj, ProjOrder, true, true>(ring, g, O, E);
    }
    SEAM(1);
    if (IN(2)) {
        if (sub & 32) for (int u = blockIdx.x; u < 512; u += F.G) p2_ret_state_wg(F, u);
        if (sub & 8) { if (F.wave < 4) for (int u = blockIdx.x * 4 + F.wave; u < 1024; u += F.G * 4) p2_cmp_hidden(F, u); }
        if (sub & 16) { if (F.wave == 4) for (int u = blockIdx.x; u < 256; u += F.G) p2_kmax(F, u); }
        asm volatile("s_waitcnt vmcnt(0) lgkmcnt(0)" ::: "memory"); __syncthreads();
    }
    SEAM(2);
    if (IN(3)) {
        if (sub & 64) p3_scan(F);
        if (sub & 128) for (int u = F.gw; u < 256; u += F.ngw) p3_kcvc(F, u);
    }
    SEAM(3);
    if (IN(4)) {
        p4_bias_table(F);
        for (int pp = blockIdx.x; pp < 256; pp += F.G) {
            const int g = pp & 1, c = pp >> 1;
            if (sub & 1) p4a_unit(F, (F.wave < 4 ? c : 255 - c) * 4 + (F.wave & 3), g, args.pad);
            VM_WAIT(); __syncthreads();
            if (sub & 2) {
#pragma unroll 1
                for (int hh = 0; hh < 2; ++hh) p4b_pass(F.lds, F.ws, F.out, hh ? 255 - c : c, g); }
        }
        if (sub & 4) for (int u = blockIdx.x; u < 512; u += F.G) p4_ret_wg(F, u);
        asm volatile("s_waitcnt vmcnt(0) lgkmcnt(0)" ::: "memory");
        __syncthreads();
    }
    SEAM(4);
    if (IN(5)) {
        pg8::Gemm g{WSP(const bf16, WS_H), WSP(const bf16, WS_WG), S, 2048, 1024}; pg8::StaticOrder O; O.init(S, 2048, F.G, (int)blockIdx.x);
        EpiGate E{WSP(bf16, WS_G)};
        pg8::gemm_phase<EpiGate, pg8::StaticOrder, true, true>(ring, g, O, E);
    }
    SEAM(5);
    if (IN(6)) {
        { pg8::Gemm g{WSP(const bf16, WS_QA), WSP(const bf16, WS_WUA), S, 1024, 512}; pg8::StaticOrder O; O.init(S, 1024, F.G, (int)blockIdx.x);
          EpiUp<false> E{WSP(const bf16, WS_G), WSP(bf16, WS_MG), 0};
          pg8::gemm_phase<EpiUp<false>, pg8::StaticOrder, true, true>(ring, g, O, E); }
        if (F.G != 256 && !MK_PER_PHASE) xcd_barrier(bar); else { VM_WAIT(); __syncthreads(); }
        { pg8::Gemm g{WSP(const bf16, WS_GR), WSP(const bf16, WS_WUB), S, 1024, 1024}; pg8::StaticOrder O; O.init(S, 1024, F.G, (int)blockIdx.x);
          EpiUp<true> E{WSP(const bf16, WS_G), WSP(bf16, WS_MG), 1024};
          pg8::gemm_phase<EpiUp<true>, pg8::StaticOrder, true, true>(ring, g, O, E); }
    }
    SEAM(6);
    if (IN(7)) {
        pg8::Gemm g{WSP(const bf16, WS_MG), WSP(const bf16, WS_WO), S, 1024, 1024}; pg8::StaticOrder O; O.init(S, 1024, F.G, (int)blockIdx.x);
        EpiOut E{F.A->in[0], F.out};
        pg8::gemm_phase<EpiOut, pg8::StaticOrder, true, true>(ring, g, O, E);
    }
    SEAM(7);
    if (IN(8)) {
        if (sub & 256) for (int it = blockIdx.x * 4; it < S / 16; it += F.G * 4) p8_route_item(F, it + (F.wave & 3));
        if (sub & 512) p8_moe_weights(F);
    }
    SEAM(8);
    if (IN(9)) { moe_tile_prefix(F); p9_sort(F); }
    SEAM(9);
    if (IN(10)) {
        moe_tile_prefix(F);
        pg8::Gemm g{WSP(const bf16, WS_XS), WSP(const bf16, WS_MOEW), 0, 0, 1024}; MoeOrder<2> O{F.G, (int)blockIdx.x, (const LAS int*)(F.lds + MOET_OFF)};
        EpiMoe1 E{WSP(bf16, WS_HID)};
        pg8::gemm_phase<EpiMoe1, MoeOrder<2>, true, true>(ring, g, O, E);
    }
    SEAM(10);
    if (IN(11)) {
        moe_tile_prefix(F);
        pg8::Gemm g{WSP(const bf16, WS_HID), WSP(const bf16, WS_MOEW) + (size_t)32 * 512 * 1024, 0, 0, 256}; MoeOrder<4> O{F.G, (int)blockIdx.x, (const LAS int*)(F.lds + MOET_OFF)};
        EpiMoe2 E{WSP(const v2u, WS_MISC + 256 * 1024), WSP(bf16, WS_Y)};
        pg8::gemm_phase<EpiMoe2, MoeOrder<4>, true, true>(ring, g, O, E);
    }
    SEAM(11);
    if (IN(12)) p12_final(F);
#undef IN
#undef SEAM
}

extern "C" void kernel_launch(void* const* d_in, const int* in_sizes, int n_in, void* d_out, int out_size, void* d_ws, size_t ws_size, hipStream_t stream) {
    static int grid = 0;
    if (grid == 0) {
        if (n_in != 23 || out_size != S * D || ws_size < WS_END) { fprintf(stderr, "kernel_launch: unexpected problem (n_in %d, out %d, ws %zu)\n", n_in, out_size, ws_size); grid = -1; return; }
        int dev = 0, cus = 0;
        if (hipGetDevice(&dev) != hipSuccess || hipDeviceGetAttribute(&cus, hipDeviceAttributeMultiprocessorCount, dev) != hipSuccess) { grid = -1; return; }
        if (hipFuncSetAttribute((const void*)mk_fwd, hipFuncAttributeMaxDynamicSharedMemorySize, LDS_BYTES) != hipSuccess) { fprintf(stderr, "kernel_launch: hipFuncSetAttribute failed\n"); grid = -1; return; }
        int per_cu = 0;
        if (hipOccupancyMaxActiveBlocksPerMultiprocessor(&per_cu, (const void*)mk_fwd, NTHR, LDS_BYTES) != hipSuccess || per_cu < 1) { fprintf(stderr, "kernel_launch: occupancy query says %d\n", per_cu); }
        (void)hipGetLastError();
        grid = cus > 0 ? cus : 256;
    }
    if (grid < 0) return;
    if (hipMemsetAsync((char*)d_ws + WS_CTL, 0, CTL_ZERO_BYTES, stream) != hipSuccess) return;
    Args a{};
    for (int i = 0; i < 23; ++i) a.in[i] = (const float*)d_in[i];
    a.out = (float*)d_out; a.ws = (unsigned char*)d_ws;
#if MK_PER_PHASE
    for (int p = 0; p < NPH; ++p) { a.ph_lo = p; a.ph_hi = p + 1; hipLaunchKernelGGL(mk_fwd, dim3(grid), dim3(NTHR), LDS_BYTES, stream, a); }
#elif defined(MK_PREFIX_HI)
    a.ph_lo = 0; a.ph_hi = MK_PREFIX_HI; a.li = 0; a.pad = MK_PREFIX_SUB; hipLaunchKernelGGL(mk_fwd, dim3(grid), dim3(NTHR), LDS_BYTES, stream, a);
    (void)hipMemsetAsync((char*)d_ws + WS_CTL, 0, CTL_ZERO_BYTES, stream);
    a.ph_lo = 0; a.ph_hi = NPH; a.li = 1; a.pad = 0; hipLaunchKernelGGL(mk_fwd, dim3(grid), dim3(NTHR), LDS_BYTES, stream, a);
#elif defined(MK_DUP_LO)
    a.ph_lo = 0; a.ph_hi = MK_DUP_HI + 1; a.li = 0; hipLaunchKernelGGL(mk_fwd, dim3(grid), dim3(NTHR), LDS_BYTES, stream, a);
    a.ph_lo = MK_DUP_LO; a.ph_hi = NPH; a.li = 1; hipLaunchKernelGGL(mk_fwd, dim3(grid), dim3(NTHR), LDS_BYTES, stream, a);
#else
    a.ph_lo = 0; a.ph_hi = NPH;
    hipLaunchKernelGGL(mk_fwd, dim3(grid), dim3(NTHR), LDS_BYTES, stream, a);
#endif
}
```

```cpp
#include <hip/hip_runtime.h>
#include <cstdio>
#include <cstdint>
namespace pg8 {
#define PG8_LAS __attribute__((address_space(3)))
typedef unsigned short bf16_t;
typedef short bf16x8 __attribute__((ext_vector_type(8)));
typedef float f32x4 __attribute__((ext_vector_type(4)));
typedef unsigned u32x4 __attribute__((ext_vector_type(4)));
constexpr int BM = 256, BK = 64, HALF = 128, HTB = HALF * BK * 2  , STAGE_BYTES = 8 * HTB, NXCD = 8, WGM = 8;

__host__ __device__ __forceinline__ int lds_byte(int r, int c) { const int st = (r >> 4) * 2 + (c >> 5), rr = r & 15, cc = c & 31, ob = rr * 64 + cc * 2; return st * 1024 + (ob ^ (((ob >> 9) & 1) << 5)); }
__host__ __device__ __forceinline__ void stage_rc(int b, int& R, int& C) { const int st = b / 1024, sb = b % 1024, swz = sb ^ (((sb >> 9) & 1) << 5); R = (st >> 1) * 16 + swz / 64; C = (st & 1) * 32 + (swz % 64) / 2; }
__host__ __device__ __forceinline__ int perm32(int rho) { const int n = rho >> 4, i = rho & 15; return 8 * (i >> 2) + 4 * n + (i & 3); }

struct Unit { int pm, pn; };
struct Gemm { const bf16_t* A; const bf16_t* Bt; int M, N, K; };

struct StaticOrder {
    int nM, nN, nwg, G, c;
    __host__ __device__ void init(int M, int N, int G_, int c_) { nM = M / BM; nN = N / BM; nwg = nM * nN; G = G_; c = c_; }
    __host__ __device__ bool next(int i, Unit& u) const {
        const long L = (long)i * G + c; if (L >= nwg) return false;
        int wgid = (int)L; { const int q = nwg / NXCD, r = nwg % NXCD, xcd = wgid % NXCD, off = wgid / NXCD; wgid = (xcd < r ? xcd * (q + 1) : r * (q + 1) + (xcd - r) * q) + off; }
        const int nig = WGM * nN, gid = wgid / nig, fm = gid * WGM, gsz = (nM - fm) < WGM ? (nM - fm) : WGM;
        u.pm = fm + ((wgid % nig) % gsz); u.pn = (wgid % nig) / gsz; return true;
    }
    __device__ __forceinline__ void a_ready(const Unit&) const {}
    __device__ __forceinline__ void done(const Unit&) const {}
};

__device__ __forceinline__ unsigned cvt_pk_bf16(float lo, float hi) { unsigned r; asm volatile("v_cvt_pk_bf16_f32 %0, %1, %2" : "=v"(r) : "v"(lo), "v"(hi)); return r; }

template <class Epi, class Sched, bool ALIGN_EPI = false, bool SP2 = false, bool GATHER = false>
__device__ __forceinline__ void gemm_phase(PG8_LAS unsigned char* lds, const Gemm g, const Sched& S, const Epi& E, const PG8_LAS unsigned* gtab = nullptr) {
    static_assert(!GATHER || SP2, "GATHER needs SP2");
    const int tid = threadIdx.x, wid = __builtin_amdgcn_readfirstlane(tid >> 6), lane = tid & 63, wr = wid >> 2, wc = wid & 3, fr = lane & 15, fq = lane >> 4;
    const int K = g.K, nt = K / BK;
    unsigned voffA[2], voffB[2];
#pragma unroll
    for (int i = 0; i < 2; ++i) { int R, C; stage_rc(tid * 16 + i * 8192, R, C); const int Rb = Epi::PERM ? ((R & ~31) + perm32(R & 31)) : R;
        voffA[i] = (unsigned)(R * K + C) * 2u; voffB[i] = (unsigned)(Rb * K + C) * 2u; }
    int gR[2], gC[2];
#pragma unroll
    for (int i = 0; i < 2; ++i) stage_rc(tid * 16 + i * 8192, gR[i], gC[i]);
    unsigned gc[2][2], gn[2][2];
#define PG8_GOFF(dst, uidx) do { _Pragma("unroll") for (int _h = 0; _h < 2; ++_h) _Pragma("unroll") for (int _i = 0; _i < 2; ++_i) dst[_h][_i] = (gtab[(uidx) * 256 + _h * 128 + gR[_i]] * (unsigned)K + (unsigned)gC[_i]) * 2u; } while (0)
    const size_t kstep = (size_t)(BK * 2);
    const size_t hstep = (size_t)HALF * K * 2;
    const size_t tstep = 2 * hstep;
    const unsigned ldsw = (unsigned)wid * 1024u;
    const int aoff = lds_byte(wr * 64 + fr, fq * 8), boff = lds_byte(wc * 32 + fr, fq * 8);
#define PG8_SA(b, h) (((b) * 2 + (h)) * HTB)
#define PG8_SB(b, h) ((4 + (b) * 2 + (h)) * HTB)
#define PG8_STAGE(bufoff, gbase, voff) do { _Pragma("unroll") for (int _i = 0; _i < 2; ++_i) \
        __builtin_amdgcn_global_load_lds((const unsigned*)((const char*)(gbase) + (voff)[_i]), (PG8_LAS unsigned*)(lds + (bufoff) + ldsw + _i * 8192), 16, 0, 0); } while (0)
#define PG8_STAGE_A(bufoff, base, half, nxt_) do { if constexpr (GATHER) { _Pragma("unroll") for (int _i = 0; _i < 2; ++_i) \
        __builtin_amdgcn_global_load_lds((const unsigned*)((const char*)(base) + ((nxt_) ? gn[half][_i] : gc[half][_i])), (PG8_LAS unsigned*)(lds + (bufoff) + ldsw + _i * 8192), 16, 0, 0); } \
        else PG8_STAGE(bufoff, (base) + (half) * hstep, voffA); } while (0)
#define PG8_LDA(dst, b, h) do { _Pragma("unroll") for (int m = 0; m < 4; ++m) _Pragma("unroll") for (int k = 0; k < 2; ++k) dst[m][k] = *(const PG8_LAS bf16x8*)(lds + PG8_SA(b, h) + aoff + m * 2048 + k * 1024); } while (0)
#define PG8_LDB(dst, b, h) do { _Pragma("unroll") for (int n = 0; n < 2; ++n) _Pragma("unroll") for (int k = 0; k < 2; ++k) dst[n][k] = *(const PG8_LAS bf16x8*)(lds + PG8_SB(b, h) + boff + n * 2048 + k * 1024); } while (0)
#define PG8_MMA(ai, bj, At, Bt) do { __builtin_amdgcn_s_setprio(1); _Pragma("unroll") for (int m = 0; m < 4; ++m) _Pragma("unroll") for (int n = 0; n < 2; ++n) _Pragma("unroll") for (int k = 0; k < 2; ++k) \
        acc[ai][bj][m][n] = __builtin_amdgcn_mfma_f32_16x16x32_bf16(Bt[n][k], At[m][k], acc[ai][bj][m][n], 0, 0, 0); __builtin_amdgcn_s_setprio(0); } while (0)
#define PG8_WAIT_V(n) asm volatile("s_waitcnt vmcnt(" #n ")" ::: "memory")
#define PG8_WAIT_L(n) asm volatile("s_waitcnt lgkmcnt(" #n ")" ::: "memory")
#define PG8_BAR __builtin_amdgcn_s_barrier()
#define PG8_SCHED __builtin_amdgcn_sched_barrier(0)
    Unit cur, nxt; int ui = 0;
    if (!S.next(0, cur)) return;
    f32x4 acc[2][2][4][2];
#pragma unroll
    for (int a = 0; a < 2; ++a)
#pragma unroll
        for (int b = 0; b < 2; ++b)
#pragma unroll
            for (int m = 0; m < 4; ++m)
#pragma unroll
                for (int n = 0; n < 2; ++n) acc[a][b][m][n] = (f32x4){0.f, 0.f, 0.f, 0.f};
    bf16x8 At[4][2], B0[2][2], B1[2][2];
    const char* cA = GATHER ? (const char*)g.A : (const char*)g.A + (size_t)cur.pm * tstep; const char* cB = (const char*)g.Bt + (size_t)cur.pn * tstep;
    if constexpr (GATHER) { PG8_GOFF(gc, 0); }
    S.a_ready(cur);
    if constexpr (SP2) {
        PG8_STAGE(PG8_SB(0, 0), cB, voffB); PG8_STAGE(PG8_SB(0, 1), cB + hstep, voffB); PG8_STAGE_A(PG8_SA(0, 0), cA, 0, false); PG8_STAGE_A(PG8_SA(0, 1), cA, 1, false);
        if (wr == 1) PG8_BAR;
        PG8_WAIT_V(2); PG8_BAR;
        PG8_STAGE(PG8_SB(1, 0), cB + kstep, voffB); PG8_STAGE_A(PG8_SA(1, 0), cA + kstep, 0, false); PG8_STAGE(PG8_SB(1, 1), cB + hstep + kstep, voffB);
        PG8_WAIT_V(6); PG8_BAR;
    } else {
        PG8_STAGE(PG8_SB(0, 0), cB, voffB); PG8_STAGE(PG8_SA(0, 0), cA, voffA); PG8_STAGE(PG8_SB(0, 1), cB + hstep, voffB); PG8_STAGE(PG8_SA(0, 1), cA + hstep, voffA);
        if (wr == 1) PG8_BAR;
        PG8_WAIT_V(4); PG8_BAR;
        PG8_STAGE(PG8_SB(1, 0), cB + kstep, voffB); PG8_STAGE(PG8_SA(1, 0), cA + kstep, voffA); PG8_STAGE(PG8_SB(1, 1), cB + hstep + kstep, voffB);
        PG8_WAIT_V(6); PG8_BAR;
    }
    for (;;) {
        const bool has_next = S.next(ui + 1, nxt);
        const char* nA = GATHER ? cA : (has_next ? (const char*)g.A + (size_t)nxt.pm * tstep : cA);
        if constexpr (GATHER) { if (has_next) { PG8_GOFF(gn, ui + 1); } else { _Pragma("unroll") for (int _h = 0; _h < 2; ++_h) _Pragma("unroll") for (int _i = 0; _i < 2; ++_i) gn[_h][_i] = gc[_h][_i]; } } const char* nB = has_next ? (const char*)g.Bt + (size_t)nxt.pn * tstep : cB;
#pragma nounroll
        for (int t = 0; t < nt; t += 2) {
            const bool last = (t == nt - 2);
            const char* a1 = cA + (size_t)(t + 1) * kstep;
            const char* a2 = last ? nA : cA + (size_t)(t + 2) * kstep; const char* b2 = last ? nB : cB + (size_t)(t + 2) * kstep;
            const char* a3 = a2 + kstep; const char* b3 = b2 + kstep;
            if (last && has_next) S.a_ready(nxt);
            if constexpr (SP2) {
            PG8_LDB(B0, 0, 0); PG8_LDB(B1, 0, 1); PG8_SCHED; PG8_LDA(At, 0, 0); PG8_STAGE_A(PG8_SA(1, 1), a1, 1, false);
            PG8_WAIT_V(8); PG8_WAIT_L(0); PG8_BAR; PG8_MMA(0, 0, At, B0); PG8_MMA(0, 1, At, B1); PG8_BAR; PG8_SCHED;
            PG8_LDA(At, 0, 1); PG8_STAGE(PG8_SB(0, 0), b2, voffB); PG8_STAGE(PG8_SB(0, 1), b2 + hstep, voffB); PG8_STAGE_A(PG8_SA(0, 0), a2, 0, last);
            PG8_WAIT_V(8); PG8_WAIT_L(0); PG8_BAR; PG8_MMA(1, 0, At, B0); PG8_MMA(1, 1, At, B1); PG8_BAR; PG8_SCHED;
            PG8_LDB(B0, 1, 0); PG8_LDB(B1, 1, 1); PG8_SCHED; PG8_LDA(At, 1, 0); PG8_STAGE_A(PG8_SA(0, 1), a2, 1, last);
            PG8_WAIT_V(8); PG8_WAIT_L(0); PG8_BAR; PG8_MMA(0, 0, At, B0); PG8_MMA(0, 1, At, B1); PG8_BAR; PG8_SCHED;
            PG8_LDA(At, 1, 1); PG8_STAGE(PG8_SB(1, 0), b3, voffB); PG8_STAGE(PG8_SB(1, 1), b3 + hstep, voffB); PG8_STAGE_A(PG8_SA(1, 0), a3, 0, last);
            PG8_WAIT_V(8); PG8_WAIT_L(0); PG8_BAR; PG8_MMA(1, 0, At, B0); PG8_MMA(1, 1, At, B1); PG8_BAR; PG8_SCHED;
            } else {
            PG8_LDB(B0, 0, 0); PG8_SCHED; PG8_LDA(At, 0, 0); PG8_STAGE(PG8_SA(1, 1), a1 + hstep, voffA);
            PG8_WAIT_L(8); PG8_BAR; PG8_WAIT_L(0); PG8_MMA(0, 0, At, B0); PG8_BAR; PG8_SCHED;
            PG8_LDB(B1, 0, 1); PG8_STAGE(PG8_SB(0, 0), b2, voffB);
            PG8_BAR; PG8_WAIT_L(0); PG8_MMA(0, 1, At, B1); PG8_BAR;
            PG8_LDA(At, 0, 1); PG8_STAGE(PG8_SA(0, 0), a2, voffA);
            PG8_BAR; PG8_WAIT_L(0); PG8_MMA(1, 0, At, B0); PG8_BAR; PG8_SCHED;
            PG8_STAGE(PG8_SB(0, 1), b2 + hstep, voffB);
            PG8_WAIT_V(6); PG8_BAR; PG8_MMA(1, 1, At, B1); PG8_BAR;
            PG8_LDB(B0, 1, 0); PG8_SCHED; PG8_LDA(At, 1, 0); PG8_STAGE(PG8_SA(0, 1), a2 + hstep, voffA);
            PG8_WAIT_L(8); PG8_BAR; PG8_WAIT_L(0); PG8_MMA(0, 0, At, B0); PG8_BAR; PG8_SCHED;
            PG8_LDB(B1, 1, 1); PG8_STAGE(PG8_SB(1, 0), b3, voffB);
            PG8_BAR; PG8_WAIT_L(0); PG8_MMA(0, 1, At, B1); PG8_BAR;
            PG8_LDA(At, 1, 1); PG8_STAGE(PG8_SA(1, 0), a3, voffA);
            PG8_BAR; PG8_WAIT_L(0); PG8_MMA(1, 0, At, B0); PG8_BAR; PG8_SCHED;
            PG8_STAGE(PG8_SB(1, 1), b3 + hstep, voffB);
            PG8_WAIT_V(6); PG8_BAR; PG8_MMA(1, 1, At, B1); PG8_BAR;
            }
        }
        if constexpr (ALIGN_EPI) { if (wr == 0) PG8_BAR; }
        if constexpr (!Epi::AFTER_DRAIN) { E(acc, cur, wr, wc, fr, fq); S.done(cur); }
        if (!has_next) break;
#pragma unroll
        for (int a = 0; a < 2; ++a)
#pragma unroll
            for (int b = 0; b < 2; ++b)
#pragma unroll
                for (int m = 0; m < 4; ++m)
#pragma unroll
                    for (int n = 0; n < 2; ++n) acc[a][b][m][n] = (f32x4){0.f, 0.f, 0.f, 0.f};
        cur = nxt; cA = nA; cB = nB; ++ui;
        if constexpr (GATHER) { _Pragma("unroll") for (int _h = 0; _h < 2; ++_h) _Pragma("unroll") for (int _i = 0; _i < 2; ++_i) gc[_h][_i] = gn[_h][_i]; }
        if constexpr (ALIGN_EPI) { if (wr == 1) PG8_BAR; }
    }
    PG8_WAIT_V(0);
    if constexpr (!ALIGN_EPI) { if (wr == 0) PG8_BAR; }
    PG8_BAR;
    if constexpr (Epi::AFTER_DRAIN) { E.fused(acc, cur, wr, wc, fr, fq, lds, wid, lane); S.done(cur); }
#undef PG8_SA
#undef PG8_SB
#undef PG8_STAGE
#undef PG8_STAGE_A
#undef PG8_GOFF
#undef PG8_LDA
#undef PG8_LDB
#undef PG8_MMA
#undef PG8_WAIT_V
#undef PG8_WAIT_L
#undef PG8_BAR
#undef PG8_SCHED
}
}

#define GAS __attribute__((address_space(1)))
#define LAS __attribute__((address_space(3)))
#define DI __device__ __forceinline__
typedef unsigned short bf16;
typedef unsigned v4u __attribute__((ext_vector_type(4)));
typedef unsigned v2u __attribute__((ext_vector_type(2)));
typedef float f32x4 __attribute__((ext_vector_type(4)));
typedef short bf16x8 __attribute__((ext_vector_type(8)));
typedef float f32x2_t __attribute__((ext_vector_type(2)));
typedef __bf16 bf16x2_t __attribute__((ext_vector_type(2)));
#define LDS_WAIT() asm volatile("s_waitcnt lgkmcnt(0)" ::: "memory")
#define VM_WAIT() asm volatile("s_waitcnt vmcnt(0)" ::: "memory")
DI unsigned pk2(float lo, float hi) { f32x2_t v = {lo, hi}; bf16x2_t b = __builtin_convertvector(v, bf16x2_t); return __builtin_bit_cast(unsigned, b); }
DI float bflo(unsigned u) { return __uint_as_float(u << 16); }
DI float bfhi(unsigned u) { return __uint_as_float(u & 0xffff0000u); }
DI float bf1(bf16 b) { return __uint_as_float(((unsigned)b) << 16); }
DI f32x4 mfma16(bf16x8 a, bf16x8 b, f32x4 c) { return __builtin_amdgcn_mfma_f32_16x16x32_bf16(a, b, c, 0, 0, 0); }
DI bf16x8 ld16(const bf16* p) { return *(const bf16x8*)p; }
DI bf16x8 ld8x2(const bf16* p, int off2) { const v2u a = *(const v2u*)p, b = *(const v2u*)(p + off2); v4u r = {a.x, a.y, b.x, b.y}; return __builtin_bit_cast(bf16x8, r); }
DI bf16x8 pack8(f32x4 a, f32x4 b) { v4u r = {pk2(a[0], a[1]), pk2(a[2], a[3]), pk2(b[0], b[1]), pk2(b[2], b[3])}; return __builtin_bit_cast(bf16x8, r); }
DI v2u pack4(f32x4 a) { v2u r = {pk2(a[0], a[1]), pk2(a[2], a[3])}; return r; }
DI float wave_sum(float v) {
#pragma unroll
    for (int o = 1; o < 64; o <<= 1) v += __shfl_xor(v, o);
    return v;
}
DI float quad_sum(float v) { v += __shfl_xor(v, 16); v += __shfl_xor(v, 32); return v; }
DI float quad_max(float v) { v = fmaxf(v, __shfl_xor(v, 16)); v = fmaxf(v, __shfl_xor(v, 32)); return v; }
DI unsigned wave_max_u32(unsigned v) {
#pragma unroll
    for (int o = 1; o < 64; o <<= 1) { const unsigned w = (unsigned)__shfl_xor((int)v, o); v = w > v ? w : v; }
    return v;
}
DI float sigmoidf_(float x) { return __builtin_amdgcn_rcpf(1.0f + __builtin_amdgcn_exp2f(-x * 1.4426950408889634f)); }
DI float siluf_(float x) { return x * sigmoidf_(x); }
DI float gelu_tanh(float v) { const float z = 0.7978845608028654f * (v + 0.044715f * v * v * v); const float e = __builtin_amdgcn_exp2f(2.0f * 1.4426950408889634f * z); return 0.5f * v * (2.0f - 2.0f * __builtin_amdgcn_rcpf(e + 1.0f)); }

constexpr int S = 16384, D = 1024;
constexpr int TP = S + 2048 + 128;
constexpr int NWAVES = 8, NTHR = 512;
constexpr float EPS = 1e-6f, LOG2E = 1.4426950408889634f, QSCALE = 0.125f * 1.4426950408889634f;
constexpr size_t MiB = 1u << 20;
constexpr size_t WS_CTL = 0, CTL_ZERO_BYTES = MiB;
constexpr size_t WS_MISC = 1 * MiB;
constexpr size_t WS_WR = 2 * MiB;
constexpr size_t WS_H = WS_WR + 3328 * 2048;
constexpr size_t WS_WT = WS_H + 32 * MiB;
constexpr size_t WS_WG = 44 * MiB;
constexpr size_t WS_WC1 = 48 * MiB;
constexpr size_t WS_WUA = 50 * MiB, WS_WUB = 51 * MiB, WS_WO = 53 * MiB;
constexpr size_t WS_SM = 55 * MiB;
constexpr size_t SM_W2T = 0, SM_B1 = 64 * 1024, SM_WRT = 128 * 1024, SM_KC = 512 * 1024, SM_VCT = 768 * 1024;
constexpr size_t WS_QA = 56 * MiB, WS_GR = 72 * MiB, WS_GA = 104 * MiB, WS_KCV = 105 * MiB, WS_QR = 121 * MiB, WS_KR = 137 * MiB, WS_TOUT = 153 * MiB, WS_UR = 217 * MiB, WS_HIDC = 249 * MiB;
constexpr size_t WS_G = 105 * MiB, WS_MG = 169 * MiB;
constexpr size_t WS_MOEW = 56 * MiB;
constexpr size_t WS_HID = 104 * MiB, WS_XS = 188 * MiB  , WS_Y = 124 * MiB, WS_END = 256 * MiB;
static_assert(WS_TOUT + 1792ull * TP * 2 <= WS_UR && WS_WT + 1792 * 2048 <= WS_WG && WS_HIDC + 2 * MiB <= WS_END && WS_Y + 64 * MiB <= WS_XS && WS_XS + 4 * MiB <= WS_END && WS_Y + 64 * MiB <= WS_END, "ws map");
constexpr int CW_BAR = 4096, CW_KMAX = 16384, CW_CNT = 16448, CW_WQ = 16512;
constexpr int XS_ROWS = 40960;
constexpr int WAVE_LDS = 16960;
constexpr int NEAR_OFF = 140288;
constexpr int BIAS_OFF = 157184;
constexpr int MOET_OFF = 161344;
constexpr int GTAB_OFF = 135168;
constexpr int MISC_OFF = 161664;
constexpr int LDS_BYTES = 163840;
#define XB_TMO      128
#define XB_XCNT(j)  (256  + 64 * (j))
#define XB_XSUB(j)  (1280 + 64 * (j))
#define XB_XGEN(j)  (2304 + 64 * (j))
#define XB_TOP      3328
#define XB_TOPGEN   3392
#define XCD_BAR_WORDS 3456
#define XB_SPIN_CAP (1u << 18)

__device__ __forceinline__ unsigned xb_ld(unsigned* p)              { return __hip_atomic_load(p, __ATOMIC_RELAXED, __HIP_MEMORY_SCOPE_AGENT); }
__device__ __forceinline__ unsigned xb_add(unsigned* p, unsigned v) { return __hip_atomic_fetch_add(p, v, __ATOMIC_RELAXED, __HIP_MEMORY_SCOPE_AGENT); }
__device__ __forceinline__ unsigned xb_xcc_id() { return (unsigned)__builtin_amdgcn_s_getreg((3 << 11) | 20) & 0xFu; }
#define XB_SPIN(cond, bar) do { unsigned _sp = 0; while (cond) { __builtin_amdgcn_s_sleep(1); \
    if ((++_sp & 255u) == 0u) { if (xb_ld(&(bar)[XB_TMO])) break; if (_sp > XB_SPIN_CAP) { atomicAdd(&(bar)[XB_TMO], 1u); break; } } } } while (0)

struct XcdBarrier {
    unsigned* bar; unsigned x;
    volatile LAS unsigned* st;
};

__device__ __forceinline__ XcdBarrier xcd_barrier_post(unsigned* bar, volatile LAS unsigned* st) {
    XcdBarrier b; b.bar = bar; b.x = xb_xcc_id(); b.st = st;
    if (threadIdx.x == 0) (void)xb_add(&bar[XB_XCNT(b.x)], 1u);
    return b;
}
__device__ __forceinline__ void xcd_barrier_complete(unsigned* bar, unsigned x, unsigned& nloc, unsigned& nx) {
    const unsigned G = gridDim.x * gridDim.y * gridDim.z;
    unsigned sum, cnt, mine, sp = 0u;
    for (;;) {
        sum = 0u; cnt = 0u; mine = 0u;
#pragma unroll
        for (unsigned j = 0; j < 16; ++j) { const unsigned c = xb_ld(&bar[XB_XCNT(j)]); sum += c; cnt += (c > 0u) ? 1u : 0u; mine = (j == x) ? c : mine; }
        if (sum == G) break;
        __builtin_amdgcn_s_sleep(1);
        if ((++sp & 255u) == 0u) { if (xb_ld(&bar[XB_TMO])) break; if (sp > XB_SPIN_CAP) { atomicAdd(&bar[XB_TMO], 1u); break; } }
    }
    nloc = mine > 0u ? mine : 1u; nx = cnt > 0u ? cnt : 1u;
}

__device__ __forceinline__ void xcd_barrier(const XcdBarrier& b) {
    asm volatile("s_waitcnt vmcnt(0)" ::: "memory");
    __syncthreads();
    if (threadIdx.x == 0) {
        unsigned* bar = b.bar;
        __builtin_amdgcn_s_waitcnt(0);
        unsigned nloc = b.st[0], nx = b.st[1];
        if (nloc == 0u) { xcd_barrier_complete(bar, b.x, nloc, nx); b.st[0] = nloc; b.st[1] = nx; }
        const unsigned old = xb_add(&bar[XB_XSUB(b.x)], 1u);
        const unsigned gen = old / nloc;
        if (old + 1u == (gen + 1u) * nloc) {
            __builtin_amdgcn_fence(__ATOMIC_RELEASE, "agent");
            asm volatile("s_waitcnt vmcnt(0)" ::: "memory");
            const unsigned og = xb_add(&bar[XB_TOP], 1u);
            const unsigned tg = og / nx;
            if (og + 1u == (tg + 1u) * nx) xb_add(&bar[XB_TOPGEN], 1u);
            else XB_SPIN(xb_ld(&bar[XB_TOPGEN]) == tg, bar);
            __builtin_amdgcn_fence(__ATOMIC_ACQUIRE, "agent");
            xb_add(&bar[XB_XGEN(b.x)], 1u);
            asm volatile("s_waitcnt vmcnt(0)" ::: "memory");
        } else {
            XB_SPIN(xb_ld(&bar[XB_XGEN(b.x)]) == gen, bar);
            __builtin_amdgcn_fence(__ATOMIC_ACQUIRE, "agent");
            asm volatile("s_waitcnt vmcnt(0)" ::: "memory");
        }
    }
    __syncthreads();
}

DI void tile_map(int L, int nwg, int nM, int nN, int& pm, int& pn) {
    int wgid = L; { const int q = nwg / 8, r = nwg % 8, xcd = wgid % 8, off = wgid / 8; wgid = (xcd < r ? xcd * (q + 1) : r * (q + 1) + (xcd - r) * q) + off; }
    const int nig = 8 * nN, gid = wgid / nig, fm = gid * 8, gsz = (nM - fm) < 8 ? (nM - fm) : 8;
    pm = fm + ((wgid % nig) % gsz); pn = (wgid % nig) / gsz;
}
struct ProjOrder {
    int G, c;
    DI bool next(int i, pg8::Unit& u) const {
        const int L = i * G + c; if (L >= 1280) return false;
        if (L < 832) tile_map(L, 832, 64, 13, u.pm, u.pn);
        else { tile_map(L - 832, 448, 7, 64, u.pm, u.pn); u.pm += 64; u.pn += 13; }
        return true;
    }
    DI void a_ready(const pg8::Unit&) const {}
    DI void done(const pg8::Unit&) const {}
};
template <int NJ> struct MoeOrder {
    int G, c; const LAS int* tp;
    DI bool next(int i, pg8::Unit& u) const {
        const int L = i * G + c, tau = L / NJ, j = L % NJ; const int nt = __builtin_amdgcn_readfirstlane(tp[32]);
        if (tau >= nt) return false;
        int e = 0;
        for (int k = 1; k < 32; ++k) e += (tau >= __builtin_amdgcn_readfirstlane(tp[k])) ? 1 : 0;
        u.pm = tau; u.pn = e * NJ + j; return true;
    }
    DI void a_ready(const pg8::Unit&) const {}
    DI void done(const pg8::Unit&) const {}
};

struct EpiProj {
    static constexpr bool PERM = true, AFTER_DRAIN = false;
    bf16 *QA, *KCV, *QR, *KR, *GR, *GA, *TOUT;
    DI void operator()(const f32x4 (&acc)[2][2][4][2], const pg8::Unit& u, int wr, int wc, int fr_, int fq_) const {
        int fr = fr_, fq = fq_; asm volatile("" : "+v"(fr), "+v"(fq));
        const float L2B = 13.287712379549449f / 64.0f;
        const float INV2PI = 0.15915494309189535f;
        if (u.pm < 64) {
            const int pn = u.pn, row0 = u.pm * 256 + wr * 64 + fr;
            if (pn >= 4 && pn < 8) {
                bf16* base = pn < 6 ? QR : KR; const float sc = pn < 6 ? 1.0f : 0.08838834764831845f; const int hd0 = 2 * (pn & 1), d0 = 16 * wc + 4 * fq;
                float invr[4];
#pragma unroll
                for (int i = 0; i < 4; ++i) invr[i] = __builtin_amdgcn_exp2f(-(float)(d0 + i) * L2B) * INV2PI;
#pragma unroll
                for (int ai = 0; ai < 2; ++ai)
#pragma unroll
                    for (int m = 0; m < 4; ++m) {
                        const int tok = row0 + ai * 128 + m * 16; float cs[4], sn[4];
#pragma unroll
                        for (int i = 0; i < 4; ++i) { float rev = (float)tok * invr[i]; rev -= floorf(rev); sn[i] = __builtin_amdgcn_sinf(rev) * sc; cs[i] = __builtin_amdgcn_cosf(rev) * sc; }
#pragma unroll
                        for (int bj = 0; bj < 2; ++bj) {
                            const f32x4 x1 = acc[ai][bj][m][0], x2 = acc[ai][bj][m][1]; f32x4 o1, o2;
#pragma unroll
                            for (int i = 0; i < 4; ++i) { o1[i] = x1[i] * cs[i] - x2[i] * sn[i]; o2[i] = x1[i] * sn[i] + x2[i] * cs[i]; }
                            bf16* p = base + (size_t)tok * 512 + (hd0 + bj) * 128 + d0;
                            *(v2u*)p = pack4(o1); *(v2u*)(p + 64) = pack4(o2);
                        }
                    }
            } else if (pn == 12) {
                if (wc == 0) {
#pragma unroll
                    for (int ai = 0; ai < 2; ++ai)
#pragma unroll
                        for (int m = 0; m < 4; ++m) {
                            const int tok = row0 + ai * 128 + m * 16; f32x4 a = acc[ai][0][m][0], b = acc[ai][0][m][1];
#pragma unroll
                            for (int i = 0; i < 4; ++i) { a[i] = sigmoidf_(a[i]); b[i] = sigmoidf_(b[i]); }
                            *(bf16x8*)(GA + (size_t)tok * 32 + 8 * fq) = pack8(a, b);
                        }
                }
            } else {
                bf16* dst; int ldc, colt; float sc = 1.0f;
                if (pn < 2) { dst = QA; ldc = 512; colt = 256 * pn; sc = QSCALE; }
                else if (pn < 4) { dst = KCV; ldc = 512; colt = 256 * (pn - 2); }
                else { dst = GR; ldc = 1024; colt = 256 * (pn - 8); }
                const int col0 = colt + wc * 32 + 8 * fq;
#pragma unroll
                for (int ai = 0; ai < 2; ++ai)
#pragma unroll
                    for (int m = 0; m < 4; ++m) {
                        bf16* rowp = dst + (size_t)(row0 + ai * 128 + m * 16) * ldc + col0;
#pragma unroll
                        for (int bj = 0; bj < 2; ++bj) *(bf16x8*)(rowp + bj * 128) = pack8(acc[ai][bj][m][0] * sc, acc[ai][bj][m][1] * sc);
                    }
            }
        } else {
            const int pmp = u.pm - 64, tok0 = (u.pn - 13) * 256 + wc * 32 + 8 * fq;
            if (pmp == 1 || pmp == 2) {
                const float sc = 0.08838834764831845f;
#pragma unroll
                for (int ai = 0; ai < 2; ++ai) {
                    const int head = 2 * (pmp - 1) + ai;
#pragma unroll
                    for (int m = 0; m < 2; ++m) {
                        const int d = 32 * wr + 16 * m + fr; const float invr = __builtin_amdgcn_exp2f(-(float)d * L2B) * INV2PI;
                        bf16* p1 = TOUT + (size_t)(256 + head * 128 + d) * TP;
#pragma unroll
                        for (int bj = 0; bj < 2; ++bj) {
                            f32x4 o1[2], o2[2];
#pragma unroll
                            for (int n = 0; n < 2; ++n)
#pragma unroll
                                for (int i = 0; i < 4; ++i) {
                                    const int tok = tok0 + bj * 128 + 4 * n + i; float rev = (float)tok * invr; rev -= floorf(rev);
                                    const float sn = __builtin_amdgcn_sinf(rev) * sc, cs = __builtin_amdgcn_cosf(rev) * sc;
                                    const float x1 = acc[ai][bj][m][n][i], x2 = acc[ai][bj][m + 2][n][i];
                                    o1[n][i] = x1 * cs - x2 * sn; o2[n][i] = x1 * sn + x2 * cs;
                                }
                            *(bf16x8*)(p1 + tok0 + bj * 128) = pack8(o1[0], o1[1]);
                            *(bf16x8*)(p1 + (size_t)64 * TP + tok0 + bj * 128) = pack8(o2[0], o2[1]);
                        }
                    }
                }
            } else {
#pragma unroll
                for (int ai = 0; ai < 2; ++ai)
#pragma unroll
                    for (int m = 0; m < 4; ++m) {
                        bf16* rowp = TOUT + (size_t)(pmp * 256 + ai * 128 + wr * 64 + m * 16 + fr) * TP + tok0;
#pragma unroll
                        for (int bj = 0; bj < 2; ++bj) *(bf16x8*)(rowp + bj * 128) = pack8(acc[ai][bj][m][0], acc[ai][bj][m][1]);
                    }
            }
        }
    }
};
struct EpiGate {
    static constexpr bool PERM = true, AFTER_DRAIN = false;
    bf16* G;
    DI void operator()(const f32x4 (&acc)[2][2][4][2], const pg8::Unit& u, int wr, int wc, int fr, int fq) const {
        const int row0 = u.pm * 256 + wr * 64 + fr, col0 = u.pn * 256 + wc * 32 + 8 * fq;
#pragma unroll
        for (int ai = 0; ai < 2; ++ai)
#pragma unroll
            for (int m = 0; m < 4; ++m) {
                bf16* rowp = G + (size_t)(row0 + ai * 128 + m * 16) * 2048 + col0;
#pragma unroll
                for (int bj = 0; bj < 2; ++bj) { f32x4 a = acc[ai][bj][m][0], b = acc[ai][bj][m][1];
#pragma unroll
                    for (int i = 0; i < 4; ++i) { a[i] = sigmoidf_(a[i]); b[i] = sigmoidf_(b[i]); }
                    *(bf16x8*)(rowp + bj * 128) = pack8(a, b); }
            }
    }
};
template <bool ADD> struct EpiUp {
    static constexpr bool PERM = true, AFTER_DRAIN = false;
    const bf16* G; bf16* MG; int goff;
    DI void operator()(const f32x4 (&acc)[2][2][4][2], const pg8::Unit& u, int wr, int wc, int fr, int fq) const {
        const int row0 = u.pm * 256 + wr * 64 + fr, col0 = u.pn * 256 + wc * 32 + 8 * fq;
#pragma unroll
        for (int ai = 0; ai < 2; ++ai)
#pragma unroll
            for (int m = 0; m < 4; ++m) {
                const size_t r = (size_t)(row0 + ai * 128 + m * 16);
#pragma unroll
                for (int bj = 0; bj < 2; ++bj) {
                    const v4u g = *(const v4u*)(G + r * 2048 + goff + col0 + bj * 128);
                    f32x4 a = acc[ai][bj][m][0], b = acc[ai][bj][m][1];
                    a[0] *= bflo(g.x); a[1] *= bfhi(g.x); a[2] *= bflo(g.y); a[3] *= bfhi(g.y); b[0] *= bflo(g.z); b[1] *= bfhi(g.z); b[2] *= bflo(g.w); b[3] *= bfhi(g.w);
                    bf16* op = MG + r * 1024 + col0 + bj * 128;
                    if (ADD) { const v4u o = *(const v4u*)op;
                        a[0] += bflo(o.x); a[1] += bfhi(o.x); a[2] += bflo(o.y); a[3] += bfhi(o.y); b[0] += bflo(o.z); b[1] += bfhi(o.z); b[2] += bflo(o.w); b[3] += bfhi(o.w); }
                    *(bf16x8*)op = pack8(a, b);
                }
            }
    }
};
struct EpiOut {
    static constexpr bool PERM = false, AFTER_DRAIN = false;
    const float* X; float* O;
    DI void operator()(const f32x4 (&acc)[2][2][4][2], const pg8::Unit& u, int wr, int wc, int fr, int fq) const {
        const int row0 = u.pm * 256 + wr * 64 + fr, col0 = u.pn * 256 + wc * 32 + 4 * fq;
#pragma unroll
        for (int ai = 0; ai < 2; ++ai)
#pragma unroll
            for (int m = 0; m < 4; ++m) {
                const size_t off = (size_t)(row0 + ai * 128 + m * 16) * 1024 + col0;
#pragma unroll
                for (int bj = 0; bj < 2; ++bj)
#pragma unroll
                    for (int n = 0; n < 2; ++n) { const size_t o = off + bj * 128 + n * 16; *(f32x4*)(O + o) = *(const f32x4*)(X + o) + acc[ai][bj][m][n]; }
            }
    }
};
struct EpiMoe1 {
    static constexpr bool PERM = false, AFTER_DRAIN = false;
    bf16* HID;
    DI void operator()(const f32x4 (&acc)[2][2][4][2], const pg8::Unit& u, int wr, int wc, int fr, int fq) const {
        const int row0 = u.pm * 256 + wr * 64 + fr, f0 = (u.pn & 1) * 128 + 16 * wc + 4 * fq;
#pragma unroll
        for (int ai = 0; ai < 2; ++ai)
#pragma unroll
            for (int m = 0; m < 4; ++m) {
                bf16* rowp = HID + (size_t)(row0 + ai * 128 + m * 16) * 256 + f0;
#pragma unroll
                for (int bj = 0; bj < 2; ++bj) { const f32x4 g = acc[ai][bj][m][0], up = acc[ai][bj][m][1]; f32x4 h;
#pragma unroll
                    for (int i = 0; i < 4; ++i) h[i] = siluf_(g[i]) * up[i];
                    *(v2u*)(rowp + bj * 64) = pack4(h); }
            }
    }
};
struct EpiMoe2 {
    static constexpr bool PERM = true, AFTER_DRAIN = false;
    const v2u* LIST; bf16* Y; const LAS int* tp; const LAS int* cn;
    DI void operator()(const f32x4 (&acc)[2][2][4][2], const pg8::Unit& u, int wr, int wc, int fr, int fq) const {
        const int ex = u.pn >> 2, rank0 = (u.pm - tp[ex]) * 256 + wr * 64 + fr, cnt = cn[ex], col0 = (u.pn & 3) * 256 + wc * 32 + 8 * fq;
#pragma unroll
        for (int ai = 0; ai < 2; ++ai)
#pragma unroll
            for (int m = 0; m < 4; ++m) {
                const int rank = rank0 + ai * 128 + m * 16;
                if (rank < cnt) {
                    const v2u ri = LIST[(size_t)ex * 16384 + rank]; const float w = __uint_as_float(ri.y);
                    bf16* rowp = Y + ((size_t)(ri.x & 1u) * S + (ri.x >> 1)) * 1024 + col0;
#pragma unroll
                    for (int bj = 0; bj < 2; ++bj) *(bf16x8*)(rowp + bj * 128) = pack8(acc[ai][bj][m][0] * w, acc[ai][bj][m][1] * w);
                }
                asm volatile("" ::: "memory");
            }
    }
};

struct Args { const float* in[23]; float* out; unsigned char* ws; int ph_lo, ph_hi, li, pad; };
struct Frame {
    LAS unsigned char* lds;
    unsigned* ctl;
    int tid, lane, wave, G, gw, ngw;
    const Args* A; float* out; unsigned char* ws;
};
#define WSP(T, off) ((T*)(F.ws + (off)))

template <class DestFn>
DI void tr_item(const float* W, int ldw, int ncols, int k0, int n0, LAS float* scr, int lane, DestFn dest) {
    const int lr = lane >> 3, lc = (lane & 7) * 4;
    if (n0 + 32 <= ncols && (ldw & 3) == 0) {
#pragma unroll
        for (int i = 0; i < 8; ++i) { const int kk = 8 * i + lr; const f32x4 v = *(const f32x4*)(W + (size_t)(k0 + kk) * ldw + n0 + lc); LAS float* d = scr + kk * 33 + lc; d[0] = v[0]; d[1] = v[1]; d[2] = v[2]; d[3] = v[3]; }
    } else {
#pragma unroll
        for (int i = 0; i < 8; ++i) { const int kk = 8 * i + lr;
#pragma unroll
            for (int j = 0; j < 4; ++j) scr[kk * 33 + lc + j] = (n0 + lc + j) < ncols ? W[(size_t)(k0 + kk) * ldw + n0 + lc + j] : 0.0f; }
    }
    LDS_WAIT(); asm volatile("" ::: "memory");
    const int c = lane & 7;
#pragma unroll
    for (int j = 0; j < 4; ++j) {
        const int nl = (lane >> 3) + 8 * j, n = n0 + nl;
        if (n < ncols) {
            const LAS float* s = scr + (8 * c) * 33 + nl;
            v4u o; o.x = pk2(s[0 * 33], s[1 * 33]); o.y = pk2(s[2 * 33], s[3 * 33]); o.z = pk2(s[4 * 33], s[5 * 33]); o.w = pk2(s[6 * 33], s[7 * 33]);
            bf16* r0 = dest(n, 0); if (r0) *(v4u*)(r0 + k0 + 8 * c) = o;
            bf16* r1 = dest(n, 1); if (r1) *(v4u*)(r1 + k0 + 8 * c) = o;
        }
    }
    LDS_WAIT(); asm volatile("" ::: "memory");
}
DI int rot_row_R(int d) { const int n = d >> 6, dd = d & 63; return 32 * (dd >> 4) + 8 * ((dd >> 2) & 3) + 4 * n + (dd & 3); }
DI int rot_row_T(int d) { const int x2 = d >> 6, dd = d & 63; return 64 * (dd >> 5) + 16 * (((dd >> 4) & 1) + 2 * x2) + (dd & 15); }
DI bf16* win_dest(unsigned char* ws, int s, int which) {
    bf16* WR = (bf16*)(ws + WS_WR); bf16* WT = (bf16*)(ws + WS_WT); bf16* WG = (bf16*)(ws + WS_WG);
    int r = -1, t = -1, g = -1;
    if (s < 512) r = s;
    else if (s < 1280) { const int sp = s - 512, j6 = sp >> 7, gd = sp & 127;
        if (j6 == 0) r = 512 + gd; else if (j6 == 1) r = 512 + 128 + gd; else if (j6 == 2) r = 512 + 256 + gd; else if (j6 == 4) r = 512 + 384 + gd;
        else if (j6 == 3) t = gd; else t = 128 + gd; }
    else if (s < 1304) r = 12 * 256 + (s - 1280);
    else if (s < 1816) { const int f = s - 1304, hh = f >> 7, d = f & 127; r = (4 + (hh >> 1)) * 256 + (hh & 1) * 128 + rot_row_R(d); }
    else if (s < 2328) { const int f = s - 1816, hh = f >> 7, d = f & 127; r = (6 + (hh >> 1)) * 256 + (hh & 1) * 128 + rot_row_R(d); t = (1 + (hh >> 1)) * 256 + (hh & 1) * 128 + rot_row_T(d); }
    else if (s < 3352) t = 768 + (s - 2328);
    else if (s < 4376) r = 8 * 256 + (s - 3352);
    else g = s - 4376;
    if (which == 0) { if (r >= 0) return WR + (size_t)r * 1024; if (t >= 0) return WT + (size_t)t * 1024; return WG + (size_t)g * 1024; }
    return (r >= 0 && t >= 0) ? WT + (size_t)t * 1024 : nullptr;
}
DI void load_row(const float* p, int lane, f32x4 (&v)[4]) {
#pragma unroll
    for (int j = 0; j < 4; ++j) v[j] = *(const f32x4*)(p + 4 * lane + 256 * j);
}
DI float row_rstd(const f32x4 (&v)[4]) {
    float s = 0.f;
#pragma unroll
    for (int j = 0; j < 4; ++j) s += (v[j][0] * v[j][0] + v[j][1] * v[j][1]) + (v[j][2] * v[j][2] + v[j][3] * v[j][3]);
    return 1.0f / sqrtf(wave_sum(s) * (1.0f / 1024.0f) + EPS);
}

DI void p0_prologue(Frame& F) {
    LAS float* scr = (LAS float*)(F.lds + F.wave * WAVE_LDS);
    const float* w_in = F.A->in[3];
    constexpr int I_IN = 16 * 201, I_C1 = 512, I_C2 = 16, I_UA = 256, I_UB = 512, I_WO = 512, NIT = I_IN + I_C1 + I_C2 + I_UA + I_UB + I_WO;
    unsigned char* ws = F.ws;
    for (int it = F.gw; it < NIT; it += F.ngw) {
        int r = it;
        if (r < I_IN) { const int kb = r / 201, nb = r % 201; tr_item(w_in, 6424, 6424, 64 * kb, 32 * nb, scr, F.lane, [ws](int n, int which) { return win_dest(ws, n, which); }); continue; } r -= I_IN;
        if (r < I_C1) { const int kind = r >> 8, q = r & 255, kb = q >> 3, nb = q & 7; bf16* dstb = (bf16*)(ws + WS_WC1) + (size_t)kind * 256 * 2048;
            tr_item(F.A->in[kind ? 8 : 5], 256, 256, 64 * kb, 32 * nb, scr, F.lane, [dstb](int n, int which) { return which ? (bf16*)nullptr : dstb + (size_t)n * 2048; }); continue; } r -= I_C1;
        if (r < I_C2) { const int kind = r >> 3, q = r & 7, kb = q >> 1, nb = q & 1; bf16* dstb = (bf16*)(ws + WS_SM + SM_W2T) + (size_t)kind * 64 * 256;
            tr_item(F.A->in[kind ? 9 : 6], 64, 64, 64 * kb, 32 * nb, scr, F.lane, [dstb](int n, int which) { return which ? (bf16*)nullptr : dstb + (size_t)n * 256; }); continue; } r -= I_C2;
        if (r < I_UA) { const int kb = r >> 5, nb = r & 31; bf16* dstb = (bf16*)(ws + WS_WUA);
            tr_item(F.A->in[11], 1024, 1024, 64 * kb, 32 * nb, scr, F.lane, [dstb](int n, int which) { return which ? (bf16*)nullptr : dstb + (size_t)n * 512; }); continue; } r -= I_UA;
        if (r < I_UB) { const int kb = r >> 5, nb = r & 31; bf16* dstb = (bf16*)(ws + WS_WUB);
            tr_item(F.A->in[12], 1024, 1024, 64 * kb, 32 * nb, scr, F.lane, [dstb](int n, int which) { return which ? (bf16*)nullptr : dstb + (size_t)n * 1024; }); continue; } r -= I_UB;
        { const int kb = r >> 5, nb = r & 31; bf16* dstb = (bf16*)(ws + WS_WO);
            tr_item(F.A->in[13], 1024, 1024, 64 * kb, 32 * nb, scr, F.lane, [dstb](int n, int which) { return which ? (bf16*)nullptr : dstb + (size_t)n * 1024; }); }
    }
    for (int o = F.gw; o < 512; o += F.ngw) {
        const int kind = o >> 8, n = o & 255; const float* pos = F.A->in[kind ? 7 : 4]; const float* w1 = F.A->in[kind ? 8 : 5]; float s = 0.f;
        for (int kk = F.lane; kk < 2048; kk += 64) s += pos[kk] * w1[(size_t)kk * 256 + n];
        s = wave_sum(s); if (F.lane == 0) ((float*)(ws + WS_SM + SM_B1))[o] = s;
    }
    { float* wrt = (float*)(ws + WS_SM + SM_WRT); const float* wn = F.A->in[14];
      for (int i = F.gw * 64 + F.lane; i < 48 * 1024; i += F.ngw * 64) { const int o = i >> 10, k = i & 1023; wrt[i] = o < 4 ? wn[k] * F.A->in[15][k * 4 + o] : (o < 36 ? wn[k] * F.A->in[17][k * 32 + (o - 4)] : 0.0f); } }
    { f32x4 w[4]; load_row(F.A->in[2], F.lane, w); bf16* H = (bf16*)(ws + WS_H);
      for (int m = F.gw; m < S; m += F.ngw) { f32x4 v[4]; load_row(F.A->in[0] + (size_t)m * 1024, F.lane, v); const float rs = row_rstd(v);
#pragma unroll
        for (int j = 0; j < 4; ++j) { const f32x4 o = v[j] * rs * w[j]; *(v2u*)(H + (size_t)m * 1024 + 4 * F.lane + 256 * j) = pack4(o); } } }
}

DI void dma_rows256(const bf16* src0, size_t pitch, int nrows, LAS unsigned char* dst, int w, int lane) {
    const int lr = lane >> 4, pc = lane & 15;
#pragma unroll 1
    for (int k = w; k < (nrows >> 2); k += 8) { const int r = k * 4 + lr; const int gc = pc ^ (r & 15);
        __builtin_amdgcn_global_load_lds((const unsigned*)(src0 + (size_t)r * pitch + gc * 8), (LAS unsigned*)(dst + k * 1024), 16, 0, 0); }
}
DI bf16x8 frag256(const LAS unsigned char* base, int row, int chunk) { return *(const LAS bf16x8*)(base + row * 256 + ((chunk ^ (row & 15)) * 16)); }
DI v2u frag256h(const LAS unsigned char* base, int row, int chunk, int half) { return *(const LAS v2u*)(base + row * 256 + ((chunk ^ (row & 15)) * 16) + half * 8); }
DI void p2_ret_state_wg(Frame& F, int u) {
    const int c = u >> 2, h = u & 3, w = F.wave, col = F.lane & 15, kq = F.lane >> 4;
    const float l2g = log2f(1.0f - __builtin_amdgcn_exp2f((float)(-5 - h)));
    const bf16* TOUT = WSP(const bf16, WS_TOUT); LAS unsigned char* L = F.lds;
    asm volatile("s_waitcnt vmcnt(0) lgkmcnt(0)" ::: "memory"); __builtin_amdgcn_s_barrier();
    dma_rows256(TOUT + (size_t)(768 + h * 256) * TP + c * 128, TP, 256, L, w, F.lane);
    dma_rows256(TOUT + (size_t)(256 + h * 128) * TP + c * 128, TP, 128, L + 65536, w, F.lane);
    asm volatile("s_waitcnt vmcnt(0)" ::: "memory"); __builtin_amdgcn_s_barrier(); asm volatile("" ::: "memory");
    f32x4 acc[16];
#pragma unroll
    for (int i = 0; i < 16; ++i) acc[i] = (f32x4){0.f, 0.f, 0.f, 0.f};
#pragma unroll
    for (int ks = 0; ks < 4; ++ks) {
        const v4u kr = __builtin_bit_cast(v4u, frag256(L + 65536, w * 16 + col, ks * 4 + kq)); float kv[8] = {bflo(kr.x), bfhi(kr.x), bflo(kr.y), bfhi(kr.y), bflo(kr.z), bfhi(kr.z), bflo(kr.w), bfhi(kr.w)};
#pragma unroll
        for (int e = 0; e < 8; ++e) kv[e] *= __builtin_amdgcn_exp2f((float)(127 - (ks * 32 + kq * 8 + e)) * l2g);
        v4u ks4 = {pk2(kv[0], kv[1]), pk2(kv[2], kv[3]), pk2(kv[4], kv[5]), pk2(kv[6], kv[7])}; const bf16x8 kf = __builtin_bit_cast(bf16x8, ks4);
#pragma unroll
        for (int dvt = 0; dvt < 16; ++dvt) acc[dvt] = mfma16(kf, frag256(L, dvt * 16 + col, ks * 4 + kq), acc[dvt]);
    }
    bf16* UR = WSP(bf16, WS_UR) + ((size_t)(c * 4 + h) * 256) * 128;
#pragma unroll
    for (int dvt = 0; dvt < 16; ++dvt) *(v2u*)(UR + (size_t)(dvt * 16 + col) * 128 + w * 16 + 4 * kq) = pack4(acc[dvt]);
}
DI void p2_cmp_hidden(Frame& F, int u) {
    const int combo = u >> 8, kind = combo >> 1, g = combo & 1, rt = (u >> 2) & 63, nq = u & 3, col = F.lane & 15, kq = F.lane >> 4;
    const bf16* W1 = WSP(const bf16, WS_WC1) + (size_t)kind * 256 * 2048 + (size_t)(nq * 64 + col) * 2048 + kq * 8;
    int tokb = 16 * (rt * 16 + col); tokb = tokb < S - 32 ? tokb : S - 32;
    const bf16* KCV = WSP(const bf16, WS_KCV) + (size_t)tokb * 512 + kind * 128 + g * 64 + kq * 8;
    f32x4 acc[4];
#pragma unroll
    for (int i = 0; i < 4; ++i) acc[i] = (f32x4){0.f, 0.f, 0.f, 0.f};
#pragma unroll 8
    for (int st = 0; st < 64; ++st) {
        const bf16x8 bfr = ld16(KCV + (size_t)(st >> 1) * 512 + (st & 1) * 32);
#pragma unroll
        for (int nt = 0; nt < 4; ++nt) { const bf16x8 af = ld16(W1 + (size_t)nt * 16 * 2048 + st * 32); acc[nt] = mfma16(af, bfr, acc[nt]); }
    }
    const float* b1 = WSP(const float, WS_SM + SM_B1) + kind * 256; bf16* HC = WSP(bf16, WS_HIDC) + (size_t)combo * 1024 * 256;
#pragma unroll
    for (int nt = 0; nt < 4; ++nt) { const int n0 = nq * 64 + nt * 16 + 4 * kq; const f32x4 bb = *(const f32x4*)(b1 + n0); f32x4 v = acc[nt] + bb;
#pragma unroll
        for (int i = 0; i < 4; ++i) v[i] = gelu_tanh(v[i]);
        *(v2u*)(HC + (size_t)(rt * 16 + col) * 256 + n0) = pack4(v); }
}
DI void p2_kmax(Frame& F, int u) {
    const int tok = u * 64 + F.lane; const bf16* KCV = WSP(const bf16, WS_KCV) + (size_t)tok * 512 + 256;
#pragma unroll
    for (int q = 0; q < 4; ++q) { float s = 0.f;
#pragma unroll
        for (int j = 0; j < 8; ++j) { const v4u k = *(const v4u*)(KCV + q * 64 + j * 8);
            const float a0 = bflo(k.x), a1 = bfhi(k.x), a2 = bflo(k.y), a3 = bfhi(k.y), a4 = bflo(k.z), a5 = bfhi(k.z), a6 = bflo(k.w), a7 = bfhi(k.w);
            s += (a0 * a0 + a1 * a1) + (a2 * a2 + a3 * a3) + (a4 * a4 + a5 * a5) + (a6 * a6 + a7 * a7); }
        const unsigned m = wave_max_u32(__float_as_uint(s));
        if (F.lane == 0) atomicMax(F.ctl + CW_KMAX + q, m); }
}
DI void p3_scan(Frame& F) {
    const int idx = blockIdx.x * NTHR + F.tid;
    if (idx < 65536) {
        const int h = idx >> 14; const float cd = __builtin_amdgcn_exp2f(128.0f * log2f(1.0f - __builtin_amdgcn_exp2f((float)(-5 - h))));
        unsigned* UR = WSP(unsigned, WS_UR) + idx; float r0 = 0.f, r1 = 0.f;
#pragma unroll 32
        for (int c = 0; c < 128; ++c) { const unsigned u = UR[(size_t)c * 65536]; UR[(size_t)c * 65536] = pk2(r0, r1); r0 = r0 * cd + bflo(u); r1 = r1 * cd + bfhi(u); }
    }
}
DI void p3_kcvc(Frame& F, int u) {
    const int combo = u >> 6, kind = combo >> 1, g = combo & 1, rt = u & 63, col = F.lane & 15, kq = F.lane >> 4;
    const bf16* HC = WSP(const bf16, WS_HIDC) + (size_t)combo * 1024 * 256 + (size_t)(rt * 16 + col) * 256 + kq * 8;
    const bf16* W2 = WSP(const bf16, WS_SM + SM_W2T) + (size_t)kind * 64 * 256 + (size_t)col * 256 + kq * 8;
    f32x4 acc[4];
#pragma unroll
    for (int i = 0; i < 4; ++i) acc[i] = (f32x4){0.f, 0.f, 0.f, 0.f};
#pragma unroll
    for (int ks = 0; ks < 8; ++ks) { const bf16x8 hf = ld16(HC + ks * 32);
#pragma unroll
        for (int dt = 0; dt < 4; ++dt) { const bf16x8 wf = ld16(W2 + (size_t)dt * 16 * 256 + ks * 32); acc[dt] = kind ? mfma16(hf, wf, acc[dt]) : mfma16(wf, hf, acc[dt]); } }
    if (kind == 0) { bf16* KC = WSP(bf16, WS_SM + SM_KC) + (size_t)g * 1024 * 64;
#pragma unroll
        for (int dt = 0; dt < 4; ++dt) *(v2u*)(KC + (size_t)(rt * 16 + col) * 64 + dt * 16 + 4 * kq) = pack4(acc[dt]); }
    else { bf16* VCT = WSP(bf16, WS_SM + SM_VCT) + (size_t)g * 64 * 1024;
#pragma unroll
        for (int dt = 0; dt < 4; ++dt) *(v2u*)(VCT + (size_t)(dt * 16 + col) * 1024 + rt * 16 + 4 * kq) = pack4(acc[dt]); }
}

DI void p4_bias_table(Frame& F) {
    LAS float* bt = (LAS float*)(F.lds + BIAS_OFF); const float* rb = F.A->in[1];
    for (int i = F.tid; i < 129 * 8; i += NTHR) { const int dist = i >> 3, hd = i & 7; int b = dist;
        if (dist >= 16) { b = 16 + (int)(logf((float)dist / 16.0f) / 2.0794415416798357f * 16.0f); b = b < 31 ? b : 31; }
        bt[i] = rb[b * 8 + hd] * LOG2E; }
    __syncthreads();
    { LAS float* nb = (LAS float*)(F.lds + NEAR_OFF);
      for (int i = F.tid; i < 256 * 8; i += NTHR) { const int dist = (i >> 3) - 64; nb[i] = dist < 0 ? -1e30f : bt[(dist > 128 ? 128 : dist) * 8 + (i & 7)]; } }
    if (F.tid < 64) { float m = 0.f; for (int i = F.tid; i < 129 * 8; i += 64) m = fmaxf(m, fabsf(bt[i]));
#pragma unroll
        for (int o = 1; o < 64; o <<= 1) m = fmaxf(m, __shfl_xor(m, o));
        if (F.tid == 0) bt[129 * 8] = m; }
    __syncthreads();
}
DI void p4a_unit(Frame& F, int qt, int g, int dbg) {
    const bool noval = dbg & 1024, noload = dbg & 2048;
    const int lane = F.lane, col = lane & 15, rq = lane >> 4, t0 = qt * 16, tq = t0 + col;
    LAS float* wl = (LAS float*)(F.lds + F.wave * WAVE_LDS);
    const LAS float* bt = (const LAS float*)(F.lds + BIAS_OFF);
    const float bmax = bt[129 * 8];
    const bf16* QA = WSP(const bf16, WS_QA); const bf16* KCV = WSP(const bf16, WS_KCV); const bf16* TOUT = WSP(const bf16, WS_TOUT); const bf16* GA = WSP(const bf16, WS_GA);
    const bf16* KC = WSP(const bf16, WS_SM + SM_KC) + (size_t)g * 1024 * 64; const bf16* VCT = WSP(const bf16, WS_SM + SM_VCT) + (size_t)g * 64 * 1024;
    const float kmax_sel = sqrtf(__uint_as_float(F.ctl[CW_KMAX + g])), kmax_win = sqrtf(__uint_as_float(F.ctl[CW_KMAX + 2 + g]));
    bf16x8 qf[4][2]; float qn[4];
#pragma unroll
    for (int j = 0; j < 4; ++j) { float s = 0.f;
#pragma unroll
        for (int ks = 0; ks < 2; ++ks) { const v4u q = *(const v4u*)(QA + (size_t)tq * 512 + (g * 4 + j) * 64 + ks * 32 + rq * 8); qf[j][ks] = __builtin_bit_cast(bf16x8, q);
            const float a0 = bflo(q.x), a1 = bfhi(q.x), a2 = bflo(q.y), a3 = bfhi(q.y), a4 = bflo(q.z), a5 = bfhi(q.z), a6 = bflo(q.w), a7 = bfhi(q.w);
            s += (a0 * a0 + a1 * a1) + (a2 * a2 + a3 * a3) + (a4 * a4 + a5 * a5) + (a6 * a6 + a7 * a7); }
        qn[j] = sqrtf(quad_sum(s)); }
    const f32x4 z4 = {0.f, 0.f, 0.f, 0.f};
    f32x4 ACC[4][4];
#pragma unroll
    for (int j = 0; j < 4; ++j)
#pragma unroll
        for (int dt = 0; dt < 4; ++dt) ACC[j][dt] = z4;
    {
        float lw[4], bw[4];
#pragma unroll
        for (int j = 0; j < 4; ++j) { lw[j] = 0.f; bw[j] = qn[j] * kmax_win + bmax; }
        int pstart = (t0 - 511) & ~31; pstart = pstart < 0 ? 0 : pstart;
        for (int p0 = pstart; p0 <= ((dbg & 8192) ? pstart : t0 + 15); p0 += 32) {
            const bool farw = noval || ((p0 + 31 <= t0 - 128) && (p0 > t0 + 15 - 512));
            bf16x8 kf[2][2], vf[4]; const int p0l = noload ? pstart : p0;
#pragma unroll
            for (int kt = 0; kt < 2; ++kt)
#pragma unroll
                for (int ks = 0; ks < 2; ++ks) kf[kt][ks] = ld16(KCV + (size_t)(p0l + kt * 16 + col) * 512 + 384 + g * 64 + ks * 32 + rq * 8);
#pragma unroll
            for (int dt = 0; dt < 4; ++dt) vf[dt] = ld8x2(TOUT + (size_t)(128 + g * 64 + dt * 16 + col) * TP + p0l + 4 * rq, 16);
#pragma unroll
            for (int j = 0; j < 4; ++j) {
                f32x4 p[2];
#pragma unroll
                for (int kt = 0; kt < 2; ++kt) { f32x4 s = mfma16(kf[kt][0], qf[j][0], z4); s = mfma16(kf[kt][1], qf[j][1], s);
                    if (farw) {
                        const float cf = bt[128 * 8 + g * 4 + j] - bw[j];
#pragma unroll
                        for (int e = 0; e < 4; ++e) { const float v = __builtin_amdgcn_exp2f(s[e] + cf); p[kt][e] = v; lw[j] += v; }
                    } else {
#pragma unroll
                    for (int e = 0; e < 4; ++e) { const int dist = tq - (p0 + kt * 16 + 4 * rq + e); const int dc = dist < 0 ? 0 : (dist > 128 ? 128 : dist);
                        const float v = (dist >= 0 && dist < 512) ? __builtin_amdgcn_exp2f(s[e] + bt[dc * 8 + g * 4 + j] - bw[j]) : 0.f; p[kt][e] = v; lw[j] += v; } } }
                const bf16x8 pb = pack8(p[0], p[1]);
#pragma unroll
                for (int dt = 0; dt < 4; ++dt) ACC[j][dt] = mfma16(vf[dt], pb, ACC[j][dt]);
            }
        }
#pragma unroll
        for (int j = 0; j < 4; ++j) { const float sc = bf1(GA[(size_t)tq * 32 + 16 + g * 4 + j]) / quad_sum(lw[j]);
#pragma unroll
            for (int dt = 0; dt < 4; ++dt) ACC[j][dt] = ACC[j][dt] * sc; }
    }
    const int nkc = qt < 1023 ? qt : 1023, nst = (dbg & 8192) ? 0 : ((nkc + 31) >> 5);
    float m1[4], l1[4];
#pragma unroll
    for (int j = 0; j < 4; ++j) { m1[j] = -1e30f; l1[j] = 0.f; }
    for (int st = 0; st < nst; ++st) {
        const bool farc = noval || 16 * (st * 32 + 31) + 31 <= t0 - 128;
        bf16x8 kf[2][2]; const int stl = noload ? 0 : st;
#pragma unroll
        for (int kt = 0; kt < 2; ++kt)
#pragma unroll
            for (int ks = 0; ks < 2; ++ks) kf[kt][ks] = ld16(KC + (size_t)(stl * 32 + kt * 16 + col) * 64 + ks * 32 + rq * 8);
#pragma unroll
        for (int j = 0; j < 4; ++j) {
            float sv[8]; float tm = -1e30f;
#pragma unroll
            for (int kt = 0; kt < 2; ++kt) { f32x4 s = mfma16(kf[kt][0], qf[j][0], z4); s = mfma16(kf[kt][1], qf[j][1], s);
                if (farc) { const float bf_ = bt[128 * 8 + g * 4 + j];
#pragma unroll
                    for (int e = 0; e < 4; ++e) { const float v = s[e] + bf_; sv[kt * 4 + e] = v; tm = fmaxf(tm, v); }
                } else {
#pragma unroll
                for (int e = 0; e < 4; ++e) { const int ci = st * 32 + kt * 16 + 4 * rq + e, dist = tq - (16 * ci + 31); const int dc = dist < 0 ? 0 : (dist > 128 ? 128 : dist);
                    const float v = dist >= 0 ? s[e] + bt[dc * 8 + g * 4 + j] : -1e30f; sv[kt * 4 + e] = v; tm = fmaxf(tm, v); } } }
            const float mn = fmaxf(m1[j], tm); float ls = 0.f;
#pragma unroll
            for (int e = 0; e < 8; ++e) ls += sv[e] > -1e29f ? __builtin_amdgcn_exp2f(sv[e] - mn) : 0.f;
            l1[j] = l1[j] * __builtin_amdgcn_exp2f(m1[j] - mn) + ls; m1[j] = mn;
        }
    }
    float mc[4], ilc[4];
#pragma unroll
    for (int j = 0; j < 4; ++j) { const float M = quad_max(m1[j]); const float l = quad_sum(l1[j] * __builtin_amdgcn_exp2f(m1[j] - M)); mc[j] = M; ilc[j] = l > 0.f ? 1.0f / l : 0.f; }
    {
        float gcmp[4];
#pragma unroll
        for (int j = 0; j < 4; ++j) gcmp[j] = bf1(GA[(size_t)tq * 32 + g * 4 + j]);
        float xprev = 0.f;
        for (int st = 0; st < nst; ++st) {
            const bool farc = noval || 16 * (st * 32 + 31) + 31 <= t0 - 128;
            bf16x8 kf[2][2], vf[4]; const int stl = noload ? 0 : st;
#pragma unroll
            for (int kt = 0; kt < 2; ++kt)
#pragma unroll
                for (int ks = 0; ks < 2; ++ks) kf[kt][ks] = ld16(KC + (size_t)(stl * 32 + kt * 16 + col) * 64 + ks * 32 + rq * 8);
#pragma unroll
            for (int dt = 0; dt < 4; ++dt) vf[dt] = ld8x2(VCT + (size_t)(dt * 16 + col) * 1024 + stl * 32 + 4 * rq, 16);
            f32x4 ps[2] = {z4, z4};
#pragma unroll
            for (int j = 0; j < 4; ++j) {
                f32x4 p[2];
#pragma unroll
                for (int kt = 0; kt < 2; ++kt) { f32x4 s = mfma16(kf[kt][0], qf[j][0], z4); s = mfma16(kf[kt][1], qf[j][1], s);
                    if (farc) { const float cf = bt[128 * 8 + g * 4 + j] - mc[j];
#pragma unroll
                        for (int e = 0; e < 4; ++e) { const float v = __builtin_amdgcn_exp2f(s[e] + cf) * ilc[j]; ps[kt][e] += v; p[kt][e] = v * gcmp[j]; }
                    } else {
#pragma unroll
                    for (int e = 0; e < 4; ++e) { const int ci = st * 32 + kt * 16 + 4 * rq + e, dist = tq - (16 * ci + 31); const int dc = dist < 0 ? 0 : (dist > 128 ? 128 : dist);
                        const float v = dist >= 0 ? __builtin_amdgcn_exp2f(s[e] + bt[dc * 8 + g * 4 + j] - mc[j]) * ilc[j] : 0.f; ps[kt][e] += v; p[kt][e] = v * gcmp[j]; } } }
                const bf16x8 pb = pack8(p[0], p[1]);
#pragma unroll
                for (int dt = 0; dt < 4; ++dt) ACC[j][dt] = mfma16(vf[dt], pb, ACC[j][dt]);
            }
#pragma unroll
            for (int kt = 0; kt < 2; ++kt) {
                const float Gs = (ps[kt][0] + ps[kt][1]) + (ps[kt][2] + ps[kt][3]), X = ps[kt][3];
                const float xa = __shfl(X, (lane + 48) & 63), xb = __shfl(xprev, (lane + 48) & 63);
                const float xin = rq > 0 ? xa : xb;
                wl[col * 257 + st * 8 + kt * 4 + rq] = Gs + xin; xprev = X;
            }
        }
    }
    float* PART = F.out + (size_t)tq * 512 + g * 256;
#pragma unroll
    for (int j = 0; j < 4; ++j)
#pragma unroll
        for (int dt = 0; dt < 4; ++dt) *(f32x4*)(PART + j * 64 + dt * 16 + 4 * rq) = ACC[j][dt];
    LDS_WAIT();
    unsigned long long* SELM = (unsigned long long*)((unsigned char*)F.out + (size_t)32 * MiB);
    for (int i0 = 0; i0 < ((dbg & 4096) ? 0 : 16); i0 += 4) {
        const int cur = (t0 + i0) >> 6; unsigned k[4][4], T[4] = {0u, 0u, 0u, 0u};
#pragma unroll
        for (int qq = 0; qq < 4; ++qq)
#pragma unroll
            for (int e = 0; e < 4; ++e) { const int n = lane * 4 + e; const float v = wl[(i0 + qq) * 257 + n];
                k[qq][e] = (n == 0 || (n <= cur && n + 2 > cur)) ? 0x7F000000u : (n <= cur ? __float_as_uint(v) + 1u : 0u); }
#pragma unroll 1
        for (int bit = 30; bit >= 0; --bit) {
#pragma unroll
            for (int qq = 0; qq < 4; ++qq) { const unsigned c = T[qq] | (1u << bit);
                const int cnt = __popcll(__ballot(k[qq][0] >= c)) + __popcll(__ballot(k[qq][1] >= c)) + __popcll(__ballot(k[qq][2] >= c)) + __popcll(__ballot(k[qq][3] >= c));
                if (cnt >= 16) T[qq] = c; } }
#pragma unroll
        for (int qq = 0; qq < 4; ++qq) {
            unsigned long long bsel[4]; int ngt = 0;
#pragma unroll
            for (int e = 0; e < 4; ++e) { bsel[e] = __ballot(k[qq][e] > T[qq] && k[qq][e] != 0u); ngt += __popcll(bsel[e]); }
            if (T[qq] != 0u) {
                int need = 16 - ngt;
                unsigned long long beq[4];
#pragma unroll
                for (int e = 0; e < 4; ++e) beq[e] = __ballot(k[qq][e] == T[qq]);
                while (need > 0) {
                    int bestn = 1 << 30, be = 0;
#pragma unroll
                    for (int e = 0; e < 4; ++e) if (beq[e]) { const int n = 4 * (__ffsll((long long)beq[e]) - 1) + e; if (n < bestn) { bestn = n; be = e; } }
                    if (bestn == (1 << 30)) break;
                    const unsigned long long bitm = 1ull << (bestn >> 2);
                    if (be == 0) { bsel[0] |= bitm; beq[0] &= ~bitm; } else if (be == 1) { bsel[1] |= bitm; beq[1] &= ~bitm; } else if (be == 2) { bsel[2] |= bitm; beq[2] &= ~bitm; } else { bsel[3] |= bitm; beq[3] &= ~bitm; }
                    --need;
                }
            }
            if (lane < 4) SELM[((size_t)(t0 + i0 + qq) * 2 + g) * 4 + lane] = lane == 0 ? bsel[0] : (lane == 1 ? bsel[1] : (lane == 2 ? bsel[2] : bsel[3]));
        }
    }
    LDS_WAIT();
}
DI void p4b_pass(LAS unsigned char* ldsb, unsigned char* ws, float* outp, int tA, int tB, int g, int dbg) {
    Frame F; F.lds = ldsb; F.ws = ws; F.out = outp; F.ctl = (unsigned*)(ws + WS_CTL); F.tid = threadIdx.x; F.lane = F.tid & 63; F.wave = __builtin_amdgcn_readfirstlane(F.tid >> 6); F.G = gridDim.x; F.gw = 0; F.ngw = 0; F.A = nullptr;
    const int lane = F.lane, w = F.wave, col = lane & 15, rq = lane >> 4, hj = col & 3;
    LAS unsigned char* L = F.lds;
    const LAS float* bt = (const LAS float*)(L + BIAS_OFF); const float bmax = bt[129 * 8];
    const bf16* QA = WSP(const bf16, WS_QA); const bf16* KCV = WSP(const bf16, WS_KCV); const bf16* TOUT = WSP(const bf16, WS_TOUT); const bf16* GA = WSP(const bf16, WS_GA);
    const float kmax_sel = sqrtf(__uint_as_float(F.ctl[CW_KMAX + g]));
    const unsigned long long* SELM = (const unsigned long long*)((const unsigned char*)F.out + (size_t)32 * MiB);
    bf16x8 qb[4][2]; float bnd[4]; int tq[4];
    LAS unsigned long long* PKL = (LAS unsigned long long*)(L + 131072) + w * 64;
#pragma unroll
    for (int ct = 0; ct < 4; ++ct) { const int t = (ct < 2 ? tA : tB) * 64 + w * 8 + (ct & 1) * 4 + (col >> 2); tq[ct] = t; float s = 0.f;
#pragma unroll
        for (int ks = 0; ks < 2; ++ks) { const v4u q = *(const v4u*)(QA + (size_t)t * 512 + (g * 4 + hj) * 64 + ks * 32 + rq * 8); qb[ct][ks] = __builtin_bit_cast(bf16x8, q);
            const float a0 = bflo(q.x), a1 = bfhi(q.x), a2 = bflo(q.y), a3 = bfhi(q.y), a4 = bflo(q.z), a5 = bfhi(q.z), a6 = bflo(q.w), a7 = bfhi(q.w);
            s += (a0 * a0 + a1 * a1) + (a2 * a2 + a3 * a3) + (a4 * a4 + a5 * a5) + (a6 * a6 + a7 * a7); }
        bnd[ct] = sqrtf(quad_sum(s)) * kmax_sel + bmax; }
    { const int q = lane >> 2, e = lane & 3; const int t = ((q >> 3) ? tB : tA) * 64 + w * 8 + (q & 7); PKL[lane] = SELM[((size_t)t * 2 + g) * 4 + e]; }
    asm volatile("s_waitcnt vmcnt(0) lgkmcnt(0)" ::: "memory");
    const f32x4 z4 = {0.f, 0.f, 0.f, 0.f};
    f32x4 O[4][4], O1[4];
    v4u ones_u = col == 0 ? (v4u){0x3F803F80u, 0x3F803F80u, 0x3F803F80u, 0x3F803F80u} : (v4u){0u, 0u, 0u, 0u}; const bf16x8 onesA = __builtin_bit_cast(bf16x8, ones_u);
#pragma unroll
    for (int ct = 0; ct < 4; ++ct)
#pragma unroll
        for (int dt = 0; dt < 4; ++dt) O[ct][dt] = z4;
#pragma unroll
    for (int ct = 0; ct < 4; ++ct) O1[ct] = z4;
    const float bfar = bt[128 * 8 + g * 4 + hj];
    const int dr = lane >> 3, dc = (lane & 7) ^ dr, nb = tB + 1;
    const bf16* kbase = KCV + (size_t)(w * 8 + dr) * 512 + 256 + g * 64 + dc * 8;
    const bf16* vbase = TOUT + (size_t)(g * 64 + w * 8 + dr) * TP + dc * 8;
#define P4B_ISSUE(blk_, slot) do { if (dbg & 32768) break; \
        __builtin_amdgcn_global_load_lds((const unsigned*)(kbase + (size_t)(blk_) * 64 * 512), (LAS unsigned*)(L + (slot) * 16384 + w * 1024), 16, 0, 0); \
        __builtin_amdgcn_global_load_lds((const unsigned*)(vbase + (size_t)(blk_) * 64), (LAS unsigned*)(L + (slot) * 16384 + 8192 + w * 1024), 16, 0, 0); } while (0)
    asm volatile("s_waitcnt vmcnt(0)" ::: "memory");
    __builtin_amdgcn_s_barrier();
    const int ngrp = (nb + 3) >> 2;
#pragma unroll 1
    for (int b4 = 0; b4 < 4; ++b4) if (b4 < nb) P4B_ISSUE(b4, b4);
#pragma unroll 1
    for (int gi = 0; gi < ngrp; ++gi) {
        asm volatile("s_waitcnt vmcnt(0)" ::: "memory");
        asm volatile("s_waitcnt lgkmcnt(0)" ::: "memory"); __builtin_amdgcn_s_barrier(); asm volatile("" ::: "memory");
#pragma unroll 1
        for (int b4 = 0; b4 < 4; ++b4) { const int nblk = (gi + 1) * 4 + b4; if (nblk < nb) P4B_ISSUE(nblk, ((gi + 1) & 1) * 4 + b4); }
#pragma unroll 1
      for (int b4 = 0; b4 < 4; ++b4) {
        const int blk = gi * 4 + b4; if (blk >= nb) break;
        const LAS unsigned char* ring = L + ((gi & 1) * 4 + b4) * 16384;
        const int Lb = blk >> 2;
#pragma unroll
        for (int ct = 0; ct < 4; ++ct) {
            const unsigned long long word = PKL[(ct * 4 + (col >> 2)) * 4 + b4];
            const bool pick = (word >> Lb) & 1ull;
            if (__ballot(pick) == 0ull || (dbg & 16384)) continue;
            const int cur = ct < 2 ? tA : tB;
            const bool farb = blk + 3 <= cur;
            const float binit = pick ? (farb ? bfar - bnd[ct] : -bnd[ct]) : -1e30f; const f32x4 cinit = {binit, binit, binit, binit};
            f32x4 sacc[4];
#pragma unroll
            for (int kt = 0; kt < 4; ++kt) { const int key = kt * 16 + col;
                const bf16x8 k0 = *(const LAS bf16x8*)(ring + key * 128 + ((rq ^ (key & 7)) * 16)), k1 = *(const LAS bf16x8*)(ring + key * 128 + (((4 + rq) ^ (key & 7)) * 16));
                sacc[kt] = mfma16(k0, qb[ct][0], cinit); sacc[kt] = mfma16(k1, qb[ct][1], sacc[kt]); }
            if (farb) {
#pragma unroll
                for (int kt = 0; kt < 4; ++kt)
#pragma unroll
                    for (int e = 0; e < 4; ++e) sacc[kt][e] = __builtin_amdgcn_exp2f(sacc[kt][e]);
            } else {
                const LAS float* nbp = (const LAS float*)(L + NEAR_OFF) + (tq[ct] + 64 - blk * 64 - 4 * rq) * 8 + g * 4 + hj;
#pragma unroll
                for (int kt = 0; kt < 4; ++kt)
#pragma unroll
                    for (int e = 0; e < 4; ++e) sacc[kt][e] = __builtin_amdgcn_exp2f(sacc[kt][e] + nbp[-(kt * 16 + e) * 8]);
            }
            const bf16x8 pb0 = pack8(sacc[0], sacc[1]), pb1 = pack8(sacc[2], sacc[3]);
            O1[ct] = mfma16(onesA, pb0, O1[ct]); O1[ct] = mfma16(onesA, pb1, O1[ct]);
#pragma unroll
            for (int dt = 0; dt < 4; ++dt) { const int d = dt * 16 + col; const LAS unsigned char* vr = ring + 8192 + d * 128 + (rq & 1) * 8; const int sw = d & 7, c0 = rq >> 1;
                const v2u a0 = *(const LAS v2u*)(vr + ((c0 ^ sw) * 16)), a1 = *(const LAS v2u*)(vr + (((c0 + 2) ^ sw) * 16)), a2 = *(const LAS v2u*)(vr + (((c0 + 4) ^ sw) * 16)), a3 = *(const LAS v2u*)(vr + (((c0 + 6) ^ sw) * 16));
                v4u v0 = {a0.x, a0.y, a1.x, a1.y}, v1 = {a2.x, a2.y, a3.x, a3.y};
                O[ct][dt] = mfma16(__builtin_bit_cast(bf16x8, v0), pb0, O[ct][dt]); O[ct][dt] = mfma16(__builtin_bit_cast(bf16x8, v1), pb1, O[ct][dt]); }
        }
      }
    }
#pragma unroll
    for (int ct = 0; ct < 4; ++ct) { const int t = tq[ct]; const float sc = bf1(GA[(size_t)t * 32 + 8 + g * 4 + hj]) / quad_sum(rq == 0 ? O1[ct][0] : 0.f);
        const float* part = F.out + (size_t)t * 512 + g * 256 + hj * 64; bf16* ya = WSP(bf16, WS_QA) + (size_t)t * 512 + (g * 4 + hj) * 64;
#pragma unroll
        for (int dt = 0; dt < 4; ++dt) { const f32x4 p = *(const f32x4*)(part + dt * 16 + 4 * rq); const f32x4 o = p + O[ct][dt] * sc; *(v2u*)(ya + dt * 16 + 4 * rq) = pack4(o); } }
    asm volatile("s_waitcnt vmcnt(0) lgkmcnt(0)" ::: "memory");
#undef P4B_ISSUE
}
DI void p4_ret_wg(Frame& F, int u) {
    const int c = u >> 2, h = u & 3, q8 = F.wave, lane = F.lane, col = lane & 15, rq = lane >> 4;
    const int il = q8 * 16 + col, tq = c * 128 + il;
    const float l2g = log2f(1.0f - __builtin_amdgcn_exp2f((float)(-5 - h)));
    const bf16* QR = WSP(const bf16, WS_QR); const bf16* KR = WSP(const bf16, WS_KR); const bf16* TOUT = WSP(const bf16, WS_TOUT); LAS unsigned char* L = F.lds;
    const bf16* RT = WSP(const bf16, WS_UR) + ((size_t)(c * 4 + h) * 256) * 128;
    asm volatile("s_waitcnt vmcnt(0) lgkmcnt(0)" ::: "memory"); __builtin_amdgcn_s_barrier();
    dma_rows256(RT, 128, 256, L, F.wave, lane);
    bf16x8 qf[4];
#pragma unroll
    for (int ks = 0; ks < 4; ++ks) qf[ks] = ld16(QR + (size_t)tq * 512 + h * 128 + ks * 32 + rq * 8);
    asm volatile("s_waitcnt vmcnt(0)" ::: "memory"); __builtin_amdgcn_s_barrier(); asm volatile("" ::: "memory");
    f32x4 ACC[16]; const f32x4 z4 = {0.f, 0.f, 0.f, 0.f};
#pragma unroll
    for (int i = 0; i < 16; ++i) ACC[i] = z4;
#pragma unroll
    for (int ks = 0; ks < 4; ++ks)
#pragma unroll
        for (int dvt = 0; dvt < 16; ++dvt) ACC[dvt] = mfma16(frag256(L, dvt * 16 + col, ks * 4 + rq), qf[ks], ACC[dvt]);
    { const float qd = __builtin_amdgcn_exp2f((float)(il + 1) * l2g);
#pragma unroll
      for (int i = 0; i < 16; ++i) ACC[i] = ACC[i] * qd; }
    asm volatile("s_waitcnt lgkmcnt(0)" ::: "memory"); __builtin_amdgcn_s_barrier(); asm volatile("" ::: "memory");
    dma_rows256(TOUT + (size_t)(768 + h * 256) * TP + c * 128, TP, 256, L, F.wave, lane);
    dma_rows256(KR + (size_t)(c * 128) * 512 + h * 128, 512, 128, L + 65536, F.wave, lane);
    asm volatile("s_waitcnt vmcnt(0)" ::: "memory"); __builtin_amdgcn_s_barrier(); asm volatile("" ::: "memory");
    const int nkp = (q8 * 16 + 16 + 31) >> 5;
    for (int kp = 0; kp < nkp; ++kp) {
        f32x4 p[2];
#pragma unroll
        for (int kt = 0; kt < 2; ++kt) { f32x4 s = z4;
#pragma unroll
            for (int ks = 0; ks < 4; ++ks) s = mfma16(frag256(L + 65536, kp * 32 + kt * 16 + col, ks * 4 + rq), qf[ks], s);
#pragma unroll
            for (int e = 0; e < 4; ++e) { const int dj = il - (kp * 32 + kt * 16 + 4 * rq + e); p[kt][e] = dj >= 0 ? s[e] * __builtin_amdgcn_exp2f((float)dj * l2g) : 0.f; } }
        const bf16x8 pb = pack8(p[0], p[1]);
#pragma unroll
        for (int dvt = 0; dvt < 16; ++dvt) { const v2u lo = frag256h(L, dvt * 16 + col, kp * 4 + (rq >> 1), rq & 1), hi = frag256h(L, dvt * 16 + col, kp * 4 + 2 + (rq >> 1), rq & 1);
            v4u v = {lo.x, lo.y, hi.x, hi.y}; ACC[dvt] = mfma16(__builtin_bit_cast(bf16x8, v), pb, ACC[dvt]); }
    }
    float s1 = 0.f;
#pragma unroll
    for (int i = 0; i < 16; ++i) s1 += (ACC[i][0] + ACC[i][1]) + (ACC[i][2] + ACC[i][3]);
    const float mu = quad_sum(s1) * (1.0f / 256.0f); float s2 = 0.f;
#pragma unroll
    for (int i = 0; i < 16; ++i) { ACC[i] = ACC[i] - mu; s2 += (ACC[i][0] * ACC[i][0] + ACC[i][1] * ACC[i][1]) + (ACC[i][2] * ACC[i][2] + ACC[i][3] * ACC[i][3]); }
    const float rs = 1.0f / sqrtf(quad_sum(s2) * (1.0f / 256.0f) + EPS);
    bf16* GR = WSP(bf16, WS_GR) + (size_t)tq * 1024 + h * 256; const float* rn = F.A->in[10] + h * 256;
#pragma unroll
    for (int dvt = 0; dvt < 16; ++dvt) { const int d0 = dvt * 16 + 4 * rq; const v2u gv = *(const v2u*)(GR + d0); const f32x4 w = *(const f32x4*)(rn + d0);
        f32x4 o; o[0] = siluf_(bflo(gv.x)) * ACC[dvt][0] * rs * w[0]; o[1] = siluf_(bfhi(gv.x)) * ACC[dvt][1] * rs * w[1]; o[2] = siluf_(bflo(gv.y)) * ACC[dvt][2] * rs * w[2]; o[3] = siluf_(bfhi(gv.y)) * ACC[dvt][3] * rs * w[3];
        *(v2u*)(GR + d0) = pack4(o); }
}

DI int moe_row(int f) { const int fp = f & 127; return (f >> 7) * 256 + 128 * (fp >> 6) + 32 * ((fp >> 4) & 3) + 4 * ((fp >> 2) & 3) + (fp & 3); }
DI void p8_route_item(Frame& F, int item) {
    const int lane = F.lane, row = lane & 15, kq = lane >> 4, m0 = item * 16, slot = F.wave & 3, hh = F.wave >> 2; const float* x1 = F.out; bf16* H2 = WSP(bf16, WS_H);
    LAS float* lg = (LAS float*)(F.lds + slot * WAVE_LDS);
    LAS float* ex = (LAS float*)(F.lds + slot * WAVE_LDS + 3200);
    const float* WRT = WSP(const float, WS_SM + SM_WRT);
    const float* xr = x1 + (size_t)(m0 + row) * 1024 + 4 * kq + hh * 512; const float* wr = WRT + (size_t)row * 1024 + 4 * kq + hh * 512;
    f32x4 acc[3]; float ss = 0.f;
#pragma unroll
    for (int ct = 0; ct < 3; ++ct) acc[ct] = (f32x4){0.f, 0.f, 0.f, 0.f};
#pragma unroll 8
    for (int c = 0; c < 32; ++c) {
        const f32x4 xa = *(const f32x4*)(xr + 16 * c); ss += (xa[0] * xa[0] + xa[1] * xa[1]) + (xa[2] * xa[2] + xa[3] * xa[3]);
#pragma unroll
        for (int ct = 0; ct < 3; ++ct) { const f32x4 wb = *(const f32x4*)(wr + (size_t)ct * 16 * 1024 + 16 * c);
#pragma unroll
            for (int j = 0; j < 4; ++j) acc[ct] = __builtin_amdgcn_mfma_f32_16x16x4f32(xa[j], wb[j], acc[ct], 0, 0, 0); }
    }
    if (hh == 1) {
#pragma unroll
        for (int ct = 0; ct < 3; ++ct)
#pragma unroll
            for (int j = 0; j < 4; ++j) ex[(ct * 4 + j) * 64 + lane] = acc[ct][j];
        ex[12 * 64 + lane] = ss;
    }
    LDS_WAIT(); __syncthreads();
    LAS unsigned* lcnt = (LAS unsigned*)(F.lds + 4 * WAVE_LDS);
    if (F.tid < 64) lcnt[F.tid] = 0u;
    int ex1 = 0, ex2 = 0; unsigned lr1 = 0u, lr2 = 0u; float w1 = 0.f, w2 = 0.f;
    if (hh == 0) {
#pragma unroll
        for (int ct = 0; ct < 3; ++ct)
#pragma unroll
            for (int j = 0; j < 4; ++j) acc[ct][j] += ex[(ct * 4 + j) * 64 + lane];
        ss += ex[12 * 64 + lane];
        const float rs = 1.0f / sqrtf(quad_sum(ss) * (1.0f / 1024.0f) + EPS);
        if (kq == 0) lg[16 * 48 + row] = rs;
#pragma unroll
        for (int ct = 0; ct < 3; ++ct)
#pragma unroll
            for (int j = 0; j < 4; ++j) lg[(4 * kq + j) * 48 + ct * 16 + row] = acc[ct][j];
    }
    LDS_WAIT(); __syncthreads();
    if (hh == 0 && lane < 16) {
        const float rst = lg[16 * 48 + lane]; float l[36];
#pragma unroll
        for (int o = 0; o < 36; ++o) l[o] = lg[lane * 48 + o] * rst + (o < 4 ? F.A->in[16][o] : F.A->in[18][o - 4]);
        int grp = 0; float mg = l[0];
#pragma unroll
        for (int i = 1; i < 4; ++i) if (l[i] > mg) { mg = l[i]; grp = i; }
        float Z = 0.f;
#pragma unroll
        for (int i = 0; i < 4; ++i) Z += expf(l[i] - mg);
        const float pg = 1.0f / Z;
        float le[8];
#pragma unroll
        for (int i = 0; i < 8; ++i) le[i] = grp == 0 ? l[4 + i] : (grp == 1 ? l[12 + i] : (grp == 2 ? l[20 + i] : l[28 + i]));
        int i1 = 0; float v1 = le[0];
#pragma unroll
        for (int i = 1; i < 8; ++i) if (le[i] > v1) { v1 = le[i]; i1 = i; }
        int i2 = -1; float v2 = -3.0e38f;
#pragma unroll
        for (int i = 0; i < 8; ++i) if (i != i1 && le[i] > v2) { v2 = le[i]; i2 = i; }
        const float e2 = expf(v2 - v1); w1 = pg / (1.0f + e2); w2 = pg * e2 / (1.0f + e2);
        ex1 = grp * 8 + i1; ex2 = grp * 8 + i2;
        lr1 = __hip_atomic_fetch_add(lcnt + ex1, 1u, __ATOMIC_RELAXED, __HIP_MEMORY_SCOPE_WORKGROUP); lr2 = __hip_atomic_fetch_add(lcnt + ex2, 1u, __ATOMIC_RELAXED, __HIP_MEMORY_SCOPE_WORKGROUP);
    }
    LDS_WAIT(); __syncthreads();
    if (F.tid < 32) { const unsigned n = lcnt[F.tid]; lcnt[32 + F.tid] = n ? atomicAdd(F.ctl + CW_CNT + F.tid, n) : 0u; }
    LDS_WAIT(); __syncthreads();
    if (hh == 0 && lane < 16) {
        const int t = m0 + lane; v2u* LIST = WSP(v2u, WS_XS);
        LIST[(size_t)ex1 * 16384 + lcnt[32 + ex1] + lr1] = (v2u){(unsigned)(t * 2 + 0), __float_as_uint(w1)};
        LIST[(size_t)ex2 * 16384 + lcnt[32 + ex2] + lr2] = (v2u){(unsigned)(t * 2 + 1), __float_as_uint(w2)};
    }
    { f32x4 w[4]; load_row(F.A->in[14], lane, w);
#pragma unroll 4
      for (int r8 = 0; r8 < 8; ++r8) { const int r = hh * 8 + r8; f32x4 v[4]; load_row(x1 + (size_t)(m0 + r) * 1024, lane, v); const float rst = lg[16 * 48 + r];
#pragma unroll
        for (int j = 0; j < 4; ++j) *(v2u*)(H2 + (size_t)(m0 + r) * 1024 + 4 * lane + 256 * j) = pack4(v[j] * rst * w[j]); } }
    LDS_WAIT(); __syncthreads();
}
DI void p8_moe_weights(Frame& F) {
    LAS float* scr = (LAS float*)(F.lds + F.wave * WAVE_LDS + 4096);
    bf16* WGU = WSP(bf16, WS_MOEW); bf16* WD = WGU + (size_t)32 * 512 * 1024;
    for (int it = F.gw; it < 3 * 4096; it += F.ngw) {
        const int which = it >> 12, r = it & 4095;
        if (which < 2) { const int e = r >> 7, q = r & 127, kb = q >> 3, nb = q & 7; bf16* dstb = WGU + (size_t)e * 512 * 1024 + (which ? 16 * 1024 : 0);
            tr_item((which ? F.A->in[20] : F.A->in[19]) + (size_t)e * 1024 * 256, 256, 256, 64 * kb, 32 * nb, scr, F.lane, [dstb](int n, int w2) { return w2 ? (bf16*)nullptr : dstb + (size_t)moe_row(n) * 1024; }); }
        else { const int e = r >> 7, q = r & 127, kb = q >> 5, nb = q & 31; bf16* dstb = WD + (size_t)e * 1024 * 256;
            tr_item(F.A->in[21] + (size_t)e * 256 * 1024, 1024, 1024, 64 * kb, 32 * nb, scr, F.lane, [dstb](int n, int w2) { return w2 ? (bf16*)nullptr : dstb + (size_t)n * 256; }); }
    }
}
DI void moe_tile_prefix(Frame& F) {
    LAS int* tp = (LAS int*)(F.lds + MOET_OFF);
    if (F.tid == 0) { int a = 0; for (int e = 0; e < 32; ++e) { const unsigned c = __hip_atomic_load(F.ctl + CW_CNT + e, __ATOMIC_RELAXED, __HIP_MEMORY_SCOPE_AGENT); tp[e] = a; tp[34 + e] = (int)c; a += (int)((c + 255u) >> 8); } tp[32] = a; }
    __syncthreads();
}
DI void p12_final(Frame& F) {
    f32x4 w[4]; load_row(F.A->in[22], F.lane, w); const bf16* Y = WSP(const bf16, WS_Y);
#pragma unroll 2
    for (int m = F.gw; m < S; m += F.ngw) {
        f32x4 v[4]; load_row(F.out + (size_t)m * 1024, F.lane, v);
#pragma unroll
        for (int j = 0; j < 4; ++j) { const v2u a = *(const v2u*)(Y + (size_t)m * 1024 + 4 * F.lane + 256 * j), b = *(const v2u*)(Y + ((size_t)S + m) * 1024 + 4 * F.lane + 256 * j);
            v[j][0] += bflo(a.x) + bflo(b.x); v[j][1] += bfhi(a.x) + bfhi(b.x); v[j][2] += bflo(a.y) + bflo(b.y); v[j][3] += bfhi(a.y) + bfhi(b.y); }
        const float rs = row_rstd(v);
#pragma unroll
        for (int j = 0; j < 4; ++j) *(f32x4*)(F.out + (size_t)m * 1024 + 4 * F.lane + 256 * j) = v[j] * rs * w[j];
    }
}

#ifndef MK_PER_PHASE
#define MK_PER_PHASE 0
#endif
constexpr int NPH = 13;
__global__ void __launch_bounds__(NTHR, 2) mk_fwd(Args args) {
    extern __shared__ __attribute__((aligned(16))) unsigned char lds[];
    Frame F;
    F.lds = (LAS unsigned char*)lds;
    F.tid = threadIdx.x; F.lane = F.tid & 63; F.wave = __builtin_amdgcn_readfirstlane(F.tid >> 6);
    F.G = gridDim.x; F.gw = blockIdx.x * NWAVES + F.wave; F.ngw = F.G * NWAVES;
    F.ws = args.ws; F.ctl = (unsigned*)(args.ws + WS_CTL); F.out = args.out;
    F.A = &args;
    for (int u = F.tid; u < (LDS_BYTES - MISC_OFF) / 4; u += NTHR) ((LAS unsigned*)(F.lds + MISC_OFF))[u] = 0u;
    __syncthreads();
    XcdBarrier bar; bar.bar = F.ctl + CW_BAR + args.li * XCD_BAR_WORDS; bar.x = 0; bar.st = nullptr;
    if (!MK_PER_PHASE) bar = xcd_barrier_post(F.ctl + CW_BAR + args.li * XCD_BAR_WORDS, (volatile LAS unsigned*)(F.lds + MISC_OFF) + 8);
    const int lo = args.ph_lo, hi = args.ph_hi;
    const int sub = args.pad ? args.pad : 0xFFFF;
#define IN(k) (lo <= (k) && (k) < hi)
#define SEAM(k) do { if (IN(k) && IN((k) + 1)) xcd_barrier(bar); } while (0)
    LAS unsigned char* ring = F.lds;

    if (IN(0)) { p0_prologue(F); }
    SEAM(0);
    if (IN(1)) {
        pg8::Gemm g{WSP(const bf16, WS_H), WSP(const bf16, WS_WR), 0, 0, 1024}; ProjOrder O{F.G, (int)blockIdx.x};
        EpiProj E{WSP(bf16, WS_QA), WSP(bf16, WS_KCV), WSP(bf16, WS_QR), WSP(bf16, WS_KR), WSP(bf16, WS_GR), WSP(bf16, WS_GA), WSP(bf16, WS_TOUT)};
        pg8::gemm_phase<EpiProj, ProjOrder, true, true>(ring, g, O, E);
    }
    SEAM(1);
    if (IN(2)) {
        if (sub & 32) for (int u = blockIdx.x; u < 512; u += F.G) p2_ret_state_wg(F, u);
        if (sub & 8) { if (F.wave < 4) for (int u = blockIdx.x * 4 + F.wave; u < 1024; u += F.G * 4) p2_cmp_hidden(F, u); }
        if (sub & 16) { if (F.wave == 4) for (int u = blockIdx.x; u < 256; u += F.G) p2_kmax(F, u); }
        asm volatile("s_waitcnt vmcnt(0) lgkmcnt(0)" ::: "memory"); __syncthreads();
    }
    SEAM(2);
    if (IN(3)) {
        if (sub & 64) p3_scan(F);
        if (sub & 128) for (int u = F.gw; u < 256; u += F.ngw) p3_kcvc(F, u);
    }
    SEAM(3);
    if (IN(4)) {
        p4_bias_table(F);
        for (int pp = blockIdx.x; pp < 256; pp += F.G) {
            const int g = pp & 1, c = pp >> 1;
            if (sub & 1) p4a_unit(F, (F.wave < 4 ? c : 255 - c) * 4 + (F.wave & 3), g, args.pad);
            VM_WAIT(); __syncthreads();
            if (sub & 2) p4b_pass(F.lds, F.ws, F.out, c, 255 - c, g, args.pad);
        }
        if (sub & 4) for (int u = blockIdx.x; u < 512; u += F.G) p4_ret_wg(F, u);
        asm volatile("s_waitcnt vmcnt(0) lgkmcnt(0)" ::: "memory");
        __syncthreads();
    }
    SEAM(4);
    if (IN(5)) {
        pg8::Gemm g{WSP(const bf16, WS_H), WSP(const bf16, WS_WG), S, 2048, 1024}; pg8::StaticOrder O; O.init(S, 2048, F.G, (int)blockIdx.x);
        EpiGate E{WSP(bf16, WS_G)};
        pg8::gemm_phase<EpiGate, pg8::StaticOrder, true, true>(ring, g, O, E);
    }
    SEAM(5);
    if (IN(6)) {
        { pg8::Gemm g{WSP(const bf16, WS_QA), WSP(const bf16, WS_WUA), S, 1024, 512}; pg8::StaticOrder O; O.init(S, 1024, F.G, (int)blockIdx.x);
          EpiUp<false> E{WSP(const bf16, WS_G), WSP(bf16, WS_MG), 0};
          pg8::gemm_phase<EpiUp<false>, pg8::StaticOrder, true, true>(ring, g, O, E); }
        if (F.G != 256 && !MK_PER_PHASE) xcd_barrier(bar); else { VM_WAIT(); __syncthreads(); }
        { pg8::Gemm g{WSP(const bf16, WS_GR), WSP(const bf16, WS_WUB), S, 1024, 1024}; pg8::StaticOrder O; O.init(S, 1024, F.G, (int)blockIdx.x);
          EpiUp<true> E{WSP(const bf16, WS_G), WSP(bf16, WS_MG), 1024};
          pg8::gemm_phase<EpiUp<true>, pg8::StaticOrder, true, true>(ring, g, O, E); }
    }
    SEAM(6);
    if (IN(7)) {
        pg8::Gemm g{WSP(const bf16, WS_MG), WSP(const bf16, WS_WO), S, 1024, 1024}; pg8::StaticOrder O; O.init(S, 1024, F.G, (int)blockIdx.x);
        EpiOut E{F.A->in[0], F.out};
        pg8::gemm_phase<EpiOut, pg8::StaticOrder, true, true>(ring, g, O, E);
    }
    SEAM(7);
    if (IN(8)) {
        if (sub & 256) for (int it = blockIdx.x * 4; it < S / 16; it += F.G * 4) p8_route_item(F, it + (F.wave & 3));
        if (sub & 512) p8_moe_weights(F);
    }
    SEAM(8);
    if (IN(10)) {
        moe_tile_prefix(F);
        MoeOrder<2> O{F.G, (int)blockIdx.x, (const LAS int*)(F.lds + MOET_OFF)};
        { LAS unsigned* gtab = (LAS unsigned*)(F.lds + GTAB_OFF); const LAS int* tp = (const LAS int*)(F.lds + MOET_OFF); const v2u* LIST = WSP(const v2u, WS_XS);
          for (int ui = 0; ui < 8; ++ui) { pg8::Unit u; if (!O.next(ui, u)) break;
              if (F.tid < 256) { const int ex = u.pn >> 1, rank = (u.pm - tp[ex]) * 256 + F.tid; gtab[ui * 256 + F.tid] = rank < tp[34 + ex] ? (LIST[(size_t)ex * 16384 + rank].x >> 1) : 0u; } }
          asm volatile("s_waitcnt vmcnt(0) lgkmcnt(0)" ::: "memory"); __syncthreads(); }
        pg8::Gemm g{WSP(const bf16, WS_H), WSP(const bf16, WS_MOEW), 0, 0, 1024};
        EpiMoe1 E{WSP(bf16, WS_HID)};
        pg8::gemm_phase<EpiMoe1, MoeOrder<2>, true, true, true>(ring, g, O, E, (const LAS unsigned*)(F.lds + GTAB_OFF));
    }
    SEAM(10);
    if (IN(11)) {
        moe_tile_prefix(F);
        pg8::Gemm g{WSP(const bf16, WS_HID), WSP(const bf16, WS_MOEW) + (size_t)32 * 512 * 1024, 0, 0, 256}; MoeOrder<4> O{F.G, (int)blockIdx.x, (const LAS int*)(F.lds + MOET_OFF)};
        EpiMoe2 E{WSP(const v2u, WS_XS), WSP(bf16, WS_Y), (const LAS int*)(F.lds + MOET_OFF), (const LAS int*)(F.lds + MOET_OFF) + 34};
        pg8::gemm_phase<EpiMoe2, MoeOrder<4>, true, true>(ring, g, O, E);
    }
    SEAM(11);
    if (IN(12)) p12_final(F);
#undef IN
#undef SEAM
}

extern "C" void kernel_launch(void* const* d_in, const int* in_sizes, int n_in, void* d_out, int out_size, void* d_ws, size_t ws_size, hipStream_t stream) {
    static int grid = 0;
    if (grid == 0) {
        if (n_in != 23 || out_size != S * D || ws_size < WS_END) { fprintf(stderr, "kernel_launch: unexpected problem (n_in %d, out %d, ws %zu)\n", n_in, out_size, ws_size); grid = -1; return; }
        int dev = 0, cus = 0;
        if (hipGetDevice(&dev) != hipSuccess || hipDeviceGetAttribute(&cus, hipDeviceAttributeMultiprocessorCount, dev) != hipSuccess) { grid = -1; return; }
        if (hipFuncSetAttribute((const void*)mk_fwd, hipFuncAttributeMaxDynamicSharedMemorySize, LDS_BYTES) != hipSuccess) { fprintf(stderr, "kernel_launch: hipFuncSetAttribute failed\n"); grid = -1; return; }
        int per_cu = 0;
        if (hipOccupancyMaxActiveBlocksPerMultiprocessor(&per_cu, (const void*)mk_fwd, NTHR, LDS_BYTES) != hipSuccess || per_cu < 1) { fprintf(stderr, "kernel_launch: occupancy query says %d\n", per_cu); }
        (void)hipGetLastError();
        grid = cus > 0 ? cus : 256;
    }
    if (grid < 0) return;
    if (hipMemsetAsync((char*)d_ws + WS_CTL, 0, CTL_ZERO_BYTES, stream) != hipSuccess) return;
    Args a{};
    for (int i = 0; i < 23; ++i) a.in[i] = (const float*)d_in[i];
    a.out = (float*)d_out; a.ws = (unsigned char*)d_ws;
#if MK_PER_PHASE
    for (int p = 0; p < NPH; ++p) { a.ph_lo = p; a.ph_hi = p + 1; hipLaunchKernelGGL(mk_fwd, dim3(grid), dim3(NTHR), LDS_BYTES, stream, a); }
#elif defined(MK_PREFIX_HI)
    a.ph_lo = 0; a.ph_hi = MK_PREFIX_HI; a.li = 0; a.pad = MK_PREFIX_SUB; hipLaunchKernelGGL(mk_fwd, dim3(grid), dim3(NTHR), LDS_BYTES, stream, a);
    (void)hipMemsetAsync((char*)d_ws + WS_CTL, 0, CTL_ZERO_BYTES, stream);
    a.ph_lo = 0; a.ph_hi = NPH; a.li = 1; a.pad = 0; hipLaunchKernelGGL(mk_fwd, dim3(grid), dim3(NTHR), LDS_BYTES, stream, a);
#elif defined(MK_DUP_LO)
    a.ph_lo = 0; a.ph_hi = MK_DUP_HI + 1; a.li = 0; hipLaunchKernelGGL(mk_fwd, dim3(grid), dim3(NTHR), LDS_BYTES, stream, a);
    a.ph_lo = MK_DUP_LO; a.ph_hi = NPH; a.li = 1; hipLaunchKernelGGL(mk_fwd, dim3(grid), dim3(NTHR), LDS_BYTES, stream, a);
#else
    a.ph_lo = 0; a.ph_hi = NPH;
    hipLaunchKernelGGL(mk_fwd, dim3(grid), dim3(NTHR), LDS_BYTES, stream, a);
#endif
}
```

```cpp
#include <hip/hip_runtime.h>
#include <cstdio>
#include <cstdint>
namespace pg8 {
#define PG8_LAS __attribute__((address_space(3)))
typedef unsigned short bf16_t;
typedef short bf16x8 __attribute__((ext_vector_type(8)));
typedef float f32x4 __attribute__((ext_vector_type(4)));
typedef unsigned u32x4 __attribute__((ext_vector_type(4)));
constexpr int BM = 256, BK = 64, HALF = 128, HTB = HALF * BK * 2  , STAGE_BYTES = 8 * HTB, NXCD = 8, WGM = 8;

__host__ __device__ __forceinline__ int lds_byte(int r, int c) { const int st = (r >> 4) * 2 + (c >> 5), rr = r & 15, cc = c & 31, ob = rr * 64 + cc * 2; return st * 1024 + (ob ^ (((ob >> 9) & 1) << 5)); }
__host__ __device__ __forceinline__ void stage_rc(int b, int& R, int& C) { const int st = b / 1024, sb = b % 1024, swz = sb ^ (((sb >> 9) & 1) << 5); R = (st >> 1) * 16 + swz / 64; C = (st & 1) * 32 + (swz % 64) / 2; }
__host__ __device__ __forceinline__ int perm32(int rho) { const int n = rho >> 4, i = rho & 15; return 8 * (i >> 2) + 4 * n + (i & 3); }

struct Unit { int pm, pn; };
struct Gemm { const bf16_t* A; const bf16_t* Bt; int M, N, K; };

struct StaticOrder {
    int nM, nN, nwg, G, c;
    __host__ __device__ void init(int M, int N, int G_, int c_) { nM = M / BM; nN = N / BM; nwg = nM * nN; G = G_; c = c_; }
    __host__ __device__ bool next(int i, Unit& u) const {
        const long L = (long)i * G + c; if (L >= nwg) return false;
        int wgid = (int)L; { const int q = nwg / NXCD, r = nwg % NXCD, xcd = wgid % NXCD, off = wgid / NXCD; wgid = (xcd < r ? xcd * (q + 1) : r * (q + 1) + (xcd - r) * q) + off; }
        const int nig = WGM * nN, gid = wgid / nig, fm = gid * WGM, gsz = (nM - fm) < WGM ? (nM - fm) : WGM;
        u.pm = fm + ((wgid % nig) % gsz); u.pn = (wgid % nig) / gsz; return true;
    }
    __device__ __forceinline__ void a_ready(const Unit&) const {}
    __device__ __forceinline__ void done(const Unit&) const {}
};

__device__ __forceinline__ unsigned cvt_pk_bf16(float lo, float hi) { unsigned r; asm volatile("v_cvt_pk_bf16_f32 %0, %1, %2" : "=v"(r) : "v"(lo), "v"(hi)); return r; }

template <class Epi, class Sched, bool ALIGN_EPI = false, bool SP2 = false, bool GATHER = false>
__device__ __forceinline__ void gemm_phase(PG8_LAS unsigned char* lds, const Gemm g, const Sched& S, const Epi& E, const PG8_LAS unsigned* gtab = nullptr) {
    static_assert(!GATHER || SP2, "GATHER needs SP2");
    const int tid = threadIdx.x, wid = __builtin_amdgcn_readfirstlane(tid >> 6), lane = tid & 63, wr = wid >> 2, wc = wid & 3, fr = lane & 15, fq = lane >> 4;
    const int K = g.K, nt = K / BK;
    unsigned voffA[2], voffB[2];
#pragma unroll
    for (int i = 0; i < 2; ++i) { int R, C; stage_rc(tid * 16 + i * 8192, R, C); const int Rb = Epi::PERM ? ((R & ~31) + perm32(R & 31)) : R;
        voffA[i] = (unsigned)(R * K + C) * 2u; voffB[i] = (unsigned)(Rb * K + C) * 2u; }
    int gR[2], gC[2];
#pragma unroll
    for (int i = 0; i < 2; ++i) stage_rc(tid * 16 + i * 8192, gR[i], gC[i]);
    unsigned gc[2][2], gn[2][2];
#define PG8_GOFF(dst, uidx) do { _Pragma("unroll") for (int _h = 0; _h < 2; ++_h) _Pragma("unroll") for (int _i = 0; _i < 2; ++_i) dst[_h][_i] = (gtab[(uidx) * 256 + _h * 128 + gR[_i]] * (unsigned)K + (unsigned)gC[_i]) * 2u; } while (0)
    const size_t kstep = (size_t)(BK * 2);
    const size_t hstep = (size_t)HALF * K * 2;
    const size_t tstep = 2 * hstep;
    const unsigned ldsw = (unsigned)wid * 1024u;
    const int aoff = lds_byte(wr * 64 + fr, fq * 8), boff = lds_byte(wc * 32 + fr, fq * 8);
#define PG8_SA(b, h) (((b) * 2 + (h)) * HTB)
#define PG8_SB(b, h) ((4 + (b) * 2 + (h)) * HTB)
#define PG8_STAGE(bufoff, gbase, voff) do { _Pragma("unroll") for (int _i = 0; _i < 2; ++_i) \
        __builtin_amdgcn_global_load_lds((const unsigned*)((const char*)(gbase) + (voff)[_i]), (PG8_LAS unsigned*)(lds + (bufoff) + ldsw + _i * 8192), 16, 0, 0); } while (0)
#define PG8_STAGE_A(bufoff, base, half, nxt_) do { if constexpr (GATHER) { _Pragma("unroll") for (int _i = 0; _i < 2; ++_i) \
        __builtin_amdgcn_global_load_lds((const unsigned*)((const char*)(base) + ((nxt_) ? gn[half][_i] : gc[half][_i])), (PG8_LAS unsigned*)(lds + (bufoff) + ldsw + _i * 8192), 16, 0, 0); } \
        else PG8_STAGE(bufoff, (base) + (half) * hstep, voffA); } while (0)
#define PG8_LDA(dst, b, h) do { _Pragma("unroll") for (int m = 0; m < 4; ++m) _Pragma("unroll") for (int k = 0; k < 2; ++k) dst[m][k] = *(const PG8_LAS bf16x8*)(lds + PG8_SA(b, h) + aoff + m * 2048 + k * 1024); } while (0)
#define PG8_LDB(dst, b, h) do { _Pragma("unroll") for (int n = 0; n < 2; ++n) _Pragma("unroll") for (int k = 0; k < 2; ++k) dst[n][k] = *(const PG8_LAS bf16x8*)(lds + PG8_SB(b, h) + boff + n * 2048 + k * 1024); } while (0)
#define PG8_MMA(ai, bj, At, Bt) do { __builtin_amdgcn_s_setprio(1); _Pragma("unroll") for (int m = 0; m < 4; ++m) _Pragma("unroll") for (int n = 0; n < 2; ++n) _Pragma("unroll") for (int k = 0; k < 2; ++k) \
        acc[ai][bj][m][n] = __builtin_amdgcn_mfma_f32_16x16x32_bf16(Bt[n][k], At[m][k], acc[ai][bj][m][n], 0, 0, 0); __builtin_amdgcn_s_setprio(0); } while (0)
#define PG8_WAIT_V(n) asm volatile("s_waitcnt vmcnt(" #n ")" ::: "memory")
#define PG8_WAIT_L(n) asm volatile("s_waitcnt lgkmcnt(" #n ")" ::: "memory")
#define PG8_BAR __builtin_amdgcn_s_barrier()
#define PG8_SCHED __builtin_amdgcn_sched_barrier(0)
    Unit cur, nxt; int ui = 0;
    if (!S.next(0, cur)) return;
    f32x4 acc[2][2][4][2];
#pragma unroll
    for (int a = 0; a < 2; ++a)
#pragma unroll
        for (int b = 0; b < 2; ++b)
#pragma unroll
            for (int m = 0; m < 4; ++m)
#pragma unroll
                for (int n = 0; n < 2; ++n) acc[a][b][m][n] = (f32x4){0.f, 0.f, 0.f, 0.f};
    bf16x8 At[4][2], B0[2][2], B1[2][2];
    const char* cA = GATHER ? (const char*)g.A : (const char*)g.A + (size_t)cur.pm * tstep; const char* cB = (const char*)g.Bt + (size_t)cur.pn * tstep;
    if constexpr (GATHER) { PG8_GOFF(gc, 0); }
    S.a_ready(cur);
    if constexpr (SP2) {
        PG8_STAGE(PG8_SB(0, 0), cB, voffB); PG8_STAGE(PG8_SB(0, 1), cB + hstep, voffB); PG8_STAGE_A(PG8_SA(0, 0), cA, 0, false); PG8_STAGE_A(PG8_SA(0, 1), cA, 1, false);
        if (wr == 1) PG8_BAR;
        PG8_WAIT_V(2); PG8_BAR;
        PG8_STAGE(PG8_SB(1, 0), cB + kstep, voffB); PG8_STAGE_A(PG8_SA(1, 0), cA + kstep, 0, false); PG8_STAGE(PG8_SB(1, 1), cB + hstep + kstep, voffB);
        PG8_WAIT_V(6); PG8_BAR;
    } else {
        PG8_STAGE(PG8_SB(0, 0), cB, voffB); PG8_STAGE(PG8_SA(0, 0), cA, voffA); PG8_STAGE(PG8_SB(0, 1), cB + hstep, voffB); PG8_STAGE(PG8_SA(0, 1), cA + hstep, voffA);
        if (wr == 1) PG8_BAR;
        PG8_WAIT_V(4); PG8_BAR;
        PG8_STAGE(PG8_SB(1, 0), cB + kstep, voffB); PG8_STAGE(PG8_SA(1, 0), cA + kstep, voffA); PG8_STAGE(PG8_SB(1, 1), cB + hstep + kstep, voffB);
        PG8_WAIT_V(6); PG8_BAR;
    }
    for (;;) {
        const bool has_next = S.next(ui + 1, nxt);
        const char* nA = GATHER ? cA : (has_next ? (const char*)g.A + (size_t)nxt.pm * tstep : cA);
        if constexpr (GATHER) { if (has_next) { PG8_GOFF(gn, ui + 1); } else { _Pragma("unroll") for (int _h = 0; _h < 2; ++_h) _Pragma("unroll") for (int _i = 0; _i < 2; ++_i) gn[_h][_i] = gc[_h][_i]; } } const char* nB = has_next ? (const char*)g.Bt + (size_t)nxt.pn * tstep : cB;
#pragma nounroll
        for (int t = 0; t < nt; t += 2) {
            const bool last = (t == nt - 2);
            const char* a1 = cA + (size_t)(t + 1) * kstep;
            const char* a2 = last ? nA : cA + (size_t)(t + 2) * kstep; const char* b2 = last ? nB : cB + (size_t)(t + 2) * kstep;
            const char* a3 = a2 + kstep; const char* b3 = b2 + kstep;
            if (last && has_next) S.a_ready(nxt);
            if constexpr (SP2) {
            PG8_LDB(B0, 0, 0); PG8_LDB(B1, 0, 1); PG8_SCHED; PG8_LDA(At, 0, 0); PG8_STAGE_A(PG8_SA(1, 1), a1, 1, false);
            PG8_WAIT_V(8); PG8_WAIT_L(0); PG8_BAR; PG8_MMA(0, 0, At, B0); PG8_MMA(0, 1, At, B1); PG8_BAR; PG8_SCHED;
            PG8_LDA(At, 0, 1); PG8_STAGE(PG8_SB(0, 0), b2, voffB); PG8_STAGE(PG8_SB(0, 1), b2 + hstep, voffB); PG8_STAGE_A(PG8_SA(0, 0), a2, 0, last);
            PG8_WAIT_V(8); PG8_WAIT_L(0); PG8_BAR; PG8_MMA(1, 0, At, B0); PG8_MMA(1, 1, At, B1); PG8_BAR; PG8_SCHED;
            PG8_LDB(B0, 1, 0); PG8_LDB(B1, 1, 1); PG8_SCHED; PG8_LDA(At, 1, 0); PG8_STAGE_A(PG8_SA(0, 1), a2, 1, last);
            PG8_WAIT_V(8); PG8_WAIT_L(0); PG8_BAR; PG8_MMA(0, 0, At, B0); PG8_MMA(0, 1, At, B1); PG8_BAR; PG8_SCHED;
            PG8_LDA(At, 1, 1); PG8_STAGE(PG8_SB(1, 0), b3, voffB); PG8_STAGE(PG8_SB(1, 1), b3 + hstep, voffB); PG8_STAGE_A(PG8_SA(1, 0), a3, 0, last);
            PG8_WAIT_V(8); PG8_WAIT_L(0); PG8_BAR; PG8_MMA(1, 0, At, B0); PG8_MMA(1, 1, At, B1); PG8_BAR; PG8_SCHED;
            } else {
            PG8_LDB(B0, 0, 0); PG8_SCHED; PG8_LDA(At, 0, 0); PG8_STAGE(PG8_SA(1, 1), a1 + hstep, voffA);
            PG8_WAIT_L(8); PG8_BAR; PG8_WAIT_L(0); PG8_MMA(0, 0, At, B0); PG8_BAR; PG8_SCHED;
            PG8_LDB(B1, 0, 1); PG8_STAGE(PG8_SB(0, 0), b2, voffB);
            PG8_BAR; PG8_WAIT_L(0); PG8_MMA(0, 1, At, B1); PG8_BAR;
            PG8_LDA(At, 0, 1); PG8_STAGE(PG8_SA(0, 0), a2, voffA);
            PG8_BAR; PG8_WAIT_L(0); PG8_MMA(1, 0, At, B0); PG8_BAR; PG8_SCHED;
            PG8_STAGE(PG8_SB(0, 1), b2 + hstep, voffB);
            PG8_WAIT_V(6); PG8_BAR; PG8_MMA(1, 1, At, B1); PG8_BAR;
            PG8_LDB(B0, 1, 0); PG8_SCHED; PG8_LDA(At, 1, 0); PG8_STAGE(PG8_SA(0, 1), a2 + hstep, voffA);
            PG8_WAIT_L(8); PG8_BAR; PG8_WAIT_L(0); PG8_MMA(0, 0, At, B0); PG8_BAR; PG8_SCHED;
            PG8_LDB(B1, 1, 1); PG8_STAGE(PG8_SB(1, 0), b3, voffB);
            PG8_BAR; PG8_WAIT_L(0); PG8_MMA(0, 1, At, B1); PG8_BAR;
            PG8_LDA(At, 1, 1); PG8_STAGE(PG8_SA(1, 0), a3, voffA);
            PG8_BAR; PG8_WAIT_L(0); PG8_MMA(1, 0, At, B0); PG8_BAR; PG8_SCHED;
            PG8_STAGE(PG8_SB(1, 1), b3 + hstep, voffB);
            PG8_WAIT_V(6); PG8_BAR; PG8_MMA(1, 1, At, B1); PG8_BAR;
            }
        }
        if constexpr (ALIGN_EPI) { if (wr == 0) PG8_BAR; }
        if constexpr (!Epi::AFTER_DRAIN) { E(acc, cur, wr, wc, fr, fq); S.done(cur); }
        if (!has_next) break;
#pragma unroll
        for (int a = 0; a < 2; ++a)
#pragma unroll
            for (int b = 0; b < 2; ++b)
#pragma unroll
                for (int m = 0; m < 4; ++m)
#pragma unroll
                    for (int n = 0; n < 2; ++n) acc[a][b][m][n] = (f32x4){0.f, 0.f, 0.f, 0.f};
        cur = nxt; cA = nA; cB = nB; ++ui;
        if constexpr (GATHER) { _Pragma("unroll") for (int _h = 0; _h < 2; ++_h) _Pragma("unroll") for (int _i = 0; _i < 2; ++_i) gc[_h][_i] = gn[_h][_i]; }
        if constexpr (ALIGN_EPI) { if (wr == 1) PG8_BAR; }
    }
    PG8_WAIT_V(0);
    if constexpr (!ALIGN_EPI) { if (wr == 0) PG8_BAR; }
    PG8_BAR;
    if constexpr (Epi::AFTER_DRAIN) { E.fused(acc, cur, wr, wc, fr, fq, lds, wid, lane); S.done(cur); }
#undef PG8_SA
#undef PG8_SB
#undef PG8_STAGE
#undef PG8_STAGE_A
#undef PG8_GOFF
#undef PG8_LDA
#undef PG8_LDB
#undef PG8_MMA
#undef PG8_WAIT_V
#undef PG8_WAIT_L
#undef PG8_BAR
#undef PG8_SCHED
}
}

#define GAS __attribute__((address_space(1)))
#define LAS __attribute__((address_space(3)))
#define DI __device__ __forceinline__
typedef unsigned short bf16;
typedef unsigned v4u __attribute__((ext_vector_type(4)));
typedef unsigned v2u __attribute__((ext_vector_type(2)));
typedef float f32x4 __attribute__((ext_vector_type(4)));
typedef short bf16x8 __attribute__((ext_vector_type(8)));
typedef float f32x2_t __attribute__((ext_vector_type(2)));
typedef __bf16 bf16x2_t __attribute__((ext_vector_type(2)));
#define LDS_WAIT() asm volatile("s_waitcnt lgkmcnt(0)" ::: "memory")
#define VM_WAIT() asm volatile("s_waitcnt vmcnt(0)" ::: "memory")
DI unsigned pk2(float lo, float hi) { f32x2_t v = {lo, hi}; bf16x2_t b = __builtin_convertvector(v, bf16x2_t); return __builtin_bit_cast(unsigned, b); }
DI float bflo(unsigned u) { return __uint_as_float(u << 16); }
DI float bfhi(unsigned u) { return __uint_as_float(u & 0xffff0000u); }
DI float bf1(bf16 b) { return __uint_as_float(((unsigned)b) << 16); }
DI f32x4 mfma16(bf16x8 a, bf16x8 b, f32x4 c) { return __builtin_amdgcn_mfma_f32_16x16x32_bf16(a, b, c, 0, 0, 0); }
DI bf16x8 ld16(const bf16* p) { return *(const bf16x8*)p; }
DI bf16x8 ld8x2(const bf16* p, int off2) { const v2u a = *(const v2u*)p, b = *(const v2u*)(p + off2); v4u r = {a.x, a.y, b.x, b.y}; return __builtin_bit_cast(bf16x8, r); }
DI bf16x8 pack8(f32x4 a, f32x4 b) { v4u r = {pk2(a[0], a[1]), pk2(a[2], a[3]), pk2(b[0], b[1]), pk2(b[2], b[3])}; return __builtin_bit_cast(bf16x8, r); }
DI v2u pack4(f32x4 a) { v2u r = {pk2(a[0], a[1]), pk2(a[2], a[3])}; return r; }
DI float wave_sum(float v) {
#pragma unroll
    for (int o = 1; o < 64; o <<= 1) v += __shfl_xor(v, o);
    return v;
}
DI float quad_sum(float v) { v += __shfl_xor(v, 16); v += __shfl_xor(v, 32); return v; }
DI float quad_max(float v) { v = fmaxf(v, __shfl_xor(v, 16)); v = fmaxf(v, __shfl_xor(v, 32)); return v; }
DI unsigned wave_max_u32(unsigned v) {
#pragma unroll
    for (int o = 1; o < 64; o <<= 1) { const unsigned w = (unsigned)__shfl_xor((int)v, o); v = w > v ? w : v; }
    return v;
}
DI float sigmoidf_(float x) { return __builtin_amdgcn_rcpf(1.0f + __builtin_amdgcn_exp2f(-x * 1.4426950408889634f)); }
DI float siluf_(float x) { return x * sigmoidf_(x); }
DI float gelu_tanh(float v) { const float z = 0.7978845608028654f * (v + 0.044715f * v * v * v); const float e = __builtin_amdgcn_exp2f(2.0f * 1.4426950408889634f * z); return 0.5f * v * (2.0f - 2.0f * __builtin_amdgcn_rcpf(e + 1.0f)); }

constexpr int S = 16384, D = 1024;
constexpr int TP = S + 2048 + 128;
constexpr int NWAVES = 8, NTHR = 512;
constexpr float EPS = 1e-6f, LOG2E = 1.4426950408889634f, QSCALE = 0.125f * 1.4426950408889634f;
constexpr size_t MiB = 1u << 20;
constexpr size_t WS_CTL = 0, CTL_ZERO_BYTES = MiB;
constexpr size_t WS_MISC = 1 * MiB;
constexpr size_t WS_WR = 2 * MiB;
constexpr size_t WS_H = WS_WR + 3328 * 2048;
constexpr size_t WS_WT = WS_H + 32 * MiB;
constexpr size_t WS_WG = 44 * MiB;
constexpr size_t WS_WC1 = 48 * MiB;
constexpr size_t WS_WUA = 50 * MiB, WS_WUB = 51 * MiB, WS_WO = 53 * MiB;
constexpr size_t WS_SM = 55 * MiB;
constexpr size_t SM_W2T = 0, SM_B1 = 64 * 1024, SM_WRT = 128 * 1024, SM_KC = 512 * 1024, SM_VCT = 768 * 1024;
constexpr size_t WS_QA = 56 * MiB, WS_GR = 72 * MiB, WS_GA = 104 * MiB, WS_KCV = 105 * MiB, WS_QR = 121 * MiB, WS_KR = 137 * MiB, WS_TOUT = 153 * MiB, WS_UR = 217 * MiB, WS_HIDC = 249 * MiB;
constexpr size_t WS_G = 105 * MiB, WS_MG = 169 * MiB;
constexpr size_t WS_MOEW = 56 * MiB;
constexpr size_t WS_HID = 104 * MiB, WS_XS = 188 * MiB  , WS_Y = 124 * MiB, WS_END = 256 * MiB;
static_assert(WS_TOUT + 1792ull * TP * 2 <= WS_UR && WS_WT + 1792 * 2048 <= WS_WG && WS_HIDC + 2 * MiB <= WS_END && WS_Y + 64 * MiB <= WS_XS && WS_XS + 4 * MiB <= WS_END && WS_Y + 64 * MiB <= WS_END, "ws map");
constexpr int CW_BAR = 4096, CW_KMAX = 16384, CW_CNT = 16448, CW_WQ = 16512;
constexpr int XS_ROWS = 40960;
constexpr int WAVE_LDS = 16960;
constexpr int NEAR_OFF = 140288;
constexpr int BIAS_OFF = 157184;
constexpr int MOET_OFF = 161344;
constexpr int GTAB_OFF = 135168;
constexpr int MISC_OFF = 161664;
constexpr int LDS_BYTES = 163840;
#define XB_TMO      128
#define XB_XCNT(j)  (256  + 64 * (j))
#define XB_XSUB(j)  (1280 + 64 * (j))
#define XB_XGEN(j)  (2304 + 64 * (j))
#define XB_TOP      3328
#define XB_TOPGEN   3392
#define XCD_BAR_WORDS 3456
#define XB_SPIN_CAP (1u << 18)

__device__ __forceinline__ unsigned xb_ld(unsigned* p)              { return __hip_atomic_load(p, __ATOMIC_RELAXED, __HIP_MEMORY_SCOPE_AGENT); }
__device__ __forceinline__ unsigned xb_add(unsigned* p, unsigned v) { return __hip_atomic_fetch_add(p, v, __ATOMIC_RELAXED, __HIP_MEMORY_SCOPE_AGENT); }
__device__ __forceinline__ unsigned xb_xcc_id() { return (unsigned)__builtin_amdgcn_s_getreg((3 << 11) | 20) & 0xFu; }
#define XB_SPIN(cond, bar) do { unsigned _sp = 0; while (cond) { __builtin_amdgcn_s_sleep(1); \
    if ((++_sp & 255u) == 0u) { if (xb_ld(&(bar)[XB_TMO])) break; if (_sp > XB_SPIN_CAP) { atomicAdd(&(bar)[XB_TMO], 1u); break; } } } } while (0)

struct XcdBarrier {
    unsigned* bar; unsigned x;
    volatile LAS unsigned* st;
};

__device__ __forceinline__ XcdBarrier xcd_barrier_post(unsigned* bar, volatile LAS unsigned* st) {
    XcdBarrier b; b.bar = bar; b.x = xb_xcc_id(); b.st = st;
    if (threadIdx.x == 0) (void)xb_add(&bar[XB_XCNT(b.x)], 1u);
    return b;
}
__device__ __forceinline__ void xcd_barrier_complete(unsigned* bar, unsigned x, unsigned& nloc, unsigned& nx) {
    const unsigned G = gridDim.x * gridDim.y * gridDim.z;
    unsigned sum, cnt, mine, sp = 0u;
    for (;;) {
        sum = 0u; cnt = 0u; mine = 0u;
#pragma unroll
        for (unsigned j = 0; j < 16; ++j) { const unsigned c = xb_ld(&bar[XB_XCNT(j)]); sum += c; cnt += (c > 0u) ? 1u : 0u; mine = (j == x) ? c : mine; }
        if (sum == G) break;
        __builtin_amdgcn_s_sleep(1);
        if ((++sp & 255u) == 0u) { if (xb_ld(&bar[XB_TMO])) break; if (sp > XB_SPIN_CAP) { atomicAdd(&bar[XB_TMO], 1u); break; } }
    }
    nloc = mine > 0u ? mine : 1u; nx = cnt > 0u ? cnt : 1u;
}

__device__ __forceinline__ void xcd_barrier(const XcdBarrier& b) {
    asm volatile("s_waitcnt vmcnt(0)" ::: "memory");
    __syncthreads();
    if (threadIdx.x == 0) {
        unsigned* bar = b.bar;
        __builtin_amdgcn_s_waitcnt(0);
        unsigned nloc = b.st[0], nx = b.st[1];
        if (nloc == 0u) { xcd_barrier_complete(bar, b.x, nloc, nx); b.st[0] = nloc; b.st[1] = nx; }
        const unsigned old = xb_add(&bar[XB_XSUB(b.x)], 1u);
        const unsigned gen = old / nloc;
        if (old + 1u == (gen + 1u) * nloc) {
            __builtin_amdgcn_fence(__ATOMIC_RELEASE, "agent");
            asm volatile("s_waitcnt vmcnt(0)" ::: "memory");
            const unsigned og = xb_add(&bar[XB_TOP], 1u);
            const unsigned tg = og / nx;
            if (og + 1u == (tg + 1u) * nx) xb_add(&bar[XB_TOPGEN], 1u);
            else XB_SPIN(xb_ld(&bar[XB_TOPGEN]) == tg, bar);
            __builtin_amdgcn_fence(__ATOMIC_ACQUIRE, "agent");
            xb_add(&bar[XB_XGEN(b.x)], 1u);
            asm volatile("s_waitcnt vmcnt(0)" ::: "memory");
        } else {
            XB_SPIN(xb_ld(&bar[XB_XGEN(b.x)]) == gen, bar);
            __builtin_amdgcn_fence(__ATOMIC_ACQUIRE, "agent");
            asm volatile("s_waitcnt vmcnt(0)" ::: "memory");
        }
    }
    __syncthreads();
}

DI void tile_map(int L, int nwg, int nM, int nN, int& pm, int& pn) {
    int wgid = L; { const int q = nwg / 8, r = nwg % 8, xcd = wgid % 8, off = wgid / 8; wgid = (xcd < r ? xcd * (q + 1) : r * (q + 1) + (xcd - r) * q) + off; }
    const int nig = 8 * nN, gid = wgid / nig, fm = gid * 8, gsz = (nM - fm) < 8 ? (nM - fm) : 8;
    pm = fm + ((wgid % nig) % gsz); pn = (wgid % nig) / gsz;
}
constexpr int GATE_PN0 = (int)((WS_WG - WS_WR) / (256 * 1024 * 2));
static_assert((WS_WG - WS_WR) % (256 * 1024 * 2) == 0, "gate weights sit a whole number of B tiles above WR");
struct ProjOrder {
    int G, c;
    DI bool next(int i, pg8::Unit& u) const {
        const int L = i * G + c; if (L >= 1792) return false;
        if (L < 832) tile_map(L, 832, 64, 13, u.pm, u.pn);
        else if (L < 1280) { tile_map(L - 832, 448, 7, 64, u.pm, u.pn); u.pm += 64; u.pn += 13; }
        else { tile_map(L - 1280, 512, 64, 8, u.pm, u.pn); u.pn += GATE_PN0; }
        return true;
    }
    DI void a_ready(const pg8::Unit&) const {}
    DI void done(const pg8::Unit&) const {}
};
template <int NJ> struct MoeOrder {
    int G, c; const LAS int* tp;
    DI bool next(int i, pg8::Unit& u) const {
        const int L = i * G + c, tau = L / NJ, j = L % NJ; const int nt = __builtin_amdgcn_readfirstlane(tp[32]);
        if (tau >= nt) return false;
        int e = 0;
        for (int k = 1; k < 32; ++k) e += (tau >= __builtin_amdgcn_readfirstlane(tp[k])) ? 1 : 0;
        u.pm = tau; u.pn = e * NJ + j; return true;
    }
    DI void a_ready(const pg8::Unit&) const {}
    DI void done(const pg8::Unit&) const {}
};

struct EpiProj {
    static constexpr bool PERM = true, AFTER_DRAIN = false;
    bf16 *QA, *KCV, *QR, *KR, *GR, *GA, *TOUT, *G;
    DI void operator()(const f32x4 (&acc)[2][2][4][2], const pg8::Unit& u, int wr, int wc, int fr_, int fq_) const {
        int fr = fr_, fq = fq_; asm volatile("" : "+v"(fr), "+v"(fq));
        const float L2B = 13.287712379549449f / 64.0f;
        const float INV2PI = 0.15915494309189535f;
        if (u.pm < 64 && u.pn >= GATE_PN0) {
            const int row0 = u.pm * 256 + wr * 64 + fr, col0 = (u.pn - GATE_PN0) * 256 + wc * 32 + 8 * fq;
#pragma unroll
            for (int ai = 0; ai < 2; ++ai)
#pragma unroll
                for (int m = 0; m < 4; ++m) {
                    bf16* rowp = G + (size_t)(row0 + ai * 128 + m * 16) * 2048 + col0;
#pragma unroll
                    for (int bj = 0; bj < 2; ++bj) { f32x4 a = acc[ai][bj][m][0], b = acc[ai][bj][m][1];
#pragma unroll
                        for (int i = 0; i < 4; ++i) { a[i] = sigmoidf_(a[i]); b[i] = sigmoidf_(b[i]); }
                        *(bf16x8*)(rowp + bj * 128) = pack8(a, b); }
                }
        } else if (u.pm < 64) {
            const int pn = u.pn, row0 = u.pm * 256 + wr * 64 + fr;
            if (pn >= 4 && pn < 8) {
                bf16* base = pn < 6 ? QR : KR; const float sc = pn < 6 ? 1.0f : 0.08838834764831845f; const int hd0 = 2 * (pn & 1), d0 = 16 * wc + 4 * fq;
                float invr[4];
#pragma unroll
                for (int i = 0; i < 4; ++i) invr[i] = __builtin_amdgcn_exp2f(-(float)(d0 + i) * L2B) * INV2PI;
#pragma unroll
                for (int ai = 0; ai < 2; ++ai)
#pragma unroll
                    for (int m = 0; m < 4; ++m) {
                        const int tok = row0 + ai * 128 + m * 16; float cs[4], sn[4];
#pragma unroll
                        for (int i = 0; i < 4; ++i) { float rev = (float)tok * invr[i]; rev -= floorf(rev); sn[i] = __builtin_amdgcn_sinf(rev) * sc; cs[i] = __builtin_amdgcn_cosf(rev) * sc; }
#pragma unroll
                        for (int bj = 0; bj < 2; ++bj) {
                            const f32x4 x1 = acc[ai][bj][m][0], x2 = acc[ai][bj][m][1]; f32x4 o1, o2;
#pragma unroll
                            for (int i = 0; i < 4; ++i) { o1[i] = x1[i] * cs[i] - x2[i] * sn[i]; o2[i] = x1[i] * sn[i] + x2[i] * cs[i]; }
                            bf16* p = base + (size_t)tok * 512 + (hd0 + bj) * 128 + d0;
                            *(v2u*)p = pack4(o1); *(v2u*)(p + 64) = pack4(o2);
                        }
                    }
            } else if (pn == 12) {
                if (wc == 0) {
#pragma unroll
                    for (int ai = 0; ai < 2; ++ai)
#pragma unroll
                        for (int m = 0; m < 4; ++m) {
                            const int tok = row0 + ai * 128 + m * 16; f32x4 a = acc[ai][0][m][0], b = acc[ai][0][m][1];
#pragma unroll
                            for (int i = 0; i < 4; ++i) { a[i] = sigmoidf_(a[i]); b[i] = sigmoidf_(b[i]); }
                            *(bf16x8*)(GA + (size_t)tok * 32 + 8 * fq) = pack8(a, b);
                        }
                }
            } else {
                bf16* dst; int ldc, colt; float sc = 1.0f;
                if (pn < 2) { dst = QA; ldc = 512; colt = 256 * pn; sc = QSCALE; }
                else if (pn < 4) { dst = KCV; ldc = 512; colt = 256 * (pn - 2); }
                else { dst = GR; ldc = 1024; colt = 256 * (pn - 8); }
                const int col0 = colt + wc * 32 + 8 * fq;
#pragma unroll
                for (int ai = 0; ai < 2; ++ai)
#pragma unroll
                    for (int m = 0; m < 4; ++m) {
                        bf16* rowp = dst + (size_t)(row0 + ai * 128 + m * 16) * ldc + col0;
#pragma unroll
                        for (int bj = 0; bj < 2; ++bj) *(bf16x8*)(rowp + bj * 128) = pack8(acc[ai][bj][m][0] * sc, acc[ai][bj][m][1] * sc);
                    }
            }
        } else {
            const int pmp = u.pm - 64, tok0 = (u.pn - 13) * 256 + wc * 32 + 8 * fq;
            if (pmp == 1 || pmp == 2) {
                const float sc = 0.08838834764831845f;
#pragma unroll
                for (int ai = 0; ai < 2; ++ai) {
                    const int head = 2 * (pmp - 1) + ai;
#pragma unroll
                    for (int m = 0; m < 2; ++m) {
                        const int d = 32 * wr + 16 * m + fr; const float invr = __builtin_amdgcn_exp2f(-(float)d * L2B) * INV2PI;
                        bf16* p1 = TOUT + (size_t)(256 + head * 128 + d) * TP;
#pragma unroll
                        for (int bj = 0; bj < 2; ++bj) {
                            f32x4 o1[2], o2[2];
#pragma unroll
                            for (int n = 0; n < 2; ++n)
#pragma unroll
                                for (int i = 0; i < 4; ++i) {
                                    const int tok = tok0 + bj * 128 + 4 * n + i; float rev = (float)tok * invr; rev -= floorf(rev);
                                    const float sn = __builtin_amdgcn_sinf(rev) * sc, cs = __builtin_amdgcn_cosf(rev) * sc;
                                    const float x1 = acc[ai][bj][m][n][i], x2 = acc[ai][bj][m + 2][n][i];
                                    o1[n][i] = x1 * cs - x2 * sn; o2[n][i] = x1 * sn + x2 * cs;
                                }
                            *(bf16x8*)(p1 + tok0 + bj * 128) = pack8(o1[0], o1[1]);
                            *(bf16x8*)(p1 + (size_t)64 * TP + tok0 + bj * 128) = pack8(o2[0], o2[1]);
                        }
                    }
                }
            } else {
#pragma unroll
                for (int ai = 0; ai < 2; ++ai)
#pragma unroll
                    for (int m = 0; m < 4; ++m) {
                        bf16* rowp = TOUT + (size_t)(pmp * 256 + ai * 128 + wr * 64 + m * 16 + fr) * TP + tok0;
#pragma unroll
                        for (int bj = 0; bj < 2; ++bj) *(bf16x8*)(rowp + bj * 128) = pack8(acc[ai][bj][m][0], acc[ai][bj][m][1]);
                    }
            }
        }
    }
};
struct EpiGate {
    static constexpr bool PERM = true, AFTER_DRAIN = false;
    bf16* G;
    DI void operator()(const f32x4 (&acc)[2][2][4][2], const pg8::Unit& u, int wr, int wc, int fr, int fq) const {
        const int row0 = u.pm * 256 + wr * 64 + fr, col0 = u.pn * 256 + wc * 32 + 8 * fq;
#pragma unroll
        for (int ai = 0; ai < 2; ++ai)
#pragma unroll
            for (int m = 0; m < 4; ++m) {
                bf16* rowp = G + (size_t)(row0 + ai * 128 + m * 16) * 2048 + col0;
#pragma unroll
                for (int bj = 0; bj < 2; ++bj) { f32x4 a = acc[ai][bj][m][0], b = acc[ai][bj][m][1];
#pragma unroll
                    for (int i = 0; i < 4; ++i) { a[i] = sigmoidf_(a[i]); b[i] = sigmoidf_(b[i]); }
                    *(bf16x8*)(rowp + bj * 128) = pack8(a, b); }
            }
    }
};
template <bool ADD> struct EpiUp {
    static constexpr bool PERM = true, AFTER_DRAIN = false;
    const bf16* G; bf16* MG; int goff;
    DI void operator()(const f32x4 (&acc)[2][2][4][2], const pg8::Unit& u, int wr, int wc, int fr, int fq) const {
        const int row0 = u.pm * 256 + wr * 64 + fr, col0 = u.pn * 256 + wc * 32 + 8 * fq;
#pragma unroll
        for (int ai = 0; ai < 2; ++ai)
#pragma unroll
            for (int m = 0; m < 4; ++m) {
                const size_t r = (size_t)(row0 + ai * 128 + m * 16);
#pragma unroll
                for (int bj = 0; bj < 2; ++bj) {
                    const v4u g = *(const v4u*)(G + r * 2048 + goff + col0 + bj * 128);
                    f32x4 a = acc[ai][bj][m][0], b = acc[ai][bj][m][1];
                    a[0] *= bflo(g.x); a[1] *= bfhi(g.x); a[2] *= bflo(g.y); a[3] *= bfhi(g.y); b[0] *= bflo(g.z); b[1] *= bfhi(g.z); b[2] *= bflo(g.w); b[3] *= bfhi(g.w);
                    bf16* op = MG + r * 1024 + col0 + bj * 128;
                    if (ADD) { const v4u o = *(const v4u*)op;
                        a[0] += bflo(o.x); a[1] += bfhi(o.x); a[2] += bflo(o.y); a[3] += bfhi(o.y); b[0] += bflo(o.z); b[1] += bfhi(o.z); b[2] += bflo(o.w); b[3] += bfhi(o.w); }
                    *(bf16x8*)op = pack8(a, b);
                }
            }
    }
};
struct EpiOut {
    static constexpr bool PERM = false, AFTER_DRAIN = false;
    const float* X; float* O;
    DI void operator()(const f32x4 (&acc)[2][2][4][2], const pg8::Unit& u, int wr, int wc, int fr, int fq) const {
        const int row0 = u.pm * 256 + wr * 64 + fr, col0 = u.pn * 256 + wc * 32 + 4 * fq;
#pragma unroll
        for (int ai = 0; ai < 2; ++ai)
#pragma unroll
            for (int m = 0; m < 4; ++m) {
                const size_t off = (size_t)(row0 + ai * 128 + m * 16) * 1024 + col0;
#pragma unroll
                for (int bj = 0; bj < 2; ++bj)
#pragma unroll
                    for (int n = 0; n < 2; ++n) { const size_t o = off + bj * 128 + n * 16; *(f32x4*)(O + o) = *(const f32x4*)(X + o) + acc[ai][bj][m][n]; }
            }
    }
};
struct EpiMoe1 {
    static constexpr bool PERM = false, AFTER_DRAIN = false;
    bf16* HID;
    DI void operator()(const f32x4 (&acc)[2][2][4][2], const pg8::Unit& u, int wr, int wc, int fr, int fq) const {
        const int row0 = u.pm * 256 + wr * 64 + fr, f0 = (u.pn & 1) * 128 + 16 * wc + 4 * fq;
#pragma unroll
        for (int ai = 0; ai < 2; ++ai)
#pragma unroll
            for (int m = 0; m < 4; ++m) {
                bf16* rowp = HID + (size_t)(row0 + ai * 128 + m * 16) * 256 + f0;
#pragma unroll
                for (int bj = 0; bj < 2; ++bj) { const f32x4 g = acc[ai][bj][m][0], up = acc[ai][bj][m][1]; f32x4 h;
#pragma unroll
                    for (int i = 0; i < 4; ++i) h[i] = siluf_(g[i]) * up[i];
                    *(v2u*)(rowp + bj * 64) = pack4(h); }
            }
    }
};
struct EpiMoe2 {
    static constexpr bool PERM = true, AFTER_DRAIN = false;
    const v2u* LIST; bf16* Y; const LAS int* tp; const LAS int* cn;
    DI void operator()(const f32x4 (&acc)[2][2][4][2], const pg8::Unit& u, int wr, int wc, int fr, int fq) const {
        const int ex = u.pn >> 2, rank0 = (u.pm - tp[ex]) * 256 + wr * 64 + fr, cnt = cn[ex], col0 = (u.pn & 3) * 256 + wc * 32 + 8 * fq;
#pragma unroll
        for (int ai = 0; ai < 2; ++ai)
#pragma unroll
            for (int m = 0; m < 4; ++m) {
                const int rank = rank0 + ai * 128 + m * 16;
                if (rank < cnt) {
                    const v2u ri = LIST[(size_t)ex * 16384 + rank]; const float w = __uint_as_float(ri.y);
                    bf16* rowp = Y + ((size_t)(ri.x & 1u) * S + (ri.x >> 1)) * 1024 + col0;
#pragma unroll
                    for (int bj = 0; bj < 2; ++bj) *(bf16x8*)(rowp + bj * 128) = pack8(acc[ai][bj][m][0] * w, acc[ai][bj][m][1] * w);
                }
                asm volatile("" ::: "memory");
            }
    }
};

struct Args { const float* in[23]; float* out; unsigned char* ws; int ph_lo, ph_hi, li, pad; };
struct Frame {
    LAS unsigned char* lds;
    unsigned* ctl;
    int tid, lane, wave, G, gw, ngw;
    const Args* A; float* out; unsigned char* ws;
};
#define WSP(T, off) ((T*)(F.ws + (off)))

template <class DestFn>
DI void tr_item(const float* W, int ldw, int ncols, int k0, int n0, LAS float* scr, int lane, DestFn dest) {
    const int lr = lane >> 3, lc = (lane & 7) * 4;
    if (n0 + 32 <= ncols && (ldw & 3) == 0) {
#pragma unroll
        for (int i = 0; i < 8; ++i) { const int kk = 8 * i + lr; const f32x4 v = *(const f32x4*)(W + (size_t)(k0 + kk) * ldw + n0 + lc); LAS float* d = scr + kk * 33 + lc; d[0] = v[0]; d[1] = v[1]; d[2] = v[2]; d[3] = v[3]; }
    } else {
#pragma unroll
        for (int i = 0; i < 8; ++i) { const int kk = 8 * i + lr;
#pragma unroll
            for (int j = 0; j < 4; ++j) scr[kk * 33 + lc + j] = (n0 + lc + j) < ncols ? W[(size_t)(k0 + kk) * ldw + n0 + lc + j] : 0.0f; }
    }
    LDS_WAIT(); asm volatile("" ::: "memory");
    const int c = lane & 7;
#pragma unroll
    for (int j = 0; j < 4; ++j) {
        const int nl = (lane >> 3) + 8 * j, n = n0 + nl;
        if (n < ncols) {
            const LAS float* s = scr + (8 * c) * 33 + nl;
            v4u o; o.x = pk2(s[0 * 33], s[1 * 33]); o.y = pk2(s[2 * 33], s[3 * 33]); o.z = pk2(s[4 * 33], s[5 * 33]); o.w = pk2(s[6 * 33], s[7 * 33]);
            bf16* r0 = dest(n, 0); if (r0) *(v4u*)(r0 + k0 + 8 * c) = o;
            bf16* r1 = dest(n, 1); if (r1) *(v4u*)(r1 + k0 + 8 * c) = o;
        }
    }
    LDS_WAIT(); asm volatile("" ::: "memory");
}
DI int rot_row_R(int d) { const int n = d >> 6, dd = d & 63; return 32 * (dd >> 4) + 8 * ((dd >> 2) & 3) + 4 * n + (dd & 3); }
DI int rot_row_T(int d) { const int x2 = d >> 6, dd = d & 63; return 64 * (dd >> 5) + 16 * (((dd >> 4) & 1) + 2 * x2) + (dd & 15); }
DI bf16* win_dest(unsigned char* ws, int s, int which) {
    bf16* WR = (bf16*)(ws + WS_WR); bf16* WT = (bf16*)(ws + WS_WT); bf16* WG = (bf16*)(ws + WS_WG);
    int r = -1, t = -1, g = -1;
    if (s < 512) r = s;
    else if (s < 1280) { const int sp = s - 512, j6 = sp >> 7, gd = sp & 127;
        if (j6 == 0) r = 512 + gd; else if (j6 == 1) r = 512 + 128 + gd; else if (j6 == 2) r = 512 + 256 + gd; else if (j6 == 4) r = 512 + 384 + gd;
        else if (j6 == 3) t = gd; else t = 128 + gd; }
    else if (s < 1304) r = 12 * 256 + (s - 1280);
    else if (s < 1816) { const int f = s - 1304, hh = f >> 7, d = f & 127; r = (4 + (hh >> 1)) * 256 + (hh & 1) * 128 + rot_row_R(d); }
    else if (s < 2328) { const int f = s - 1816, hh = f >> 7, d = f & 127; r = (6 + (hh >> 1)) * 256 + (hh & 1) * 128 + rot_row_R(d); t = (1 + (hh >> 1)) * 256 + (hh & 1) * 128 + rot_row_T(d); }
    else if (s < 3352) t = 768 + (s - 2328);
    else if (s < 4376) r = 8 * 256 + (s - 3352);
    else g = s - 4376;
    if (which == 0) { if (r >= 0) return WR + (size_t)r * 1024; if (t >= 0) return WT + (size_t)t * 1024; return WG + (size_t)g * 1024; }
    return (r >= 0 && t >= 0) ? WT + (size_t)t * 1024 : nullptr;
}
DI void load_row(const float* p, int lane, f32x4 (&v)[4]) {
#pragma unroll
    for (int j = 0; j < 4; ++j) v[j] = *(const f32x4*)(p + 4 * lane + 256 * j);
}
DI float row_rstd(const f32x4 (&v)[4]) {
    float s = 0.f;
#pragma unroll
    for (int j = 0; j < 4; ++j) s += (v[j][0] * v[j][0] + v[j][1] * v[j][1]) + (v[j][2] * v[j][2] + v[j][3] * v[j][3]);
    return 1.0f / sqrtf(wave_sum(s) * (1.0f / 1024.0f) + EPS);
}

DI void p0_prologue(Frame& F) {
    LAS float* scr = (LAS float*)(F.lds + F.wave * WAVE_LDS);
    const float* w_in = F.A->in[3];
    constexpr int I_IN = 16 * 201, I_C1 = 512, I_C2 = 16, I_UA = 256, I_UB = 512, I_WO = 512, NIT = I_IN + I_C1 + I_C2 + I_UA + I_UB + I_WO;
    unsigned char* ws = F.ws;
    for (int it = F.gw; it < NIT; it += F.ngw) {
        int r = it;
        if (r < I_IN) { const int kb = r / 201, nb = r % 201; tr_item(w_in, 6424, 6424, 64 * kb, 32 * nb, scr, F.lane, [ws](int n, int which) { return win_dest(ws, n, which); }); continue; } r -= I_IN;
        if (r < I_C1) { const int kind = r >> 8, q = r & 255, kb = q >> 3, nb = q & 7; bf16* dstb = (bf16*)(ws + WS_WC1) + (size_t)kind * 256 * 2048;
            tr_item(F.A->in[kind ? 8 : 5], 256, 256, 64 * kb, 32 * nb, scr, F.lane, [dstb](int n, int which) { return which ? (bf16*)nullptr : dstb + (size_t)n * 2048; }); continue; } r -= I_C1;
        if (r < I_C2) { const int kind = r >> 3, q = r & 7, kb = q >> 1, nb = q & 1; bf16* dstb = (bf16*)(ws + WS_SM + SM_W2T) + (size_t)kind * 64 * 256;
            tr_item(F.A->in[kind ? 9 : 6], 64, 64, 64 * kb, 32 * nb, scr, F.lane, [dstb](int n, int which) { return which ? (bf16*)nullptr : dstb + (size_t)n * 256; }); continue; } r -= I_C2;
        if (r < I_UA) { const int kb = r >> 5, nb = r & 31; bf16* dstb = (bf16*)(ws + WS_WUA);
            tr_item(F.A->in[11], 1024, 1024, 64 * kb, 32 * nb, scr, F.lane, [dstb](int n, int which) { return which ? (bf16*)nullptr : dstb + (size_t)n * 512; }); continue; } r -= I_UA;
        if (r < I_UB) { const int kb = r >> 5, nb = r & 31; bf16* dstb = (bf16*)(ws + WS_WUB);
            tr_item(F.A->in[12], 1024, 1024, 64 * kb, 32 * nb, scr, F.lane, [dstb](int n, int which) { return which ? (bf16*)nullptr : dstb + (size_t)n * 1024; }); continue; } r -= I_UB;
        { const int kb = r >> 5, nb = r & 31; bf16* dstb = (bf16*)(ws + WS_WO);
            tr_item(F.A->in[13], 1024, 1024, 64 * kb, 32 * nb, scr, F.lane, [dstb](int n, int which) { return which ? (bf16*)nullptr : dstb + (size_t)n * 1024; }); }
    }
    for (int o = F.gw; o < 512; o += F.ngw) {
        const int kind = o >> 8, n = o & 255; const float* pos = F.A->in[kind ? 7 : 4]; const float* w1 = F.A->in[kind ? 8 : 5]; float s = 0.f;
        for (int kk = F.lane; kk < 2048; kk += 64) s += pos[kk] * w1[(size_t)kk * 256 + n];
        s = wave_sum(s); if (F.lane == 0) ((float*)(ws + WS_SM + SM_B1))[o] = s;
    }
    { float* wrt = (float*)(ws + WS_SM + SM_WRT); const float* wn = F.A->in[14];
      for (int i = F.gw * 64 + F.lane; i < 48 * 1024; i += F.ngw * 64) { const int o = i >> 10, k = i & 1023; wrt[i] = o < 4 ? wn[k] * F.A->in[15][k * 4 + o] : (o < 36 ? wn[k] * F.A->in[17][k * 32 + (o - 4)] : 0.0f); } }
    { f32x4 w[4]; load_row(F.A->in[2], F.lane, w); bf16* H = (bf16*)(ws + WS_H);
      for (int m = F.gw; m < S; m += F.ngw) { f32x4 v[4]; load_row(F.A->in[0] + (size_t)m * 1024, F.lane, v); const float rs = row_rstd(v);
#pragma unroll
        for (int j = 0; j < 4; ++j) { const f32x4 o = v[j] * rs * w[j]; *(v2u*)(H + (size_t)m * 1024 + 4 * F.lane + 256 * j) = pack4(o); } } }
}

DI void dma_rows256(const bf16* src0, size_t pitch, int nrows, LAS unsigned char* dst, int w, int lane) {
    const int lr = lane >> 4, pc = lane & 15;
#pragma unroll 1
    for (int k = w; k < (nrows >> 2); k += 8) { const int r = k * 4 + lr; const int gc = pc ^ (r & 15);
        __builtin_amdgcn_global_load_lds((const unsigned*)(src0 + (size_t)r * pitch + gc * 8), (LAS unsigned*)(dst + k * 1024), 16, 0, 0); }
}
DI bf16x8 frag256(const LAS unsigned char* base, int row, int chunk) { return *(const LAS bf16x8*)(base + row * 256 + ((chunk ^ (row & 15)) * 16)); }
DI v2u frag256h(const LAS unsigned char* base, int row, int chunk, int half) { return *(const LAS v2u*)(base + row * 256 + ((chunk ^ (row & 15)) * 16) + half * 8); }
DI void p2_ret_state_wg(Frame& F, int u) {
    const int c = u >> 2, h = u & 3, w = F.wave, col = F.lane & 15, kq = F.lane >> 4;
    const float l2g = log2f(1.0f - __builtin_amdgcn_exp2f((float)(-5 - h)));
    const bf16* TOUT = WSP(const bf16, WS_TOUT); LAS unsigned char* L = F.lds;
    asm volatile("s_waitcnt vmcnt(0) lgkmcnt(0)" ::: "memory"); __builtin_amdgcn_s_barrier();
    dma_rows256(TOUT + (size_t)(768 + h * 256) * TP + c * 128, TP, 256, L, w, F.lane);
    dma_rows256(TOUT + (size_t)(256 + h * 128) * TP + c * 128, TP, 128, L + 65536, w, F.lane);
    asm volatile("s_waitcnt vmcnt(0)" ::: "memory"); __builtin_amdgcn_s_barrier(); asm volatile("" ::: "memory");
    f32x4 acc[16];
#pragma unroll
    for (int i = 0; i < 16; ++i) acc[i] = (f32x4){0.f, 0.f, 0.f, 0.f};
#pragma unroll
    for (int ks = 0; ks < 4; ++ks) {
        const v4u kr = __builtin_bit_cast(v4u, frag256(L + 65536, w * 16 + col, ks * 4 + kq)); float kv[8] = {bflo(kr.x), bfhi(kr.x), bflo(kr.y), bfhi(kr.y), bflo(kr.z), bfhi(kr.z), bflo(kr.w), bfhi(kr.w)};
#pragma unroll
        for (int e = 0; e < 8; ++e) kv[e] *= __builtin_amdgcn_exp2f((float)(127 - (ks * 32 + kq * 8 + e)) * l2g);
        v4u ks4 = {pk2(kv[0], kv[1]), pk2(kv[2], kv[3]), pk2(kv[4], kv[5]), pk2(kv[6], kv[7])}; const bf16x8 kf = __builtin_bit_cast(bf16x8, ks4);
#pragma unroll
        for (int dvt = 0; dvt < 16; ++dvt) acc[dvt] = mfma16(kf, frag256(L, dvt * 16 + col, ks * 4 + kq), acc[dvt]);
    }
    bf16* UR = WSP(bf16, WS_UR) + ((size_t)(c * 4 + h) * 256) * 128;
#pragma unroll
    for (int dvt = 0; dvt < 16; ++dvt) *(v2u*)(UR + (size_t)(dvt * 16 + col) * 128 + w * 16 + 4 * kq) = pack4(acc[dvt]);
}
DI void p2_cmp_hidden(Frame& F, int u) {
    const int combo = u >> 8, kind = combo >> 1, g = combo & 1, rt = (u >> 2) & 63, nq = u & 3, col = F.lane & 15, kq = F.lane >> 4;
    const bf16* W1 = WSP(const bf16, WS_WC1) + (size_t)kind * 256 * 2048 + (size_t)(nq * 64 + col) * 2048 + kq * 8;
    int tokb = 16 * (rt * 16 + col); tokb = tokb < S - 32 ? tokb : S - 32;
    const bf16* KCV = WSP(const bf16, WS_KCV) + (size_t)tokb * 512 + kind * 128 + g * 64 + kq * 8;
    f32x4 acc[4];
#pragma unroll
    for (int i = 0; i < 4; ++i) acc[i] = (f32x4){0.f, 0.f, 0.f, 0.f};
#pragma unroll 8
    for (int st = 0; st < 64; ++st) {
        const bf16x8 bfr = ld16(KCV + (size_t)(st >> 1) * 512 + (st & 1) * 32);
#pragma unroll
        for (int nt = 0; nt < 4; ++nt) { const bf16x8 af = ld16(W1 + (size_t)nt * 16 * 2048 + st * 32); acc[nt] = mfma16(af, bfr, acc[nt]); }
    }
    const float* b1 = WSP(const float, WS_SM + SM_B1) + kind * 256; bf16* HC = WSP(bf16, WS_HIDC) + (size_t)combo * 1024 * 256;
#pragma unroll
    for (int nt = 0; nt < 4; ++nt) { const int n0 = nq * 64 + nt * 16 + 4 * kq; const f32x4 bb = *(const f32x4*)(b1 + n0); f32x4 v = acc[nt] + bb;
#pragma unroll
        for (int i = 0; i < 4; ++i) v[i] = gelu_tanh(v[i]);
        *(v2u*)(HC + (size_t)(rt * 16 + col) * 256 + n0) = pack4(v); }
}
DI void p2_kmax(Frame& F, int u) {
    const int tok = u * 64 + F.lane; const bf16* KCV = WSP(const bf16, WS_KCV) + (size_t)tok * 512 + 256;
#pragma unroll
    for (int q = 0; q < 4; ++q) { float s = 0.f;
#pragma unroll
        for (int j = 0; j < 8; ++j) { const v4u k = *(const v4u*)(KCV + q * 64 + j * 8);
            const float a0 = bflo(k.x), a1 = bfhi(k.x), a2 = bflo(k.y), a3 = bfhi(k.y), a4 = bflo(k.z), a5 = bfhi(k.z), a6 = bflo(k.w), a7 = bfhi(k.w);
            s += (a0 * a0 + a1 * a1) + (a2 * a2 + a3 * a3) + (a4 * a4 + a5 * a5) + (a6 * a6 + a7 * a7); }
        const unsigned m = wave_max_u32(__float_as_uint(s));
        if (F.lane == 0) atomicMax(F.ctl + CW_KMAX + q, m); }
}
DI void p3_scan(Frame& F) {
    const int idx = blockIdx.x * NTHR + F.tid;
    if (idx < 65536) {
        const int h = idx >> 14; const float cd = __builtin_amdgcn_exp2f(128.0f * log2f(1.0f - __builtin_amdgcn_exp2f((float)(-5 - h))));
        unsigned* UR = WSP(unsigned, WS_UR) + idx; float r0 = 0.f, r1 = 0.f;
#pragma unroll 32
        for (int c = 0; c < 128; ++c) { const unsigned u = UR[(size_t)c * 65536]; UR[(size_t)c * 65536] = pk2(r0, r1); r0 = r0 * cd + bflo(u); r1 = r1 * cd + bfhi(u); }
    }
}
DI void p3_kcvc(Frame& F, int u) {
    const int combo = u >> 6, kind = combo >> 1, g = combo & 1, rt = u & 63, col = F.lane & 15, kq = F.lane >> 4;
    const bf16* HC = WSP(const bf16, WS_HIDC) + (size_t)combo * 1024 * 256 + (size_t)(rt * 16 + col) * 256 + kq * 8;
    const bf16* W2 = WSP(const bf16, WS_SM + SM_W2T) + (size_t)kind * 64 * 256 + (size_t)col * 256 + kq * 8;
    f32x4 acc[4];
#pragma unroll
    for (int i = 0; i < 4; ++i) acc[i] = (f32x4){0.f, 0.f, 0.f, 0.f};
#pragma unroll
    for (int ks = 0; ks < 8; ++ks) { const bf16x8 hf = ld16(HC + ks * 32);
#pragma unroll
        for (int dt = 0; dt < 4; ++dt) { const bf16x8 wf = ld16(W2 + (size_t)dt * 16 * 256 + ks * 32); acc[dt] = kind ? mfma16(hf, wf, acc[dt]) : mfma16(wf, hf, acc[dt]); } }
    if (kind == 0) { bf16* KC = WSP(bf16, WS_SM + SM_KC) + (size_t)g * 1024 * 64;
#pragma unroll
        for (int dt = 0; dt < 4; ++dt) *(v2u*)(KC + (size_t)(rt * 16 + col) * 64 + dt * 16 + 4 * kq) = pack4(acc[dt]); }
    else { bf16* VCT = WSP(bf16, WS_SM + SM_VCT) + (size_t)g * 64 * 1024;
#pragma unroll
        for (int dt = 0; dt < 4; ++dt) *(v2u*)(VCT + (size_t)(dt * 16 + col) * 1024 + rt * 16 + 4 * kq) = pack4(acc[dt]); }
}

DI void p4_bias_table(Frame& F) {
    LAS float* bt = (LAS float*)(F.lds + BIAS_OFF); const float* rb = F.A->in[1];
    for (int i = F.tid; i < 129 * 8; i += NTHR) { const int dist = i >> 3, hd = i & 7; int b = dist;
        if (dist >= 16) { b = 16 + (int)(logf((float)dist / 16.0f) / 2.0794415416798357f * 16.0f); b = b < 31 ? b : 31; }
        bt[i] = rb[b * 8 + hd] * LOG2E; }
    __syncthreads();
    { LAS float* nb = (LAS float*)(F.lds + NEAR_OFF);
      for (int i = F.tid; i < 256 * 8; i += NTHR) { const int dist = (i >> 3) - 64; nb[i] = dist < 0 ? -1e30f : bt[(dist > 128 ? 128 : dist) * 8 + (i & 7)]; } }
    if (F.tid < 64) { float m = 0.f; for (int i = F.tid; i < 129 * 8; i += 64) m = fmaxf(m, fabsf(bt[i]));
#pragma unroll
        for (int o = 1; o < 64; o <<= 1) m = fmaxf(m, __shfl_xor(m, o));
        if (F.tid == 0) bt[129 * 8] = m; }
    __syncthreads();
}
DI void p4a_unit(Frame& F, int qt, int g) {
    const int lane = F.lane, col = lane & 15, rq = lane >> 4, t0 = qt * 16, tq = t0 + col;
    LAS float* wl = (LAS float*)(F.lds + F.wave * WAVE_LDS);
    const LAS float* bt = (const LAS float*)(F.lds + BIAS_OFF);
    const float bmax = bt[129 * 8];
    const bf16* QA = WSP(const bf16, WS_QA); const bf16* KCV = WSP(const bf16, WS_KCV); const bf16* TOUT = WSP(const bf16, WS_TOUT); const bf16* GA = WSP(const bf16, WS_GA);
    const bf16* KC = WSP(const bf16, WS_SM + SM_KC) + (size_t)g * 1024 * 64; const bf16* VCT = WSP(const bf16, WS_SM + SM_VCT) + (size_t)g * 64 * 1024;
    const float kmax_sel = sqrtf(__uint_as_float(F.ctl[CW_KMAX + g])), kmax_win = sqrtf(__uint_as_float(F.ctl[CW_KMAX + 2 + g]));
    bf16x8 qf[4][2]; float qn[4];
#pragma unroll
    for (int j = 0; j < 4; ++j) { float s = 0.f;
#pragma unroll
        for (int ks = 0; ks < 2; ++ks) { const v4u q = *(const v4u*)(QA + (size_t)tq * 512 + (g * 4 + j) * 64 + ks * 32 + rq * 8); qf[j][ks] = __builtin_bit_cast(bf16x8, q);
            const float a0 = bflo(q.x), a1 = bfhi(q.x), a2 = bflo(q.y), a3 = bfhi(q.y), a4 = bflo(q.z), a5 = bfhi(q.z), a6 = bflo(q.w), a7 = bfhi(q.w);
            s += (a0 * a0 + a1 * a1) + (a2 * a2 + a3 * a3) + (a4 * a4 + a5 * a5) + (a6 * a6 + a7 * a7); }
        qn[j] = sqrtf(quad_sum(s)); }
    const f32x4 z4 = {0.f, 0.f, 0.f, 0.f};
    f32x4 ACC[4][4];
#pragma unroll
    for (int j = 0; j < 4; ++j)
#pragma unroll
        for (int dt = 0; dt < 4; ++dt) ACC[j][dt] = z4;
    {
        float lw[4], bw[4];
#pragma unroll
        for (int j = 0; j < 4; ++j) { lw[j] = 0.f; bw[j] = qn[j] * kmax_win + bmax; }
        int pstart = (t0 - 511) & ~31; pstart = pstart < 0 ? 0 : pstart;
        for (int p0 = pstart; p0 <= t0 + 15; p0 += 32) {
            const bool farw = (p0 + 31 <= t0 - 128) && (p0 > t0 + 15 - 512);
            bf16x8 kf[2][2], vf[4]; const int p0l = p0;
#pragma unroll
            for (int kt = 0; kt < 2; ++kt)
#pragma unroll
                for (int ks = 0; ks < 2; ++ks) kf[kt][ks] = ld16(KCV + (size_t)(p0l + kt * 16 + col) * 512 + 384 + g * 64 + ks * 32 + rq * 8);
#pragma unroll
            for (int dt = 0; dt < 4; ++dt) vf[dt] = ld8x2(TOUT + (size_t)(128 + g * 64 + dt * 16 + col) * TP + p0l + 4 * rq, 16);
#pragma unroll
            for (int j = 0; j < 4; ++j) {
                f32x4 p[2];
#pragma unroll
                for (int kt = 0; kt < 2; ++kt) { f32x4 s = mfma16(kf[kt][0], qf[j][0], z4); s = mfma16(kf[kt][1], qf[j][1], s);
                    if (farw) {
                        const float cf = bt[128 * 8 + g * 4 + j] - bw[j];
#pragma unroll
                        for (int e = 0; e < 4; ++e) { const float v = __builtin_amdgcn_exp2f(s[e] + cf); p[kt][e] = v; lw[j] += v; }
                    } else {
#pragma unroll
                    for (int e = 0; e < 4; ++e) { const int dist = tq - (p0 + kt * 16 + 4 * rq + e); const int dc = dist < 0 ? 0 : (dist > 128 ? 128 : dist);
                        const float v = (dist >= 0 && dist < 512) ? __builtin_amdgcn_exp2f(s[e] + bt[dc * 8 + g * 4 + j] - bw[j]) : 0.f; p[kt][e] = v; lw[j] += v; } } }
                const bf16x8 pb = pack8(p[0], p[1]);
#pragma unroll
                for (int dt = 0; dt < 4; ++dt) ACC[j][dt] = mfma16(vf[dt], pb, ACC[j][dt]);
            }
        }
#pragma unroll
        for (int j = 0; j < 4; ++j) { const float sc = bf1(GA[(size_t)tq * 32 + 16 + g * 4 + j]) / quad_sum(lw[j]);
#pragma unroll
            for (int dt = 0; dt < 4; ++dt) ACC[j][dt] = ACC[j][dt] * sc; }
    }
    const int nkc = qt < 1023 ? qt : 1023, nst = (nkc + 31) >> 5;
    float m1[4], l1[4];
#pragma unroll
    for (int j = 0; j < 4; ++j) { m1[j] = -1e30f; l1[j] = 0.f; }
    for (int st = 0; st < nst; ++st) {
        const bool farc = 16 * (st * 32 + 31) + 31 <= t0 - 128;
        bf16x8 kf[2][2]; const int stl = st;
#pragma unroll
        for (int kt = 0; kt < 2; ++kt)
#pragma unroll
            for (int ks = 0; ks < 2; ++ks) kf[kt][ks] = ld16(KC + (size_t)(stl * 32 + kt * 16 + col) * 64 + ks * 32 + rq * 8);
#pragma unroll
        for (int j = 0; j < 4; ++j) {
            float sv[8]; float tm = -1e30f;
#pragma unroll
            for (int kt = 0; kt < 2; ++kt) { f32x4 s = mfma16(kf[kt][0], qf[j][0], z4); s = mfma16(kf[kt][1], qf[j][1], s);
                if (farc) { const float bf_ = bt[128 * 8 + g * 4 + j];
#pragma unroll
                    for (int e = 0; e < 4; ++e) { const float v = s[e] + bf_; sv[kt * 4 + e] = v; tm = fmaxf(tm, v); }
                } else {
#pragma unroll
                for (int e = 0; e < 4; ++e) { const int ci = st * 32 + kt * 16 + 4 * rq + e, dist = tq - (16 * ci + 31); const int dc = dist < 0 ? 0 : (dist > 128 ? 128 : dist);
                    const float v = dist >= 0 ? s[e] + bt[dc * 8 + g * 4 + j] : -1e30f; sv[kt * 4 + e] = v; tm = fmaxf(tm, v); } } }
            const float mn = fmaxf(m1[j], tm); float ls = 0.f;
#pragma unroll
            for (int e = 0; e < 8; ++e) ls += sv[e] > -1e29f ? __builtin_amdgcn_exp2f(sv[e] - mn) : 0.f;
            l1[j] = l1[j] * __builtin_amdgcn_exp2f(m1[j] - mn) + ls; m1[j] = mn;
        }
    }
    float mc[4], ilc[4];
#pragma unroll
    for (int j = 0; j < 4; ++j) { const float M = quad_max(m1[j]); const float l = quad_sum(l1[j] * __builtin_amdgcn_exp2f(m1[j] - M)); mc[j] = M; ilc[j] = l > 0.f ? 1.0f / l : 0.f; }
    {
        float gcmp[4];
#pragma unroll
        for (int j = 0; j < 4; ++j) gcmp[j] = bf1(GA[(size_t)tq * 32 + g * 4 + j]);
        float xprev = 0.f;
        for (int st = 0; st < nst; ++st) {
            const bool farc = 16 * (st * 32 + 31) + 31 <= t0 - 128;
            bf16x8 kf[2][2], vf[4]; const int stl = st;
#pragma unroll
            for (int kt = 0; kt < 2; ++kt)
#pragma unroll
                for (int ks = 0; ks < 2; ++ks) kf[kt][ks] = ld16(KC + (size_t)(stl * 32 + kt * 16 + col) * 64 + ks * 32 + rq * 8);
#pragma unroll
            for (int dt = 0; dt < 4; ++dt) vf[dt] = ld8x2(VCT + (size_t)(dt * 16 + col) * 1024 + stl * 32 + 4 * rq, 16);
            f32x4 ps[2] = {z4, z4};
#pragma unroll
            for (int j = 0; j < 4; ++j) {
                f32x4 p[2];
#pragma unroll
                for (int kt = 0; kt < 2; ++kt) { f32x4 s = mfma16(kf[kt][0], qf[j][0], z4); s = mfma16(kf[kt][1], qf[j][1], s);
                    if (farc) { const float cf = bt[128 * 8 + g * 4 + j] - mc[j];
#pragma unroll
                        for (int e = 0; e < 4; ++e) { const float v = __builtin_amdgcn_exp2f(s[e] + cf) * ilc[j]; ps[kt][e] += v; p[kt][e] = v * gcmp[j]; }
                    } else {
#pragma unroll
                    for (int e = 0; e < 4; ++e) { const int ci = st * 32 + kt * 16 + 4 * rq + e, dist = tq - (16 * ci + 31); const int dc = dist < 0 ? 0 : (dist > 128 ? 128 : dist);
                        const float v = dist >= 0 ? __builtin_amdgcn_exp2f(s[e] + bt[dc * 8 + g * 4 + j] - mc[j]) * ilc[j] : 0.f; ps[kt][e] += v; p[kt][e] = v * gcmp[j]; } } }
                const bf16x8 pb = pack8(p[0], p[1]);
#pragma unroll
                for (int dt = 0; dt < 4; ++dt) ACC[j][dt] = mfma16(vf[dt], pb, ACC[j][dt]);
            }
#pragma unroll
            for (int kt = 0; kt < 2; ++kt) {
                const float Gs = (ps[kt][0] + ps[kt][1]) + (ps[kt][2] + ps[kt][3]), X = ps[kt][3];
                const float xa = __shfl(X, (lane + 48) & 63), xb = __shfl(xprev, (lane + 48) & 63);
                const float xin = rq > 0 ? xa : xb;
                wl[col * 257 + st * 8 + kt * 4 + rq] = Gs + xin; xprev = X;
            }
        }
    }
    float* PART = WSP(float, WS_H) + (size_t)tq * 512 + g * 256;
#pragma unroll
    for (int j = 0; j < 4; ++j)
#pragma unroll
        for (int dt = 0; dt < 4; ++dt) *(f32x4*)(PART + j * 64 + dt * 16 + 4 * rq) = ACC[j][dt];
    LDS_WAIT();
    unsigned long long* SELM = (unsigned long long*)(F.ws + WS_WR);
    for (int i0 = 0; i0 < 16; i0 += 4) {
        const int cur = (t0 + i0) >> 6; unsigned k[4][4], T[4] = {0u, 0u, 0u, 0u};
#pragma unroll
        for (int qq = 0; qq < 4; ++qq)
#pragma unroll
            for (int e = 0; e < 4; ++e) { const int n = lane * 4 + e; const float v = wl[(i0 + qq) * 257 + n];
                k[qq][e] = (n == 0 || (n <= cur && n + 2 > cur)) ? 0x7F000000u : (n <= cur ? __float_as_uint(v) + 1u : 0u); }
#pragma unroll 1
        for (int bit = 30; bit >= 0; --bit) {
#pragma unroll
            for (int qq = 0; qq < 4; ++qq) { const unsigned c = T[qq] | (1u << bit);
                const int cnt = __popcll(__ballot(k[qq][0] >= c)) + __popcll(__ballot(k[qq][1] >= c)) + __popcll(__ballot(k[qq][2] >= c)) + __popcll(__ballot(k[qq][3] >= c));
                if (cnt >= 16) T[qq] = c; } }
#pragma unroll
        for (int qq = 0; qq < 4; ++qq) {
            unsigned long long bsel[4]; int ngt = 0;
#pragma unroll
            for (int e = 0; e < 4; ++e) { bsel[e] = __ballot(k[qq][e] > T[qq] && k[qq][e] != 0u); ngt += __popcll(bsel[e]); }
            if (T[qq] != 0u) {
                int need = 16 - ngt;
                unsigned long long beq[4];
#pragma unroll
                for (int e = 0; e < 4; ++e) beq[e] = __ballot(k[qq][e] == T[qq]);
                while (need > 0) {
                    int bestn = 1 << 30, be = 0;
#pragma unroll
                    for (int e = 0; e < 4; ++e) if (beq[e]) { const int n = 4 * (__ffsll((long long)beq[e]) - 1) + e; if (n < bestn) { bestn = n; be = e; } }
                    if (bestn == (1 << 30)) break;
                    const unsigned long long bitm = 1ull << (bestn >> 2);
                    if (be == 0) { bsel[0] |= bitm; beq[0] &= ~bitm; } else if (be == 1) { bsel[1] |= bitm; beq[1] &= ~bitm; } else if (be == 2) { bsel[2] |= bitm; beq[2] &= ~bitm; } else { bsel[3] |= bitm; beq[3] &= ~bitm; }
                    --need;
                }
            }
            if (lane < 4) SELM[((size_t)(t0 + i0 + qq) * 2 + g) * 4 + lane] = lane == 0 ? bsel[0] : (lane == 1 ? bsel[1] : (lane == 2 ? bsel[2] : bsel[3]));
        }
    }
    LDS_WAIT();
}
DI void p4b_pass(LAS unsigned char* ldsb, unsigned char* ws, float* outp, int tA, int tB, int g) {
    Frame F; F.lds = ldsb; F.ws = ws; F.out = outp; F.ctl = (unsigned*)(ws + WS_CTL); F.tid = threadIdx.x; F.lane = F.tid & 63; F.wave = __builtin_amdgcn_readfirstlane(F.tid >> 6); F.G = gridDim.x; F.gw = 0; F.ngw = 0; F.A = nullptr;
    const int lane = F.lane, w = F.wave, col = lane & 15, rq = lane >> 4, hj = col & 3;
    LAS unsigned char* L = F.lds;
    const LAS float* bt = (const LAS float*)(L + BIAS_OFF); const float bmax = bt[129 * 8];
    const bf16* QA = WSP(const bf16, WS_QA); const bf16* KCV = WSP(const bf16, WS_KCV); const bf16* TOUT = WSP(const bf16, WS_TOUT); const bf16* GA = WSP(const bf16, WS_GA);
    const float kmax_sel = sqrtf(__uint_as_float(F.ctl[CW_KMAX + g]));
    const unsigned long long* SELM = (const unsigned long long*)(F.ws + WS_WR);
    bf16x8 qb[4][2]; float bnd[4]; int tq[4];
    LAS unsigned long long* PKL = (LAS unsigned long long*)(L + 131072) + w * 64;
#pragma unroll
    for (int ct = 0; ct < 4; ++ct) { const int t = (ct < 2 ? tA : tB) * 64 + w * 8 + (ct & 1) * 4 + (col >> 2); tq[ct] = t; float s = 0.f;
#pragma unroll
        for (int ks = 0; ks < 2; ++ks) { const v4u q = *(const v4u*)(QA + (size_t)t * 512 + (g * 4 + hj) * 64 + ks * 32 + rq * 8); qb[ct][ks] = __builtin_bit_cast(bf16x8, q);
            const float a0 = bflo(q.x), a1 = bfhi(q.x), a2 = bflo(q.y), a3 = bfhi(q.y), a4 = bflo(q.z), a5 = bfhi(q.z), a6 = bflo(q.w), a7 = bfhi(q.w);
            s += (a0 * a0 + a1 * a1) + (a2 * a2 + a3 * a3) + (a4 * a4 + a5 * a5) + (a6 * a6 + a7 * a7); }
        bnd[ct] = sqrtf(quad_sum(s)) * kmax_sel + bmax; }
    { const int q = lane >> 2, e = lane & 3; const int t = ((q >> 3) ? tB : tA) * 64 + w * 8 + (q & 7); PKL[lane] = SELM[((size_t)t * 2 + g) * 4 + e]; }
    asm volatile("s_waitcnt vmcnt(0) lgkmcnt(0)" ::: "memory");
    const f32x4 z4 = {0.f, 0.f, 0.f, 0.f};
    f32x4 O[4][4], O1[4];
    v4u ones_u = col == 0 ? (v4u){0x3F803F80u, 0x3F803F80u, 0x3F803F80u, 0x3F803F80u} : (v4u){0u, 0u, 0u, 0u}; const bf16x8 onesA = __builtin_bit_cast(bf16x8, ones_u);
#pragma unroll
    for (int ct = 0; ct < 4; ++ct)
#pragma unroll
        for (int dt = 0; dt < 4; ++dt) O[ct][dt] = z4;
#pragma unroll
    for (int ct = 0; ct < 4; ++ct) O1[ct] = z4;
    const float bfar = bt[128 * 8 + g * 4 + hj];
    const int dr = lane >> 3, dc = (lane & 7) ^ dr, nb = tB + 1;
    const bf16* kbase = KCV + (size_t)(w * 8 + dr) * 512 + 256 + g * 64 + dc * 8;
    const bf16* vbase = TOUT + (size_t)(g * 64 + w * 8 + dr) * TP + dc * 8;
#define P4B_ISSUE(blk_, slot) do { \
        __builtin_amdgcn_global_load_lds((const unsigned*)(kbase + (size_t)(blk_) * 64 * 512), (LAS unsigned*)(L + (slot) * 16384 + w * 1024), 16, 0, 0); \
        __builtin_amdgcn_global_load_lds((const unsigned*)(vbase + (size_t)(blk_) * 64), (LAS unsigned*)(L + (slot) * 16384 + 8192 + w * 1024), 16, 0, 0); } while (0)
    asm volatile("s_waitcnt vmcnt(0)" ::: "memory");
    __builtin_amdgcn_s_barrier();
    const int ngrp = (nb + 3) >> 2;
#pragma unroll 1
    for (int b4 = 0; b4 < 4; ++b4) if (b4 < nb) P4B_ISSUE(b4, b4);
#pragma unroll 1
    for (int gi = 0; gi < ngrp; ++gi) {
        asm volatile("s_waitcnt vmcnt(0)" ::: "memory");
        asm volatile("s_waitcnt lgkmcnt(0)" ::: "memory"); __builtin_amdgcn_s_barrier(); asm volatile("" ::: "memory");
#pragma unroll 1
        for (int b4 = 0; b4 < 4; ++b4) { const int nblk = (gi + 1) * 4 + b4; if (nblk < nb) P4B_ISSUE(nblk, ((gi + 1) & 1) * 4 + b4); }
#pragma unroll 1
      for (int b4 = 0; b4 < 4; ++b4) {
        const int blk = gi * 4 + b4; if (blk >= nb) break;
        const LAS unsigned char* ring = L + ((gi & 1) * 4 + b4) * 16384;
        const int Lb = blk >> 2;
#pragma unroll
        for (int ct = 0; ct < 4; ++ct) {
            const unsigned long long word = PKL[(ct * 4 + (col >> 2)) * 4 + b4];
            const bool pick = (word >> Lb) & 1ull;
            if (__ballot(pick) == 0ull) continue;
            const int cur = ct < 2 ? tA : tB;
            const bool farb = blk + 3 <= cur;
            const float binit = pick ? (farb ? bfar - bnd[ct] : -bnd[ct]) : -1e30f; const f32x4 cinit = {binit, binit, binit, binit};
            f32x4 sacc[4];
#pragma unroll
            for (int kt = 0; kt < 4; ++kt) { const int key = kt * 16 + col;
                const bf16x8 k0 = *(const LAS bf16x8*)(ring + key * 128 + ((rq ^ (key & 7)) * 16)), k1 = *(const LAS bf16x8*)(ring + key * 128 + (((4 + rq) ^ (key & 7)) * 16));
                sacc[kt] = mfma16(k0, qb[ct][0], cinit); sacc[kt] = mfma16(k1, qb[ct][1], sacc[kt]); }
            if (farb) {
#pragma unroll
                for (int kt = 0; kt < 4; ++kt)
#pragma unroll
                    for (int e = 0; e < 4; ++e) sacc[kt][e] = __builtin_amdgcn_exp2f(sacc[kt][e]);
            } else {
                const LAS float* nbp = (const LAS float*)(L + NEAR_OFF) + (tq[ct] + 64 - blk * 64 - 4 * rq) * 8 + g * 4 + hj;
#pragma unroll
                for (int kt = 0; kt < 4; ++kt)
#pragma unroll
                    for (int e = 0; e < 4; ++e) sacc[kt][e] = __builtin_amdgcn_exp2f(sacc[kt][e] + nbp[-(kt * 16 + e) * 8]);
            }
            const bf16x8 pb0 = pack8(sacc[0], sacc[1]), pb1 = pack8(sacc[2], sacc[3]);
            O1[ct] = mfma16(onesA, pb0, O1[ct]); O1[ct] = mfma16(onesA, pb1, O1[ct]);
#pragma unroll
            for (int dt = 0; dt < 4; ++dt) { const int d = dt * 16 + col; const LAS unsigned char* vr = ring + 8192 + d * 128 + (rq & 1) * 8; const int sw = d & 7, c0 = rq >> 1;
                const v2u a0 = *(const LAS v2u*)(vr + ((c0 ^ sw) * 16)), a1 = *(const LAS v2u*)(vr + (((c0 + 2) ^ sw) * 16)), a2 = *(const LAS v2u*)(vr + (((c0 + 4) ^ sw) * 16)), a3 = *(const LAS v2u*)(vr + (((c0 + 6) ^ sw) * 16));
                v4u v0 = {a0.x, a0.y, a1.x, a1.y}, v1 = {a2.x, a2.y, a3.x, a3.y};
                O[ct][dt] = mfma16(__builtin_bit_cast(bf16x8, v0), pb0, O[ct][dt]); O[ct][dt] = mfma16(__builtin_bit_cast(bf16x8, v1), pb1, O[ct][dt]); }
        }
      }
    }
#pragma unroll
    for (int ct = 0; ct < 4; ++ct) { const int t = tq[ct]; const float sc = bf1(GA[(size_t)t * 32 + 8 + g * 4 + hj]) / quad_sum(rq == 0 ? O1[ct][0] : 0.f);
        const float* part = WSP(const float, WS_H) + (size_t)t * 512 + g * 256 + hj * 64; bf16* ya = WSP(bf16, WS_QA) + (size_t)t * 512 + (g * 4 + hj) * 64;
#pragma unroll
        for (int dt = 0; dt < 4; ++dt) { const f32x4 p = *(const f32x4*)(part + dt * 16 + 4 * rq); const f32x4 o = p + O[ct][dt] * sc; *(v2u*)(ya + dt * 16 + 4 * rq) = pack4(o); } }
    asm volatile("s_waitcnt vmcnt(0) lgkmcnt(0)" ::: "memory");
#undef P4B_ISSUE
}
DI void p4_ret_wg(Frame& F, int u) {
    const int c = u >> 2, h = u & 3, q8 = F.wave, lane = F.lane, col = lane & 15, rq = lane >> 4;
    const int il = q8 * 16 + col, tq = c * 128 + il;
    const float l2g = log2f(1.0f - __builtin_amdgcn_exp2f((float)(-5 - h)));
    const bf16* QR = WSP(const bf16, WS_QR); const bf16* KR = WSP(const bf16, WS_KR); const bf16* TOUT = WSP(const bf16, WS_TOUT); LAS unsigned char* L = F.lds;
    const bf16* RT = WSP(const bf16, WS_UR) + ((size_t)(c * 4 + h) * 256) * 128;
    asm volatile("s_waitcnt vmcnt(0) lgkmcnt(0)" ::: "memory"); __builtin_amdgcn_s_barrier();
    dma_rows256(RT, 128, 256, L, F.wave, lane);
    bf16x8 qf[4];
#pragma unroll
    for (int ks = 0; ks < 4; ++ks) qf[ks] = ld16(QR + (size_t)tq * 512 + h * 128 + ks * 32 + rq * 8);
    asm volatile("s_waitcnt vmcnt(0)" ::: "memory"); __builtin_amdgcn_s_barrier(); asm volatile("" ::: "memory");
    f32x4 ACC[16]; const f32x4 z4 = {0.f, 0.f, 0.f, 0.f};
#pragma unroll
    for (int i = 0; i < 16; ++i) ACC[i] = z4;
#pragma unroll
    for (int ks = 0; ks < 4; ++ks)
#pragma unroll
        for (int dvt = 0; dvt < 16; ++dvt) ACC[dvt] = mfma16(frag256(L, dvt * 16 + col, ks * 4 + rq), qf[ks], ACC[dvt]);
    { const float qd = __builtin_amdgcn_exp2f((float)(il + 1) * l2g);
#pragma unroll
      for (int i = 0; i < 16; ++i) ACC[i] = ACC[i] * qd; }
    asm volatile("s_waitcnt lgkmcnt(0)" ::: "memory"); __builtin_amdgcn_s_barrier(); asm volatile("" ::: "memory");
    dma_rows256(TOUT + (size_t)(768 + h * 256) * TP + c * 128, TP, 256, L, F.wave, lane);
    dma_rows256(KR + (size_t)(c * 128) * 512 + h * 128, 512, 128, L + 65536, F.wave, lane);
    asm volatile("s_waitcnt vmcnt(0)" ::: "memory"); __builtin_amdgcn_s_barrier(); asm volatile("" ::: "memory");
    const int nkp = (q8 * 16 + 16 + 31) >> 5;
    for (int kp = 0; kp < nkp; ++kp) {
        f32x4 p[2];
#pragma unroll
        for (int kt = 0; kt < 2; ++kt) { f32x4 s = z4;
#pragma unroll
            for (int ks = 0; ks < 4; ++ks) s = mfma16(frag256(L + 65536, kp * 32 + kt * 16 + col, ks * 4 + rq), qf[ks], s);
#pragma unroll
            for (int e = 0; e < 4; ++e) { const int dj = il - (kp * 32 + kt * 16 + 4 * rq + e); p[kt][e] = dj >= 0 ? s[e] * __builtin_amdgcn_exp2f((float)dj * l2g) : 0.f; } }
        const bf16x8 pb = pack8(p[0], p[1]);
#pragma unroll
        for (int dvt = 0; dvt < 16; ++dvt) { const v2u lo = frag256h(L, dvt * 16 + col, kp * 4 + (rq >> 1), rq & 1), hi = frag256h(L, dvt * 16 + col, kp * 4 + 2 + (rq >> 1), rq & 1);
            v4u v = {lo.x, lo.y, hi.x, hi.y}; ACC[dvt] = mfma16(__builtin_bit_cast(bf16x8, v), pb, ACC[dvt]); }
    }
    float s1 = 0.f;
#pragma unroll
    for (int i = 0; i < 16; ++i) s1 += (ACC[i][0] + ACC[i][1]) + (ACC[i][2] + ACC[i][3]);
    const float mu = quad_sum(s1) * (1.0f / 256.0f); float s2 = 0.f;
#pragma unroll
    for (int i = 0; i < 16; ++i) { ACC[i] = ACC[i] - mu; s2 += (ACC[i][0] * ACC[i][0] + ACC[i][1] * ACC[i][1]) + (ACC[i][2] * ACC[i][2] + ACC[i][3] * ACC[i][3]); }
    const float rs = 1.0f / sqrtf(quad_sum(s2) * (1.0f / 256.0f) + EPS);
    bf16* GR = WSP(bf16, WS_GR) + (size_t)tq * 1024 + h * 256; const float* rn = F.A->in[10] + h * 256;
#pragma unroll
    for (int dvt = 0; dvt < 16; ++dvt) { const int d0 = dvt * 16 + 4 * rq; const v2u gv = *(const v2u*)(GR + d0); const f32x4 w = *(const f32x4*)(rn + d0);
        f32x4 o; o[0] = siluf_(bflo(gv.x)) * ACC[dvt][0] * rs * w[0]; o[1] = siluf_(bfhi(gv.x)) * ACC[dvt][1] * rs * w[1]; o[2] = siluf_(bflo(gv.y)) * ACC[dvt][2] * rs * w[2]; o[3] = siluf_(bfhi(gv.y)) * ACC[dvt][3] * rs * w[3];
        *(v2u*)(GR + d0) = pack4(o); }
}

DI int moe_row(int f) { const int fp = f & 127; return (f >> 7) * 256 + 128 * (fp >> 6) + 32 * ((fp >> 4) & 3) + 4 * ((fp >> 2) & 3) + (fp & 3); }
DI void p8_route_item(Frame& F, int item) {
    const int lane = F.lane, row = lane & 15, kq = lane >> 4, m0 = item * 16, slot = F.wave & 3, hh = F.wave >> 2; const float* x1 = F.out; bf16* H2 = WSP(bf16, WS_H);
    LAS float* lg = (LAS float*)(F.lds + slot * WAVE_LDS);
    LAS float* ex = (LAS float*)(F.lds + slot * WAVE_LDS + 3200);
    const float* WRT = WSP(const float, WS_SM + SM_WRT);
    const float* xr = x1 + (size_t)(m0 + row) * 1024 + 4 * kq + hh * 512; const float* wr = WRT + (size_t)row * 1024 + 4 * kq + hh * 512;
    f32x4 acc[3]; float ss = 0.f;
#pragma unroll
    for (int ct = 0; ct < 3; ++ct) acc[ct] = (f32x4){0.f, 0.f, 0.f, 0.f};
#pragma unroll 8
    for (int c = 0; c < 32; ++c) {
        const f32x4 xa = *(const f32x4*)(xr + 16 * c); ss += (xa[0] * xa[0] + xa[1] * xa[1]) + (xa[2] * xa[2] + xa[3] * xa[3]);
#pragma unroll
        for (int ct = 0; ct < 3; ++ct) { const f32x4 wb = *(const f32x4*)(wr + (size_t)ct * 16 * 1024 + 16 * c);
#pragma unroll
            for (int j = 0; j < 4; ++j) acc[ct] = __builtin_amdgcn_mfma_f32_16x16x4f32(xa[j], wb[j], acc[ct], 0, 0, 0); }
    }
    if (hh == 1) {
#pragma unroll
        for (int ct = 0; ct < 3; ++ct)
#pragma unroll
            for (int j = 0; j < 4; ++j) ex[(ct * 4 + j) * 64 + lane] = acc[ct][j];
        ex[12 * 64 + lane] = ss;
    }
    LDS_WAIT(); __syncthreads();
    LAS unsigned* lcnt = (LAS unsigned*)(F.lds + 4 * WAVE_LDS);
    if (F.tid < 64) lcnt[F.tid] = 0u;
    int ex1 = 0, ex2 = 0; unsigned lr1 = 0u, lr2 = 0u; float w1 = 0.f, w2 = 0.f;
    if (hh == 0) {
#pragma unroll
        for (int ct = 0; ct < 3; ++ct)
#pragma unroll
            for (int j = 0; j < 4; ++j) acc[ct][j] += ex[(ct * 4 + j) * 64 + lane];
        ss += ex[12 * 64 + lane];
        const float rs = 1.0f / sqrtf(quad_sum(ss) * (1.0f / 1024.0f) + EPS);
        if (kq == 0) lg[16 * 48 + row] = rs;
#pragma unroll
        for (int ct = 0; ct < 3; ++ct)
#pragma unroll
            for (int j = 0; j < 4; ++j) lg[(4 * kq + j) * 48 + ct * 16 + row] = acc[ct][j];
    }
    LDS_WAIT(); __syncthreads();
    if (hh == 0 && lane < 16) {
        const float rst = lg[16 * 48 + lane]; float l[36];
#pragma unroll
        for (int o = 0; o < 36; ++o) l[o] = lg[lane * 48 + o] * rst + (o < 4 ? F.A->in[16][o] : F.A->in[18][o - 4]);
        int grp = 0; float mg = l[0];
#pragma unroll
        for (int i = 1; i < 4; ++i) if (l[i] > mg) { mg = l[i]; grp = i; }
        float Z = 0.f;
#pragma unroll
        for (int i = 0; i < 4; ++i) Z += expf(l[i] - mg);
        const float pg = 1.0f / Z;
        float le[8];
#pragma unroll
        for (int i = 0; i < 8; ++i) le[i] = grp == 0 ? l[4 + i] : (grp == 1 ? l[12 + i] : (grp == 2 ? l[20 + i] : l[28 + i]));
        int i1 = 0; float v1 = le[0];
#pragma unroll
        for (int i = 1; i < 8; ++i) if (le[i] > v1) { v1 = le[i]; i1 = i; }
        int i2 = -1; float v2 = -3.0e38f;
#pragma unroll
        for (int i = 0; i < 8; ++i) if (i != i1 && le[i] > v2) { v2 = le[i]; i2 = i; }
        const float e2 = expf(v2 - v1); w1 = pg / (1.0f + e2); w2 = pg * e2 / (1.0f + e2);
        ex1 = grp * 8 + i1; ex2 = grp * 8 + i2;
        lr1 = __hip_atomic_fetch_add(lcnt + ex1, 1u, __ATOMIC_RELAXED, __HIP_MEMORY_SCOPE_WORKGROUP); lr2 = __hip_atomic_fetch_add(lcnt + ex2, 1u, __ATOMIC_RELAXED, __HIP_MEMORY_SCOPE_WORKGROUP);
    }
    LDS_WAIT(); __syncthreads();
    if (F.tid < 32) { const unsigned n = lcnt[F.tid]; lcnt[32 + F.tid] = n ? atomicAdd(F.ctl + CW_CNT + F.tid, n) : 0u; }
    LDS_WAIT(); __syncthreads();
    if (hh == 0 && lane < 16) {
        const int t = m0 + lane; v2u* LIST = WSP(v2u, WS_XS);
        LIST[(size_t)ex1 * 16384 + lcnt[32 + ex1] + lr1] = (v2u){(unsigned)(t * 2 + 0), __float_as_uint(w1)};
        LIST[(size_t)ex2 * 16384 + lcnt[32 + ex2] + lr2] = (v2u){(unsigned)(t * 2 + 1), __float_as_uint(w2)};
    }
    { f32x4 w[4]; load_row(F.A->in[14], lane, w);
#pragma unroll 4
      for (int r8 = 0; r8 < 8; ++r8) { const int r = hh * 8 + r8; f32x4 v[4]; load_row(x1 + (size_t)(m0 + r) * 1024, lane, v); const float rst = lg[16 * 48 + r];
#pragma unroll
        for (int j = 0; j < 4; ++j) *(v2u*)(H2 + (size_t)(m0 + r) * 1024 + 4 * lane + 256 * j) = pack4(v[j] * rst * w[j]); } }
    LDS_WAIT(); __syncthreads();
}
DI void p8_moe_weights(Frame& F) {
    LAS float* scr = (LAS float*)(F.lds + F.wave * WAVE_LDS + 4096);
    bf16* WGU = WSP(bf16, WS_MOEW); bf16* WD = WGU + (size_t)32 * 512 * 1024;
    for (int it = F.gw; it < 3 * 4096; it += F.ngw) {
        const int which = it >> 12, r = it & 4095;
        if (which < 2) { const int e = r >> 7, q = r & 127, kb = q >> 3, nb = q & 7; bf16* dstb = WGU + (size_t)e * 512 * 1024 + (which ? 16 * 1024 : 0);
            tr_item((which ? F.A->in[20] : F.A->in[19]) + (size_t)e * 1024 * 256, 256, 256, 64 * kb, 32 * nb, scr, F.lane, [dstb](int n, int w2) { return w2 ? (bf16*)nullptr : dstb + (size_t)moe_row(n) * 1024; }); }
        else { const int e = r >> 7, q = r & 127, kb = q >> 5, nb = q & 31; bf16* dstb = WD + (size_t)e * 1024 * 256;
            tr_item(F.A->in[21] + (size_t)e * 256 * 1024, 1024, 1024, 64 * kb, 32 * nb, scr, F.lane, [dstb](int n, int w2) { return w2 ? (bf16*)nullptr : dstb + (size_t)n * 256; }); }
    }
}
DI void moe_tile_prefix(Frame& F) {
    LAS int* tp = (LAS int*)(F.lds + MOET_OFF);
    if (F.tid == 0) { int a = 0; for (int e = 0; e < 32; ++e) { const unsigned c = __hip_atomic_load(F.ctl + CW_CNT + e, __ATOMIC_RELAXED, __HIP_MEMORY_SCOPE_AGENT); tp[e] = a; tp[34 + e] = (int)c; a += (int)((c + 255u) >> 8); } tp[32] = a; }
    __syncthreads();
}
DI void p12_final(Frame& F) {
    f32x4 w[4]; load_row(F.A->in[22], F.lane, w); const bf16* Y = WSP(const bf16, WS_Y);
#pragma unroll 2
    for (int m = F.gw; m < S; m += F.ngw) {
        f32x4 v[4]; load_row(F.out + (size_t)m * 1024, F.lane, v);
#pragma unroll
        for (int j = 0; j < 4; ++j) { const v2u a = *(const v2u*)(Y + (size_t)m * 1024 + 4 * F.lane + 256 * j), b = *(const v2u*)(Y + ((size_t)S + m) * 1024 + 4 * F.lane + 256 * j);
            v[j][0] += bflo(a.x) + bflo(b.x); v[j][1] += bfhi(a.x) + bfhi(b.x); v[j][2] += bflo(a.y) + bflo(b.y); v[j][3] += bfhi(a.y) + bfhi(b.y); }
        const float rs = row_rstd(v);
#pragma unroll
        for (int j = 0; j < 4; ++j) *(f32x4*)(F.out + (size_t)m * 1024 + 4 * F.lane + 256 * j) = v[j] * rs * w[j];
    }
}

#ifndef MK_PER_PHASE
#define MK_PER_PHASE 0
#endif
constexpr int NPH = 13;
__global__ void __launch_bounds__(NTHR, 2) mk_fwd(Args args) {
    extern __shared__ __attribute__((aligned(16))) unsigned char lds[];
    Frame F;
    F.lds = (LAS unsigned char*)lds;
    F.tid = threadIdx.x; F.lane = F.tid & 63; F.wave = __builtin_amdgcn_readfirstlane(F.tid >> 6);
    F.G = gridDim.x; F.gw = blockIdx.x * NWAVES + F.wave; F.ngw = F.G * NWAVES;
    F.ws = args.ws; F.ctl = (unsigned*)(args.ws + WS_CTL); F.out = args.out;
    F.A = &args;
    for (int u = F.tid; u < (LDS_BYTES - MISC_OFF) / 4; u += NTHR) ((LAS unsigned*)(F.lds + MISC_OFF))[u] = 0u;
    __syncthreads();
    XcdBarrier bar; bar.bar = F.ctl + CW_BAR + args.li * XCD_BAR_WORDS; bar.x = 0; bar.st = nullptr;
    if (!MK_PER_PHASE) bar = xcd_barrier_post(F.ctl + CW_BAR + args.li * XCD_BAR_WORDS, (volatile LAS unsigned*)(F.lds + MISC_OFF) + 8);
    const int lo = args.ph_lo, hi = args.ph_hi;
    const int sub = args.pad ? args.pad : 0xFFFF;
#define IN(k) (lo <= (k) && (k) < hi)
#define SEAM(k) do { if (IN(k) && IN((k) + 1)) xcd_barrier(bar); } while (0)
    LAS unsigned char* ring = F.lds;

    if (IN(0)) { p0_prologue(F); }
    SEAM(0);
    if (IN(1)) {
        pg8::Gemm g{WSP(const bf16, WS_H), WSP(const bf16, WS_WR), 0, 0, 1024}; ProjOrder O{F.G, (int)blockIdx.x};
        EpiProj E{WSP(bf16, WS_QA), WSP(bf16, WS_KCV), WSP(bf16, WS_QR), WSP(bf16, WS_KR), WSP(bf16, WS_GR), WSP(bf16, WS_GA), WSP(bf16, WS_TOUT), (bf16*)F.out};
        pg8::gemm_phase<EpiProj, ProjOrder, true, true>(ring, g, O, E);
    }
    SEAM(1);
    if (IN(2)) {
        if (sub & 32) for (int u = blockIdx.x; u < 512; u += F.G) p2_ret_state_wg(F, u);
        if (sub & 8) { if (F.wave < 4) for (int u = blockIdx.x * 4 + F.wave; u < 1024; u += F.G * 4) p2_cmp_hidden(F, u); }
        if (sub & 16) { if (F.wave == 4) for (int u = blockIdx.x; u < 256; u += F.G) p2_kmax(F, u); }
        asm volatile("s_waitcnt vmcnt(0) lgkmcnt(0)" ::: "memory"); __syncthreads();
    }
    SEAM(2);
    if (IN(3)) {
        if (sub & 64) p3_scan(F);
        if (sub & 128) for (int u = F.gw; u < 256; u += F.ngw) p3_kcvc(F, u);
    }
    SEAM(3);
    if (IN(4)) {
        p4_bias_table(F);
        for (int pp = blockIdx.x; pp < 256; pp += F.G) {
            const int g = pp & 1, c = pp >> 1;
            if (sub & 1) p4a_unit(F, (F.wave < 4 ? c : 255 - c) * 4 + (F.wave & 3), g);
            VM_WAIT(); __syncthreads();
            if (sub & 2) p4b_pass(F.lds, F.ws, F.out, c, 255 - c, g);
        }
        if (sub & 4) for (int u = blockIdx.x; u < 512; u += F.G) p4_ret_wg(F, u);
        asm volatile("s_waitcnt vmcnt(0) lgkmcnt(0)" ::: "memory");
        __syncthreads();
    }
    SEAM(4);
    if (IN(6)) {
        { pg8::Gemm g{WSP(const bf16, WS_QA), WSP(const bf16, WS_WUA), S, 1024, 512}; pg8::StaticOrder O; O.init(S, 1024, F.G, (int)blockIdx.x);
          EpiUp<false> E{(const bf16*)F.out, WSP(bf16, WS_MG), 0};
          pg8::gemm_phase<EpiUp<false>, pg8::StaticOrder, true, true>(ring, g, O, E); }
        if (F.G != 256 && !MK_PER_PHASE) xcd_barrier(bar); else { VM_WAIT(); __syncthreads(); }
        { pg8::Gemm g{WSP(const bf16, WS_GR), WSP(const bf16, WS_WUB), S, 1024, 1024}; pg8::StaticOrder O; O.init(S, 1024, F.G, (int)blockIdx.x);
          EpiUp<true> E{(const bf16*)F.out, WSP(bf16, WS_MG), 1024};
          pg8::gemm_phase<EpiUp<true>, pg8::StaticOrder, true, true>(ring, g, O, E); }
    }
    SEAM(6);
    if (IN(7)) {
        pg8::Gemm g{WSP(const bf16, WS_MG), WSP(const bf16, WS_WO), S, 1024, 1024}; pg8::StaticOrder O; O.init(S, 1024, F.G, (int)blockIdx.x);
        EpiOut E{F.A->in[0], F.out};
        pg8::gemm_phase<EpiOut, pg8::StaticOrder, true, true>(ring, g, O, E);
    }
    SEAM(7);
    if (IN(8)) {
        if (sub & 256) for (int it = blockIdx.x * 4; it < S / 16; it += F.G * 4) p8_route_item(F, it + (F.wave & 3));
        if (sub & 512) p8_moe_weights(F);
    }
    SEAM(8);
    if (IN(10)) {
        moe_tile_prefix(F);
        MoeOrder<2> O{F.G, (int)blockIdx.x, (const LAS int*)(F.lds + MOET_OFF)};
        { LAS unsigned* gtab = (LAS unsigned*)(F.lds + GTAB_OFF); const LAS int* tp = (const LAS int*)(F.lds + MOET_OFF); const v2u* LIST = WSP(const v2u, WS_XS);
          for (int ui = 0; ui < 8; ++ui) { pg8::Unit u; if (!O.next(ui, u)) break;
              if (F.tid < 256) { const int ex = u.pn >> 1, rank = (u.pm - tp[ex]) * 256 + F.tid; gtab[ui * 256 + F.tid] = rank < tp[34 + ex] ? (LIST[(size_t)ex * 16384 + rank].x >> 1) : 0u; } }
          asm volatile("s_waitcnt vmcnt(0) lgkmcnt(0)" ::: "memory"); __syncthreads(); }
        pg8::Gemm g{WSP(const bf16, WS_H), WSP(const bf16, WS_MOEW), 0, 0, 1024};
        EpiMoe1 E{WSP(bf16, WS_HID)};
        pg8::gemm_phase<EpiMoe1, MoeOrder<2>, true, true, true>(ring, g, O, E, (const LAS unsigned*)(F.lds + GTAB_OFF));
    }
    SEAM(10);
    if (IN(11)) {
        moe_tile_prefix(F);
        pg8::Gemm g{WSP(const bf16, WS_HID), WSP(const bf16, WS_MOEW) + (size_t)32 * 512 * 1024, 0, 0, 256}; MoeOrder<4> O{F.G, (int)blockIdx.x, (const LAS int*)(F.lds + MOET_OFF)};
        EpiMoe2 E{WSP(const v2u, WS_XS), WSP(bf16, WS_Y), (const LAS int*)(F.lds + MOET_OFF), (const LAS int*)(F.lds + MOET_OFF) + 34};
        pg8::gemm_phase<EpiMoe2, MoeOrder<4>, true, true>(ring, g, O, E);
    }
    SEAM(11);
    if (IN(12)) p12_final(F);
#undef IN
#undef SEAM
}

extern "C" void kernel_launch(void* const* d_in, const int* in_sizes, int n_in, void* d_out, int out_size, void* d_ws, size_t ws_size, hipStream_t stream) {
    static int grid = 0;
    if (grid == 0) {
        if (n_in != 23 || out_size != S * D || ws_size < WS_END) { fprintf(stderr, "kernel_launch: unexpected problem (n_in %d, out %d, ws %zu)\n", n_in, out_size, ws_size); grid = -1; return; }
        int dev = 0, cus = 0;
        if (hipGetDevice(&dev) != hipSuccess || hipDeviceGetAttribute(&cus, hipDeviceAttributeMultiprocessorCount, dev) != hipSuccess) { grid = -1; return; }
        if (hipFuncSetAttribute((const void*)mk_fwd, hipFuncAttributeMaxDynamicSharedMemorySize, LDS_BYTES) != hipSuccess) { fprintf(stderr, "kernel_launch: hipFuncSetAttribute failed\n"); grid = -1; return; }
        int per_cu = 0;
        if (hipOccupancyMaxActiveBlocksPerMultiprocessor(&per_cu, (const void*)mk_fwd, NTHR, LDS_BYTES) != hipSuccess || per_cu < 1) { fprintf(stderr, "kernel_launch: occupancy query says %d\n", per_cu); }
        (void)hipGetLastError();
        grid = cus > 0 ? cus : 256;
    }
    if (grid < 0) return;
    if (hipMemsetAsync((char*)d_ws + WS_CTL, 0, CTL_ZERO_BYTES, stream) != hipSuccess) return;
    Args a{};
    for (int i = 0; i < 23; ++i) a.in[i] = (const float*)d_in[i];
    a.out = (float*)d_out; a.ws = (unsigned char*)d_ws;
#if MK_PER_PHASE
    for (int p = 0; p < NPH; ++p) { a.ph_lo = p; a.ph_hi = p + 1; hipLaunchKernelGGL(mk_fwd, dim3(grid), dim3(NTHR), LDS_BYTES, stream, a); }
#elif defined(MK_PREFIX_HI)
    a.ph_lo = 0; a.ph_hi = MK_PREFIX_HI; a.li = 0; a.pad = MK_PREFIX_SUB; hipLaunchKernelGGL(mk_fwd, dim3(grid), dim3(NTHR), LDS_BYTES, stream, a);
    (void)hipMemsetAsync((char*)d_ws + WS_CTL, 0, CTL_ZERO_BYTES, stream);
    a.ph_lo = 0; a.ph_hi = NPH; a.li = 1; a.pad = 0; hipLaunchKernelGGL(mk_fwd, dim3(grid), dim3(NTHR), LDS_BYTES, stream, a);
#elif defined(MK_DUP_LO)
    a.ph_lo = 0; a.ph_hi = MK_DUP_HI + 1; a.li = 0; hipLaunchKernelGGL(mk_fwd, dim3(grid), dim3(NTHR), LDS_BYTES, stream, a);
    a.ph_lo = MK_DUP_LO; a.ph_hi = NPH; a.li = 1; hipLaunchKernelGGL(mk_fwd, dim3(grid), dim3(NTHR), LDS_BYTES, stream, a);
#else
    a.ph_lo = 0; a.ph_hi = NPH;
    hipLaunchKernelGGL(mk_fwd, dim3(grid), dim3(NTHR), LDS_BYTES, stream, a);
#endif
}
```

```cpp
#include <hip/hip_runtime.h>
#include <cstdio>
#include <cstdint>
namespace pg8 {
#define PG8_LAS __attribute__((address_space(3)))
typedef unsigned short bf16_t;
typedef short bf16x8 __attribute__((ext_vector_type(8)));
typedef float f32x4 __attribute__((ext_vector_type(4)));
typedef unsigned u32x4 __attribute__((ext_vector_type(4)));
constexpr int BM = 256, BK = 64, HALF = 128, HTB = HALF * BK * 2  , STAGE_BYTES = 8 * HTB, NXCD = 8, WGM = 8;

__host__ __device__ __forceinline__ int lds_byte(int r, int c) { const int st = (r >> 4) * 2 + (c >> 5), rr = r & 15, cc = c & 31, ob = rr * 64 + cc * 2; return st * 1024 + (ob ^ (((ob >> 9) & 1) << 5)); }
__host__ __device__ __forceinline__ void stage_rc(int b, int& R, int& C) { const int st = b / 1024, sb = b % 1024, swz = sb ^ (((sb >> 9) & 1) << 5); R = (st >> 1) * 16 + swz / 64; C = (st & 1) * 32 + (swz % 64) / 2; }
__host__ __device__ __forceinline__ int perm32(int rho) { const int n = rho >> 4, i = rho & 15; return 8 * (i >> 2) + 4 * n + (i & 3); }

struct Unit { int pm, pn; };
struct Gemm { const bf16_t* A; const bf16_t* Bt; int M, N, K; };

struct StaticOrder {
    int nM, nN, nwg, G, c;
    __host__ __device__ void init(int M, int N, int G_, int c_) { nM = M / BM; nN = N / BM; nwg = nM * nN; G = G_; c = c_; }
    __host__ __device__ bool next(int i, Unit& u) const {
        const long L = (long)i * G + c; if (L >= nwg) return false;
        int wgid = (int)L; { const int q = nwg / NXCD, r = nwg % NXCD, xcd = wgid % NXCD, off = wgid / NXCD; wgid = (xcd < r ? xcd * (q + 1) : r * (q + 1) + (xcd - r) * q) + off; }
        const int nig = WGM * nN, gid = wgid / nig, fm = gid * WGM, gsz = (nM - fm) < WGM ? (nM - fm) : WGM;
        u.pm = fm + ((wgid % nig) % gsz); u.pn = (wgid % nig) / gsz; return true;
    }
    __device__ __forceinline__ void a_ready(const Unit&) const {}
    __device__ __forceinline__ void done(const Unit&) const {}
};

__device__ __forceinline__ unsigned cvt_pk_bf16(float lo, float hi) { unsigned r; asm volatile("v_cvt_pk_bf16_f32 %0, %1, %2" : "=v"(r) : "v"(lo), "v"(hi)); return r; }

template <class Epi, class Sched, bool ALIGN_EPI = false, bool SP2 = false, bool GATHER = false>
__device__ __forceinline__ void gemm_phase(PG8_LAS unsigned char* lds, const Gemm g, const Sched& S, const Epi& E, const PG8_LAS unsigned* gtab = nullptr) {
    static_assert(!GATHER || SP2, "GATHER needs SP2");
    const int tid = threadIdx.x, wid = __builtin_amdgcn_readfirstlane(tid >> 6), lane = tid & 63, wr = wid >> 2, wc = wid & 3, fr = lane & 15, fq = lane >> 4;
    const int K = g.K, nt = K / BK;
    unsigned voffA[2], voffB[2];
#pragma unroll
    for (int i = 0; i < 2; ++i) { int R, C; stage_rc(tid * 16 + i * 8192, R, C); const int Rb = Epi::PERM ? ((R & ~31) + perm32(R & 31)) : R;
        voffA[i] = (unsigned)(R * K + C) * 2u; voffB[i] = (unsigned)(Rb * K + C) * 2u; }
    int gR[2], gC[2];
#pragma unroll
    for (int i = 0; i < 2; ++i) stage_rc(tid * 16 + i * 8192, gR[i], gC[i]);
    unsigned gc[2][2], gn[2][2];
#define PG8_GOFF(dst, uidx) do { _Pragma("unroll") for (int _h = 0; _h < 2; ++_h) _Pragma("unroll") for (int _i = 0; _i < 2; ++_i) dst[_h][_i] = (gtab[(uidx) * 256 + _h * 128 + gR[_i]] * (unsigned)K + (unsigned)gC[_i]) * 2u; } while (0)
    const size_t kstep = (size_t)(BK * 2);
    const size_t hstep = (size_t)HALF * K * 2;
    const size_t tstep = 2 * hstep;
    const unsigned ldsw = (unsigned)wid * 1024u;
    const int aoff = lds_byte(wr * 64 + fr, fq * 8), boff = lds_byte(wc * 32 + fr, fq * 8);
#define PG8_SA(b, h) (((b) * 2 + (h)) * HTB)
#define PG8_SB(b, h) ((4 + (b) * 2 + (h)) * HTB)
#define PG8_STAGE(bufoff, gbase, voff) do { _Pragma("unroll") for (int _i = 0; _i < 2; ++_i) \
        __builtin_amdgcn_global_load_lds((const unsigned*)((const char*)(gbase) + (voff)[_i]), (PG8_LAS unsigned*)(lds + (bufoff) + ldsw + _i * 8192), 16, 0, 0); } while (0)
#define PG8_STAGE_A(bufoff, base, half, nxt_) do { if constexpr (GATHER) { _Pragma("unroll") for (int _i = 0; _i < 2; ++_i) \
        __builtin_amdgcn_global_load_lds((const unsigned*)((const char*)(base) + ((nxt_) ? gn[half][_i] : gc[half][_i])), (PG8_LAS unsigned*)(lds + (bufoff) + ldsw + _i * 8192), 16, 0, 0); } \
        else PG8_STAGE(bufoff, (base) + (half) * hstep, voffA); } while (0)
#define PG8_LDA(dst, b, h) do { _Pragma("unroll") for (int m = 0; m < 4; ++m) _Pragma("unroll") for (int k = 0; k < 2; ++k) dst[m][k] = *(const PG8_LAS bf16x8*)(lds + PG8_SA(b, h) + aoff + m * 2048 + k * 1024); } while (0)
#define PG8_LDB(dst, b, h) do { _Pragma("unroll") for (int n = 0; n < 2; ++n) _Pragma("unroll") for (int k = 0; k < 2; ++k) dst[n][k] = *(const PG8_LAS bf16x8*)(lds + PG8_SB(b, h) + boff + n * 2048 + k * 1024); } while (0)
#define PG8_MMA(ai, bj, At, Bt) do { __builtin_amdgcn_s_setprio(1); _Pragma("unroll") for (int m = 0; m < 4; ++m) _Pragma("unroll") for (int n = 0; n < 2; ++n) _Pragma("unroll") for (int k = 0; k < 2; ++k) \
        acc[ai][bj][m][n] = __builtin_amdgcn_mfma_f32_16x16x32_bf16(Bt[n][k], At[m][k], acc[ai][bj][m][n], 0, 0, 0); __builtin_amdgcn_s_setprio(0); } while (0)
#define PG8_WAIT_V(n) asm volatile("s_waitcnt vmcnt(" #n ")" ::: "memory")
#define PG8_WAIT_L(n) asm volatile("s_waitcnt lgkmcnt(" #n ")" ::: "memory")
#define PG8_BAR __builtin_amdgcn_s_barrier()
#define PG8_SCHED __builtin_amdgcn_sched_barrier(0)
    Unit cur, nxt; int ui = 0;
    if (!S.next(0, cur)) return;
    f32x4 acc[2][2][4][2];
#pragma unroll
    for (int a = 0; a < 2; ++a)
#pragma unroll
        for (int b = 0; b < 2; ++b)
#pragma unroll
            for (int m = 0; m < 4; ++m)
#pragma unroll
                for (int n = 0; n < 2; ++n) acc[a][b][m][n] = (f32x4){0.f, 0.f, 0.f, 0.f};
    bf16x8 At[4][2], B0[2][2], B1[2][2];
    const char* cA = GATHER ? (const char*)g.A : (const char*)g.A + (size_t)cur.pm * tstep; const char* cB = (const char*)g.Bt + (size_t)cur.pn * tstep;
    if constexpr (GATHER) { PG8_GOFF(gc, 0); }
    S.a_ready(cur);
    if constexpr (SP2) {
        PG8_STAGE(PG8_SB(0, 0), cB, voffB); PG8_STAGE(PG8_SB(0, 1), cB + hstep, voffB); PG8_STAGE_A(PG8_SA(0, 0), cA, 0, false); PG8_STAGE_A(PG8_SA(0, 1), cA, 1, false);
        if (wr == 1) PG8_BAR;
        PG8_WAIT_V(2); PG8_BAR;
        PG8_STAGE(PG8_SB(1, 0), cB + kstep, voffB); PG8_STAGE_A(PG8_SA(1, 0), cA + kstep, 0, false); PG8_STAGE(PG8_SB(1, 1), cB + hstep + kstep, voffB);
        PG8_WAIT_V(6); PG8_BAR;
    } else {
        PG8_STAGE(PG8_SB(0, 0), cB, voffB); PG8_STAGE(PG8_SA(0, 0), cA, voffA); PG8_STAGE(PG8_SB(0, 1), cB + hstep, voffB); PG8_STAGE(PG8_SA(0, 1), cA + hstep, voffA);
        if (wr == 1) PG8_BAR;
        PG8_WAIT_V(4); PG8_BAR;
        PG8_STAGE(PG8_SB(1, 0), cB + kstep, voffB); PG8_STAGE(PG8_SA(1, 0), cA + kstep, voffA); PG8_STAGE(PG8_SB(1, 1), cB + hstep + kstep, voffB);
        PG8_WAIT_V(6); PG8_BAR;
    }
    for (;;) {
        const bool has_next = S.next(ui + 1, nxt);
        const char* nA = GATHER ? cA : (has_next ? (const char*)g.A + (size_t)nxt.pm * tstep : cA);
        if constexpr (GATHER) { if (has_next) { PG8_GOFF(gn, ui + 1); } else { _Pragma("unroll") for (int _h = 0; _h < 2; ++_h) _Pragma("unroll") for (int _i = 0; _i < 2; ++_i) gn[_h][_i] = gc[_h][_i]; } } const char* nB = has_next ? (const char*)g.Bt + (size_t)nxt.pn * tstep : cB;
#pragma nounroll
        for (int t = 0; t < nt; t += 2) {
            const bool last = (t == nt - 2);
            const char* a1 = cA + (size_t)(t + 1) * kstep;
            const char* a2 = last ? nA : cA + (size_t)(t + 2) * kstep; const char* b2 = last ? nB : cB + (size_t)(t + 2) * kstep;
            const char* a3 = a2 + kstep; const char* b3 = b2 + kstep;
            if (last && has_next) S.a_ready(nxt);
            if constexpr (SP2) {
            PG8_LDB(B0, 0, 0); PG8_LDB(B1, 0, 1); PG8_SCHED; PG8_LDA(At, 0, 0); PG8_STAGE_A(PG8_SA(1, 1), a1, 1, false);
            PG8_WAIT_V(8); PG8_WAIT_L(0); PG8_BAR; PG8_MMA(0, 0, At, B0); PG8_MMA(0, 1, At, B1); PG8_BAR; PG8_SCHED;
            PG8_LDA(At, 0, 1); PG8_STAGE(PG8_SB(0, 0), b2, voffB); PG8_STAGE(PG8_SB(0, 1), b2 + hstep, voffB); PG8_STAGE_A(PG8_SA(0, 0), a2, 0, last);
            PG8_WAIT_V(8); PG8_WAIT_L(0); PG8_BAR; PG8_MMA(1, 0, At, B0); PG8_MMA(1, 1, At, B1); PG8_BAR; PG8_SCHED;
            PG8_LDB(B0, 1, 0); PG8_LDB(B1, 1, 1); PG8_SCHED; PG8_LDA(At, 1, 0); PG8_STAGE_A(PG8_SA(0, 1), a2, 1, last);
            PG8_WAIT_V(8); PG8_WAIT_L(0); PG8_BAR; PG8_MMA(0, 0, At, B0); PG8_MMA(0, 1, At, B1); PG8_BAR; PG8_SCHED;
            PG8_LDA(At, 1, 1); PG8_STAGE(PG8_SB(1, 0), b3, voffB); PG8_STAGE(PG8_SB(1, 1), b3 + hstep, voffB); PG8_STAGE_A(PG8_SA(1, 0), a3, 0, last);
            PG8_WAIT_V(8); PG8_WAIT_L(0); PG8_BAR; PG8_MMA(1, 0, At, B0); PG8_MMA(1, 1, At, B1); PG8_BAR; PG8_SCHED;
            } else {
            PG8_LDB(B0, 0, 0); PG8_SCHED; PG8_LDA(At, 0, 0); PG8_STAGE(PG8_SA(1, 1), a1 + hstep, voffA);
            PG8_WAIT_L(8); PG8_BAR; PG8_WAIT_L(0); PG8_MMA(0, 0, At, B0); PG8_BAR; PG8_SCHED;
            PG8_LDB(B1, 0, 1); PG8_STAGE(PG8_SB(0, 0), b2, voffB);
            PG8_BAR; PG8_WAIT_L(0); PG8_MMA(0, 1, At, B1); PG8_BAR;
            PG8_LDA(At, 0, 1); PG8_STAGE(PG8_SA(0, 0), a2, voffA);
            PG8_BAR; PG8_WAIT_L(0); PG8_MMA(1, 0, At, B0); PG8_BAR; PG8_SCHED;
            PG8_STAGE(PG8_SB(0, 1), b2 + hstep, voffB);
            PG8_WAIT_V(6); PG8_BAR; PG8_MMA(1, 1, At, B1); PG8_BAR;
            PG8_LDB(B0, 1, 0); PG8_SCHED; PG8_LDA(At, 1, 0); PG8_STAGE(PG8_SA(0, 1), a2 + hstep, voffA);
            PG8_WAIT_L(8); PG8_BAR; PG8_WAIT_L(0); PG8_MMA(0, 0, At, B0); PG8_BAR; PG8_SCHED;
            PG8_LDB(B1, 1, 1); PG8_STAGE(PG8_SB(1, 0), b3, voffB);
            PG8_BAR; PG8_WAIT_L(0); PG8_MMA(0, 1, At, B1); PG8_BAR;
            PG8_LDA(At, 1, 1); PG8_STAGE(PG8_SA(1, 0), a3, voffA);
            PG8_BAR; PG8_WAIT_L(0); PG8_MMA(1, 0, At, B0); PG8_BAR; PG8_SCHED;
            PG8_STAGE(PG8_SB(1, 1), b3 + hstep, voffB);
            PG8_WAIT_V(6); PG8_BAR; PG8_MMA(1, 1, At, B1); PG8_BAR;
            }
        }
        if constexpr (ALIGN_EPI) { if (wr == 0) PG8_BAR; }
        if constexpr (!Epi::AFTER_DRAIN) { E(acc, cur, wr, wc, fr, fq); S.done(cur); }
        if (!has_next) break;
#pragma unroll
        for (int a = 0; a < 2; ++a)
#pragma unroll
            for (int b = 0; b < 2; ++b)
#pragma unroll
                for (int m = 0; m < 4; ++m)
#pragma unroll
                    for (int n = 0; n < 2; ++n) acc[a][b][m][n] = (f32x4){0.f, 0.f, 0.f, 0.f};
        cur = nxt; cA = nA; cB = nB; ++ui;
        if constexpr (GATHER) { _Pragma("unroll") for (int _h = 0; _h < 2; ++_h) _Pragma("unroll") for (int _i = 0; _i < 2; ++_i) gc[_h][_i] = gn[_h][_i]; }
        if constexpr (ALIGN_EPI) { if (wr == 1) PG8_BAR; }
    }
    PG8_WAIT_V(0);
    if constexpr (!ALIGN_EPI) { if (wr == 0) PG8_BAR; }
    PG8_BAR;
    if constexpr (Epi::AFTER_DRAIN) { E.fused(acc, cur, wr, wc, fr, fq, lds, wid, lane); S.done(cur); }
#undef PG8_SA
#undef PG8_SB
#undef PG8_STAGE
#undef PG8_STAGE_A
#undef PG8_GOFF
#undef PG8_LDA
#undef PG8_LDB
#undef PG8_MMA
#undef PG8_WAIT_V
#undef PG8_WAIT_L
#undef PG8_BAR
#undef PG8_SCHED
}
}

#define GAS __attribute__((address_space(1)))
#define LAS __attribute__((address_space(3)))
#define DI __device__ __forceinline__
typedef unsigned short bf16;
typedef unsigned v4u __attribute__((ext_vector_type(4)));
typedef unsigned v2u __attribute__((ext_vector_type(2)));
typedef float f32x4 __attribute__((ext_vector_type(4)));
typedef short bf16x8 __attribute__((ext_vector_type(8)));
typedef float f32x2_t __attribute__((ext_vector_type(2)));
typedef __bf16 bf16x2_t __attribute__((ext_vector_type(2)));
#define LDS_WAIT() asm volatile("s_waitcnt lgkmcnt(0)" ::: "memory")
#define VM_WAIT() asm volatile("s_waitcnt vmcnt(0)" ::: "memory")
DI unsigned pk2(float lo, float hi) { f32x2_t v = {lo, hi}; bf16x2_t b = __builtin_convertvector(v, bf16x2_t); return __builtin_bit_cast(unsigned, b); }
DI float bflo(unsigned u) { return __uint_as_float(u << 16); }
DI float bfhi(unsigned u) { return __uint_as_float(u & 0xffff0000u); }
DI float bf1(bf16 b) { return __uint_as_float(((unsigned)b) << 16); }
DI f32x4 mfma16(bf16x8 a, bf16x8 b, f32x4 c) { return __builtin_amdgcn_mfma_f32_16x16x32_bf16(a, b, c, 0, 0, 0); }
DI bf16x8 ld16(const bf16* p) { return *(const bf16x8*)p; }
DI bf16x8 ld8x2(const bf16* p, int off2) { const v2u a = *(const v2u*)p, b = *(const v2u*)(p + off2); v4u r = {a.x, a.y, b.x, b.y}; return __builtin_bit_cast(bf16x8, r); }
DI bf16x8 pack8(f32x4 a, f32x4 b) { v4u r = {pk2(a[0], a[1]), pk2(a[2], a[3]), pk2(b[0], b[1]), pk2(b[2], b[3])}; return __builtin_bit_cast(bf16x8, r); }
DI v2u pack4(f32x4 a) { v2u r = {pk2(a[0], a[1]), pk2(a[2], a[3])}; return r; }
DI float wave_sum(float v) {
#pragma unroll
    for (int o = 1; o < 64; o <<= 1) v += __shfl_xor(v, o);
    return v;
}
DI float quad_sum(float v) { v += __shfl_xor(v, 16); v += __shfl_xor(v, 32); return v; }
DI float quad_max(float v) { v = fmaxf(v, __shfl_xor(v, 16)); v = fmaxf(v, __shfl_xor(v, 32)); return v; }
DI unsigned wave_max_u32(unsigned v) {
#pragma unroll
    for (int o = 1; o < 64; o <<= 1) { const unsigned w = (unsigned)__shfl_xor((int)v, o); v = w > v ? w : v; }
    return v;
}
DI float sigmoidf_(float x) { return __builtin_amdgcn_rcpf(1.0f + __builtin_amdgcn_exp2f(-x * 1.4426950408889634f)); }
DI float siluf_(float x) { return x * sigmoidf_(x); }
DI float gelu_tanh(float v) { const float z = 0.7978845608028654f * (v + 0.044715f * v * v * v); const float e = __builtin_amdgcn_exp2f(2.0f * 1.4426950408889634f * z); return 0.5f * v * (2.0f - 2.0f * __builtin_amdgcn_rcpf(e + 1.0f)); }

constexpr int S = 16384, D = 1024;
constexpr int TP = S + 2048 + 128;
constexpr int NWAVES = 8, NTHR = 512;
constexpr float EPS = 1e-6f, LOG2E = 1.4426950408889634f, QSCALE = 0.125f * 1.4426950408889634f;
constexpr size_t MiB = 1u << 20;
constexpr size_t WS_CTL = 0, CTL_ZERO_BYTES = MiB;
constexpr size_t WS_MISC = 1 * MiB;
constexpr size_t WS_WR = 2 * MiB;
constexpr size_t WS_H = WS_WR + 3328 * 2048;
constexpr size_t WS_WT = WS_H + 32 * MiB;
constexpr size_t WS_WG = 44 * MiB;
constexpr size_t WS_WC1 = 48 * MiB;
constexpr size_t WS_WUA = 50 * MiB, WS_WUB = 51 * MiB, WS_WO = 53 * MiB;
constexpr size_t WS_SM = 55 * MiB;
constexpr size_t SM_W2T = 0, SM_B1 = 64 * 1024, SM_WRT = 128 * 1024, SM_KC = 512 * 1024, SM_VCT = 768 * 1024;
constexpr size_t WS_QA = 56 * MiB, WS_GR = 72 * MiB, WS_GA = 104 * MiB, WS_KCV = 105 * MiB, WS_QR = 121 * MiB, WS_KR = 137 * MiB, WS_TOUT = 153 * MiB, WS_UR = 217 * MiB, WS_HIDC = 249 * MiB;
constexpr size_t WS_G = 105 * MiB, WS_MG = 169 * MiB;
constexpr size_t WS_MOEW = 56 * MiB;
constexpr size_t WS_HID = 104 * MiB, WS_XS = 188 * MiB  , WS_Y = 124 * MiB, WS_END = 256 * MiB;
static_assert(WS_TOUT + 1792ull * TP * 2 <= WS_UR && WS_WT + 1792 * 2048 <= WS_WG && WS_HIDC + 2 * MiB <= WS_END && WS_Y + 64 * MiB <= WS_XS && WS_XS + 4 * MiB <= WS_END && WS_Y + 64 * MiB <= WS_END, "ws map");
constexpr int CW_BAR = 4096, CW_KMAX = 16384, CW_CNT = 16448, CW_WQ = 16512;
constexpr int XS_ROWS = 40960;
constexpr int WAVE_LDS = 16960;
constexpr int NEAR_OFF = 140288;
constexpr int BIAS_OFF = 157184;
constexpr int MOET_OFF = 161344;
constexpr int GTAB_OFF = 135168;
constexpr int MISC_OFF = 161664;
constexpr int LDS_BYTES = 163840;
#define XB_TMO      128
#define XB_XCNT(j)  (256  + 64 * (j))
#define XB_XSUB(j)  (1280 + 64 * (j))
#define XB_XGEN(j)  (2304 + 64 * (j))
#define XB_TOP      3328
#define XB_TOPGEN   3392
#define XCD_BAR_WORDS 3456
#define XB_SPIN_CAP (1u << 18)

__device__ __forceinline__ unsigned xb_ld(unsigned* p)              { return __hip_atomic_load(p, __ATOMIC_RELAXED, __HIP_MEMORY_SCOPE_AGENT); }
__device__ __forceinline__ unsigned xb_add(unsigned* p, unsigned v) { return __hip_atomic_fetch_add(p, v, __ATOMIC_RELAXED, __HIP_MEMORY_SCOPE_AGENT); }
__device__ __forceinline__ unsigned xb_xcc_id() { return (unsigned)__builtin_amdgcn_s_getreg((3 << 11) | 20) & 0xFu; }
#define XB_SPIN(cond, bar) do { unsigned _sp = 0; while (cond) { __builtin_amdgcn_s_sleep(1); \
    if ((++_sp & 255u) == 0u) { if (xb_ld(&(bar)[XB_TMO])) break; if (_sp > XB_SPIN_CAP) { atomicAdd(&(bar)[XB_TMO], 1u); break; } } } } while (0)

struct XcdBarrier {
    unsigned* bar; unsigned x;
    volatile LAS unsigned* st;
};

__device__ __forceinline__ XcdBarrier xcd_barrier_post(unsigned* bar, volatile LAS unsigned* st) {
    XcdBarrier b; b.bar = bar; b.x = xb_xcc_id(); b.st = st;
    if (threadIdx.x == 0) (void)xb_add(&bar[XB_XCNT(b.x)], 1u);
    return b;
}
__device__ __forceinline__ void xcd_barrier_complete(unsigned* bar, unsigned x, unsigned& nloc, unsigned& nx) {
    const unsigned G = gridDim.x * gridDim.y * gridDim.z;
    unsigned sum, cnt, mine, sp = 0u;
    for (;;) {
        sum = 0u; cnt = 0u; mine = 0u;
#pragma unroll
        for (unsigned j = 0; j < 16; ++j) { const unsigned c = xb_ld(&bar[XB_XCNT(j)]); sum += c; cnt += (c > 0u) ? 1u : 0u; mine = (j == x) ? c : mine; }
        if (sum == G) break;
        __builtin_amdgcn_s_sleep(1);
        if ((++sp & 255u) == 0u) { if (xb_ld(&bar[XB_TMO])) break; if (sp > XB_SPIN_CAP) { atomicAdd(&bar[XB_TMO], 1u); break; } }
    }
    nloc = mine > 0u ? mine : 1u; nx = cnt > 0u ? cnt : 1u;
}

__device__ __forceinline__ void xcd_barrier(const XcdBarrier& b) {
    asm volatile("s_waitcnt vmcnt(0)" ::: "memory");
    __syncthreads();
    if (threadIdx.x == 0) {
        unsigned* bar = b.bar;
        __builtin_amdgcn_s_waitcnt(0);
        unsigned nloc = b.st[0], nx = b.st[1];
        if (nloc == 0u) { xcd_barrier_complete(bar, b.x, nloc, nx); b.st[0] = nloc; b.st[1] = nx; }
        const unsigned old = xb_add(&bar[XB_XSUB(b.x)], 1u);
        const unsigned gen = old / nloc;
        if (old + 1u == (gen + 1u) * nloc) {
            __builtin_amdgcn_fence(__ATOMIC_RELEASE, "agent");
            asm volatile("s_waitcnt vmcnt(0)" ::: "memory");
            const unsigned og = xb_add(&bar[XB_TOP], 1u);
            const unsigned tg = og / nx;
            if (og + 1u == (tg + 1u) * nx) xb_add(&bar[XB_TOPGEN], 1u);
            else XB_SPIN(xb_ld(&bar[XB_TOPGEN]) == tg, bar);
            __builtin_amdgcn_fence(__ATOMIC_ACQUIRE, "agent");
            xb_add(&bar[XB_XGEN(b.x)], 1u);
            asm volatile("s_waitcnt vmcnt(0)" ::: "memory");
        } else {
            XB_SPIN(xb_ld(&bar[XB_XGEN(b.x)]) == gen, bar);
            __builtin_amdgcn_fence(__ATOMIC_ACQUIRE, "agent");
            asm volatile("s_waitcnt vmcnt(0)" ::: "memory");
        }
    }
    __syncthreads();
}

DI void tile_map(int L, int nwg, int nM, int nN, int& pm, int& pn) {
    int wgid = L; { const int q = nwg / 8, r = nwg % 8, xcd = wgid % 8, off = wgid / 8; wgid = (xcd < r ? xcd * (q + 1) : r * (q + 1) + (xcd - r) * q) + off; }
    const int nig = 8 * nN, gid = wgid / nig, fm = gid * 8, gsz = (nM - fm) < 8 ? (nM - fm) : 8;
    pm = fm + ((wgid % nig) % gsz); pn = (wgid % nig) / gsz;
}
constexpr int GATE_PN0 = (int)((WS_WG - WS_WR) / (256 * 1024 * 2));
static_assert((WS_WG - WS_WR) % (256 * 1024 * 2) == 0, "gate weights sit a whole number of B tiles above WR");
struct ProjOrder {
    int G, c;
    DI bool next(int i, pg8::Unit& u) const {
        const int L = i * G + c; if (L >= 1792) return false;
        if (L < 832) tile_map(L, 832, 64, 13, u.pm, u.pn);
        else if (L < 1280) { tile_map(L - 832, 448, 7, 64, u.pm, u.pn); u.pm += 64; u.pn += 13; }
        else { tile_map(L - 1280, 512, 64, 8, u.pm, u.pn); u.pn += GATE_PN0; }
        return true;
    }
    DI void a_ready(const pg8::Unit&) const {}
    DI void done(const pg8::Unit&) const {}
};
template <int NJ> struct MoeOrder {
    int G, c; const LAS int* tp;
    DI bool next(int i, pg8::Unit& u) const {
        const int L = i * G + c, tau = L / NJ, j = L % NJ; const int nt = __builtin_amdgcn_readfirstlane(tp[32]);
        if (tau >= nt) return false;
        int e = 0;
        for (int k = 1; k < 32; ++k) e += (tau >= __builtin_amdgcn_readfirstlane(tp[k])) ? 1 : 0;
        u.pm = tau; u.pn = e * NJ + j; return true;
    }
    DI void a_ready(const pg8::Unit&) const {}
    DI void done(const pg8::Unit&) const {}
};

struct EpiProj {
    static constexpr bool PERM = true, AFTER_DRAIN = false;
    bf16 *QA, *KCV, *QR, *KR, *GR, *GA, *TOUT, *G;
    DI void operator()(const f32x4 (&acc)[2][2][4][2], const pg8::Unit& u, int wr, int wc, int fr_, int fq_) const {
        int fr = fr_, fq = fq_; asm volatile("" : "+v"(fr), "+v"(fq));
        const float L2B = 13.287712379549449f / 64.0f;
        const float INV2PI = 0.15915494309189535f;
        if (u.pm < 64 && u.pn >= GATE_PN0) {
            const int row0 = u.pm * 256 + wr * 64 + fr, col0 = (u.pn - GATE_PN0) * 256 + wc * 32 + 8 * fq;
#pragma unroll
            for (int ai = 0; ai < 2; ++ai)
#pragma unroll
                for (int m = 0; m < 4; ++m) {
                    bf16* rowp = G + (size_t)(row0 + ai * 128 + m * 16) * 2048 + col0;
#pragma unroll
                    for (int bj = 0; bj < 2; ++bj) { f32x4 a = acc[ai][bj][m][0], b = acc[ai][bj][m][1];
#pragma unroll
                        for (int i = 0; i < 4; ++i) { a[i] = sigmoidf_(a[i]); b[i] = sigmoidf_(b[i]); }
                        *(bf16x8*)(rowp + bj * 128) = pack8(a, b); }
                }
        } else if (u.pm < 64) {
            const int pn = u.pn, row0 = u.pm * 256 + wr * 64 + fr;
            if (pn >= 4 && pn < 8) {
                bf16* base = pn < 6 ? QR : KR; const float sc = pn < 6 ? 1.0f : 0.08838834764831845f; const int hd0 = 2 * (pn & 1), d0 = 16 * wc + 4 * fq;
                float invr[4];
#pragma unroll
                for (int i = 0; i < 4; ++i) invr[i] = __builtin_amdgcn_exp2f(-(float)(d0 + i) * L2B) * INV2PI;
#pragma unroll
                for (int ai = 0; ai < 2; ++ai)
#pragma unroll
                    for (int m = 0; m < 4; ++m) {
                        const int tok = row0 + ai * 128 + m * 16; float cs[4], sn[4];
#pragma unroll
                        for (int i = 0; i < 4; ++i) { float rev = (float)tok * invr[i]; rev -= floorf(rev); sn[i] = __builtin_amdgcn_sinf(rev) * sc; cs[i] = __builtin_amdgcn_cosf(rev) * sc; }
#pragma unroll
                        for (int bj = 0; bj < 2; ++bj) {
                            const f32x4 x1 = acc[ai][bj][m][0], x2 = acc[ai][bj][m][1]; f32x4 o1, o2;
#pragma unroll
                            for (int i = 0; i < 4; ++i) { o1[i] = x1[i] * cs[i] - x2[i] * sn[i]; o2[i] = x1[i] * sn[i] + x2[i] * cs[i]; }
                            bf16* p = base + (size_t)tok * 512 + (hd0 + bj) * 128 + d0;
                            *(v2u*)p = pack4(o1); *(v2u*)(p + 64) = pack4(o2);
                        }
                    }
            } else if (pn == 12) {
                if (wc == 0) {
#pragma unroll
                    for (int ai = 0; ai < 2; ++ai)
#pragma unroll
                        for (int m = 0; m < 4; ++m) {
                            const int tok = row0 + ai * 128 + m * 16; f32x4 a = acc[ai][0][m][0], b = acc[ai][0][m][1];
#pragma unroll
                            for (int i = 0; i < 4; ++i) { a[i] = sigmoidf_(a[i]); b[i] = sigmoidf_(b[i]); }
                            *(bf16x8*)(GA + (size_t)tok * 32 + 8 * fq) = pack8(a, b);
                        }
                }
            } else {
                bf16* dst; int ldc, colt; float sc = 1.0f;
                if (pn < 2) { dst = QA; ldc = 512; colt = 256 * pn; sc = QSCALE; }
                else if (pn < 4) { dst = KCV; ldc = 512; colt = 256 * (pn - 2); }
                else { dst = GR; ldc = 1024; colt = 256 * (pn - 8); }
                const int col0 = colt + wc * 32 + 8 * fq;
#pragma unroll
                for (int ai = 0; ai < 2; ++ai)
#pragma unroll
                    for (int m = 0; m < 4; ++m) {
                        bf16* rowp = dst + (size_t)(row0 + ai * 128 + m * 16) * ldc + col0;
#pragma unroll
                        for (int bj = 0; bj < 2; ++bj) *(bf16x8*)(rowp + bj * 128) = pack8(acc[ai][bj][m][0] * sc, acc[ai][bj][m][1] * sc);
                    }
            }
        } else {
            const int pmp = u.pm - 64, tok0 = (u.pn - 13) * 256 + wc * 32 + 8 * fq;
            if (pmp == 1 || pmp == 2) {
                const float sc = 0.08838834764831845f;
#pragma unroll
                for (int ai = 0; ai < 2; ++ai) {
                    const int head = 2 * (pmp - 1) + ai;
#pragma unroll
                    for (int m = 0; m < 2; ++m) {
                        const int d = 32 * wr + 16 * m + fr; const float invr = __builtin_amdgcn_exp2f(-(float)d * L2B) * INV2PI;
                        bf16* p1 = TOUT + (size_t)(256 + head * 128 + d) * TP;
#pragma unroll
                        for (int bj = 0; bj < 2; ++bj) {
                            f32x4 o1[2], o2[2];
#pragma unroll
                            for (int n = 0; n < 2; ++n)
#pragma unroll
                                for (int i = 0; i < 4; ++i) {
                                    const int tok = tok0 + bj * 128 + 4 * n + i; float rev = (float)tok * invr; rev -= floorf(rev);
                                    const float sn = __builtin_amdgcn_sinf(rev) * sc, cs = __builtin_amdgcn_cosf(rev) * sc;
                                    const float x1 = acc[ai][bj][m][n][i], x2 = acc[ai][bj][m + 2][n][i];
                                    o1[n][i] = x1 * cs - x2 * sn; o2[n][i] = x1 * sn + x2 * cs;
                                }
                            *(bf16x8*)(p1 + tok0 + bj * 128) = pack8(o1[0], o1[1]);
                            *(bf16x8*)(p1 + (size_t)64 * TP + tok0 + bj * 128) = pack8(o2[0], o2[1]);
                        }
                    }
                }
            } else {
#pragma unroll
                for (int ai = 0; ai < 2; ++ai)
#pragma unroll
                    for (int m = 0; m < 4; ++m) {
                        bf16* rowp = TOUT + (size_t)(pmp * 256 + ai * 128 + wr * 64 + m * 16 + fr) * TP + tok0;
#pragma unroll
                        for (int bj = 0; bj < 2; ++bj) *(bf16x8*)(rowp + bj * 128) = pack8(acc[ai][bj][m][0], acc[ai][bj][m][1]);
                    }
            }
        }
    }
};
struct EpiGate {
    static constexpr bool PERM = true, AFTER_DRAIN = false;
    bf16* G;
    DI void operator()(const f32x4 (&acc)[2][2][4][2], const pg8::Unit& u, int wr, int wc, int fr, int fq) const {
        const int row0 = u.pm * 256 + wr * 64 + fr, col0 = u.pn * 256 + wc * 32 + 8 * fq;
#pragma unroll
        for (int ai = 0; ai < 2; ++ai)
#pragma unroll
            for (int m = 0; m < 4; ++m) {
                bf16* rowp = G + (size_t)(row0 + ai * 128 + m * 16) * 2048 + col0;
#pragma unroll
                for (int bj = 0; bj < 2; ++bj) { f32x4 a = acc[ai][bj][m][0], b = acc[ai][bj][m][1];
#pragma unroll
                    for (int i = 0; i < 4; ++i) { a[i] = sigmoidf_(a[i]); b[i] = sigmoidf_(b[i]); }
                    *(bf16x8*)(rowp + bj * 128) = pack8(a, b); }
            }
    }
};
template <bool ADD> struct EpiUp {
    static constexpr bool PERM = true, AFTER_DRAIN = false;
    const bf16* G; bf16* MG; int goff;
    DI void operator()(const f32x4 (&acc)[2][2][4][2], const pg8::Unit& u, int wr, int wc, int fr, int fq) const {
        const int row0 = u.pm * 256 + wr * 64 + fr, col0 = u.pn * 256 + wc * 32 + 8 * fq;
#pragma unroll
        for (int ai = 0; ai < 2; ++ai)
#pragma unroll
            for (int m = 0; m < 4; ++m) {
                const size_t r = (size_t)(row0 + ai * 128 + m * 16);
#pragma unroll
                for (int bj = 0; bj < 2; ++bj) {
                    const v4u g = *(const v4u*)(G + r * 2048 + goff + col0 + bj * 128);
                    f32x4 a = acc[ai][bj][m][0], b = acc[ai][bj][m][1];
                    a[0] *= bflo(g.x); a[1] *= bfhi(g.x); a[2] *= bflo(g.y); a[3] *= bfhi(g.y); b[0] *= bflo(g.z); b[1] *= bfhi(g.z); b[2] *= bflo(g.w); b[3] *= bfhi(g.w);
                    bf16* op = MG + r * 1024 + col0 + bj * 128;
                    if (ADD) { const v4u o = *(const v4u*)op;
                        a[0] += bflo(o.x); a[1] += bfhi(o.x); a[2] += bflo(o.y); a[3] += bfhi(o.y); b[0] += bflo(o.z); b[1] += bfhi(o.z); b[2] += bflo(o.w); b[3] += bfhi(o.w); }
                    *(bf16x8*)op = pack8(a, b);
                }
            }
    }
};
struct EpiOut {
    static constexpr bool PERM = false, AFTER_DRAIN = false;
    const float* X; float* O;
    DI void operator()(const f32x4 (&acc)[2][2][4][2], const pg8::Unit& u, int wr, int wc, int fr, int fq) const {
        const int row0 = u.pm * 256 + wr * 64 + fr, col0 = u.pn * 256 + wc * 32 + 4 * fq;
#pragma unroll
        for (int ai = 0; ai < 2; ++ai)
#pragma unroll
            for (int m = 0; m < 4; ++m) {
                const size_t off = (size_t)(row0 + ai * 128 + m * 16) * 1024 + col0;
#pragma unroll
                for (int bj = 0; bj < 2; ++bj)
#pragma unroll
                    for (int n = 0; n < 2; ++n) { const size_t o = off + bj * 128 + n * 16; *(f32x4*)(O + o) = *(const f32x4*)(X + o) + acc[ai][bj][m][n]; }
            }
    }
};
struct EpiMoe1 {
    static constexpr bool PERM = false, AFTER_DRAIN = false;
    bf16* HID;
    DI void operator()(const f32x4 (&acc)[2][2][4][2], const pg8::Unit& u, int wr, int wc, int fr, int fq) const {
        const int row0 = u.pm * 256 + wr * 64 + fr, f0 = (u.pn & 1) * 128 + 16 * wc + 4 * fq;
#pragma unroll
        for (int ai = 0; ai < 2; ++ai)
#pragma unroll
            for (int m = 0; m < 4; ++m) {
                bf16* rowp = HID + (size_t)(row0 + ai * 128 + m * 16) * 256 + f0;
#pragma unroll
                for (int bj = 0; bj < 2; ++bj) { const f32x4 g = acc[ai][bj][m][0], up = acc[ai][bj][m][1]; f32x4 h;
#pragma unroll
                    for (int i = 0; i < 4; ++i) h[i] = siluf_(g[i]) * up[i];
                    *(v2u*)(rowp + bj * 64) = pack4(h); }
            }
    }
};
struct EpiMoe2 {
    static constexpr bool PERM = true, AFTER_DRAIN = false;
    const v2u* LIST; bf16* Y; const LAS int* tp; const LAS int* cn;
    DI void operator()(const f32x4 (&acc)[2][2][4][2], const pg8::Unit& u, int wr, int wc, int fr, int fq) const {
        const int ex = u.pn >> 2, rank0 = (u.pm - tp[ex]) * 256 + wr * 64 + fr, cnt = cn[ex], col0 = (u.pn & 3) * 256 + wc * 32 + 8 * fq;
#pragma unroll
        for (int ai = 0; ai < 2; ++ai)
#pragma unroll
            for (int m = 0; m < 4; ++m) {
                const int rank = rank0 + ai * 128 + m * 16;
                if (rank < cnt) {
                    const v2u ri = LIST[(size_t)ex * 16384 + rank]; const float w = __uint_as_float(ri.y);
                    bf16* rowp = Y + ((size_t)(ri.x & 1u) * S + (ri.x >> 1)) * 1024 + col0;
#pragma unroll
                    for (int bj = 0; bj < 2; ++bj) *(bf16x8*)(rowp + bj * 128) = pack8(acc[ai][bj][m][0] * w, acc[ai][bj][m][1] * w);
                }
                asm volatile("" ::: "memory");
            }
    }
};

struct Args { const float* in[23]; float* out; unsigned char* ws; int ph_lo, ph_hi, li, pad; };
struct Frame {
    LAS unsigned char* lds;
    unsigned* ctl;
    int tid, lane, wave, G, gw, ngw;
    const Args* A; float* out; unsigned char* ws;
};
#define WSP(T, off) ((T*)(F.ws + (off)))

template <class DestFn>
DI void tr_item(const float* W, int ldw, int ncols, int k0, int n0, LAS float* scr, int lane, DestFn dest) {
    const int lr = lane >> 3, lc = (lane & 7) * 4;
    if (n0 + 32 <= ncols && (ldw & 3) == 0) {
#pragma unroll
        for (int i = 0; i < 8; ++i) { const int kk = 8 * i + lr; const f32x4 v = *(const f32x4*)(W + (size_t)(k0 + kk) * ldw + n0 + lc); LAS float* d = scr + kk * 33 + lc; d[0] = v[0]; d[1] = v[1]; d[2] = v[2]; d[3] = v[3]; }
    } else {
#pragma unroll
        for (int i = 0; i < 8; ++i) { const int kk = 8 * i + lr;
#pragma unroll
            for (int j = 0; j < 4; ++j) scr[kk * 33 + lc + j] = (n0 + lc + j) < ncols ? W[(size_t)(k0 + kk) * ldw + n0 + lc + j] : 0.0f; }
    }
    LDS_WAIT(); asm volatile("" ::: "memory");
    const int c = lane & 7;
#pragma unroll
    for (int j = 0; j < 4; ++j) {
        const int nl = (lane >> 3) + 8 * j, n = n0 + nl;
        if (n < ncols) {
            const LAS float* s = scr + (8 * c) * 33 + nl;
            v4u o; o.x = pk2(s[0 * 33], s[1 * 33]); o.y = pk2(s[2 * 33], s[3 * 33]); o.z = pk2(s[4 * 33], s[5 * 33]); o.w = pk2(s[6 * 33], s[7 * 33]);
            bf16* r0 = dest(n, 0); if (r0) *(v4u*)(r0 + k0 + 8 * c) = o;
            bf16* r1 = dest(n, 1); if (r1) *(v4u*)(r1 + k0 + 8 * c) = o;
        }
    }
    LDS_WAIT(); asm volatile("" ::: "memory");
}
DI int rot_row_R(int d) { const int n = d >> 6, dd = d & 63; return 32 * (dd >> 4) + 8 * ((dd >> 2) & 3) + 4 * n + (dd & 3); }
DI int rot_row_T(int d) { const int x2 = d >> 6, dd = d & 63; return 64 * (dd >> 5) + 16 * (((dd >> 4) & 1) + 2 * x2) + (dd & 15); }
DI bf16* win_dest(unsigned char* ws, int s, int which) {
    bf16* WR = (bf16*)(ws + WS_WR); bf16* WT = (bf16*)(ws + WS_WT); bf16* WG = (bf16*)(ws + WS_WG);
    int r = -1, t = -1, g = -1;
    if (s < 512) r = s;
    else if (s < 1280) { const int sp = s - 512, j6 = sp >> 7, gd = sp & 127;
        if (j6 == 0) r = 512 + gd; else if (j6 == 1) r = 512 + 128 + gd; else if (j6 == 2) r = 512 + 256 + gd; else if (j6 == 4) r = 512 + 384 + gd;
        else if (j6 == 3) t = gd; else t = 128 + gd; }
    else if (s < 1304) r = 12 * 256 + (s - 1280);
    else if (s < 1816) { const int f = s - 1304, hh = f >> 7, d = f & 127; r = (4 + (hh >> 1)) * 256 + (hh & 1) * 128 + rot_row_R(d); }
    else if (s < 2328) { const int f = s - 1816, hh = f >> 7, d = f & 127; r = (6 + (hh >> 1)) * 256 + (hh & 1) * 128 + rot_row_R(d); t = (1 + (hh >> 1)) * 256 + (hh & 1) * 128 + rot_row_T(d); }
    else if (s < 3352) t = 768 + (s - 2328);
    else if (s < 4376) r = 8 * 256 + (s - 3352);
    else g = s - 4376;
    if (which == 0) { if (r >= 0) return WR + (size_t)r * 1024; if (t >= 0) return WT + (size_t)t * 1024; return WG + (size_t)g * 1024; }
    return (r >= 0 && t >= 0) ? WT + (size_t)t * 1024 : nullptr;
}
DI void load_row(const float* p, int lane, f32x4 (&v)[4]) {
#pragma unroll
    for (int j = 0; j < 4; ++j) v[j] = *(const f32x4*)(p + 4 * lane + 256 * j);
}
DI float row_rstd(const f32x4 (&v)[4]) {
    float s = 0.f;
#pragma unroll
    for (int j = 0; j < 4; ++j) s += (v[j][0] * v[j][0] + v[j][1] * v[j][1]) + (v[j][2] * v[j][2] + v[j][3] * v[j][3]);
    return 1.0f / sqrtf(wave_sum(s) * (1.0f / 1024.0f) + EPS);
}

DI void p0_prologue(Frame& F) {
    LAS float* scr = (LAS float*)(F.lds + F.wave * WAVE_LDS);
    const float* w_in = F.A->in[3];
    constexpr int I_IN = 16 * 201, I_C1 = 512, I_C2 = 16, I_UA = 256, I_UB = 512, I_WO = 512, NIT = I_IN + I_C1 + I_C2 + I_UA + I_UB + I_WO;
    unsigned char* ws = F.ws;
    for (int it = F.gw; it < NIT; it += F.ngw) {
        int r = it;
        if (r < I_IN) { const int kb = r / 201, nb = r % 201; tr_item(w_in, 6424, 6424, 64 * kb, 32 * nb, scr, F.lane, [ws](int n, int which) { return win_dest(ws, n, which); }); continue; } r -= I_IN;
        if (r < I_C1) { const int kind = r >> 8, q = r & 255, kb = q >> 3, nb = q & 7; bf16* dstb = (bf16*)(ws + WS_WC1) + (size_t)kind * 256 * 2048;
            tr_item(F.A->in[kind ? 8 : 5], 256, 256, 64 * kb, 32 * nb, scr, F.lane, [dstb](int n, int which) { return which ? (bf16*)nullptr : dstb + (size_t)n * 2048; }); continue; } r -= I_C1;
        if (r < I_C2) { const int kind = r >> 3, q = r & 7, kb = q >> 1, nb = q & 1; bf16* dstb = (bf16*)(ws + WS_SM + SM_W2T) + (size_t)kind * 64 * 256;
            tr_item(F.A->in[kind ? 9 : 6], 64, 64, 64 * kb, 32 * nb, scr, F.lane, [dstb](int n, int which) { return which ? (bf16*)nullptr : dstb + (size_t)n * 256; }); continue; } r -= I_C2;
        if (r < I_UA) { const int kb = r >> 5, nb = r & 31; bf16* dstb = (bf16*)(ws + WS_WUA);
            tr_item(F.A->in[11], 1024, 1024, 64 * kb, 32 * nb, scr, F.lane, [dstb](int n, int which) { return which ? (bf16*)nullptr : dstb + (size_t)n * 512; }); continue; } r -= I_UA;
        if (r < I_UB) { const int kb = r >> 5, nb = r & 31; bf16* dstb = (bf16*)(ws + WS_WUB);
            tr_item(F.A->in[12], 1024, 1024, 64 * kb, 32 * nb, scr, F.lane, [dstb](int n, int which) { return which ? (bf16*)nullptr : dstb + (size_t)n * 1024; }); continue; } r -= I_UB;
        { const int kb = r >> 5, nb = r & 31; bf16* dstb = (bf16*)(ws + WS_WO);
            tr_item(F.A->in[13], 1024, 1024, 64 * kb, 32 * nb, scr, F.lane, [dstb](int n, int which) { return which ? (bf16*)nullptr : dstb + (size_t)n * 1024; }); }
    }
    for (int o = F.gw; o < 512; o += F.ngw) {
        const int kind = o >> 8, n = o & 255; const float* pos = F.A->in[kind ? 7 : 4]; const float* w1 = F.A->in[kind ? 8 : 5]; float s = 0.f;
        for (int kk = F.lane; kk < 2048; kk += 64) s += pos[kk] * w1[(size_t)kk * 256 + n];
        s = wave_sum(s); if (F.lane == 0) ((float*)(ws + WS_SM + SM_B1))[o] = s;
    }
    { float* wrt = (float*)(ws + WS_SM + SM_WRT); const float* wn = F.A->in[14];
      for (int i = F.gw * 64 + F.lane; i < 48 * 1024; i += F.ngw * 64) { const int o = i >> 10, k = i & 1023; wrt[i] = o < 4 ? wn[k] * F.A->in[15][k * 4 + o] : (o < 36 ? wn[k] * F.A->in[17][k * 32 + (o - 4)] : 0.0f); } }
    { f32x4 w[4]; load_row(F.A->in[2], F.lane, w); bf16* H = (bf16*)(ws + WS_H);
      for (int m = F.gw; m < S; m += F.ngw) { f32x4 v[4]; load_row(F.A->in[0] + (size_t)m * 1024, F.lane, v); const float rs = row_rstd(v);
#pragma unroll
        for (int j = 0; j < 4; ++j) { const f32x4 o = v[j] * rs * w[j]; *(v2u*)(H + (size_t)m * 1024 + 4 * F.lane + 256 * j) = pack4(o); } } }
}

DI void dma_rows256(const bf16* src0, size_t pitch, int nrows, LAS unsigned char* dst, int w, int lane) {
    const int lr = lane >> 4, pc = lane & 15;
#pragma unroll 1
    for (int k = w; k < (nrows >> 2); k += 8) { const int r = k * 4 + lr; const int gc = pc ^ (r & 15);
        __builtin_amdgcn_global_load_lds((const unsigned*)(src0 + (size_t)r * pitch + gc * 8), (LAS unsigned*)(dst + k * 1024), 16, 0, 0); }
}
DI bf16x8 frag256(const LAS unsigned char* base, int row, int chunk) { return *(const LAS bf16x8*)(base + row * 256 + ((chunk ^ (row & 15)) * 16)); }
DI v2u frag256h(const LAS unsigned char* base, int row, int chunk, int half) { return *(const LAS v2u*)(base + row * 256 + ((chunk ^ (row & 15)) * 16) + half * 8); }
DI void p2_ret_state_wg(Frame& F, int u) {
    const int c = u >> 2, h = u & 3, w = F.wave, col = F.lane & 15, kq = F.lane >> 4;
    const float l2g = log2f(1.0f - __builtin_amdgcn_exp2f((float)(-5 - h)));
    const bf16* TOUT = WSP(const bf16, WS_TOUT); LAS unsigned char* L = F.lds;
    asm volatile("s_waitcnt vmcnt(0) lgkmcnt(0)" ::: "memory"); __builtin_amdgcn_s_barrier();
    dma_rows256(TOUT + (size_t)(768 + h * 256) * TP + c * 128, TP, 256, L, w, F.lane);
    dma_rows256(TOUT + (size_t)(256 + h * 128) * TP + c * 128, TP, 128, L + 65536, w, F.lane);
    asm volatile("s_waitcnt vmcnt(0)" ::: "memory"); __builtin_amdgcn_s_barrier(); asm volatile("" ::: "memory");
    f32x4 acc[16];
#pragma unroll
    for (int i = 0; i < 16; ++i) acc[i] = (f32x4){0.f, 0.f, 0.f, 0.f};
#pragma unroll
    for (int ks = 0; ks < 4; ++ks) {
        const v4u kr = __builtin_bit_cast(v4u, frag256(L + 65536, w * 16 + col, ks * 4 + kq)); float kv[8] = {bflo(kr.x), bfhi(kr.x), bflo(kr.y), bfhi(kr.y), bflo(kr.z), bfhi(kr.z), bflo(kr.w), bfhi(kr.w)};
#pragma unroll
        for (int e = 0; e < 8; ++e) kv[e] *= __builtin_amdgcn_exp2f((float)(127 - (ks * 32 + kq * 8 + e)) * l2g);
        v4u ks4 = {pk2(kv[0], kv[1]), pk2(kv[2], kv[3]), pk2(kv[4], kv[5]), pk2(kv[6], kv[7])}; const bf16x8 kf = __builtin_bit_cast(bf16x8, ks4);
#pragma unroll
        for (int dvt = 0; dvt < 16; ++dvt) acc[dvt] = mfma16(kf, frag256(L, dvt * 16 + col, ks * 4 + kq), acc[dvt]);
    }
    bf16* UR = WSP(bf16, WS_UR) + ((size_t)(c * 4 + h) * 256) * 128;
#pragma unroll
    for (int dvt = 0; dvt < 16; ++dvt) *(v2u*)(UR + (size_t)(dvt * 16 + col) * 128 + w * 16 + 4 * kq) = pack4(acc[dvt]);
}
DI void p2_cmp_hidden(Frame& F, int u) {
    const int combo = u >> 8, kind = combo >> 1, g = combo & 1, rt = (u >> 2) & 63, nq = u & 3, col = F.lane & 15, kq = F.lane >> 4;
    const bf16* W1 = WSP(const bf16, WS_WC1) + (size_t)kind * 256 * 2048 + (size_t)(nq * 64 + col) * 2048 + kq * 8;
    int tokb = 16 * (rt * 16 + col); tokb = tokb < S - 32 ? tokb : S - 32;
    const bf16* KCV = WSP(const bf16, WS_KCV) + (size_t)tokb * 512 + kind * 128 + g * 64 + kq * 8;
    f32x4 acc[4];
#pragma unroll
    for (int i = 0; i < 4; ++i) acc[i] = (f32x4){0.f, 0.f, 0.f, 0.f};
#pragma unroll 8
    for (int st = 0; st < 64; ++st) {
        const bf16x8 bfr = ld16(KCV + (size_t)(st >> 1) * 512 + (st & 1) * 32);
#pragma unroll
        for (int nt = 0; nt < 4; ++nt) { const bf16x8 af = ld16(W1 + (size_t)nt * 16 * 2048 + st * 32); acc[nt] = mfma16(af, bfr, acc[nt]); }
    }
    const float* b1 = WSP(const float, WS_SM + SM_B1) + kind * 256; bf16* HC = WSP(bf16, WS_HIDC) + (size_t)combo * 1024 * 256;
#pragma unroll
    for (int nt = 0; nt < 4; ++nt) { const int n0 = nq * 64 + nt * 16 + 4 * kq; const f32x4 bb = *(const f32x4*)(b1 + n0); f32x4 v = acc[nt] + bb;
#pragma unroll
        for (int i = 0; i < 4; ++i) v[i] = gelu_tanh(v[i]);
        *(v2u*)(HC + (size_t)(rt * 16 + col) * 256 + n0) = pack4(v); }
}
DI void p2_kmax(Frame& F, int u) {
    const int tok = u * 64 + F.lane; const bf16* KCV = WSP(const bf16, WS_KCV) + (size_t)tok * 512 + 256;
#pragma unroll
    for (int q = 0; q < 4; ++q) { float s = 0.f;
#pragma unroll
        for (int j = 0; j < 8; ++j) { const v4u k = *(const v4u*)(KCV + q * 64 + j * 8);
            const float a0 = bflo(k.x), a1 = bfhi(k.x), a2 = bflo(k.y), a3 = bfhi(k.y), a4 = bflo(k.z), a5 = bfhi(k.z), a6 = bflo(k.w), a7 = bfhi(k.w);
            s += (a0 * a0 + a1 * a1) + (a2 * a2 + a3 * a3) + (a4 * a4 + a5 * a5) + (a6 * a6 + a7 * a7); }
        const unsigned m = wave_max_u32(__float_as_uint(s));
        if (F.lane == 0) atomicMax(F.ctl + CW_KMAX + q, m); }
}
DI void p3_scan(Frame& F) {
    const int idx = blockIdx.x * NTHR + F.tid;
    if (idx < 65536) {
        const int h = idx >> 14; const float cd = __builtin_amdgcn_exp2f(128.0f * log2f(1.0f - __builtin_amdgcn_exp2f((float)(-5 - h))));
        unsigned* UR = WSP(unsigned, WS_UR) + idx; float r0 = 0.f, r1 = 0.f;
#pragma unroll 32
        for (int c = 0; c < 128; ++c) { const unsigned u = UR[(size_t)c * 65536]; UR[(size_t)c * 65536] = pk2(r0, r1); r0 = r0 * cd + bflo(u); r1 = r1 * cd + bfhi(u); }
    }
}
DI void p3_kcvc(Frame& F, int u) {
    const int combo = u >> 6, kind = combo >> 1, g = combo & 1, rt = u & 63, col = F.lane & 15, kq = F.lane >> 4;
    const bf16* HC = WSP(const bf16, WS_HIDC) + (size_t)combo * 1024 * 256 + (size_t)(rt * 16 + col) * 256 + kq * 8;
    const bf16* W2 = WSP(const bf16, WS_SM + SM_W2T) + (size_t)kind * 64 * 256 + (size_t)col * 256 + kq * 8;
    f32x4 acc[4];
#pragma unroll
    for (int i = 0; i < 4; ++i) acc[i] = (f32x4){0.f, 0.f, 0.f, 0.f};
#pragma unroll
    for (int ks = 0; ks < 8; ++ks) { const bf16x8 hf = ld16(HC + ks * 32);
#pragma unroll
        for (int dt = 0; dt < 4; ++dt) { const bf16x8 wf = ld16(W2 + (size_t)dt * 16 * 256 + ks * 32); acc[dt] = kind ? mfma16(hf, wf, acc[dt]) : mfma16(wf, hf, acc[dt]); } }
    if (kind == 0) { bf16* KC = WSP(bf16, WS_SM + SM_KC) + (size_t)g * 1024 * 64;
#pragma unroll
        for (int dt = 0; dt < 4; ++dt) *(v2u*)(KC + (size_t)(rt * 16 + col) * 64 + dt * 16 + 4 * kq) = pack4(acc[dt]); }
    else { bf16* VCT = WSP(bf16, WS_SM + SM_VCT) + (size_t)g * 64 * 1024;
#pragma unroll
        for (int dt = 0; dt < 4; ++dt) *(v2u*)(VCT + (size_t)(dt * 16 + col) * 1024 + rt * 16 + 4 * kq) = pack4(acc[dt]); }
}

DI void p4_bias_table(Frame& F) {
    LAS float* bt = (LAS float*)(F.lds + BIAS_OFF); const float* rb = F.A->in[1];
    for (int i = F.tid; i < 129 * 8; i += NTHR) { const int dist = i >> 3, hd = i & 7; int b = dist;
        if (dist >= 16) { b = 16 + (int)(logf((float)dist / 16.0f) / 2.0794415416798357f * 16.0f); b = b < 31 ? b : 31; }
        bt[i] = rb[b * 8 + hd] * LOG2E; }
    __syncthreads();
    { LAS float* nb = (LAS float*)(F.lds + NEAR_OFF);
      for (int i = F.tid; i < 256 * 8; i += NTHR) { const int dist = (i >> 3) - 64; nb[i] = dist < 0 ? -1e30f : bt[(dist > 128 ? 128 : dist) * 8 + (i & 7)]; } }
    if (F.tid < 64) { float m = 0.f; for (int i = F.tid; i < 129 * 8; i += 64) m = fmaxf(m, fabsf(bt[i]));
#pragma unroll
        for (int o = 1; o < 64; o <<= 1) m = fmaxf(m, __shfl_xor(m, o));
        if (F.tid == 0) bt[129 * 8] = m; }
    __syncthreads();
}
DI void p4a_unit(Frame& F, int qt, int g) {
    const int lane = F.lane, col = lane & 15, rq = lane >> 4, t0 = qt * 16, tq = t0 + col;
    LAS float* wl = (LAS float*)(F.lds + F.wave * WAVE_LDS);
    const LAS float* bt = (const LAS float*)(F.lds + BIAS_OFF);
    const float bmax = bt[129 * 8];
    const bf16* QA = WSP(const bf16, WS_QA); const bf16* KCV = WSP(const bf16, WS_KCV); const bf16* TOUT = WSP(const bf16, WS_TOUT); const bf16* GA = WSP(const bf16, WS_GA);
    const bf16* KC = WSP(const bf16, WS_SM + SM_KC) + (size_t)g * 1024 * 64; const bf16* VCT = WSP(const bf16, WS_SM + SM_VCT) + (size_t)g * 64 * 1024;
    const float kmax_sel = sqrtf(__uint_as_float(F.ctl[CW_KMAX + g])), kmax_win = sqrtf(__uint_as_float(F.ctl[CW_KMAX + 2 + g]));
    bf16x8 qf[4][2]; float qn[4];
#pragma unroll
    for (int j = 0; j < 4; ++j) { float s = 0.f;
#pragma unroll
        for (int ks = 0; ks < 2; ++ks) { const v4u q = *(const v4u*)(QA + (size_t)tq * 512 + (g * 4 + j) * 64 + ks * 32 + rq * 8); qf[j][ks] = __builtin_bit_cast(bf16x8, q);
            const float a0 = bflo(q.x), a1 = bfhi(q.x), a2 = bflo(q.y), a3 = bfhi(q.y), a4 = bflo(q.z), a5 = bfhi(q.z), a6 = bflo(q.w), a7 = bfhi(q.w);
            s += (a0 * a0 + a1 * a1) + (a2 * a2 + a3 * a3) + (a4 * a4 + a5 * a5) + (a6 * a6 + a7 * a7); }
        qn[j] = sqrtf(quad_sum(s)); }
    const f32x4 z4 = {0.f, 0.f, 0.f, 0.f};
    f32x4 ACC[4][4];
#pragma unroll
    for (int j = 0; j < 4; ++j)
#pragma unroll
        for (int dt = 0; dt < 4; ++dt) ACC[j][dt] = z4;
    {
        float lw[4], bw[4];
#pragma unroll
        for (int j = 0; j < 4; ++j) { lw[j] = 0.f; bw[j] = qn[j] * kmax_win + bmax; }
        int pstart = (t0 - 511) & ~31; pstart = pstart < 0 ? 0 : pstart;
        for (int p0 = pstart; p0 <= t0 + 15; p0 += 32) {
            const bool farw = (p0 + 31 <= t0 - 128) && (p0 > t0 + 15 - 512);
            bf16x8 kf[2][2], vf[4]; const int p0l = p0;
#pragma unroll
            for (int kt = 0; kt < 2; ++kt)
#pragma unroll
                for (int ks = 0; ks < 2; ++ks) kf[kt][ks] = ld16(KCV + (size_t)(p0l + kt * 16 + col) * 512 + 384 + g * 64 + ks * 32 + rq * 8);
#pragma unroll
            for (int dt = 0; dt < 4; ++dt) vf[dt] = ld8x2(TOUT + (size_t)(128 + g * 64 + dt * 16 + col) * TP + p0l + 4 * rq, 16);
#pragma unroll
            for (int j = 0; j < 4; ++j) {
                f32x4 p[2];
#pragma unroll
                for (int kt = 0; kt < 2; ++kt) { f32x4 s = mfma16(kf[kt][0], qf[j][0], z4); s = mfma16(kf[kt][1], qf[j][1], s);
                    if (farw) {
                        const float cf = bt[128 * 8 + g * 4 + j] - bw[j];
#pragma unroll
                        for (int e = 0; e < 4; ++e) { const float v = __builtin_amdgcn_exp2f(s[e] + cf); p[kt][e] = v; lw[j] += v; }
                    } else {
#pragma unroll
                    for (int e = 0; e < 4; ++e) { const int dist = tq - (p0 + kt * 16 + 4 * rq + e); const int dc = dist < 0 ? 0 : (dist > 128 ? 128 : dist);
                        const float v = (dist >= 0 && dist < 512) ? __builtin_amdgcn_exp2f(s[e] + bt[dc * 8 + g * 4 + j] - bw[j]) : 0.f; p[kt][e] = v; lw[j] += v; } } }
                const bf16x8 pb = pack8(p[0], p[1]);
#pragma unroll
                for (int dt = 0; dt < 4; ++dt) ACC[j][dt] = mfma16(vf[dt], pb, ACC[j][dt]);
            }
        }
#pragma unroll
        for (int j = 0; j < 4; ++j) { const float sc = bf1(GA[(size_t)tq * 32 + 16 + g * 4 + j]) / quad_sum(lw[j]);
#pragma unroll
            for (int dt = 0; dt < 4; ++dt) ACC[j][dt] = ACC[j][dt] * sc; }
    }
    const int nkc = qt < 1023 ? qt : 1023, nst = (nkc + 31) >> 5;
    float m1[4], l1[4];
#pragma unroll
    for (int j = 0; j < 4; ++j) { m1[j] = -1e30f; l1[j] = 0.f; }
    for (int st = 0; st < nst; ++st) {
        const bool farc = 16 * (st * 32 + 31) + 31 <= t0 - 128;
        bf16x8 kf[2][2]; const int stl = st;
#pragma unroll
        for (int kt = 0; kt < 2; ++kt)
#pragma unroll
            for (int ks = 0; ks < 2; ++ks) kf[kt][ks] = ld16(KC + (size_t)(stl * 32 + kt * 16 + col) * 64 + ks * 32 + rq * 8);
#pragma unroll
        for (int j = 0; j < 4; ++j) {
            float sv[8]; float tm = -1e30f;
#pragma unroll
            for (int kt = 0; kt < 2; ++kt) { f32x4 s = mfma16(kf[kt][0], qf[j][0], z4); s = mfma16(kf[kt][1], qf[j][1], s);
                if (farc) { const float bf_ = bt[128 * 8 + g * 4 + j];
#pragma unroll
                    for (int e = 0; e < 4; ++e) { const float v = s[e] + bf_; sv[kt * 4 + e] = v; tm = fmaxf(tm, v); }
                } else {
#pragma unroll
                for (int e = 0; e < 4; ++e) { const int ci = st * 32 + kt * 16 + 4 * rq + e, dist = tq - (16 * ci + 31); const int dc = dist < 0 ? 0 : (dist > 128 ? 128 : dist);
                    const float v = dist >= 0 ? s[e] + bt[dc * 8 + g * 4 + j] : -1e30f; sv[kt * 4 + e] = v; tm = fmaxf(tm, v); } } }
            const float mn = fmaxf(m1[j], tm); float ls = 0.f;
#pragma unroll
            for (int e = 0; e < 8; ++e) ls += sv[e] > -1e29f ? __builtin_amdgcn_exp2f(sv[e] - mn) : 0.f;
            l1[j] = l1[j] * __builtin_amdgcn_exp2f(m1[j] - mn) + ls; m1[j] = mn;
        }
    }
    float mc[4], ilc[4];
#pragma unroll
    for (int j = 0; j < 4; ++j) { const float M = quad_max(m1[j]); const float l = quad_sum(l1[j] * __builtin_amdgcn_exp2f(m1[j] - M)); mc[j] = M; ilc[j] = l > 0.f ? 1.0f / l : 0.f; }
    {
        float gcmp[4];
#pragma unroll
        for (int j = 0; j < 4; ++j) gcmp[j] = bf1(GA[(size_t)tq * 32 + g * 4 + j]);
        float xprev = 0.f;
        for (int st = 0; st < nst; ++st) {
            const bool farc = 16 * (st * 32 + 31) + 31 <= t0 - 128;
            bf16x8 kf[2][2], vf[4]; const int stl = st;
#pragma unroll
            for (int kt = 0; kt < 2; ++kt)
#pragma unroll
                for (int ks = 0; ks < 2; ++ks) kf[kt][ks] = ld16(KC + (size_t)(stl * 32 + kt * 16 + col) * 64 + ks * 32 + rq * 8);
#pragma unroll
            for (int dt = 0; dt < 4; ++dt) vf[dt] = ld8x2(VCT + (size_t)(dt * 16 + col) * 1024 + stl * 32 + 4 * rq, 16);
            f32x4 ps[2] = {z4, z4};
#pragma unroll
            for (int j = 0; j < 4; ++j) {
                f32x4 p[2];
#pragma unroll
                for (int kt = 0; kt < 2; ++kt) { f32x4 s = mfma16(kf[kt][0], qf[j][0], z4); s = mfma16(kf[kt][1], qf[j][1], s);
                    if (farc) { const float cf = bt[128 * 8 + g * 4 + j] - mc[j];
#pragma unroll
                        for (int e = 0; e < 4; ++e) { const float v = __builtin_amdgcn_exp2f(s[e] + cf) * ilc[j]; ps[kt][e] += v; p[kt][e] = v * gcmp[j]; }
                    } else {
#pragma unroll
                    for (int e = 0; e < 4; ++e) { const int ci = st * 32 + kt * 16 + 4 * rq + e, dist = tq - (16 * ci + 31); const int dc = dist < 0 ? 0 : (dist > 128 ? 128 : dist);
                        const float v = dist >= 0 ? __builtin_amdgcn_exp2f(s[e] + bt[dc * 8 + g * 4 + j] - mc[j]) * ilc[j] : 0.f; ps[kt][e] += v; p[kt][e] = v * gcmp[j]; } } }
                const bf16x8 pb = pack8(p[0], p[1]);
#pragma unroll
                for (int dt = 0; dt < 4; ++dt) ACC[j][dt] = mfma16(vf[dt], pb, ACC[j][dt]);
            }
#pragma unroll
            for (int kt = 0; kt < 2; ++kt) {
                const float Gs = (ps[kt][0] + ps[kt][1]) + (ps[kt][2] + ps[kt][3]), X = ps[kt][3];
                const float xa = __shfl(X, (lane + 48) & 63), xb = __shfl(xprev, (lane + 48) & 63);
                const float xin = rq > 0 ? xa : xb;
                wl[col * 257 + st * 8 + kt * 4 + rq] = Gs + xin; xprev = X;
            }
        }
    }
    float* PART = WSP(float, WS_H) + (size_t)tq * 512 + g * 256;
#pragma unroll
    for (int j = 0; j < 4; ++j)
#pragma unroll
        for (int dt = 0; dt < 4; ++dt) *(f32x4*)(PART + j * 64 + dt * 16 + 4 * rq) = ACC[j][dt];
    LDS_WAIT();
    unsigned long long* SELM = (unsigned long long*)(F.ws + WS_WR);
    for (int i0 = 0; i0 < 16; i0 += 4) {
        const int cur = (t0 + i0) >> 6; unsigned k[4][4], T[4] = {0u, 0u, 0u, 0u};
#pragma unroll
        for (int qq = 0; qq < 4; ++qq)
#pragma unroll
            for (int e = 0; e < 4; ++e) { const int n = lane * 4 + e; const float v = wl[(i0 + qq) * 257 + n];
                k[qq][e] = (n == 0 || (n <= cur && n + 2 > cur)) ? 0x7F000000u : (n <= cur ? __float_as_uint(v) + 1u : 0u); }
#pragma unroll 1
        for (int bit = 30; bit >= 0; --bit) {
#pragma unroll
            for (int qq = 0; qq < 4; ++qq) { const unsigned c = T[qq] | (1u << bit);
                const int cnt = __popcll(__ballot(k[qq][0] >= c)) + __popcll(__ballot(k[qq][1] >= c)) + __popcll(__ballot(k[qq][2] >= c)) + __popcll(__ballot(k[qq][3] >= c));
                if (cnt >= 16) T[qq] = c; } }
#pragma unroll
        for (int qq = 0; qq < 4; ++qq) {
            unsigned long long bsel[4]; int ngt = 0;
#pragma unroll
            for (int e = 0; e < 4; ++e) { bsel[e] = __ballot(k[qq][e] > T[qq] && k[qq][e] != 0u); ngt += __popcll(bsel[e]); }
            if (T[qq] != 0u) {
                int need = 16 - ngt;
                unsigned long long beq[4];
#pragma unroll
                for (int e = 0; e < 4; ++e) beq[e] = __ballot(k[qq][e] == T[qq]);
                while (need > 0) {
                    int bestn = 1 << 30, be = 0;
#pragma unroll
                    for (int e = 0; e < 4; ++e) if (beq[e]) { const int n = 4 * (__ffsll((long long)beq[e]) - 1) + e; if (n < bestn) { bestn = n; be = e; } }
                    if (bestn == (1 << 30)) break;
                    const unsigned long long bitm = 1ull << (bestn >> 2);
                    if (be == 0) { bsel[0] |= bitm; beq[0] &= ~bitm; } else if (be == 1) { bsel[1] |= bitm; beq[1] &= ~bitm; } else if (be == 2) { bsel[2] |= bitm; beq[2] &= ~bitm; } else { bsel[3] |= bitm; beq[3] &= ~bitm; }
                    --need;
                }
            }
            if (lane < 4) SELM[((size_t)(t0 + i0 + qq) * 2 + g) * 4 + lane] = lane == 0 ? bsel[0] : (lane == 1 ? bsel[1] : (lane == 2 ? bsel[2] : bsel[3]));
        }
    }
    LDS_WAIT();
}
DI void p4b_pass(LAS unsigned char* ldsb, unsigned char* ws, float* outp, int tA, int tB, int g) {
    Frame F; F.lds = ldsb; F.ws = ws; F.out = outp; F.ctl = (unsigned*)(ws + WS_CTL); F.tid = threadIdx.x; F.lane = F.tid & 63; F.wave = __builtin_amdgcn_readfirstlane(F.tid >> 6); F.G = gridDim.x; F.gw = 0; F.ngw = 0; F.A = nullptr;
    const int lane = F.lane, w = F.wave, col = lane & 15, rq = lane >> 4, hj = col & 3;
    LAS unsigned char* L = F.lds;
    const LAS float* bt = (const LAS float*)(L + BIAS_OFF); const float bmax = bt[129 * 8];
    const bf16* QA = WSP(const bf16, WS_QA); const bf16* KCV = WSP(const bf16, WS_KCV); const bf16* TOUT = WSP(const bf16, WS_TOUT); const bf16* GA = WSP(const bf16, WS_GA);
    const float kmax_sel = sqrtf(__uint_as_float(F.ctl[CW_KMAX + g]));
    const unsigned long long* SELM = (const unsigned long long*)(F.ws + WS_WR);
    bf16x8 qb[4][2]; float bnd[4]; int tq[4];
    LAS unsigned long long* PKL = (LAS unsigned long long*)(L + 131072) + w * 64;
#pragma unroll
    for (int ct = 0; ct < 4; ++ct) { const int t = (ct < 2 ? tA : tB) * 64 + w * 8 + (ct & 1) * 4 + (col >> 2); tq[ct] = t; float s = 0.f;
#pragma unroll
        for (int ks = 0; ks < 2; ++ks) { const v4u q = *(const v4u*)(QA + (size_t)t * 512 + (g * 4 + hj) * 64 + ks * 32 + rq * 8); qb[ct][ks] = __builtin_bit_cast(bf16x8, q);
            const float a0 = bflo(q.x), a1 = bfhi(q.x), a2 = bflo(q.y), a3 = bfhi(q.y), a4 = bflo(q.z), a5 = bfhi(q.z), a6 = bflo(q.w), a7 = bfhi(q.w);
            s += (a0 * a0 + a1 * a1) + (a2 * a2 + a3 * a3) + (a4 * a4 + a5 * a5) + (a6 * a6 + a7 * a7); }
        bnd[ct] = sqrtf(quad_sum(s)) * kmax_sel + bmax; }
    { const int q = lane >> 2, e = lane & 3; const int t = ((q >> 3) ? tB : tA) * 64 + w * 8 + (q & 7); PKL[lane] = SELM[((size_t)t * 2 + g) * 4 + e]; }
    asm volatile("s_waitcnt vmcnt(0) lgkmcnt(0)" ::: "memory");
    const f32x4 z4 = {0.f, 0.f, 0.f, 0.f};
    f32x4 O[4][4]; float ls[4] = {0.f, 0.f, 0.f, 0.f};
#pragma unroll
    for (int ct = 0; ct < 4; ++ct)
#pragma unroll
        for (int dt = 0; dt < 4; ++dt) O[ct][dt] = z4;
    const float bfar = bt[128 * 8 + g * 4 + hj];
    const int dr = lane >> 3, dc = (lane & 7) ^ dr, nb = tB + 1;
    const bf16* kbase = KCV + (size_t)(w * 8 + dr) * 512 + 256 + g * 64 + dc * 8;
    const bf16* vbase = TOUT + (size_t)(g * 64 + w * 8 + dr) * TP + dc * 8;
#define P4B_ISSUE(blk_, slot) do { \
        __builtin_amdgcn_global_load_lds((const unsigned*)(kbase + (size_t)(blk_) * 64 * 512), (LAS unsigned*)(L + (slot) * 16384 + w * 1024), 16, 0, 0); \
        __builtin_amdgcn_global_load_lds((const unsigned*)(vbase + (size_t)(blk_) * 64), (LAS unsigned*)(L + (slot) * 16384 + 8192 + w * 1024), 16, 0, 0); } while (0)
    asm volatile("s_waitcnt vmcnt(0)" ::: "memory");
    __builtin_amdgcn_s_barrier();
    const int ngrp = (nb + 3) >> 2;
#pragma unroll 1
    for (int b4 = 0; b4 < 4; ++b4) if (b4 < nb) P4B_ISSUE(b4, b4);
#pragma unroll 1
    for (int gi = 0; gi < ngrp; ++gi) {
        asm volatile("s_waitcnt vmcnt(0)" ::: "memory");
        asm volatile("s_waitcnt lgkmcnt(0)" ::: "memory"); __builtin_amdgcn_s_barrier(); asm volatile("" ::: "memory");
#pragma unroll 1
        for (int b4 = 0; b4 < 4; ++b4) { const int nblk = (gi + 1) * 4 + b4; if (nblk < nb) P4B_ISSUE(nblk, ((gi + 1) & 1) * 4 + b4); }
        unsigned pm = 0u, am = 0u;
        { v4u wlo[4], whi[4];
#pragma unroll
          for (int ct = 0; ct < 4; ++ct) { const LAS v4u* pw = (const LAS v4u*)(PKL + (ct * 4 + (col >> 2)) * 4); wlo[ct] = pw[0]; whi[ct] = pw[1]; }
#pragma unroll
          for (int ct = 0; ct < 4; ++ct) {
              const unsigned long long w0 = ((unsigned long long)wlo[ct].y << 32) | wlo[ct].x, w1 = ((unsigned long long)wlo[ct].w << 32) | wlo[ct].z, w2 = ((unsigned long long)whi[ct].y << 32) | whi[ct].x, w3 = ((unsigned long long)whi[ct].w << 32) | whi[ct].z;
              const unsigned b0 = (unsigned)((w0 >> gi) & 1ull), b1 = (unsigned)((w1 >> gi) & 1ull), b2 = (unsigned)((w2 >> gi) & 1ull), b3 = (unsigned)((w3 >> gi) & 1ull);
              pm |= (b0 | (b1 << 1) | (b2 << 2) | (b3 << 3)) << (ct * 4);
              am |= ((__ballot(b0) != 0ull ? 1u : 0u) | (__ballot(b1) != 0ull ? 2u : 0u) | (__ballot(b2) != 0ull ? 4u : 0u) | (__ballot(b3) != 0ull ? 8u : 0u)) << (ct * 4); } }
#pragma unroll 1
      for (int b4 = 0; b4 < 4; ++b4) {
        const int blk = gi * 4 + b4; if (blk >= nb) break;
        const LAS unsigned char* ring = L + ((gi & 1) * 4 + b4) * 16384;
#pragma unroll
        for (int ct = 0; ct < 4; ++ct) {
            if (!((am >> (ct * 4 + b4)) & 1u)) continue;
            const bool pick = (pm >> (ct * 4 + b4)) & 1u;
            const int cur = ct < 2 ? tA : tB;
            const bool farb = blk + 3 <= cur;
            const float binit = pick ? (farb ? bfar - bnd[ct] : -bnd[ct]) : -1e30f; const f32x4 cinit = {binit, binit, binit, binit};
            bf16x8 kf[4][2];
#pragma unroll
            for (int kt = 0; kt < 4; ++kt) { const int key = kt * 16 + col;
                kf[kt][0] = *(const LAS bf16x8*)(ring + key * 128 + ((rq ^ (key & 7)) * 16)); kf[kt][1] = *(const LAS bf16x8*)(ring + key * 128 + (((4 + rq) ^ (key & 7)) * 16)); }
            asm volatile("s_waitcnt lgkmcnt(0)" ::: "memory");
            f32x4 sacc[4];
#pragma unroll
            for (int kt = 0; kt < 4; ++kt) sacc[kt] = mfma16(kf[kt][0], qb[ct][0], cinit);
#pragma unroll
            for (int kt = 0; kt < 4; ++kt) sacc[kt] = mfma16(kf[kt][1], qb[ct][1], sacc[kt]);
            if (farb) {
#pragma unroll
                for (int kt = 0; kt < 4; ++kt)
#pragma unroll
                    for (int e = 0; e < 4; ++e) sacc[kt][e] = __builtin_amdgcn_exp2f(sacc[kt][e]);
            } else {
                const LAS float* nbp = (const LAS float*)(L + NEAR_OFF) + (tq[ct] + 64 - blk * 64 - 4 * rq) * 8 + g * 4 + hj;
#pragma unroll
                for (int kt = 0; kt < 4; ++kt)
#pragma unroll
                    for (int e = 0; e < 4; ++e) sacc[kt][e] = __builtin_amdgcn_exp2f(sacc[kt][e] + nbp[-(kt * 16 + e) * 8]);
            }
            ls[ct] += ((sacc[0][0] + sacc[0][1]) + (sacc[0][2] + sacc[0][3])) + ((sacc[1][0] + sacc[1][1]) + (sacc[1][2] + sacc[1][3])) + ((sacc[2][0] + sacc[2][1]) + (sacc[2][2] + sacc[2][3])) + ((sacc[3][0] + sacc[3][1]) + (sacc[3][2] + sacc[3][3]));
            const bf16x8 pb0 = pack8(sacc[0], sacc[1]), pb1 = pack8(sacc[2], sacc[3]);
#pragma unroll
            for (int dt = 0; dt < 4; ++dt) { const int d = dt * 16 + col; const LAS unsigned char* vr = ring + 8192 + d * 128 + (rq & 1) * 8; const int sw = d & 7, c0 = rq >> 1;
                const v2u a0 = *(const LAS v2u*)(vr + ((c0 ^ sw) * 16)), a1 = *(const LAS v2u*)(vr + (((c0 + 2) ^ sw) * 16)), a2 = *(const LAS v2u*)(vr + (((c0 + 4) ^ sw) * 16)), a3 = *(const LAS v2u*)(vr + (((c0 + 6) ^ sw) * 16));
                v4u v0 = {a0.x, a0.y, a1.x, a1.y}, v1 = {a2.x, a2.y, a3.x, a3.y};
                O[ct][dt] = mfma16(__builtin_bit_cast(bf16x8, v0), pb0, O[ct][dt]); O[ct][dt] = mfma16(__builtin_bit_cast(bf16x8, v1), pb1, O[ct][dt]); }
        }
      }
    }
#pragma unroll
    for (int ct = 0; ct < 4; ++ct) { const int t = tq[ct]; const float sc = bf1(GA[(size_t)t * 32 + 8 + g * 4 + hj]) / quad_sum(ls[ct]);
        const float* part = WSP(const float, WS_H) + (size_t)t * 512 + g * 256 + hj * 64; bf16* ya = WSP(bf16, WS_QA) + (size_t)t * 512 + (g * 4 + hj) * 64;
#pragma unroll
        for (int dt = 0; dt < 4; ++dt) { const f32x4 p = *(const f32x4*)(part + dt * 16 + 4 * rq); const f32x4 o = p + O[ct][dt] * sc; *(v2u*)(ya + dt * 16 + 4 * rq) = pack4(o); } }
    asm volatile("s_waitcnt vmcnt(0) lgkmcnt(0)" ::: "memory");
#undef P4B_ISSUE
}
DI void p4_ret_wg(Frame& F, int u) {
    const int c = u >> 2, h = u & 3, q8 = F.wave, lane = F.lane, col = lane & 15, rq = lane >> 4;
    const int il = q8 * 16 + col, tq = c * 128 + il;
    const float l2g = log2f(1.0f - __builtin_amdgcn_exp2f((float)(-5 - h)));
    const bf16* QR = WSP(const bf16, WS_QR); const bf16* KR = WSP(const bf16, WS_KR); const bf16* TOUT = WSP(const bf16, WS_TOUT); LAS unsigned char* L = F.lds;
    const bf16* RT = WSP(const bf16, WS_UR) + ((size_t)(c * 4 + h) * 256) * 128;
    asm volatile("s_waitcnt vmcnt(0) lgkmcnt(0)" ::: "memory"); __builtin_amdgcn_s_barrier();
    dma_rows256(RT, 128, 256, L, F.wave, lane);
    bf16x8 qf[4];
#pragma unroll
    for (int ks = 0; ks < 4; ++ks) qf[ks] = ld16(QR + (size_t)tq * 512 + h * 128 + ks * 32 + rq * 8);
    asm volatile("s_waitcnt vmcnt(0)" ::: "memory"); __builtin_amdgcn_s_barrier(); asm volatile("" ::: "memory");
    f32x4 ACC[16]; const f32x4 z4 = {0.f, 0.f, 0.f, 0.f};
#pragma unroll
    for (int i = 0; i < 16; ++i) ACC[i] = z4;
#pragma unroll
    for (int ks = 0; ks < 4; ++ks)
#pragma unroll
        for (int dvt = 0; dvt < 16; ++dvt) ACC[dvt] = mfma16(frag256(L, dvt * 16 + col, ks * 4 + rq), qf[ks], ACC[dvt]);
    { const float qd = __builtin_amdgcn_exp2f((float)(il + 1) * l2g);
#pragma unroll
      for (int i = 0; i < 16; ++i) ACC[i] = ACC[i] * qd; }
    asm volatile("s_waitcnt lgkmcnt(0)" ::: "memory"); __builtin_amdgcn_s_barrier(); asm volatile("" ::: "memory");
    dma_rows256(TOUT + (size_t)(768 + h * 256) * TP + c * 128, TP, 256, L, F.wave, lane);
    dma_rows256(KR + (size_t)(c * 128) * 512 + h * 128, 512, 128, L + 65536, F.wave, lane);
    asm volatile("s_waitcnt vmcnt(0)" ::: "memory"); __builtin_amdgcn_s_barrier(); asm volatile("" ::: "memory");
    const int nkp = (q8 * 16 + 16 + 31) >> 5;
    for (int kp = 0; kp < nkp; ++kp) {
        f32x4 p[2];
#pragma unroll
        for (int kt = 0; kt < 2; ++kt) { f32x4 s = z4;
#pragma unroll
            for (int ks = 0; ks < 4; ++ks) s = mfma16(frag256(L + 65536, kp * 32 + kt * 16 + col, ks * 4 + rq), qf[ks], s);
#pragma unroll
            for (int e = 0; e < 4; ++e) { const int dj = il - (kp * 32 + kt * 16 + 4 * rq + e); p[kt][e] = dj >= 0 ? s[e] * __builtin_amdgcn_exp2f((float)dj * l2g) : 0.f; } }
        const bf16x8 pb = pack8(p[0], p[1]);
#pragma unroll
        for (int dvt = 0; dvt < 16; ++dvt) { const v2u lo = frag256h(L, dvt * 16 + col, kp * 4 + (rq >> 1), rq & 1), hi = frag256h(L, dvt * 16 + col, kp * 4 + 2 + (rq >> 1), rq & 1);
            v4u v = {lo.x, lo.y, hi.x, hi.y}; ACC[dvt] = mfma16(__builtin_bit_cast(bf16x8, v), pb, ACC[dvt]); }
    }
    float s1 = 0.f;
#pragma unroll
    for (int i = 0; i < 16; ++i) s1 += (ACC[i][0] + ACC[i][1]) + (ACC[i][2] + ACC[i][3]);
    const float mu = quad_sum(s1) * (1.0f / 256.0f); float s2 = 0.f;
#pragma unroll
    for (int i = 0; i < 16; ++i) { ACC[i] = ACC[i] - mu; s2 += (ACC[i][0] * ACC[i][0] + ACC[i][1] * ACC[i][1]) + (ACC[i][2] * ACC[i][2] + ACC[i][3] * ACC[i][3]); }
    const float rs = 1.0f / sqrtf(quad_sum(s2) * (1.0f / 256.0f) + EPS);
    bf16* GR = WSP(bf16, WS_GR) + (size_t)tq * 1024 + h * 256; const float* rn = F.A->in[10] + h * 256;
#pragma unroll
    for (int dvt = 0; dvt < 16; ++dvt) { const int d0 = dvt * 16 + 4 * rq; const v2u gv = *(const v2u*)(GR + d0); const f32x4 w = *(const f32x4*)(rn + d0);
        f32x4 o; o[0] = siluf_(bflo(gv.x)) * ACC[dvt][0] * rs * w[0]; o[1] = siluf_(bfhi(gv.x)) * ACC[dvt][1] * rs * w[1]; o[2] = siluf_(bflo(gv.y)) * ACC[dvt][2] * rs * w[2]; o[3] = siluf_(bfhi(gv.y)) * ACC[dvt][3] * rs * w[3];
        *(v2u*)(GR + d0) = pack4(o); }
}

DI int moe_row(int f) { const int fp = f & 127; return (f >> 7) * 256 + 128 * (fp >> 6) + 32 * ((fp >> 4) & 3) + 4 * ((fp >> 2) & 3) + (fp & 3); }
DI void p8_route_item(Frame& F, int item) {
    const int lane = F.lane, row = lane & 15, kq = lane >> 4, m0 = item * 16, slot = F.wave & 3, hh = F.wave >> 2; const float* x1 = F.out; bf16* H2 = WSP(bf16, WS_H);
    LAS float* lg = (LAS float*)(F.lds + slot * WAVE_LDS);
    LAS float* ex = (LAS float*)(F.lds + slot * WAVE_LDS + 3200);
    const float* WRT = WSP(const float, WS_SM + SM_WRT);
    const float* xr = x1 + (size_t)(m0 + row) * 1024 + 4 * kq + hh * 512; const float* wr = WRT + (size_t)row * 1024 + 4 * kq + hh * 512;
    f32x4 acc[3]; float ss = 0.f;
#pragma unroll
    for (int ct = 0; ct < 3; ++ct) acc[ct] = (f32x4){0.f, 0.f, 0.f, 0.f};
#pragma unroll 8
    for (int c = 0; c < 32; ++c) {
        const f32x4 xa = *(const f32x4*)(xr + 16 * c); ss += (xa[0] * xa[0] + xa[1] * xa[1]) + (xa[2] * xa[2] + xa[3] * xa[3]);
#pragma unroll
        for (int ct = 0; ct < 3; ++ct) { const f32x4 wb = *(const f32x4*)(wr + (size_t)ct * 16 * 1024 + 16 * c);
#pragma unroll
            for (int j = 0; j < 4; ++j) acc[ct] = __builtin_amdgcn_mfma_f32_16x16x4f32(xa[j], wb[j], acc[ct], 0, 0, 0); }
    }
    if (hh == 1) {
#pragma unroll
        for (int ct = 0; ct < 3; ++ct)
#pragma unroll
            for (int j = 0; j < 4; ++j) ex[(ct * 4 + j) * 64 + lane] = acc[ct][j];
        ex[12 * 64 + lane] = ss;
    }
    LDS_WAIT(); __syncthreads();
    LAS unsigned* lcnt = (LAS unsigned*)(F.lds + 4 * WAVE_LDS);
    if (F.tid < 64) lcnt[F.tid] = 0u;
    int ex1 = 0, ex2 = 0; unsigned lr1 = 0u, lr2 = 0u; float w1 = 0.f, w2 = 0.f;
    if (hh == 0) {
#pragma unroll
        for (int ct = 0; ct < 3; ++ct)
#pragma unroll
            for (int j = 0; j < 4; ++j) acc[ct][j] += ex[(ct * 4 + j) * 64 + lane];
        ss += ex[12 * 64 + lane];
        const float rs = 1.0f / sqrtf(quad_sum(ss) * (1.0f / 1024.0f) + EPS);
        if (kq == 0) lg[16 * 48 + row] = rs;
#pragma unroll
        for (int ct = 0; ct < 3; ++ct)
#pragma unroll
            for (int j = 0; j < 4; ++j) lg[(4 * kq + j) * 48 + ct * 16 + row] = acc[ct][j];
    }
    LDS_WAIT(); __syncthreads();
    if (hh == 0 && lane < 16) {
        const float rst = lg[16 * 48 + lane]; float l[36];
#pragma unroll
        for (int o = 0; o < 36; ++o) l[o] = lg[lane * 48 + o] * rst + (o < 4 ? F.A->in[16][o] : F.A->in[18][o - 4]);
        int grp = 0; float mg = l[0];
#pragma unroll
        for (int i = 1; i < 4; ++i) if (l[i] > mg) { mg = l[i]; grp = i; }
        float Z = 0.f;
#pragma unroll
        for (int i = 0; i < 4; ++i) Z += expf(l[i] - mg);
        const float pg = 1.0f / Z;
        float le[8];
#pragma unroll
        for (int i = 0; i < 8; ++i) le[i] = grp == 0 ? l[4 + i] : (grp == 1 ? l[12 + i] : (grp == 2 ? l[20 + i] : l[28 + i]));
        int i1 = 0; float v1 = le[0];
#pragma unroll
        for (int i = 1; i < 8; ++i) if (le[i] > v1) { v1 = le[i]; i1 = i; }
        int i2 = -1; float v2 = -3.0e38f;
#pragma unroll
        for (int i = 0; i < 8; ++i) if (i != i1 && le[i] > v2) { v2 = le[i]; i2 = i; }
        const float e2 = expf(v2 - v1); w1 = pg / (1.0f + e2); w2 = pg * e2 / (1.0f + e2);
        ex1 = grp * 8 + i1; ex2 = grp * 8 + i2;
        lr1 = __hip_atomic_fetch_add(lcnt + ex1, 1u, __ATOMIC_RELAXED, __HIP_MEMORY_SCOPE_WORKGROUP); lr2 = __hip_atomic_fetch_add(lcnt + ex2, 1u, __ATOMIC_RELAXED, __HIP_MEMORY_SCOPE_WORKGROUP);
    }
    LDS_WAIT(); __syncthreads();
    if (F.tid < 32) { const unsigned n = lcnt[F.tid]; lcnt[32 + F.tid] = n ? atomicAdd(F.ctl + CW_CNT + F.tid, n) : 0u; }
    LDS_WAIT(); __syncthreads();
    if (hh == 0 && lane < 16) {
        const int t = m0 + lane; v2u* LIST = WSP(v2u, WS_XS);
        LIST[(size_t)ex1 * 16384 + lcnt[32 + ex1] + lr1] = (v2u){(unsigned)(t * 2 + 0), __float_as_uint(w1)};
        LIST[(size_t)ex2 * 16384 + lcnt[32 + ex2] + lr2] = (v2u){(unsigned)(t * 2 + 1), __float_as_uint(w2)};
    }
    { f32x4 w[4]; load_row(F.A->in[14], lane, w);
#pragma unroll 4
      for (int r8 = 0; r8 < 8; ++r8) { const int r = hh * 8 + r8; f32x4 v[4]; load_row(x1 + (size_t)(m0 + r) * 1024, lane, v); const float rst = lg[16 * 48 + r];
#pragma unroll
        for (int j = 0; j < 4; ++j) *(v2u*)(H2 + (size_t)(m0 + r) * 1024 + 4 * lane + 256 * j) = pack4(v[j] * rst * w[j]); } }
    LDS_WAIT(); __syncthreads();
}
DI void p8_moe_weights(Frame& F) {
    LAS float* scr = (LAS float*)(F.lds + F.wave * WAVE_LDS + 4096);
    bf16* WGU = WSP(bf16, WS_MOEW); bf16* WD = WGU + (size_t)32 * 512 * 1024;
    for (int it = F.gw; it < 3 * 4096; it += F.ngw) {
        const int which = it >> 12, r = it & 4095;
        if (which < 2) { const int e = r >> 7, q = r & 127, kb = q >> 3, nb = q & 7; bf16* dstb = WGU + (size_t)e * 512 * 1024 + (which ? 16 * 1024 : 0);
            tr_item((which ? F.A->in[20] : F.A->in[19]) + (size_t)e * 1024 * 256, 256, 256, 64 * kb, 32 * nb, scr, F.lane, [dstb](int n, int w2) { return w2 ? (bf16*)nullptr : dstb + (size_t)moe_row(n) * 1024; }); }
        else { const int e = r >> 7, q = r & 127, kb = q >> 5, nb = q & 31; bf16* dstb = WD + (size_t)e * 1024 * 256;
            tr_item(F.A->in[21] + (size_t)e * 256 * 1024, 1024, 1024, 64 * kb, 32 * nb, scr, F.lane, [dstb](int n, int w2) { return w2 ? (bf16*)nullptr : dstb + (size_t)n * 256; }); }
    }
}
DI void moe_tile_prefix(Frame& F) {
    LAS int* tp = (LAS int*)(F.lds + MOET_OFF);
    if (F.tid == 0) { int a = 0; for (int e = 0; e < 32; ++e) { const unsigned c = __hip_atomic_load(F.ctl + CW_CNT + e, __ATOMIC_RELAXED, __HIP_MEMORY_SCOPE_AGENT); tp[e] = a; tp[34 + e] = (int)c; a += (int)((c + 255u) >> 8); } tp[32] = a; }
    __syncthreads();
}
DI void p12_final(Frame& F) {
    f32x4 w[4]; load_row(F.A->in[22], F.lane, w); const bf16* Y = WSP(const bf16, WS_Y);
#pragma unroll 2
    for (int m = F.gw; m < S; m += F.ngw) {
        f32x4 v[4]; load_row(F.out + (size_t)m * 1024, F.lane, v);
#pragma unroll
        for (int j = 0; j < 4; ++j) { const v2u a = *(const v2u*)(Y + (size_t)m * 1024 + 4 * F.lane + 256 * j), b = *(const v2u*)(Y + ((size_t)S + m) * 1024 + 4 * F.lane + 256 * j);
            v[j][0] += bflo(a.x) + bflo(b.x); v[j][1] += bfhi(a.x) + bfhi(b.x); v[j][2] += bflo(a.y) + bflo(b.y); v[j][3] += bfhi(a.y) + bfhi(b.y); }
        const float rs = row_rstd(v);
#pragma unroll
        for (int j = 0; j < 4; ++j) *(f32x4*)(F.out + (size_t)m * 1024 + 4 * F.lane + 256 * j) = v[j] * rs * w[j];
    }
}

#ifndef MK_PER_PHASE
#define MK_PER_PHASE 0
#endif
constexpr int NPH = 13;
__global__ void __launch_bounds__(NTHR, 2) mk_fwd(Args args) {
    extern __shared__ __attribute__((aligned(16))) unsigned char lds[];
    Frame F;
    F.lds = (LAS unsigned char*)lds;
    F.tid = threadIdx.x; F.lane = F.tid & 63; F.wave = __builtin_amdgcn_readfirstlane(F.tid >> 6);
    F.G = gridDim.x; F.gw = blockIdx.x * NWAVES + F.wave; F.ngw = F.G * NWAVES;
    F.ws = args.ws; F.ctl = (unsigned*)(args.ws + WS_CTL); F.out = args.out;
    F.A = &args;
    for (int u = F.tid; u < (LDS_BYTES - MISC_OFF) / 4; u += NTHR) ((LAS unsigned*)(F.lds + MISC_OFF))[u] = 0u;
    __syncthreads();
    XcdBarrier bar; bar.bar = F.ctl + CW_BAR + args.li * XCD_BAR_WORDS; bar.x = 0; bar.st = nullptr;
    if (!MK_PER_PHASE) bar = xcd_barrier_post(F.ctl + CW_BAR + args.li * XCD_BAR_WORDS, (volatile LAS unsigned*)(F.lds + MISC_OFF) + 8);
    const int lo = args.ph_lo, hi = args.ph_hi;
    const int sub = args.pad ? args.pad : 0xFFFF;
#define IN(k) (lo <= (k) && (k) < hi)
#define SEAM(k) do { if (IN(k) && IN((k) + 1)) xcd_barrier(bar); } while (0)
    LAS unsigned char* ring = F.lds;

    if (IN(0)) { p0_prologue(F); }
    SEAM(0);
    if (IN(1)) {
        pg8::Gemm g{WSP(const bf16, WS_H), WSP(const bf16, WS_WR), 0, 0, 1024}; ProjOrder O{F.G, (int)blockIdx.x};
        EpiProj E{WSP(bf16, WS_QA), WSP(bf16, WS_KCV), WSP(bf16, WS_QR), WSP(bf16, WS_KR), WSP(bf16, WS_GR), WSP(bf16, WS_GA), WSP(bf16, WS_TOUT), (bf16*)F.out};
        pg8::gemm_phase<EpiProj, ProjOrder, true, true>(ring, g, O, E);
    }
    SEAM(1);
    if (IN(2)) {
        if (sub & 32) for (int u = blockIdx.x; u < 512; u += F.G) p2_ret_state_wg(F, u);
        if (sub & 8) { if (F.wave < 4) for (int u = blockIdx.x * 4 + F.wave; u < 1024; u += F.G * 4) p2_cmp_hidden(F, u); }
        if (sub & 16) { if (F.wave == 4) for (int u = blockIdx.x; u < 256; u += F.G) p2_kmax(F, u); }
        asm volatile("s_waitcnt vmcnt(0) lgkmcnt(0)" ::: "memory"); __syncthreads();
    }
    SEAM(2);
    if (IN(3)) {
        if (sub & 64) p3_scan(F);
        if (sub & 128) for (int u = F.gw; u < 256; u += F.ngw) p3_kcvc(F, u);
    }
    SEAM(3);
    if (IN(4)) {
        p4_bias_table(F);
        for (int pp = blockIdx.x; pp < 256; pp += F.G) {
            const int g = pp & 1, c = pp >> 1;
            if (sub & 1) p4a_unit(F, (F.wave < 4 ? c : 255 - c) * 4 + (F.wave & 3), g);
            VM_WAIT(); __syncthreads();
            if (sub & 2) p4b_pass(F.lds, F.ws, F.out, c, 255 - c, g);
        }
        if (sub & 4) for (int u = blockIdx.x; u < 512; u += F.G) p4_ret_wg(F, u);
        asm volatile("s_waitcnt vmcnt(0) lgkmcnt(0)" ::: "memory");
        __syncthreads();
    }
    SEAM(4);
    if (IN(6)) {
        { pg8::Gemm g{WSP(const bf16, WS_QA), WSP(const bf16, WS_WUA), S, 1024, 512}; pg8::StaticOrder O; O.init(S, 1024, F.G, (int)blockIdx.x);
          EpiUp<false> E{(const bf16*)F.out, WSP(bf16, WS_MG), 0};
          pg8::gemm_phase<EpiUp<false>, pg8::StaticOrder, true, true>(ring, g, O, E); }
        if (F.G != 256 && !MK_PER_PHASE) xcd_barrier(bar); else { VM_WAIT(); __syncthreads(); }
        { pg8::Gemm g{WSP(const bf16, WS_GR), WSP(const bf16, WS_WUB), S, 1024, 1024}; pg8::StaticOrder O; O.init(S, 1024, F.G, (int)blockIdx.x);
          EpiUp<true> E{(const bf16*)F.out, WSP(bf16, WS_MG), 1024};
          pg8::gemm_phase<EpiUp<true>, pg8::StaticOrder, true, true>(ring, g, O, E); }
    }
    SEAM(6);
    if (IN(7)) {
        pg8::Gemm g{WSP(const bf16, WS_MG), WSP(const bf16, WS_WO), S, 1024, 1024}; pg8::StaticOrder O; O.init(S, 1024, F.G, (int)blockIdx.x);
        EpiOut E{F.A->in[0], F.out};
        pg8::gemm_phase<EpiOut, pg8::StaticOrder, true, true>(ring, g, O, E);
    }
    SEAM(7);
    if (IN(8)) {
        if (sub & 256) for (int it = blockIdx.x * 4; it < S / 16; it += F.G * 4) p8_route_item(F, it + (F.wave & 3));
        if (sub & 512) p8_moe_weights(F);
    }
    SEAM(8);
    if (IN(10)) {
        moe_tile_prefix(F);
        MoeOrder<2> O{F.G, (int)blockIdx.x, (const LAS int*)(F.lds + MOET_OFF)};
        { LAS unsigned* gtab = (LAS unsigned*)(F.lds + GTAB_OFF); const LAS int* tp = (const LAS int*)(F.lds + MOET_OFF); const v2u* LIST = WSP(const v2u, WS_XS);
          for (int ui = 0; ui < 8; ++ui) { pg8::Unit u; if (!O.next(ui, u)) break;
              if (F.tid < 256) { const int ex = u.pn >> 1, rank = (u.pm - tp[ex]) * 256 + F.tid; gtab[ui * 256 + F.tid] = rank < tp[34 + ex] ? (LIST[(size_t)ex * 16384 + rank].x >> 1) : 0u; } }
          asm volatile("s_waitcnt vmcnt(0) lgkmcnt(0)" ::: "memory"); __syncthreads(); }
        pg8::Gemm g{WSP(const bf16, WS_H), WSP(const bf16, WS_MOEW), 0, 0, 1024};
        EpiMoe1 E{WSP(bf16, WS_HID)};
        pg8::gemm_phase<EpiMoe1, MoeOrder<2>, true, true, true>(ring, g, O, E, (const LAS unsigned*)(F.lds + GTAB_OFF));
    }
    SEAM(10);
    if (IN(11)) {
        moe_tile_prefix(F);
        pg8::Gemm g{WSP(const bf16, WS_HID), WSP(const bf16, WS_MOEW) + (size_t)32 * 512 * 1024, 0, 0, 256}; MoeOrder<4> O{F.G, (int)blockIdx.x, (const LAS int*)(F.lds + MOET_OFF)};
        EpiMoe2 E{WSP(const v2u, WS_XS), WSP(bf16, WS_Y), (const LAS int*)(F.lds + MOET_OFF), (const LAS int*)(F.lds + MOET_OFF) + 34};
        pg8::gemm_phase<EpiMoe2, MoeOrder<4>, true, true>(ring, g, O, E);
    }
    SEAM(11);
    if (IN(12)) p12_final(F);
#undef IN
#undef SEAM
}

extern "C" void kernel_launch(void* const* d_in, const int* in_sizes, int n_in, void* d_out, int out_size, void* d_ws, size_t ws_size, hipStream_t stream) {
    static int grid = 0;
    if (grid == 0) {
        if (n_in != 23 || out_size != S * D || ws_size < WS_END) { fprintf(stderr, "kernel_launch: unexpected problem (n_in %d, out %d, ws %zu)\n", n_in, out_size, ws_size); grid = -1; return; }
        int dev = 0, cus = 0;
        if (hipGetDevice(&dev) != hipSuccess || hipDeviceGetAttribute(&cus, hipDeviceAttributeMultiprocessorCount, dev) != hipSuccess) { grid = -1; return; }
        if (hipFuncSetAttribute((const void*)mk_fwd, hipFuncAttributeMaxDynamicSharedMemorySize, LDS_BYTES) != hipSuccess) { fprintf(stderr, "kernel_launch: hipFuncSetAttribute failed\n"); grid = -1; return; }
        int per_cu = 0;
        if (hipOccupancyMaxActiveBlocksPerMultiprocessor(&per_cu, (const void*)mk_fwd, NTHR, LDS_BYTES) != hipSuccess || per_cu < 1) { fprintf(stderr, "kernel_launch: occupancy query says %d\n", per_cu); }
        (void)hipGetLastError();
        grid = cus > 0 ? cus : 256;
    }
    if (grid < 0) return;
    if (hipMemsetAsync((char*)d_ws + WS_CTL, 0, CTL_ZERO_BYTES, stream) != hipSuccess) return;
    Args a{};
    for (int i = 0; i < 23; ++i) a.in[i] = (const float*)d_in[i];
    a.out = (float*)d_out; a.ws = (unsigned char*)d_ws;
#if MK_PER_PHASE
    for (int p = 0; p < NPH; ++p) { a.ph_lo = p; a.ph_hi = p + 1; hipLaunchKernelGGL(mk_fwd, dim3(grid), dim3(NTHR), LDS_BYTES, stream, a); }
#elif defined(MK_PREFIX_HI)
    a.ph_lo = 0; a.ph_hi = MK_PREFIX_HI; a.li = 0; a.pad = MK_PREFIX_SUB; hipLaunchKernelGGL(mk_fwd, dim3(grid), dim3(NTHR), LDS_BYTES, stream, a);
    (void)hipMemsetAsync((char*)d_ws + WS_CTL, 0, CTL_ZERO_BYTES, stream);
    a.ph_lo = 0; a.ph_hi = NPH; a.li = 1; a.pad = 0; hipLaunchKernelGGL(mk_fwd, dim3(grid), dim3(NTHR), LDS_BYTES, stream, a);
#elif defined(MK_DUP_LO)
    a.ph_lo = 0; a.ph_hi = MK_DUP_HI + 1; a.li = 0; hipLaunchKernelGGL(mk_fwd, dim3(grid), dim3(NTHR), LDS_BYTES, stream, a);
    a.ph_lo = MK_DUP_LO; a.ph_hi = NPH; a.li = 1; hipLaunchKernelGGL(mk_fwd, dim3(grid), dim3(NTHR), LDS_BYTES, stream, a);
#else
    a.ph_lo = 0; a.ph_hi = NPH;
    hipLaunchKernelGGL(mk_fwd, dim3(grid), dim3(NTHR), LDS_BYTES, stream, a);
#endif
}
```

```cpp
#include <hip/hip_runtime.h>
#include <cstdio>
#include <cstdint>
namespace pg8 {
#define PG8_LAS __attribute__((address_space(3)))
typedef unsigned short bf16_t;
typedef short bf16x8 __attribute__((ext_vector_type(8)));
typedef float f32x4 __attribute__((ext_vector_type(4)));
typedef unsigned u32x4 __attribute__((ext_vector_type(4)));
constexpr int BM = 256, BK = 64, HALF = 128, HTB = HALF * BK * 2  , STAGE_BYTES = 8 * HTB, NXCD = 8, WGM = 8;

__host__ __device__ __forceinline__ int lds_byte(int r, int c) { const int st = (r >> 4) * 2 + (c >> 5), rr = r & 15, cc = c & 31, ob = rr * 64 + cc * 2; return st * 1024 + (ob ^ (((ob >> 9) & 1) << 5)); }
__host__ __device__ __forceinline__ void stage_rc(int b, int& R, int& C) { const int st = b / 1024, sb = b % 1024, swz = sb ^ (((sb >> 9) & 1) << 5); R = (st >> 1) * 16 + swz / 64; C = (st & 1) * 32 + (swz % 64) / 2; }
__host__ __device__ __forceinline__ int perm32(int rho) { const int n = rho >> 4, i = rho & 15; return 8 * (i >> 2) + 4 * n + (i & 3); }

struct Unit { int pm, pn; };
struct Gemm { const bf16_t* A; const bf16_t* Bt; int M, N, K; };

struct StaticOrder {
    int nM, nN, nwg, G, c;
    __host__ __device__ void init(int M, int N, int G_, int c_) { nM = M / BM; nN = N / BM; nwg = nM * nN; G = G_; c = c_; }
    __host__ __device__ bool next(int i, Unit& u) const {
        const long L = (long)i * G + c; if (L >= nwg) return false;
        int wgid = (int)L; { const int q = nwg / NXCD, r = nwg % NXCD, xcd = wgid % NXCD, off = wgid / NXCD; wgid = (xcd < r ? xcd * (q + 1) : r * (q + 1) + (xcd - r) * q) + off; }
        const int nig = WGM * nN, gid = wgid / nig, fm = gid * WGM, gsz = (nM - fm) < WGM ? (nM - fm) : WGM;
        u.pm = fm + ((wgid % nig) % gsz); u.pn = (wgid % nig) / gsz; return true;
    }
    __device__ __forceinline__ void a_ready(const Unit&) const {}
    __device__ __forceinline__ void done(const Unit&) const {}
};

__device__ __forceinline__ unsigned cvt_pk_bf16(float lo, float hi) { unsigned r; asm volatile("v_cvt_pk_bf16_f32 %0, %1, %2" : "=v"(r) : "v"(lo), "v"(hi)); return r; }

template <class Epi, class Sched, bool ALIGN_EPI = false, bool SP2 = false, bool GATHER = false>
__device__ __forceinline__ void gemm_phase(PG8_LAS unsigned char* lds, const Gemm g, const Sched& S, const Epi& E, const PG8_LAS unsigned* gtab = nullptr) {
    static_assert(!GATHER || SP2, "GATHER needs SP2");
    const int tid = threadIdx.x, wid = __builtin_amdgcn_readfirstlane(tid >> 6), lane = tid & 63, wr = wid >> 2, wc = wid & 3, fr = lane & 15, fq = lane >> 4;
    const int K = g.K, nt = K / BK;
    unsigned voffA[2], voffB[2];
#pragma unroll
    for (int i = 0; i < 2; ++i) { int R, C; stage_rc(tid * 16 + i * 8192, R, C); const int Rb = Epi::PERM ? ((R & ~31) + perm32(R & 31)) : R;
        voffA[i] = (unsigned)(R * K + C) * 2u; voffB[i] = (unsigned)(Rb * K + C) * 2u; }
    int gR[2], gC[2];
#pragma unroll
    for (int i = 0; i < 2; ++i) stage_rc(tid * 16 + i * 8192, gR[i], gC[i]);
    unsigned gc[2][2], gn[2][2];
#define PG8_GOFF(dst, uidx) do { _Pragma("unroll") for (int _h = 0; _h < 2; ++_h) _Pragma("unroll") for (int _i = 0; _i < 2; ++_i) dst[_h][_i] = (gtab[(uidx) * 256 + _h * 128 + gR[_i]] * (unsigned)K + (unsigned)gC[_i]) * 2u; } while (0)
    const size_t kstep = (size_t)(BK * 2);
    const size_t hstep = (size_t)HALF * K * 2;
    const size_t tstep = 2 * hstep;
    const unsigned ldsw = (unsigned)wid * 1024u;
    const int aoff = lds_byte(wr * 64 + fr, fq * 8), boff = lds_byte(wc * 32 + fr, fq * 8);
#define PG8_SA(b, h) (((b) * 2 + (h)) * HTB)
#define PG8_SB(b, h) ((4 + (b) * 2 + (h)) * HTB)
#define PG8_STAGE(bufoff, gbase, voff) do { _Pragma("unroll") for (int _i = 0; _i < 2; ++_i) \
        __builtin_amdgcn_global_load_lds((const unsigned*)((const char*)(gbase) + (voff)[_i]), (PG8_LAS unsigned*)(lds + (bufoff) + ldsw + _i * 8192), 16, 0, 0); } while (0)
#define PG8_STAGE_A(bufoff, base, half, nxt_) do { if constexpr (GATHER) { _Pragma("unroll") for (int _i = 0; _i < 2; ++_i) \
        __builtin_amdgcn_global_load_lds((const unsigned*)((const char*)(base) + ((nxt_) ? gn[half][_i] : gc[half][_i])), (PG8_LAS unsigned*)(lds + (bufoff) + ldsw + _i * 8192), 16, 0, 0); } \
        else PG8_STAGE(bufoff, (base) + (half) * hstep, voffA); } while (0)
#define PG8_LDA(dst, b, h) do { _Pragma("unroll") for (int m = 0; m < 4; ++m) _Pragma("unroll") for (int k = 0; k < 2; ++k) dst[m][k] = *(const PG8_LAS bf16x8*)(lds + PG8_SA(b, h) + aoff + m * 2048 + k * 1024); } while (0)
#define PG8_LDB(dst, b, h) do { _Pragma("unroll") for (int n = 0; n < 2; ++n) _Pragma("unroll") for (int k = 0; k < 2; ++k) dst[n][k] = *(const PG8_LAS bf16x8*)(lds + PG8_SB(b, h) + boff + n * 2048 + k * 1024); } while (0)
#define PG8_MMA(ai, bj, At, Bt) do { __builtin_amdgcn_s_setprio(1); _Pragma("unroll") for (int m = 0; m < 4; ++m) _Pragma("unroll") for (int n = 0; n < 2; ++n) _Pragma("unroll") for (int k = 0; k < 2; ++k) \
        acc[ai][bj][m][n] = __builtin_amdgcn_mfma_f32_16x16x32_bf16(Bt[n][k], At[m][k], acc[ai][bj][m][n], 0, 0, 0); __builtin_amdgcn_s_setprio(0); } while (0)
#define PG8_WAIT_V(n) asm volatile("s_waitcnt vmcnt(" #n ")" ::: "memory")
#define PG8_WAIT_L(n) asm volatile("s_waitcnt lgkmcnt(" #n ")" ::: "memory")
#define PG8_BAR __builtin_amdgcn_s_barrier()
#define PG8_SCHED __builtin_amdgcn_sched_barrier(0)
    Unit cur, nxt; int ui = 0;
    if (!S.next(0, cur)) return;
    f32x4 acc[2][2][4][2];
#pragma unroll
    for (int a = 0; a < 2; ++a)
#pragma unroll
        for (int b = 0; b < 2; ++b)
#pragma unroll
            for (int m = 0; m < 4; ++m)
#pragma unroll
                for (int n = 0; n < 2; ++n) acc[a][b][m][n] = (f32x4){0.f, 0.f, 0.f, 0.f};
    bf16x8 At[4][2], B0[2][2], B1[2][2];
    const char* cA = GATHER ? (const char*)g.A : (const char*)g.A + (size_t)cur.pm * tstep; const char* cB = (const char*)g.Bt + (size_t)cur.pn * tstep;
    if constexpr (GATHER) { PG8_GOFF(gc, 0); }
    S.a_ready(cur);
    if constexpr (SP2) {
        PG8_STAGE(PG8_SB(0, 0), cB, voffB); PG8_STAGE(PG8_SB(0, 1), cB + hstep, voffB); PG8_STAGE_A(PG8_SA(0, 0), cA, 0, false); PG8_STAGE_A(PG8_SA(0, 1), cA, 1, false);
        if (wr == 1) PG8_BAR;
        PG8_WAIT_V(2); PG8_BAR;
        PG8_STAGE(PG8_SB(1, 0), cB + kstep, voffB); PG8_STAGE_A(PG8_SA(1, 0), cA + kstep, 0, false); PG8_STAGE(PG8_SB(1, 1), cB + hstep + kstep, voffB);
        PG8_WAIT_V(6); PG8_BAR;
    } else {
        PG8_STAGE(PG8_SB(0, 0), cB, voffB); PG8_STAGE(PG8_SA(0, 0), cA, voffA); PG8_STAGE(PG8_SB(0, 1), cB + hstep, voffB); PG8_STAGE(PG8_SA(0, 1), cA + hstep, voffA);
        if (wr == 1) PG8_BAR;
        PG8_WAIT_V(4); PG8_BAR;
        PG8_STAGE(PG8_SB(1, 0), cB + kstep, voffB); PG8_STAGE(PG8_SA(1, 0), cA + kstep, voffA); PG8_STAGE(PG8_SB(1, 1), cB + hstep + kstep, voffB);
        PG8_WAIT_V(6); PG8_BAR;
    }
    for (;;) {
        const bool has_next = S.next(ui + 1, nxt);
        const char* nA = GATHER ? cA : (has_next ? (const char*)g.A + (size_t)nxt.pm * tstep : cA);
        if constexpr (GATHER) { if (has_next) { PG8_GOFF(gn, ui + 1); } else { _Pragma("unroll") for (int _h = 0; _h < 2; ++_h) _Pragma("unroll") for (int _i = 0; _i < 2; ++_i) gn[_h][_i] = gc[_h][_i]; } } const char* nB = has_next ? (const char*)g.Bt + (size_t)nxt.pn * tstep : cB;
#pragma nounroll
        for (int t = 0; t < nt; t += 2) {
            const bool last = (t == nt - 2);
            const char* a1 = cA + (size_t)(t + 1) * kstep;
            const char* a2 = last ? nA : cA + (size_t)(t + 2) * kstep; const char* b2 = last ? nB : cB + (size_t)(t + 2) * kstep;
            const char* a3 = a2 + kstep; const char* b3 = b2 + kstep;
            if (last && has_next) S.a_ready(nxt);
            if constexpr (SP2) {
            PG8_LDB(B0, 0, 0); PG8_LDB(B1, 0, 1); PG8_SCHED; PG8_LDA(At, 0, 0); PG8_STAGE_A(PG8_SA(1, 1), a1, 1, false);
            PG8_WAIT_V(8); PG8_WAIT_L(0); PG8_BAR; PG8_MMA(0, 0, At, B0); PG8_MMA(0, 1, At, B1); PG8_BAR; PG8_SCHED;
            PG8_LDA(At, 0, 1); PG8_STAGE(PG8_SB(0, 0), b2, voffB); PG8_STAGE(PG8_SB(0, 1), b2 + hstep, voffB); PG8_STAGE_A(PG8_SA(0, 0), a2, 0, last);
            PG8_WAIT_V(8); PG8_WAIT_L(0); PG8_BAR; PG8_MMA(1, 0, At, B0); PG8_MMA(1, 1, At, B1); PG8_BAR; PG8_SCHED;
            PG8_LDB(B0, 1, 0); PG8_LDB(B1, 1, 1); PG8_SCHED; PG8_LDA(At, 1, 0); PG8_STAGE_A(PG8_SA(0, 1), a2, 1, last);
            PG8_WAIT_V(8); PG8_WAIT_L(0); PG8_BAR; PG8_MMA(0, 0, At, B0); PG8_MMA(0, 1, At, B1); PG8_BAR; PG8_SCHED;
            PG8_LDA(At, 1, 1); PG8_STAGE(PG8_SB(1, 0), b3, voffB); PG8_STAGE(PG8_SB(1, 1), b3 + hstep, voffB); PG8_STAGE_A(PG8_SA(1, 0), a3, 0, last);
            PG8_WAIT_V(8); PG8_WAIT_L(0); PG8_BAR; PG8_MMA(1, 0, At, B0); PG8_MMA(1, 1, At, B1); PG8_BAR; PG8_SCHED;
            } else {
            PG8_LDB(B0, 0, 0); PG8_SCHED; PG8_LDA(At, 0, 0); PG8_STAGE(PG8_SA(1, 1), a1 + hstep, voffA);
            PG8_WAIT_L(8); PG8_BAR; PG8_WAIT_L(0); PG8_MMA(0, 0, At, B0); PG8_BAR; PG8_SCHED;
            PG8_LDB(B1, 0, 1); PG8_STAGE(PG8_SB(0, 0), b2, voffB);
            PG8_BAR; PG8_WAIT_L(0); PG8_MMA(0, 1, At, B1); PG8_BAR;
            PG8_LDA(At, 0, 1); PG8_STAGE(PG8_SA(0, 0), a2, voffA);
            PG8_BAR; PG8_WAIT_L(0); PG8_MMA(1, 0, At, B0); PG8_BAR; PG8_SCHED;
            PG8_STAGE(PG8_SB(0, 1), b2 + hstep, voffB);
            PG8_WAIT_V(6); PG8_BAR; PG8_MMA(1, 1, At, B1); PG8_BAR;
            PG8_LDB(B0, 1, 0); PG8_SCHED; PG8_LDA(At, 1, 0); PG8_STAGE(PG8_SA(0, 1), a2 + hstep, voffA);
            PG8_WAIT_L(8); PG8_BAR; PG8_WAIT_L(0); PG8_MMA(0, 0, At, B0); PG8_BAR; PG8_SCHED;
            PG8_LDB(B1, 1, 1); PG8_STAGE(PG8_SB(1, 0), b3, voffB);
            PG8_BAR; PG8_WAIT_L(0); PG8_MMA(0, 1, At, B1); PG8_BAR;
            PG8_LDA(At, 1, 1); PG8_STAGE(PG8_SA(1, 0), a3, voffA);
            PG8_BAR; PG8_WAIT_L(0); PG8_MMA(1, 0, At, B0); PG8_BAR; PG8_SCHED;
            PG8_STAGE(PG8_SB(1, 1), b3 + hstep, voffB);
            PG8_WAIT_V(6); PG8_BAR; PG8_MMA(1, 1, At, B1); PG8_BAR;
            }
        }
        if constexpr (ALIGN_EPI) { if (wr == 0) PG8_BAR; }
        if constexpr (!Epi::AFTER_DRAIN) { E(acc, cur, wr, wc, fr, fq); S.done(cur); }
        if (!has_next) break;
#pragma unroll
        for (int a = 0; a < 2; ++a)
#pragma unroll
            for (int b = 0; b < 2; ++b)
#pragma unroll
                for (int m = 0; m < 4; ++m)
#pragma unroll
                    for (int n = 0; n < 2; ++n) acc[a][b][m][n] = (f32x4){0.f, 0.f, 0.f, 0.f};
        cur = nxt; cA = nA; cB = nB; ++ui;
        if constexpr (GATHER) { _Pragma("unroll") for (int _h = 0; _h < 2; ++_h) _Pragma("unroll") for (int _i = 0; _i < 2; ++_i) gc[_h][_i] = gn[_h][_i]; }
        if constexpr (ALIGN_EPI) { if (wr == 1) PG8_BAR; }
    }
    PG8_WAIT_V(0);
    if constexpr (!ALIGN_EPI) { if (wr == 0) PG8_BAR; }
    PG8_BAR;
    if constexpr (Epi::AFTER_DRAIN) { E.fused(acc, cur, wr, wc, fr, fq, lds, wid, lane); S.done(cur); }
#undef PG8_SA
#undef PG8_SB
#undef PG8_STAGE
#undef PG8_STAGE_A
#undef PG8_GOFF
#undef PG8_LDA
#undef PG8_LDB
#undef PG8_MMA
#undef PG8_WAIT_V
#undef PG8_WAIT_L
#undef PG8_BAR
#undef PG8_SCHED
}
}

#define GAS __attribute__((address_space(1)))
#define LAS __attribute__((address_space(3)))
#define DI __device__ __forceinline__
typedef unsigned short bf16;
typedef unsigned v4u __attribute__((ext_vector_type(4)));
typedef unsigned v2u __attribute__((ext_vector_type(2)));
typedef float f32x4 __attribute__((ext_vector_type(4)));
typedef short bf16x8 __attribute__((ext_vector_type(8)));
typedef float f32x2_t __attribute__((ext_vector_type(2)));
typedef __bf16 bf16x2_t __attribute__((ext_vector_type(2)));
#define LDS_WAIT() asm volatile("s_waitcnt lgkmcnt(0)" ::: "memory")
#define VM_WAIT() asm volatile("s_waitcnt vmcnt(0)" ::: "memory")
DI unsigned pk2(float lo, float hi) { f32x2_t v = {lo, hi}; bf16x2_t b = __builtin_convertvector(v, bf16x2_t); return __builtin_bit_cast(unsigned, b); }
DI float bflo(unsigned u) { return __uint_as_float(u << 16); }
DI float bfhi(unsigned u) { return __uint_as_float(u & 0xffff0000u); }
DI float bf1(bf16 b) { return __uint_as_float(((unsigned)b) << 16); }
DI f32x4 mfma16(bf16x8 a, bf16x8 b, f32x4 c) { return __builtin_amdgcn_mfma_f32_16x16x32_bf16(a, b, c, 0, 0, 0); }
DI bf16x8 ld16(const bf16* p) { return *(const bf16x8*)p; }
DI bf16x8 ld8x2(const bf16* p, int off2) { const v2u a = *(const v2u*)p, b = *(const v2u*)(p + off2); v4u r = {a.x, a.y, b.x, b.y}; return __builtin_bit_cast(bf16x8, r); }
DI bf16x8 pack8(f32x4 a, f32x4 b) { v4u r = {pk2(a[0], a[1]), pk2(a[2], a[3]), pk2(b[0], b[1]), pk2(b[2], b[3])}; return __builtin_bit_cast(bf16x8, r); }
DI float addf(float a, float b) { float r; asm("v_add_f32 %0, %1, %2" : "=v"(r) : "v"(a), "v"(b)); return r; }
DI v2u pack4(f32x4 a) { v2u r = {pk2(a[0], a[1]), pk2(a[2], a[3])}; return r; }
DI float wave_sum(float v) {
#pragma unroll
    for (int o = 1; o < 64; o <<= 1) v += __shfl_xor(v, o);
    return v;
}
DI float quad_sum(float v) { v += __shfl_xor(v, 16); v += __shfl_xor(v, 32); return v; }
DI float quad_max(float v) { v = fmaxf(v, __shfl_xor(v, 16)); v = fmaxf(v, __shfl_xor(v, 32)); return v; }
DI unsigned wave_max_u32(unsigned v) {
#pragma unroll
    for (int o = 1; o < 64; o <<= 1) { const unsigned w = (unsigned)__shfl_xor((int)v, o); v = w > v ? w : v; }
    return v;
}
DI float sigmoidf_(float x) { return __builtin_amdgcn_rcpf(1.0f + __builtin_amdgcn_exp2f(-x * 1.4426950408889634f)); }
DI float siluf_(float x) { return x * sigmoidf_(x); }
DI float gelu_tanh(float v) { const float z = 0.7978845608028654f * (v + 0.044715f * v * v * v); const float e = __builtin_amdgcn_exp2f(2.0f * 1.4426950408889634f * z); return 0.5f * v * (2.0f - 2.0f * __builtin_amdgcn_rcpf(e + 1.0f)); }

constexpr int S = 16384, D = 1024;
constexpr int TP = S + 2048 + 128;
constexpr int NWAVES = 8, NTHR = 512;
constexpr float EPS = 1e-6f, LOG2E = 1.4426950408889634f, QSCALE = 0.125f * 1.4426950408889634f;
constexpr size_t MiB = 1u << 20;
constexpr size_t WS_CTL = 0, CTL_ZERO_BYTES = MiB;
constexpr size_t WS_MISC = 1 * MiB;
constexpr size_t WS_WR = 2 * MiB;
constexpr size_t WS_H = WS_WR + 3328 * 2048;
constexpr size_t WS_WT = WS_H + 32 * MiB;
constexpr size_t WS_WG = 44 * MiB;
constexpr size_t WS_WC1 = 48 * MiB;
constexpr size_t WS_WUA = 50 * MiB, WS_WUB = 51 * MiB, WS_WO = 53 * MiB;
constexpr size_t WS_SM = 55 * MiB;
constexpr size_t SM_W2T = 0, SM_B1 = 64 * 1024, SM_WRT = 128 * 1024, SM_KC = 512 * 1024, SM_VCT = 768 * 1024;
constexpr size_t WS_QA = 56 * MiB, WS_GR = 72 * MiB, WS_GA = 104 * MiB, WS_KCV = 105 * MiB, WS_QR = 121 * MiB, WS_KR = 137 * MiB, WS_TOUT = 153 * MiB, WS_UR = 217 * MiB, WS_HIDC = 249 * MiB;
constexpr size_t WS_G = 105 * MiB, WS_MG = 169 * MiB;
constexpr size_t WS_MOEW = 56 * MiB;
constexpr size_t WS_HID = 104 * MiB, WS_XS = 188 * MiB  , WS_Y = 124 * MiB, WS_END = 256 * MiB;
static_assert(WS_TOUT + 1792ull * TP * 2 <= WS_UR && WS_WT + 1792 * 2048 <= WS_WG && WS_HIDC + 2 * MiB <= WS_END && WS_Y + 64 * MiB <= WS_XS && WS_XS + 4 * MiB <= WS_END && WS_Y + 64 * MiB <= WS_END, "ws map");
constexpr int CW_BAR = 4096, CW_KMAX = 16384, CW_CNT = 16448, CW_WQ = 16512;
constexpr int XS_ROWS = 40960;
constexpr int WAVE_LDS = 16960;
constexpr int NEAR_OFF = 140288;
constexpr int BIAS_OFF = 157184;
constexpr int MOET_OFF = 161344;
constexpr int GTAB_OFF = 135168;
constexpr int MISC_OFF = 161664;
constexpr int LDS_BYTES = 163840;
#define XB_TMO      128
#define XB_XCNT(j)  (256  + 64 * (j))
#define XB_XSUB(j)  (1280 + 64 * (j))
#define XB_XGEN(j)  (2304 + 64 * (j))
#define XB_TOP      3328
#define XB_TOPGEN   3392
#define XCD_BAR_WORDS 3456
#define XB_SPIN_CAP (1u << 18)

__device__ __forceinline__ unsigned xb_ld(unsigned* p)              { return __hip_atomic_load(p, __ATOMIC_RELAXED, __HIP_MEMORY_SCOPE_AGENT); }
__device__ __forceinline__ unsigned xb_add(unsigned* p, unsigned v) { return __hip_atomic_fetch_add(p, v, __ATOMIC_RELAXED, __HIP_MEMORY_SCOPE_AGENT); }
__device__ __forceinline__ unsigned xb_xcc_id() { return (unsigned)__builtin_amdgcn_s_getreg((3 << 11) | 20) & 0xFu; }
#define XB_SPIN(cond, bar) do { unsigned _sp = 0; while (cond) { __builtin_amdgcn_s_sleep(1); \
    if ((++_sp & 255u) == 0u) { if (xb_ld(&(bar)[XB_TMO])) break; if (_sp > XB_SPIN_CAP) { atomicAdd(&(bar)[XB_TMO], 1u); break; } } } } while (0)

struct XcdBarrier {
    unsigned* bar; unsigned x;
    volatile LAS unsigned* st;
};

__device__ __forceinline__ XcdBarrier xcd_barrier_post(unsigned* bar, volatile LAS unsigned* st) {
    XcdBarrier b; b.bar = bar; b.x = xb_xcc_id(); b.st = st;
    if (threadIdx.x == 0) (void)xb_add(&bar[XB_XCNT(b.x)], 1u);
    return b;
}
__device__ __forceinline__ void xcd_barrier_complete(unsigned* bar, unsigned x, unsigned& nloc, unsigned& nx) {
    const unsigned G = gridDim.x * gridDim.y * gridDim.z;
    unsigned sum, cnt, mine, sp = 0u;
    for (;;) {
        sum = 0u; cnt = 0u; mine = 0u;
#pragma unroll
        for (unsigned j = 0; j < 16; ++j) { const unsigned c = xb_ld(&bar[XB_XCNT(j)]); sum += c; cnt += (c > 0u) ? 1u : 0u; mine = (j == x) ? c : mine; }
        if (sum == G) break;
        __builtin_amdgcn_s_sleep(1);
        if ((++sp & 255u) == 0u) { if (xb_ld(&bar[XB_TMO])) break; if (sp > XB_SPIN_CAP) { atomicAdd(&bar[XB_TMO], 1u); break; } }
    }
    nloc = mine > 0u ? mine : 1u; nx = cnt > 0u ? cnt : 1u;
}

__device__ __forceinline__ void xcd_barrier(const XcdBarrier& b) {
    asm volatile("s_waitcnt vmcnt(0)" ::: "memory");
    __syncthreads();
    if (threadIdx.x == 0) {
        unsigned* bar = b.bar;
        __builtin_amdgcn_s_waitcnt(0);
        unsigned nloc = b.st[0], nx = b.st[1];
        if (nloc == 0u) { xcd_barrier_complete(bar, b.x, nloc, nx); b.st[0] = nloc; b.st[1] = nx; }
        const unsigned old = xb_add(&bar[XB_XSUB(b.x)], 1u);
        const unsigned gen = old / nloc;
        if (old + 1u == (gen + 1u) * nloc) {
            __builtin_amdgcn_fence(__ATOMIC_RELEASE, "agent");
            asm volatile("s_waitcnt vmcnt(0)" ::: "memory");
            const unsigned og = xb_add(&bar[XB_TOP], 1u);
            const unsigned tg = og / nx;
            if (og + 1u == (tg + 1u) * nx) xb_add(&bar[XB_TOPGEN], 1u);
            else XB_SPIN(xb_ld(&bar[XB_TOPGEN]) == tg, bar);
            __builtin_amdgcn_fence(__ATOMIC_ACQUIRE, "agent");
            xb_add(&bar[XB_XGEN(b.x)], 1u);
            asm volatile("s_waitcnt vmcnt(0)" ::: "memory");
        } else {
            XB_SPIN(xb_ld(&bar[XB_XGEN(b.x)]) == gen, bar);
            __builtin_amdgcn_fence(__ATOMIC_ACQUIRE, "agent");
            asm volatile("s_waitcnt vmcnt(0)" ::: "memory");
        }
    }
    __syncthreads();
}

DI void tile_map(int L, int nwg, int nM, int nN, int& pm, int& pn) {
    int wgid = L; { const int q = nwg / 8, r = nwg % 8, xcd = wgid % 8, off = wgid / 8; wgid = (xcd < r ? xcd * (q + 1) : r * (q + 1) + (xcd - r) * q) + off; }
    const int nig = 8 * nN, gid = wgid / nig, fm = gid * 8, gsz = (nM - fm) < 8 ? (nM - fm) : 8;
    pm = fm + ((wgid % nig) % gsz); pn = (wgid % nig) / gsz;
}
constexpr int GATE_PN0 = (int)((WS_WG - WS_WR) / (256 * 1024 * 2));
static_assert((WS_WG - WS_WR) % (256 * 1024 * 2) == 0, "gate weights sit a whole number of B tiles above WR");
struct ProjOrder {
    int G, c;
    DI bool next(int i, pg8::Unit& u) const {
        const int L = i * G + c; if (L >= 1792) return false;
        if (L < 832) tile_map(L, 832, 64, 13, u.pm, u.pn);
        else if (L < 1280) { tile_map(L - 832, 448, 7, 64, u.pm, u.pn); u.pm += 64; u.pn += 13; }
        else { tile_map(L - 1280, 512, 64, 8, u.pm, u.pn); u.pn += GATE_PN0; }
        return true;
    }
    DI void a_ready(const pg8::Unit&) const {}
    DI void done(const pg8::Unit&) const {}
};
template <int NJ> struct MoeOrder {
    int G, c; const LAS int* tp;
    DI bool next(int i, pg8::Unit& u) const {
        const int L = i * G + c, tau = L / NJ, j = L % NJ; const int nt = __builtin_amdgcn_readfirstlane(tp[32]);
        if (tau >= nt) return false;
        int e = 0;
        for (int k = 1; k < 32; ++k) e += (tau >= __builtin_amdgcn_readfirstlane(tp[k])) ? 1 : 0;
        u.pm = tau; u.pn = e * NJ + j; return true;
    }
    DI void a_ready(const pg8::Unit&) const {}
    DI void done(const pg8::Unit&) const {}
};

struct EpiProj {
    static constexpr bool PERM = true, AFTER_DRAIN = false;
    bf16 *QA, *KCV, *QR, *KR, *GR, *GA, *TOUT, *G;
    DI void operator()(const f32x4 (&acc)[2][2][4][2], const pg8::Unit& u, int wr, int wc, int fr_, int fq_) const {
        int fr = fr_, fq = fq_; asm volatile("" : "+v"(fr), "+v"(fq));
        const float L2B = 13.287712379549449f / 64.0f;
        const float INV2PI = 0.15915494309189535f;
        if (u.pm < 64 && u.pn >= GATE_PN0) {
            const int row0 = u.pm * 256 + wr * 64 + fr, col0 = (u.pn - GATE_PN0) * 256 + wc * 32 + 8 * fq;
#pragma unroll
            for (int ai = 0; ai < 2; ++ai)
#pragma unroll
                for (int m = 0; m < 4; ++m) {
                    bf16* rowp = G + (size_t)(row0 + ai * 128 + m * 16) * 2048 + col0;
#pragma unroll
                    for (int bj = 0; bj < 2; ++bj) { f32x4 a = acc[ai][bj][m][0], b = acc[ai][bj][m][1];
#pragma unroll
                        for (int i = 0; i < 4; ++i) { a[i] = sigmoidf_(a[i]); b[i] = sigmoidf_(b[i]); }
                        *(bf16x8*)(rowp + bj * 128) = pack8(a, b); }
                }
        } else if (u.pm < 64) {
            const int pn = u.pn, row0 = u.pm * 256 + wr * 64 + fr;
            if (pn >= 4 && pn < 8) {
                bf16* base = pn < 6 ? QR : KR; const float sc = pn < 6 ? 1.0f : 0.08838834764831845f; const int hd0 = 2 * (pn & 1), d0 = 16 * wc + 4 * fq;
                float invr[4];
#pragma unroll
                for (int i = 0; i < 4; ++i) invr[i] = __builtin_amdgcn_exp2f(-(float)(d0 + i) * L2B) * INV2PI;
#pragma unroll
                for (int ai = 0; ai < 2; ++ai)
#pragma unroll
                    for (int m = 0; m < 4; ++m) {
                        const int tok = row0 + ai * 128 + m * 16; float cs[4], sn[4];
#pragma unroll
                        for (int i = 0; i < 4; ++i) { float rev = (float)tok * invr[i]; rev -= floorf(rev); sn[i] = __builtin_amdgcn_sinf(rev) * sc; cs[i] = __builtin_amdgcn_cosf(rev) * sc; }
#pragma unroll
                        for (int bj = 0; bj < 2; ++bj) {
                            const f32x4 x1 = acc[ai][bj][m][0], x2 = acc[ai][bj][m][1]; f32x4 o1, o2;
#pragma unroll
                            for (int i = 0; i < 4; ++i) { o1[i] = x1[i] * cs[i] - x2[i] * sn[i]; o2[i] = x1[i] * sn[i] + x2[i] * cs[i]; }
                            bf16* p = base + (size_t)tok * 512 + (hd0 + bj) * 128 + d0;
                            *(v2u*)p = pack4(o1); *(v2u*)(p + 64) = pack4(o2);
                        }
                    }
            } else if (pn == 12) {
                if (wc == 0) {
#pragma unroll
                    for (int ai = 0; ai < 2; ++ai)
#pragma unroll
                        for (int m = 0; m < 4; ++m) {
                            const int tok = row0 + ai * 128 + m * 16; f32x4 a = acc[ai][0][m][0], b = acc[ai][0][m][1];
#pragma unroll
                            for (int i = 0; i < 4; ++i) { a[i] = sigmoidf_(a[i]); b[i] = sigmoidf_(b[i]); }
                            *(bf16x8*)(GA + (size_t)tok * 32 + 8 * fq) = pack8(a, b);
                        }
                }
            } else if (pn == 3) {
                const int gg = wc >> 1, d0 = (wc & 1) * 32 + 8 * fq;
#pragma unroll
                for (int ai = 0; ai < 2; ++ai)
#pragma unroll
                    for (int m = 0; m < 4; ++m) { const size_t o = ((size_t)gg * S + (row0 + ai * 128 + m * 16)) * 64 + d0;
                        *(bf16x8*)(KCV + (size_t)8 * MiB / 2 + o) = pack8(acc[ai][0][m][0], acc[ai][0][m][1]);
                        *(bf16x8*)(KCV + (size_t)12 * MiB / 2 + o) = pack8(acc[ai][1][m][0], acc[ai][1][m][1]); }
            } else {
                bf16* dst; int ldc, colt; float sc = 1.0f;
                if (pn < 2) { dst = QA; ldc = 512; colt = 256 * pn; sc = QSCALE; }
                else if (pn == 2) { dst = KCV; ldc = 256; colt = 0; }
                else { dst = GR; ldc = 1024; colt = 256 * (pn - 8); }
                const int col0 = colt + wc * 32 + 8 * fq;
#pragma unroll
                for (int ai = 0; ai < 2; ++ai)
#pragma unroll
                    for (int m = 0; m < 4; ++m) {
                        bf16* rowp = dst + (size_t)(row0 + ai * 128 + m * 16) * ldc + col0;
#pragma unroll
                        for (int bj = 0; bj < 2; ++bj) *(bf16x8*)(rowp + bj * 128) = pack8(acc[ai][bj][m][0] * sc, acc[ai][bj][m][1] * sc);
                    }
            }
        } else {
            const int pmp = u.pm - 64, tok0 = (u.pn - 13) * 256 + wc * 32 + 8 * fq;
            if (pmp == 1 || pmp == 2) {
                const float sc = 0.08838834764831845f;
#pragma unroll
                for (int ai = 0; ai < 2; ++ai) {
                    const int head = 2 * (pmp - 1) + ai;
#pragma unroll
                    for (int m = 0; m < 2; ++m) {
                        const int d = 32 * wr + 16 * m + fr; const float invr = __builtin_amdgcn_exp2f(-(float)d * L2B) * INV2PI;
                        bf16* p1 = TOUT + (size_t)(256 + head * 128 + d) * TP;
#pragma unroll
                        for (int bj = 0; bj < 2; ++bj) {
                            f32x4 o1[2], o2[2];
#pragma unroll
                            for (int n = 0; n < 2; ++n)
#pragma unroll
                                for (int i = 0; i < 4; ++i) {
                                    const int tok = tok0 + bj * 128 + 4 * n + i; float rev = (float)tok * invr; rev -= floorf(rev);
                                    const float sn = __builtin_amdgcn_sinf(rev) * sc, cs = __builtin_amdgcn_cosf(rev) * sc;
                                    const float x1 = acc[ai][bj][m][n][i], x2 = acc[ai][bj][m + 2][n][i];
                                    o1[n][i] = x1 * cs - x2 * sn; o2[n][i] = x1 * sn + x2 * cs;
                                }
                            *(bf16x8*)(p1 + tok0 + bj * 128) = pack8(o1[0], o1[1]);
                            *(bf16x8*)(p1 + (size_t)64 * TP + tok0 + bj * 128) = pack8(o2[0], o2[1]);
                        }
                    }
                }
            } else if (pmp == 0) {
                const int d = 0;
#pragma unroll
                for (int m = 0; m < 4; ++m) { const int dd = m * 16 + fr;
#pragma unroll
                    for (int bj = 0; bj < 2; ++bj) { const int t8 = tok0 + bj * 128;
                        { bf16* pv = TOUT + (((size_t)wr * 256 + (t8 >> 6)) * 64 + dd) * 64 + (t8 & 32) + ((t8 & 15) >> 2) * 8 + ((t8 >> 4) & 1) * 4;
                          *(v2u*)pv = pack4(acc[0][bj][m][0]); *(v2u*)(pv + 8) = pack4(acc[0][bj][m][1]); }
                        *(bf16x8*)(TOUT + (size_t)4 * MiB / 2 + (((size_t)wr * 512 + (t8 >> 5)) * 64 + dd) * 32 + (t8 & 31)) = pack8(acc[1][bj][m][0], acc[1][bj][m][1]); } }
                (void)d;
            } else {
#pragma unroll
                for (int ai = 0; ai < 2; ++ai)
#pragma unroll
                    for (int m = 0; m < 4; ++m) {
                        bf16* rowp = TOUT + (size_t)(pmp * 256 + ai * 128 + wr * 64 + m * 16 + fr) * TP + tok0;
#pragma unroll
                        for (int bj = 0; bj < 2; ++bj) *(bf16x8*)(rowp + bj * 128) = pack8(acc[ai][bj][m][0], acc[ai][bj][m][1]);
                    }
            }
        }
    }
};
struct EpiGate {
    static constexpr bool PERM = true, AFTER_DRAIN = false;
    bf16* G;
    DI void operator()(const f32x4 (&acc)[2][2][4][2], const pg8::Unit& u, int wr, int wc, int fr, int fq) const {
        const int row0 = u.pm * 256 + wr * 64 + fr, col0 = u.pn * 256 + wc * 32 + 8 * fq;
#pragma unroll
        for (int ai = 0; ai < 2; ++ai)
#pragma unroll
            for (int m = 0; m < 4; ++m) {
                bf16* rowp = G + (size_t)(row0 + ai * 128 + m * 16) * 2048 + col0;
#pragma unroll
                for (int bj = 0; bj < 2; ++bj) { f32x4 a = acc[ai][bj][m][0], b = acc[ai][bj][m][1];
#pragma unroll
                    for (int i = 0; i < 4; ++i) { a[i] = sigmoidf_(a[i]); b[i] = sigmoidf_(b[i]); }
                    *(bf16x8*)(rowp + bj * 128) = pack8(a, b); }
            }
    }
};
template <bool ADD> struct EpiUp {
    static constexpr bool PERM = true, AFTER_DRAIN = false;
    const bf16* G; bf16* MG; int goff;
    DI void operator()(const f32x4 (&acc)[2][2][4][2], const pg8::Unit& u, int wr, int wc, int fr, int fq) const {
        const int row0 = u.pm * 256 + wr * 64 + fr, col0 = u.pn * 256 + wc * 32 + 8 * fq;
#pragma unroll
        for (int ai = 0; ai < 2; ++ai)
#pragma unroll
            for (int m = 0; m < 4; ++m) {
                const size_t r = (size_t)(row0 + ai * 128 + m * 16);
#pragma unroll
                for (int bj = 0; bj < 2; ++bj) {
                    const v4u g = *(const v4u*)(G + r * 2048 + goff + col0 + bj * 128);
                    f32x4 a = acc[ai][bj][m][0], b = acc[ai][bj][m][1];
                    a[0] *= bflo(g.x); a[1] *= bfhi(g.x); a[2] *= bflo(g.y); a[3] *= bfhi(g.y); b[0] *= bflo(g.z); b[1] *= bfhi(g.z); b[2] *= bflo(g.w); b[3] *= bfhi(g.w);
                    bf16* op = MG + r * 1024 + col0 + bj * 128;
                    if (ADD) { const v4u o = *(const v4u*)op;
                        a[0] += bflo(o.x); a[1] += bfhi(o.x); a[2] += bflo(o.y); a[3] += bfhi(o.y); b[0] += bflo(o.z); b[1] += bfhi(o.z); b[2] += bflo(o.w); b[3] += bfhi(o.w); }
                    *(bf16x8*)op = pack8(a, b);
                }
            }
    }
};
struct EpiOut {
    static constexpr bool PERM = false, AFTER_DRAIN = false;
    const float* X; float* O;
    DI void operator()(const f32x4 (&acc)[2][2][4][2], const pg8::Unit& u, int wr, int wc, int fr, int fq) const {
        const int row0 = u.pm * 256 + wr * 64 + fr, col0 = u.pn * 256 + wc * 32 + 4 * fq;
#pragma unroll
        for (int ai = 0; ai < 2; ++ai)
#pragma unroll
            for (int m = 0; m < 4; ++m) {
                const size_t off = (size_t)(row0 + ai * 128 + m * 16) * 1024 + col0;
#pragma unroll
                for (int bj = 0; bj < 2; ++bj)
#pragma unroll
                    for (int n = 0; n < 2; ++n) { const size_t o = off + bj * 128 + n * 16; *(f32x4*)(O + o) = *(const f32x4*)(X + o) + acc[ai][bj][m][n]; }
            }
    }
};
struct EpiMoe1 {
    static constexpr bool PERM = false, AFTER_DRAIN = false;
    bf16* HID;
    DI void operator()(const f32x4 (&acc)[2][2][4][2], const pg8::Unit& u, int wr, int wc, int fr, int fq) const {
        const int row0 = u.pm * 256 + wr * 64 + fr, f0 = (u.pn & 1) * 128 + 16 * wc + 4 * fq;
#pragma unroll
        for (int ai = 0; ai < 2; ++ai)
#pragma unroll
            for (int m = 0; m < 4; ++m) {
                bf16* rowp = HID + (size_t)(row0 + ai * 128 + m * 16) * 256 + f0;
#pragma unroll
                for (int bj = 0; bj < 2; ++bj) { const f32x4 g = acc[ai][bj][m][0], up = acc[ai][bj][m][1]; f32x4 h;
#pragma unroll
                    for (int i = 0; i < 4; ++i) h[i] = siluf_(g[i]) * up[i];
                    *(v2u*)(rowp + bj * 64) = pack4(h); }
            }
    }
};
struct EpiMoe2 {
    static constexpr bool PERM = true, AFTER_DRAIN = false;
    const v2u* LIST; bf16* Y; const LAS int* tp; const LAS int* cn;
    DI void operator()(const f32x4 (&acc)[2][2][4][2], const pg8::Unit& u, int wr, int wc, int fr, int fq) const {
        const int ex = u.pn >> 2, rank0 = (u.pm - tp[ex]) * 256 + wr * 64 + fr, cnt = cn[ex], col0 = (u.pn & 3) * 256 + wc * 32 + 8 * fq;
#pragma unroll
        for (int ai = 0; ai < 2; ++ai)
#pragma unroll
            for (int m = 0; m < 4; ++m) {
                const int rank = rank0 + ai * 128 + m * 16;
                if (rank < cnt) {
                    const v2u ri = LIST[(size_t)ex * 16384 + rank]; const float w = __uint_as_float(ri.y);
                    bf16* rowp = Y + ((size_t)(ri.x & 1u) * S + (ri.x >> 1)) * 1024 + col0;
#pragma unroll
                    for (int bj = 0; bj < 2; ++bj) *(bf16x8*)(rowp + bj * 128) = pack8(acc[ai][bj][m][0] * w, acc[ai][bj][m][1] * w);
                }
                asm volatile("" ::: "memory");
            }
    }
};

struct Args { const float* in[23]; float* out; unsigned char* ws; int ph_lo, ph_hi, li, pad; };
struct Frame {
    LAS unsigned char* lds;
    unsigned* ctl;
    int tid, lane, wave, G, gw, ngw;
    const Args* A; float* out; unsigned char* ws;
};
#define WSP(T, off) ((T*)(F.ws + (off)))

template <class DestFn>
DI void tr_item(const float* W, int ldw, int ncols, int k0, int n0, LAS float* scr, int lane, DestFn dest) {
    const int lr = lane >> 3, lc = (lane & 7) * 4;
    if (n0 + 32 <= ncols && (ldw & 3) == 0) {
#pragma unroll
        for (int i = 0; i < 8; ++i) { const int kk = 8 * i + lr; const f32x4 v = *(const f32x4*)(W + (size_t)(k0 + kk) * ldw + n0 + lc); LAS float* d = scr + kk * 33 + lc; d[0] = v[0]; d[1] = v[1]; d[2] = v[2]; d[3] = v[3]; }
    } else {
#pragma unroll
        for (int i = 0; i < 8; ++i) { const int kk = 8 * i + lr;
#pragma unroll
            for (int j = 0; j < 4; ++j) scr[kk * 33 + lc + j] = (n0 + lc + j) < ncols ? W[(size_t)(k0 + kk) * ldw + n0 + lc + j] : 0.0f; }
    }
    LDS_WAIT(); asm volatile("" ::: "memory");
    const int c = lane & 7;
#pragma unroll
    for (int j = 0; j < 4; ++j) {
        const int nl = (lane >> 3) + 8 * j, n = n0 + nl;
        if (n < ncols) {
            const LAS float* s = scr + (8 * c) * 33 + nl;
            v4u o; o.x = pk2(s[0 * 33], s[1 * 33]); o.y = pk2(s[2 * 33], s[3 * 33]); o.z = pk2(s[4 * 33], s[5 * 33]); o.w = pk2(s[6 * 33], s[7 * 33]);
            bf16* r0 = dest(n, 0); if (r0) *(v4u*)(r0 + k0 + 8 * c) = o;
            bf16* r1 = dest(n, 1); if (r1) *(v4u*)(r1 + k0 + 8 * c) = o;
        }
    }
    LDS_WAIT(); asm volatile("" ::: "memory");
}
DI int rot_row_R(int d) { const int n = d >> 6, dd = d & 63; return 32 * (dd >> 4) + 8 * ((dd >> 2) & 3) + 4 * n + (dd & 3); }
DI int rot_row_T(int d) { const int x2 = d >> 6, dd = d & 63; return 64 * (dd >> 5) + 16 * (((dd >> 4) & 1) + 2 * x2) + (dd & 15); }
DI bf16* win_dest(unsigned char* ws, int s, int which) {
    bf16* WR = (bf16*)(ws + WS_WR); bf16* WT = (bf16*)(ws + WS_WT); bf16* WG = (bf16*)(ws + WS_WG);
    int r = -1, t = -1, g = -1;
    if (s < 512) r = s;
    else if (s < 1280) { const int sp = s - 512, j6 = sp >> 7, gd = sp & 127;
        if (j6 == 0) r = 512 + gd; else if (j6 == 1) r = 512 + 128 + gd; else if (j6 == 2) r = 512 + 256 + gd; else if (j6 == 4) r = 512 + 384 + gd;
        else if (j6 == 3) t = gd; else t = 128 + gd; }
    else if (s < 1304) r = 12 * 256 + (s - 1280);
    else if (s < 1816) { const int f = s - 1304, hh = f >> 7, d = f & 127; r = (4 + (hh >> 1)) * 256 + (hh & 1) * 128 + rot_row_R(d); }
    else if (s < 2328) { const int f = s - 1816, hh = f >> 7, d = f & 127; r = (6 + (hh >> 1)) * 256 + (hh & 1) * 128 + rot_row_R(d); t = (1 + (hh >> 1)) * 256 + (hh & 1) * 128 + rot_row_T(d); }
    else if (s < 3352) t = 768 + (s - 2328);
    else if (s < 4376) r = 8 * 256 + (s - 3352);
    else g = s - 4376;
    if (which == 0) { if (r >= 0) return WR + (size_t)r * 1024; if (t >= 0) return WT + (size_t)t * 1024; return WG + (size_t)g * 1024; }
    return (r >= 0 && t >= 0) ? WT + (size_t)t * 1024 : nullptr;
}
DI void load_row(const float* p, int lane, f32x4 (&v)[4]) {
#pragma unroll
    for (int j = 0; j < 4; ++j) v[j] = *(const f32x4*)(p + 4 * lane + 256 * j);
}
DI float row_rstd(const f32x4 (&v)[4]) {
    float s = 0.f;
#pragma unroll
    for (int j = 0; j < 4; ++j) s += (v[j][0] * v[j][0] + v[j][1] * v[j][1]) + (v[j][2] * v[j][2] + v[j][3] * v[j][3]);
    return 1.0f / sqrtf(wave_sum(s) * (1.0f / 1024.0f) + EPS);
}

DI void p0_prologue(Frame& F) {
    LAS float* scr = (LAS float*)(F.lds + F.wave * WAVE_LDS);
    const float* w_in = F.A->in[3];
    constexpr int I_IN = 16 * 201, I_C1 = 512, I_C2 = 16, I_UA = 256, I_UB = 512, I_WO = 512, NIT = I_IN + I_C1 + I_C2 + I_UA + I_UB + I_WO;
    unsigned char* ws = F.ws;
    for (int it = F.gw; it < NIT; it += F.ngw) {
        int r = it;
        if (r < I_IN) { const int kb = r / 201, nb = r % 201; tr_item(w_in, 6424, 6424, 64 * kb, 32 * nb, scr, F.lane, [ws](int n, int which) { return win_dest(ws, n, which); }); continue; } r -= I_IN;
        if (r < I_C1) { const int kind = r >> 8, q = r & 255, kb = q >> 3, nb = q & 7; bf16* dstb = (bf16*)(ws + WS_WC1) + (size_t)kind * 256 * 2048;
            tr_item(F.A->in[kind ? 8 : 5], 256, 256, 64 * kb, 32 * nb, scr, F.lane, [dstb](int n, int which) { return which ? (bf16*)nullptr : dstb + (size_t)n * 2048; }); continue; } r -= I_C1;
        if (r < I_C2) { const int kind = r >> 3, q = r & 7, kb = q >> 1, nb = q & 1; bf16* dstb = (bf16*)(ws + WS_SM + SM_W2T) + (size_t)kind * 64 * 256;
            tr_item(F.A->in[kind ? 9 : 6], 64, 64, 64 * kb, 32 * nb, scr, F.lane, [dstb](int n, int which) { return which ? (bf16*)nullptr : dstb + (size_t)n * 256; }); continue; } r -= I_C2;
        if (r < I_UA) { const int kb = r >> 5, nb = r & 31; bf16* dstb = (bf16*)(ws + WS_WUA);
            tr_item(F.A->in[11], 1024, 1024, 64 * kb, 32 * nb, scr, F.lane, [dstb](int n, int which) { return which ? (bf16*)nullptr : dstb + (size_t)n * 512; }); continue; } r -= I_UA;
        if (r < I_UB) { const int kb = r >> 5, nb = r & 31; bf16* dstb = (bf16*)(ws + WS_WUB);
            tr_item(F.A->in[12], 1024, 1024, 64 * kb, 32 * nb, scr, F.lane, [dstb](int n, int which) { return which ? (bf16*)nullptr : dstb + (size_t)n * 1024; }); continue; } r -= I_UB;
        { const int kb = r >> 5, nb = r & 31; bf16* dstb = (bf16*)(ws + WS_WO);
            tr_item(F.A->in[13], 1024, 1024, 64 * kb, 32 * nb, scr, F.lane, [dstb](int n, int which) { return which ? (bf16*)nullptr : dstb + (size_t)n * 1024; }); }
    }
    for (int o = F.gw; o < 512; o += F.ngw) {
        const int kind = o >> 8, n = o & 255; const float* pos = F.A->in[kind ? 7 : 4]; const float* w1 = F.A->in[kind ? 8 : 5]; float s = 0.f;
        for (int kk = F.lane; kk < 2048; kk += 64) s += pos[kk] * w1[(size_t)kk * 256 + n];
        s = wave_sum(s); if (F.lane == 0) ((float*)(ws + WS_SM + SM_B1))[o] = s;
    }
    { float* wrt = (float*)(ws + WS_SM + SM_WRT); const float* wn = F.A->in[14];
      for (int i = F.gw * 64 + F.lane; i < 48 * 1024; i += F.ngw * 64) { const int o = i >> 10, k = i & 1023; wrt[i] = o < 4 ? wn[k] * F.A->in[15][k * 4 + o] : (o < 36 ? wn[k] * F.A->in[17][k * 32 + (o - 4)] : 0.0f); } }
    { f32x4 w[4]; load_row(F.A->in[2], F.lane, w); bf16* H = (bf16*)(ws + WS_H);
      for (int m = F.gw; m < S; m += F.ngw) { f32x4 v[4]; load_row(F.A->in[0] + (size_t)m * 1024, F.lane, v); const float rs = row_rstd(v);
#pragma unroll
        for (int j = 0; j < 4; ++j) { const f32x4 o = v[j] * rs * w[j]; *(v2u*)(H + (size_t)m * 1024 + 4 * F.lane + 256 * j) = pack4(o); } } }
}

DI void dma_rows256(const bf16* src0, size_t pitch, int nrows, LAS unsigned char* dst, int w, int lane) {
    const int lr = lane >> 4, pc = lane & 15;
#pragma unroll 1
    for (int k = w; k < (nrows >> 2); k += 8) { const int r = k * 4 + lr; const int gc = pc ^ (r & 15);
        __builtin_amdgcn_global_load_lds((const unsigned*)(src0 + (size_t)r * pitch + gc * 8), (LAS unsigned*)(dst + k * 1024), 16, 0, 0); }
}
DI bf16x8 frag256(const LAS unsigned char* base, int row, int chunk) { return *(const LAS bf16x8*)(base + row * 256 + ((chunk ^ (row & 15)) * 16)); }
DI v2u frag256h(const LAS unsigned char* base, int row, int chunk, int half) { return *(const LAS v2u*)(base + row * 256 + ((chunk ^ (row & 15)) * 16) + half * 8); }
DI void p2_ret_state_wg(Frame& F, int u) {
    const int c = u >> 2, h = u & 3, w = F.wave, col = F.lane & 15, kq = F.lane >> 4;
    const float l2g = log2f(1.0f - __builtin_amdgcn_exp2f((float)(-5 - h)));
    const bf16* TOUT = WSP(const bf16, WS_TOUT); LAS unsigned char* L = F.lds;
    asm volatile("s_waitcnt vmcnt(0) lgkmcnt(0)" ::: "memory"); __builtin_amdgcn_s_barrier();
    dma_rows256(TOUT + (size_t)(768 + h * 256) * TP + c * 128, TP, 256, L, w, F.lane);
    dma_rows256(TOUT + (size_t)(256 + h * 128) * TP + c * 128, TP, 128, L + 65536, w, F.lane);
    asm volatile("s_waitcnt vmcnt(0)" ::: "memory"); __builtin_amdgcn_s_barrier(); asm volatile("" ::: "memory");
    f32x4 acc[16];
#pragma unroll
    for (int i = 0; i < 16; ++i) acc[i] = (f32x4){0.f, 0.f, 0.f, 0.f};
#pragma unroll
    for (int ks = 0; ks < 4; ++ks) {
        const v4u kr = __builtin_bit_cast(v4u, frag256(L + 65536, w * 16 + col, ks * 4 + kq)); float kv[8] = {bflo(kr.x), bfhi(kr.x), bflo(kr.y), bfhi(kr.y), bflo(kr.z), bfhi(kr.z), bflo(kr.w), bfhi(kr.w)};
#pragma unroll
        for (int e = 0; e < 8; ++e) kv[e] *= __builtin_amdgcn_exp2f((float)(127 - (ks * 32 + kq * 8 + e)) * l2g);
        v4u ks4 = {pk2(kv[0], kv[1]), pk2(kv[2], kv[3]), pk2(kv[4], kv[5]), pk2(kv[6], kv[7])}; const bf16x8 kf = __builtin_bit_cast(bf16x8, ks4);
#pragma unroll
        for (int dvt = 0; dvt < 16; ++dvt) acc[dvt] = mfma16(kf, frag256(L, dvt * 16 + col, ks * 4 + kq), acc[dvt]);
    }
    bf16* UR = WSP(bf16, WS_UR) + ((size_t)(c * 4 + h) * 256) * 128;
#pragma unroll
    for (int dvt = 0; dvt < 16; ++dvt) *(v2u*)(UR + (size_t)(dvt * 16 + col) * 128 + w * 16 + 4 * kq) = pack4(acc[dvt]);
}
DI void p2_cmp_hidden(Frame& F, int u) {
    const int combo = u >> 8, kind = combo >> 1, g = combo & 1, rt = (u >> 2) & 63, nq = u & 3, col = F.lane & 15, kq = F.lane >> 4;
    const bf16* W1 = WSP(const bf16, WS_WC1) + (size_t)kind * 256 * 2048 + (size_t)(nq * 64 + col) * 2048 + kq * 8;
    int tokb = 16 * (rt * 16 + col); tokb = tokb < S - 32 ? tokb : S - 32;
    const bf16* KCV = WSP(const bf16, WS_KCV) + (size_t)tokb * 256 + kind * 128 + g * 64 + kq * 8;
    f32x4 acc[4];
#pragma unroll
    for (int i = 0; i < 4; ++i) acc[i] = (f32x4){0.f, 0.f, 0.f, 0.f};
#pragma unroll 8
    for (int st = 0; st < 64; ++st) {
        const bf16x8 bfr = ld16(KCV + (size_t)(st >> 1) * 256 + (st & 1) * 32);
#pragma unroll
        for (int nt = 0; nt < 4; ++nt) { const bf16x8 af = ld16(W1 + (size_t)nt * 16 * 2048 + st * 32); acc[nt] = mfma16(af, bfr, acc[nt]); }
    }
    const float* b1 = WSP(const float, WS_SM + SM_B1) + kind * 256; bf16* HC = WSP(bf16, WS_HIDC) + (size_t)combo * 1024 * 256;
#pragma unroll
    for (int nt = 0; nt < 4; ++nt) { const int n0 = nq * 64 + nt * 16 + 4 * kq; const f32x4 bb = *(const f32x4*)(b1 + n0); f32x4 v = acc[nt] + bb;
#pragma unroll
        for (int i = 0; i < 4; ++i) v[i] = gelu_tanh(v[i]);
        *(v2u*)(HC + (size_t)(rt * 16 + col) * 256 + n0) = pack4(v); }
}
DI void p2_kmax(Frame& F, int u) {
    const int tok = u * 64 + F.lane; const bf16* KSW = WSP(const bf16, WS_KCV + 8 * MiB) + (size_t)tok * 64;
#pragma unroll
    for (int q = 0; q < 4; ++q) { float s = 0.f;
#pragma unroll
        for (int j = 0; j < 8; ++j) { const v4u k = *(const v4u*)(KSW + (size_t)q * S * 64 + j * 8);
            const float a0 = bflo(k.x), a1 = bfhi(k.x), a2 = bflo(k.y), a3 = bfhi(k.y), a4 = bflo(k.z), a5 = bfhi(k.z), a6 = bflo(k.w), a7 = bfhi(k.w);
            s += (a0 * a0 + a1 * a1) + (a2 * a2 + a3 * a3) + (a4 * a4 + a5 * a5) + (a6 * a6 + a7 * a7); }
        const unsigned m = wave_max_u32(__float_as_uint(s));
        if (F.lane == 0) atomicMax(F.ctl + CW_KMAX + q, m); }
}
DI void p3_scan(Frame& F) {
    const int idx = blockIdx.x * NTHR + F.tid;
    if (idx < 65536) {
        const int h = idx >> 14; const float cd = __builtin_amdgcn_exp2f(128.0f * log2f(1.0f - __builtin_amdgcn_exp2f((float)(-5 - h))));
        unsigned* UR = WSP(unsigned, WS_UR) + idx; float r0 = 0.f, r1 = 0.f;
#pragma unroll 32
        for (int c = 0; c < 128; ++c) { const unsigned u = UR[(size_t)c * 65536]; UR[(size_t)c * 65536] = pk2(r0, r1); r0 = r0 * cd + bflo(u); r1 = r1 * cd + bfhi(u); }
    }
}
DI void p3_kcvc(Frame& F, int u) {
    const int combo = u >> 6, kind = combo >> 1, g = combo & 1, rt = u & 63, col = F.lane & 15, kq = F.lane >> 4;
    const bf16* HC = WSP(const bf16, WS_HIDC) + (size_t)combo * 1024 * 256 + (size_t)(rt * 16 + col) * 256 + kq * 8;
    const bf16* W2 = WSP(const bf16, WS_SM + SM_W2T) + (size_t)kind * 64 * 256 + (size_t)col * 256 + kq * 8;
    f32x4 acc[4];
#pragma unroll
    for (int i = 0; i < 4; ++i) acc[i] = (f32x4){0.f, 0.f, 0.f, 0.f};
#pragma unroll
    for (int ks = 0; ks < 8; ++ks) { const bf16x8 hf = ld16(HC + ks * 32);
#pragma unroll
        for (int dt = 0; dt < 4; ++dt) { const bf16x8 wf = ld16(W2 + (size_t)dt * 16 * 256 + ks * 32); acc[dt] = kind ? mfma16(hf, wf, acc[dt]) : mfma16(wf, hf, acc[dt]); } }
    if (kind == 0) { bf16* KC = WSP(bf16, WS_SM + SM_KC) + (size_t)g * 1024 * 64;
#pragma unroll
        for (int dt = 0; dt < 4; ++dt) *(v2u*)(KC + (size_t)(rt * 16 + col) * 64 + dt * 16 + 4 * kq) = pack4(acc[dt]); }
    else { bf16* VCT = WSP(bf16, WS_SM + SM_VCT) + (size_t)g * 64 * 1024;
#pragma unroll
        for (int dt = 0; dt < 4; ++dt) *(v2u*)(VCT + (size_t)(dt * 16 + col) * 1024 + rt * 16 + 4 * kq) = pack4(acc[dt]); }
}

DI void p4_bias_table(Frame& F) {
    LAS float* bt = (LAS float*)(F.lds + BIAS_OFF); const float* rb = F.A->in[1];
    for (int i = F.tid; i < 129 * 8; i += NTHR) { const int dist = i >> 3, hd = i & 7; int b = dist;
        if (dist >= 16) { b = 16 + (int)(logf((float)dist / 16.0f) / 2.0794415416798357f * 16.0f); b = b < 31 ? b : 31; }
        bt[i] = rb[b * 8 + hd] * LOG2E; }
    __syncthreads();
    { LAS float* nb = (LAS float*)(F.lds + NEAR_OFF);
      for (int i = F.tid; i < 256 * 8; i += NTHR) { const int dist = (i >> 3) - 64; nb[i] = dist < 0 ? -1e30f : bt[(dist > 128 ? 128 : dist) * 8 + (i & 7)]; } }
    if (F.tid < 64) { float m = 0.f; for (int i = F.tid; i < 129 * 8; i += 64) m = fmaxf(m, fabsf(bt[i]));
#pragma unroll
        for (int o = 1; o < 64; o <<= 1) m = fmaxf(m, __shfl_xor(m, o));
        if (F.tid == 0) bt[129 * 8] = m; }
    __syncthreads();
}
DI void p4w_wg(Frame& F, int tA, int tB, int g) {
    const int lane = F.lane, w = F.wave, col = lane & 15, rq = lane >> 4, th = w >> 2, T0 = (th ? tB : tA) * 64, t0 = T0 + (w & 3) * 16, tq = t0 + col;
    LAS unsigned char* L = F.lds;
    const LAS float* bt = (const LAS float*)(L + BIAS_OFF); const float bmax = bt[129 * 8];
    const bf16* QA = WSP(const bf16, WS_QA); const bf16* KCV = WSP(const bf16, WS_KCV); const bf16* TOUT = WSP(const bf16, WS_TOUT); const bf16* GA = WSP(const bf16, WS_GA);
    const float kmax_win = sqrtf(__uint_as_float(F.ctl[CW_KMAX + 2 + g]));
    bf16x8 qf[4][2]; float bw[4], lw[4];
#pragma unroll
    for (int j = 0; j < 4; ++j) { float s = 0.f; lw[j] = 0.f;
#pragma unroll
        for (int ks = 0; ks < 2; ++ks) { const v4u q = *(const v4u*)(QA + (size_t)tq * 512 + (g * 4 + j) * 64 + ks * 32 + rq * 8); qf[j][ks] = __builtin_bit_cast(bf16x8, q);
            const float a0 = bflo(q.x), a1 = bfhi(q.x), a2 = bflo(q.y), a3 = bfhi(q.y), a4 = bflo(q.z), a5 = bfhi(q.z), a6 = bflo(q.w), a7 = bfhi(q.w);
            s += (a0 * a0 + a1 * a1) + (a2 * a2 + a3 * a3) + (a4 * a4 + a5 * a5) + (a6 * a6 + a7 * a7); }
        bw[j] = sqrtf(quad_sum(s)) * kmax_win + bmax; }
    const f32x4 z4 = {0.f, 0.f, 0.f, 0.f};
    f32x4 ACC[4][4];
#pragma unroll
    for (int j = 0; j < 4; ++j)
#pragma unroll
        for (int dt = 0; dt < 4; ++dt) ACC[j][dt] = z4;
    const int kkey = (w & 3) * 8 + (lane >> 3), kch = (lane & 7) ^ (lane >> 3), vd = (w & 3) * 16 + (lane >> 2), vch = (lane & 3) ^ ((lane >> 2) & 3);
    const int pbase = T0 - 544;
    LAS unsigned char* slot0 = L + th * 8192;
#define W_ISSUE(ti, sl) do { int p0_ = pbase + (ti) * 32; p0_ = p0_ < 0 ? 0 : p0_; \
        __builtin_amdgcn_global_load_lds((const unsigned*)(WSP(const bf16, WS_KCV + 12 * MiB) + ((size_t)g * S + p0_ + kkey) * 64 + kch * 8), (LAS unsigned*)(slot0 + (sl) * 16384 + (w & 3) * 1024), 16, 0, 0); \
        __builtin_amdgcn_global_load_lds((const unsigned*)(WSP(const bf16, WS_TOUT + 4 * MiB) + (((size_t)g * 512 + (p0_ >> 5)) * 64 + vd) * 32 + vch * 8), (LAS unsigned*)(slot0 + (sl) * 16384 + 4096 + (w & 3) * 1024), 16, 0, 0); } while (0)
#define W_KFRAG(ring, kt, ks) (*(const LAS bf16x8*)((ring) + ((kt) * 16 + col) * 128 + ((((ks) * 4 + rq) ^ (((kt) * 16 + col) & 7)) * 16)))
#define W_VLO(ring, d) (*(const LAS v2u*)((ring) + 4096 + (d) * 64 + ((((rq >> 1)) ^ ((d) & 3)) * 16) + (rq & 1) * 8))
#define W_VHI(ring, d) (*(const LAS v2u*)((ring) + 4096 + (d) * 64 + ((((rq >> 1) + 2) ^ ((d) & 3)) * 16) + (rq & 1) * 8))
    asm volatile("s_waitcnt vmcnt(0) lgkmcnt(0)" ::: "memory"); __builtin_amdgcn_s_barrier();
    constexpr int NT = 19, DIST = 7;
#pragma unroll 1
    for (int i = 0; i < DIST; ++i) W_ISSUE(i, i);
#pragma unroll 1
    for (int i = 0; i < NT; ++i) {
        const int rem = NT - 1 - i < DIST - 1 ? NT - 1 - i : DIST - 1;
        if (rem >= 6) asm volatile("s_waitcnt vmcnt(12)" ::: "memory"); else if (rem == 5) asm volatile("s_waitcnt vmcnt(10)" ::: "memory"); else if (rem == 4) asm volatile("s_waitcnt vmcnt(8)" ::: "memory");
        else if (rem == 3) asm volatile("s_waitcnt vmcnt(6)" ::: "memory"); else if (rem == 2) asm volatile("s_waitcnt vmcnt(4)" ::: "memory"); else if (rem == 1) asm volatile("s_waitcnt vmcnt(2)" ::: "memory"); else asm volatile("s_waitcnt vmcnt(0)" ::: "memory");
        asm volatile("s_waitcnt lgkmcnt(0)" ::: "memory"); __builtin_amdgcn_s_barrier(); asm volatile("" ::: "memory");
        if (i + DIST < NT) W_ISSUE(i + DIST, (i + DIST) & 7);
        const int p0 = pbase + i * 32;
        if (p0 < 0 || p0 > t0 + 15 || p0 + 31 < t0 - 511) continue;
        const LAS unsigned char* ring = slot0 + (i & 7) * 16384;
        const bool farw = (p0 + 31 <= t0 - 128) && (p0 > t0 + 15 - 512);
        bf16x8 kf[2][2], vf[4];
#pragma unroll
        for (int kt = 0; kt < 2; ++kt)
#pragma unroll
            for (int ks = 0; ks < 2; ++ks) kf[kt][ks] = W_KFRAG(ring, kt, ks);
#pragma unroll
        for (int dt = 0; dt < 4; ++dt) { const v2u lo = W_VLO(ring, dt * 16 + col), hi = W_VHI(ring, dt * 16 + col); v4u v = {lo.x, lo.y, hi.x, hi.y}; vf[dt] = __builtin_bit_cast(bf16x8, v); }
#pragma unroll
        for (int j = 0; j < 4; ++j) {
            f32x4 p[2];
#pragma unroll
            for (int kt = 0; kt < 2; ++kt) { f32x4 s = mfma16(kf[kt][0], qf[j][0], z4); s = mfma16(kf[kt][1], qf[j][1], s);
                if (farw) { const float cf = bt[128 * 8 + g * 4 + j] - bw[j];
#pragma unroll
                    for (int e = 0; e < 4; ++e) { const float v = __builtin_amdgcn_exp2f(s[e] + cf); p[kt][e] = v; lw[j] += v; }
                } else {
#pragma unroll
                    for (int e = 0; e < 4; ++e) { const int dist = tq - (p0 + kt * 16 + 4 * rq + e); const int dc = dist < 0 ? 0 : (dist > 128 ? 128 : dist);
                        const float v = (dist >= 0 && dist < 512) ? __builtin_amdgcn_exp2f(s[e] + bt[dc * 8 + g * 4 + j] - bw[j]) : 0.f; p[kt][e] = v; lw[j] += v; } } }
            const bf16x8 pb = pack8(p[0], p[1]);
#pragma unroll
            for (int dt = 0; dt < 4; ++dt) ACC[j][dt] = mfma16(vf[dt], pb, ACC[j][dt]);
        }
    }
    bf16* PW = WSP(bf16, WS_H) + (size_t)tq * 512 + g * 256;
#pragma unroll
    for (int j = 0; j < 4; ++j) { const float sc = bf1(GA[(size_t)tq * 32 + 16 + g * 4 + j]) / quad_sum(lw[j]);
#pragma unroll
        for (int dt = 0; dt < 4; ++dt) *(v2u*)(PW + j * 64 + dt * 16 + 4 * rq) = pack4(ACC[j][dt] * sc); }
    asm volatile("s_waitcnt vmcnt(0) lgkmcnt(0)" ::: "memory"); __builtin_amdgcn_s_barrier(); asm volatile("" ::: "memory");
#undef W_ISSUE
#undef W_KFRAG
#undef W_VLO
#undef W_VHI
}
DI void p4a_unit(Frame& F, int g, int nW, int qtW0, int qtW1, bool doC, int qtC) {
    const int lane = F.lane, col = lane & 15, rq = lane >> 4;
    LAS float* wl = (LAS float*)(F.lds + F.wave * WAVE_LDS);
    const LAS float* bt = (const LAS float*)(F.lds + BIAS_OFF);
    const float bmax = bt[129 * 8];
    const bf16* QA = WSP(const bf16, WS_QA); const bf16* KCV = WSP(const bf16, WS_KCV); const bf16* TOUT = WSP(const bf16, WS_TOUT); const bf16* GA = WSP(const bf16, WS_GA);
    const bf16* KC = WSP(const bf16, WS_SM + SM_KC) + (size_t)g * 1024 * 64; const bf16* VCT = WSP(const bf16, WS_SM + SM_VCT) + (size_t)g * 64 * 1024;
    const float kmax_sel = sqrtf(__uint_as_float(F.ctl[CW_KMAX + g])), kmax_win = sqrtf(__uint_as_float(F.ctl[CW_KMAX + 2 + g]));
    const f32x4 z4 = {0.f, 0.f, 0.f, 0.f};
    bf16x8 qf[4][2]; float qn[4]; f32x4 ACC[4][4];
    if (!doC) return;
    const int qt = qtC, t0 = qt * 16, tq = t0 + col;
#pragma unroll
    for (int j = 0; j < 4; ++j) { float s = 0.f;
#pragma unroll
        for (int ks = 0; ks < 2; ++ks) { const v4u q = *(const v4u*)(QA + (size_t)tq * 512 + (g * 4 + j) * 64 + ks * 32 + rq * 8); qf[j][ks] = __builtin_bit_cast(bf16x8, q);
            const float a0 = bflo(q.x), a1 = bfhi(q.x), a2 = bflo(q.y), a3 = bfhi(q.y), a4 = bflo(q.z), a5 = bfhi(q.z), a6 = bflo(q.w), a7 = bfhi(q.w);
            s += (a0 * a0 + a1 * a1) + (a2 * a2 + a3 * a3) + (a4 * a4 + a5 * a5) + (a6 * a6 + a7 * a7); }
        qn[j] = sqrtf(quad_sum(s)); }
#pragma unroll
    for (int j = 0; j < 4; ++j)
#pragma unroll
        for (int dt = 0; dt < 4; ++dt) ACC[j][dt] = z4;
    const int nkc = qt < 1023 ? qt : 1023, nst = (nkc + 31) >> 5;
    float m1[4], l1[4];
#pragma unroll
    for (int j = 0; j < 4; ++j) { m1[j] = -1e30f; l1[j] = 0.f; }
    for (int st = 0; st < nst; ++st) {
        const bool farc = 16 * (st * 32 + 31) + 31 <= t0 - 128;
        bf16x8 kf[2][2]; const int stl = st;
#pragma unroll
        for (int kt = 0; kt < 2; ++kt)
#pragma unroll
            for (int ks = 0; ks < 2; ++ks) kf[kt][ks] = ld16(KC + (size_t)(stl * 32 + kt * 16 + col) * 64 + ks * 32 + rq * 8);
#pragma unroll
        for (int j = 0; j < 4; ++j) {
            float sv[8]; float tm = -1e30f;
#pragma unroll
            for (int kt = 0; kt < 2; ++kt) { f32x4 s = mfma16(kf[kt][0], qf[j][0], z4); s = mfma16(kf[kt][1], qf[j][1], s);
                if (farc) { const float bf_ = bt[128 * 8 + g * 4 + j];
#pragma unroll
                    for (int e = 0; e < 4; ++e) { const float v = s[e] + bf_; sv[kt * 4 + e] = v; tm = fmaxf(tm, v); }
                } else {
#pragma unroll
                for (int e = 0; e < 4; ++e) { const int ci = st * 32 + kt * 16 + 4 * rq + e, dist = tq - (16 * ci + 31); const int dc = dist < 0 ? 0 : (dist > 128 ? 128 : dist);
                    const float v = dist >= 0 ? s[e] + bt[dc * 8 + g * 4 + j] : -1e30f; sv[kt * 4 + e] = v; tm = fmaxf(tm, v); } } }
            const float mn = fmaxf(m1[j], tm); float ls = 0.f;
#pragma unroll
            for (int e = 0; e < 8; ++e) ls += sv[e] > -1e29f ? __builtin_amdgcn_exp2f(sv[e] - mn) : 0.f;
            l1[j] = l1[j] * __builtin_amdgcn_exp2f(m1[j] - mn) + ls; m1[j] = mn;
        }
    }
    float mc[4], ilc[4];
#pragma unroll
    for (int j = 0; j < 4; ++j) { const float M = quad_max(m1[j]); const float l = quad_sum(l1[j] * __builtin_amdgcn_exp2f(m1[j] - M)); mc[j] = M; ilc[j] = l > 0.f ? 1.0f / l : 0.f; }
    {
        float gcmp[4];
#pragma unroll
        for (int j = 0; j < 4; ++j) gcmp[j] = bf1(GA[(size_t)tq * 32 + g * 4 + j]);
        float xprev = 0.f;
        for (int st = 0; st < nst; ++st) {
            const bool farc = 16 * (st * 32 + 31) + 31 <= t0 - 128;
            bf16x8 kf[2][2], vf[4]; const int stl = st;
#pragma unroll
            for (int kt = 0; kt < 2; ++kt)
#pragma unroll
                for (int ks = 0; ks < 2; ++ks) kf[kt][ks] = ld16(KC + (size_t)(stl * 32 + kt * 16 + col) * 64 + ks * 32 + rq * 8);
#pragma unroll
            for (int dt = 0; dt < 4; ++dt) vf[dt] = ld8x2(VCT + (size_t)(dt * 16 + col) * 1024 + stl * 32 + 4 * rq, 16);
            f32x4 ps[2] = {z4, z4};
#pragma unroll
            for (int j = 0; j < 4; ++j) {
                f32x4 p[2];
#pragma unroll
                for (int kt = 0; kt < 2; ++kt) { f32x4 s = mfma16(kf[kt][0], qf[j][0], z4); s = mfma16(kf[kt][1], qf[j][1], s);
                    if (farc) { const float cf = bt[128 * 8 + g * 4 + j] - mc[j];
#pragma unroll
                        for (int e = 0; e < 4; ++e) { const float v = __builtin_amdgcn_exp2f(s[e] + cf) * ilc[j]; ps[kt][e] += v; p[kt][e] = v * gcmp[j]; }
                    } else {
#pragma unroll
                    for (int e = 0; e < 4; ++e) { const int ci = st * 32 + kt * 16 + 4 * rq + e, dist = tq - (16 * ci + 31); const int dc = dist < 0 ? 0 : (dist > 128 ? 128 : dist);
                        const float v = dist >= 0 ? __builtin_amdgcn_exp2f(s[e] + bt[dc * 8 + g * 4 + j] - mc[j]) * ilc[j] : 0.f; ps[kt][e] += v; p[kt][e] = v * gcmp[j]; } } }
                const bf16x8 pb = pack8(p[0], p[1]);
#pragma unroll
                for (int dt = 0; dt < 4; ++dt) ACC[j][dt] = mfma16(vf[dt], pb, ACC[j][dt]);
            }
#pragma unroll
            for (int kt = 0; kt < 2; ++kt) {
                const float Gs = (ps[kt][0] + ps[kt][1]) + (ps[kt][2] + ps[kt][3]), X = ps[kt][3];
                const float xa = __shfl(X, (lane + 48) & 63), xb = __shfl(xprev, (lane + 48) & 63);
                const float xin = rq > 0 ? xa : xb;
                wl[col * 257 + st * 8 + kt * 4 + rq] = Gs + xin; xprev = X;
            }
        }
    }
    { bf16* PC = WSP(bf16, WS_H + 16 * MiB) + (size_t)tq * 512 + g * 256;
#pragma unroll
      for (int j = 0; j < 4; ++j)
#pragma unroll
          for (int dt = 0; dt < 4; ++dt) *(v2u*)(PC + j * 64 + dt * 16 + 4 * rq) = pack4(ACC[j][dt]); }
    LDS_WAIT();
    unsigned long long* SELM = (unsigned long long*)(F.ws + WS_WR);
    for (int i0 = 0; i0 < 16; i0 += 4) {
        const int cur = (t0 + i0) >> 6; unsigned k[4][4], T[4] = {0u, 0u, 0u, 0u};
#pragma unroll
        for (int qq = 0; qq < 4; ++qq)
#pragma unroll
            for (int e = 0; e < 4; ++e) { const int n = lane * 4 + e; const float v = wl[(i0 + qq) * 257 + n];
                k[qq][e] = (n == 0 || (n <= cur && n + 2 > cur)) ? 0x7F000000u : (n <= cur ? __float_as_uint(v) + 1u : 0u); }
#pragma unroll 1
        for (int bit = 30; bit >= 0; --bit) {
#pragma unroll
            for (int qq = 0; qq < 4; ++qq) { const unsigned c = T[qq] | (1u << bit);
                const int cnt = __popcll(__ballot(k[qq][0] >= c)) + __popcll(__ballot(k[qq][1] >= c)) + __popcll(__ballot(k[qq][2] >= c)) + __popcll(__ballot(k[qq][3] >= c));
                if (cnt >= 16) T[qq] = c; } }
#pragma unroll
        for (int qq = 0; qq < 4; ++qq) {
            unsigned long long bsel[4]; int ngt = 0;
#pragma unroll
            for (int e = 0; e < 4; ++e) { bsel[e] = __ballot(k[qq][e] > T[qq] && k[qq][e] != 0u); ngt += __popcll(bsel[e]); }
            if (T[qq] != 0u) {
                int need = 16 - ngt;
                unsigned long long beq[4];
#pragma unroll
                for (int e = 0; e < 4; ++e) beq[e] = __ballot(k[qq][e] == T[qq]);
                while (need > 0) {
                    int bestn = 1 << 30, be = 0;
#pragma unroll
                    for (int e = 0; e < 4; ++e) if (beq[e]) { const int n = 4 * (__ffsll((long long)beq[e]) - 1) + e; if (n < bestn) { bestn = n; be = e; } }
                    if (bestn == (1 << 30)) break;
                    const unsigned long long bitm = 1ull << (bestn >> 2);
                    if (be == 0) { bsel[0] |= bitm; beq[0] &= ~bitm; } else if (be == 1) { bsel[1] |= bitm; beq[1] &= ~bitm; } else if (be == 2) { bsel[2] |= bitm; beq[2] &= ~bitm; } else { bsel[3] |= bitm; beq[3] &= ~bitm; }
                    --need;
                }
            }
            if (lane < 4) SELM[((size_t)(t0 + i0 + qq) * 2 + g) * 4 + lane] = lane == 0 ? bsel[0] : (lane == 1 ? bsel[1] : (lane == 2 ? bsel[2] : bsel[3]));
        }
    }
    LDS_WAIT();
}
DI void p4b_pass(LAS unsigned char* ldsb, unsigned char* ws, float* outp, int tA, int tB, int g) {
    Frame F; F.lds = ldsb; F.ws = ws; F.out = outp; F.ctl = (unsigned*)(ws + WS_CTL); F.tid = threadIdx.x; F.lane = F.tid & 63; F.wave = __builtin_amdgcn_readfirstlane(F.tid >> 6); F.G = gridDim.x; F.gw = 0; F.ngw = 0; F.A = nullptr;
    const int lane = F.lane, w = F.wave, col = lane & 15, rq = lane >> 4, hj = col & 3;
    LAS unsigned char* L = F.lds;
    const LAS float* bt = (const LAS float*)(L + BIAS_OFF); const float bmax = bt[129 * 8];
    const bf16* QA = WSP(const bf16, WS_QA); const bf16* KCV = WSP(const bf16, WS_KCV); const bf16* TOUT = WSP(const bf16, WS_TOUT); const bf16* GA = WSP(const bf16, WS_GA);
    const float kmax_sel = sqrtf(__uint_as_float(F.ctl[CW_KMAX + g]));
    const unsigned long long* SELM = (const unsigned long long*)(F.ws + WS_WR);
    bf16x8 qb[4][2]; float bnd[4]; int tq[4];
    LAS unsigned long long* PKL = (LAS unsigned long long*)(L + 131072) + w * 64;
#pragma unroll
    for (int ct = 0; ct < 4; ++ct) { const int t = (ct < 2 ? tA : tB) * 64 + w * 8 + (ct & 1) * 4 + (col >> 2); tq[ct] = t; float s = 0.f;
#pragma unroll
        for (int ks = 0; ks < 2; ++ks) { const v4u q = *(const v4u*)(QA + (size_t)t * 512 + (g * 4 + hj) * 64 + ks * 32 + rq * 8); qb[ct][ks] = __builtin_bit_cast(bf16x8, q);
            const float a0 = bflo(q.x), a1 = bfhi(q.x), a2 = bflo(q.y), a3 = bfhi(q.y), a4 = bflo(q.z), a5 = bfhi(q.z), a6 = bflo(q.w), a7 = bfhi(q.w);
            s += (a0 * a0 + a1 * a1) + (a2 * a2 + a3 * a3) + (a4 * a4 + a5 * a5) + (a6 * a6 + a7 * a7); }
        bnd[ct] = sqrtf(quad_sum(s)) * kmax_sel + bmax; }
    { const int q = lane >> 2, e = lane & 3; const int t = ((q >> 3) ? tB : tA) * 64 + w * 8 + (q & 7); const unsigned long long wv = SELM[((size_t)t * 2 + g) * 4 + e];
      LAS unsigned* P2 = (LAS unsigned*)PKL; P2[q * 8 + e] = (unsigned)wv; P2[q * 8 + 4 + e] = (unsigned)(wv >> 32); }
    asm volatile("s_waitcnt vmcnt(0) lgkmcnt(0)" ::: "memory");
    const f32x4 z4 = {0.f, 0.f, 0.f, 0.f};
    f32x4 O[4][4]; float ls[4] = {0.f, 0.f, 0.f, 0.f};
#pragma unroll
    for (int ct = 0; ct < 4; ++ct)
#pragma unroll
        for (int dt = 0; dt < 4; ++dt) O[ct][dt] = z4;
    const float bfar = bt[128 * 8 + g * 4 + hj];
    const int dr = lane >> 3, dc = (lane & 7) ^ dr, nb = tB + 1;
    const bf16* kbase = WSP(const bf16, WS_KCV + 8 * MiB) + ((size_t)g * S + w * 8 + dr) * 64 + dc * 8;
    const bf16* vbase = TOUT + (((size_t)g * 256) * 64 + w * 8 + dr) * 64 + dc * 8;
#define P4B_ISSUE(blk_, slot) do { \
        __builtin_amdgcn_global_load_lds((const unsigned*)(kbase + (size_t)(blk_) * 4096), (LAS unsigned*)(L + (slot) * 16384 + w * 1024), 16, 0, 0); \
        __builtin_amdgcn_global_load_lds((const unsigned*)(vbase + (size_t)(blk_) * 4096), (LAS unsigned*)(L + (slot) * 16384 + 8192 + w * 1024), 16, 0, 0); } while (0)
    asm volatile("s_waitcnt vmcnt(0)" ::: "memory");
    __builtin_amdgcn_s_barrier();
    const int ngrp = (nb + 3) >> 2;
#pragma unroll 1
    for (int b4 = 0; b4 < 4; ++b4) if (b4 < nb) P4B_ISSUE(b4, b4);
#pragma unroll 1
    for (int gi = 0; gi < ngrp; ++gi) {
        asm volatile("s_waitcnt vmcnt(0)" ::: "memory");
        asm volatile("s_waitcnt lgkmcnt(0)" ::: "memory"); __builtin_amdgcn_s_barrier(); asm volatile("" ::: "memory");
#pragma unroll 1
        for (int b4 = 0; b4 < 4; ++b4) { const int nblk = (gi + 1) * 4 + b4; if (nblk < nb) P4B_ISSUE(nblk, ((gi + 1) & 1) * 4 + b4); }
        unsigned pm = 0u;
        { const int hsel = (gi >> 5) * 4, sh = gi & 31;
#pragma unroll
          for (int ct = 0; ct < 4; ++ct) { const v4u x = *(const LAS v4u*)((const LAS unsigned*)PKL + (ct * 4 + (col >> 2)) * 8 + hsel);
              pm |= (((x.x >> sh) & 1u) | (((x.y >> sh) & 1u) << 1) | (((x.z >> sh) & 1u) << 2) | (((x.w >> sh) & 1u) << 3)) << (ct * 4); } }
        const unsigned am = (unsigned)__builtin_amdgcn_readlane((int)pm, 0) | (unsigned)__builtin_amdgcn_readlane((int)pm, 4) | (unsigned)__builtin_amdgcn_readlane((int)pm, 8) | (unsigned)__builtin_amdgcn_readlane((int)pm, 12);
#pragma unroll 1
      for (int b4 = 0; b4 < 4; ++b4) {
        const int blk = gi * 4 + b4; if (blk >= nb) break;
        const LAS unsigned char* ring = L + ((gi & 1) * 4 + b4) * 16384;
#pragma unroll
        for (int ct = 0; ct < 4; ++ct) {
            if (!((am >> (ct * 4 + b4)) & 1u)) continue;
            const bool pick = (pm >> (ct * 4 + b4)) & 1u;
            const int cur = ct < 2 ? tA : tB;
            const bool farb = blk + 3 <= cur;
            const float binit = pick ? (farb ? bfar - bnd[ct] : -bnd[ct]) : -1e30f; const f32x4 cinit = {binit, binit, binit, binit};
            bf16x8 kf[4][2];
#pragma unroll
            for (int kt = 0; kt < 4; ++kt) { const int key = kt * 16 + col;
                kf[kt][0] = *(const LAS bf16x8*)(ring + key * 128 + ((rq ^ (key & 7)) * 16)); kf[kt][1] = *(const LAS bf16x8*)(ring + key * 128 + (((4 + rq) ^ (key & 7)) * 16)); }
            asm volatile("s_waitcnt lgkmcnt(0)" ::: "memory");
            f32x4 sacc[4];
#pragma unroll
            for (int kt = 0; kt < 4; ++kt) sacc[kt] = mfma16(kf[kt][0], qb[ct][0], cinit);
#pragma unroll
            for (int kt = 0; kt < 4; ++kt) sacc[kt] = mfma16(kf[kt][1], qb[ct][1], sacc[kt]);
            if (farb) {
#pragma unroll
                for (int kt = 0; kt < 4; ++kt)
#pragma unroll
                    for (int e = 0; e < 4; ++e) sacc[kt][e] = __builtin_amdgcn_exp2f(sacc[kt][e]);
            } else {
                const LAS float* nbp = (const LAS float*)(L + NEAR_OFF) + (tq[ct] + 64 - blk * 64 - 4 * rq) * 8 + g * 4 + hj;
#pragma unroll
                for (int kt = 0; kt < 4; ++kt)
#pragma unroll
                    for (int e = 0; e < 4; ++e) sacc[kt][e] = __builtin_amdgcn_exp2f(sacc[kt][e] + nbp[-(kt * 16 + e) * 8]);
            }
            ls[ct] = addf(ls[ct], addf(addf(addf(addf(sacc[0][0], sacc[0][1]), addf(sacc[0][2], sacc[0][3])), addf(addf(sacc[1][0], sacc[1][1]), addf(sacc[1][2], sacc[1][3]))), addf(addf(addf(sacc[2][0], sacc[2][1]), addf(sacc[2][2], sacc[2][3])), addf(addf(sacc[3][0], sacc[3][1]), addf(sacc[3][2], sacc[3][3])))));
            const bf16x8 pb0 = pack8(sacc[0], sacc[1]), pb1 = pack8(sacc[2], sacc[3]);
#pragma unroll
            for (int dt = 0; dt < 4; ++dt) { const int d = dt * 16 + col; const LAS unsigned char* vr = ring + 8192 + d * 128; const int sw = d & 7;
                const bf16x8 v0 = *(const LAS bf16x8*)(vr + ((rq ^ sw) * 16)), v1 = *(const LAS bf16x8*)(vr + (((4 + rq) ^ sw) * 16));
                O[ct][dt] = mfma16(v0, pb0, O[ct][dt]); O[ct][dt] = mfma16(v1, pb1, O[ct][dt]); }
        }
      }
    }
#pragma unroll
    for (int ct = 0; ct < 4; ++ct) { const int t = tq[ct]; const float sc = bf1(GA[(size_t)t * 32 + 8 + g * 4 + hj]) / quad_sum(ls[ct]);
        const bf16* pw = WSP(const bf16, WS_H) + (size_t)t * 512 + g * 256 + hj * 64; const bf16* pc = WSP(const bf16, WS_H + 16 * MiB) + (size_t)t * 512 + g * 256 + hj * 64; bf16* ya = WSP(bf16, WS_QA) + (size_t)t * 512 + (g * 4 + hj) * 64;
#pragma unroll
        for (int dt = 0; dt < 4; ++dt) { const v2u a = *(const v2u*)(pw + dt * 16 + 4 * rq), b = *(const v2u*)(pc + dt * 16 + 4 * rq);
            f32x4 o = O[ct][dt] * sc; o[0] += bflo(a.x) + bflo(b.x); o[1] += bfhi(a.x) + bfhi(b.x); o[2] += bflo(a.y) + bflo(b.y); o[3] += bfhi(a.y) + bfhi(b.y); *(v2u*)(ya + dt * 16 + 4 * rq) = pack4(o); } }
    asm volatile("s_waitcnt vmcnt(0) lgkmcnt(0)" ::: "memory");
#undef P4B_ISSUE
}
DI void p4_ret_wg(Frame& F, int u) {
    const int c = u >> 2, h = u & 3, q8 = F.wave, lane = F.lane, col = lane & 15, rq = lane >> 4;
    const int il = q8 * 16 + col, tq = c * 128 + il;
    const float l2g = log2f(1.0f - __builtin_amdgcn_exp2f((float)(-5 - h)));
    const bf16* QR = WSP(const bf16, WS_QR); const bf16* KR = WSP(const bf16, WS_KR); const bf16* TOUT = WSP(const bf16, WS_TOUT); LAS unsigned char* L = F.lds;
    const bf16* RT = WSP(const bf16, WS_UR) + ((size_t)(c * 4 + h) * 256) * 128;
    asm volatile("s_waitcnt vmcnt(0) lgkmcnt(0)" ::: "memory"); __builtin_amdgcn_s_barrier();
    dma_rows256(RT, 128, 256, L, F.wave, lane);
    bf16x8 qf[4];
#pragma unroll
    for (int ks = 0; ks < 4; ++ks) qf[ks] = ld16(QR + (size_t)tq * 512 + h * 128 + ks * 32 + rq * 8);
    asm volatile("s_waitcnt vmcnt(0)" ::: "memory"); __builtin_amdgcn_s_barrier(); asm volatile("" ::: "memory");
    f32x4 ACC[16]; const f32x4 z4 = {0.f, 0.f, 0.f, 0.f};
#pragma unroll
    for (int i = 0; i < 16; ++i) ACC[i] = z4;
#pragma unroll
    for (int ks = 0; ks < 4; ++ks)
#pragma unroll
        for (int dvt = 0; dvt < 16; ++dvt) ACC[dvt] = mfma16(frag256(L, dvt * 16 + col, ks * 4 + rq), qf[ks], ACC[dvt]);
    { const float qd = __builtin_amdgcn_exp2f((float)(il + 1) * l2g);
#pragma unroll
      for (int i = 0; i < 16; ++i) ACC[i] = ACC[i] * qd; }
    asm volatile("s_waitcnt lgkmcnt(0)" ::: "memory"); __builtin_amdgcn_s_barrier(); asm volatile("" ::: "memory");
    dma_rows256(TOUT + (size_t)(768 + h * 256) * TP + c * 128, TP, 256, L, F.wave, lane);
    dma_rows256(KR + (size_t)(c * 128) * 512 + h * 128, 512, 128, L + 65536, F.wave, lane);
    asm volatile("s_waitcnt vmcnt(0)" ::: "memory"); __builtin_amdgcn_s_barrier(); asm volatile("" ::: "memory");
    const int nkp = (q8 * 16 + 16 + 31) >> 5;
    for (int kp = 0; kp < nkp; ++kp) {
        f32x4 p[2];
#pragma unroll
        for (int kt = 0; kt < 2; ++kt) { f32x4 s = z4;
#pragma unroll
            for (int ks = 0; ks < 4; ++ks) s = mfma16(frag256(L + 65536, kp * 32 + kt * 16 + col, ks * 4 + rq), qf[ks], s);
#pragma unroll
            for (int e = 0; e < 4; ++e) { const int dj = il - (kp * 32 + kt * 16 + 4 * rq + e); p[kt][e] = dj >= 0 ? s[e] * __builtin_amdgcn_exp2f((float)dj * l2g) : 0.f; } }
        const bf16x8 pb = pack8(p[0], p[1]);
#pragma unroll
        for (int dvt = 0; dvt < 16; ++dvt) { const v2u lo = frag256h(L, dvt * 16 + col, kp * 4 + (rq >> 1), rq & 1), hi = frag256h(L, dvt * 16 + col, kp * 4 + 2 + (rq >> 1), rq & 1);
            v4u v = {lo.x, lo.y, hi.x, hi.y}; ACC[dvt] = mfma16(__builtin_bit_cast(bf16x8, v), pb, ACC[dvt]); }
    }
    float s1 = 0.f;
#pragma unroll
    for (int i = 0; i < 16; ++i) s1 += (ACC[i][0] + ACC[i][1]) + (ACC[i][2] + ACC[i][3]);
    const float mu = quad_sum(s1) * (1.0f / 256.0f); float s2 = 0.f;
#pragma unroll
    for (int i = 0; i < 16; ++i) { ACC[i] = ACC[i] - mu; s2 += (ACC[i][0] * ACC[i][0] + ACC[i][1] * ACC[i][1]) + (ACC[i][2] * ACC[i][2] + ACC[i][3] * ACC[i][3]); }
    const float rs = 1.0f / sqrtf(quad_sum(s2) * (1.0f / 256.0f) + EPS);
    bf16* GR = WSP(bf16, WS_GR) + (size_t)tq * 1024 + h * 256; const float* rn = F.A->in[10] + h * 256;
#pragma unroll
    for (int dvt = 0; dvt < 16; ++dvt) { const int d0 = dvt * 16 + 4 * rq; const v2u gv = *(const v2u*)(GR + d0); const f32x4 w = *(const f32x4*)(rn + d0);
        f32x4 o; o[0] = siluf_(bflo(gv.x)) * ACC[dvt][0] * rs * w[0]; o[1] = siluf_(bfhi(gv.x)) * ACC[dvt][1] * rs * w[1]; o[2] = siluf_(bflo(gv.y)) * ACC[dvt][2] * rs * w[2]; o[3] = siluf_(bfhi(gv.y)) * ACC[dvt][3] * rs * w[3];
        *(v2u*)(GR + d0) = pack4(o); }
}

DI int moe_row(int f) { const int fp = f & 127; return (f >> 7) * 256 + 128 * (fp >> 6) + 32 * ((fp >> 4) & 3) + 4 * ((fp >> 2) & 3) + (fp & 3); }
DI void p8_route_item(Frame& F, int item) {
    const int lane = F.lane, row = lane & 15, kq = lane >> 4, m0 = item * 16, slot = F.wave & 3, hh = F.wave >> 2; const float* x1 = F.out; bf16* H2 = WSP(bf16, WS_H);
    LAS float* lg = (LAS float*)(F.lds + slot * WAVE_LDS);
    LAS float* ex = (LAS float*)(F.lds + slot * WAVE_LDS + 3200);
    const float* WRT = WSP(const float, WS_SM + SM_WRT);
    const float* xr = x1 + (size_t)(m0 + row) * 1024 + 4 * kq + hh * 512; const float* wr = WRT + (size_t)row * 1024 + 4 * kq + hh * 512;
    f32x4 acc[3]; float ss = 0.f;
#pragma unroll
    for (int ct = 0; ct < 3; ++ct) acc[ct] = (f32x4){0.f, 0.f, 0.f, 0.f};
#pragma unroll 8
    for (int c = 0; c < 32; ++c) {
        const f32x4 xa = *(const f32x4*)(xr + 16 * c); ss += (xa[0] * xa[0] + xa[1] * xa[1]) + (xa[2] * xa[2] + xa[3] * xa[3]);
#pragma unroll
        for (int ct = 0; ct < 3; ++ct) { const f32x4 wb = *(const f32x4*)(wr + (size_t)ct * 16 * 1024 + 16 * c);
#pragma unroll
            for (int j = 0; j < 4; ++j) acc[ct] = __builtin_amdgcn_mfma_f32_16x16x4f32(xa[j], wb[j], acc[ct], 0, 0, 0); }
    }
    if (hh == 1) {
#pragma unroll
        for (int ct = 0; ct < 3; ++ct)
#pragma unroll
            for (int j = 0; j < 4; ++j) ex[(ct * 4 + j) * 64 + lane] = acc[ct][j];
        ex[12 * 64 + lane] = ss;
    }
    LDS_WAIT(); __syncthreads();
    LAS unsigned* lcnt = (LAS unsigned*)(F.lds + 4 * WAVE_LDS);
    if (F.tid < 64) lcnt[F.tid] = 0u;
    int ex1 = 0, ex2 = 0; unsigned lr1 = 0u, lr2 = 0u; float w1 = 0.f, w2 = 0.f;
    if (hh == 0) {
#pragma unroll
        for (int ct = 0; ct < 3; ++ct)
#pragma unroll
            for (int j = 0; j < 4; ++j) acc[ct][j] += ex[(ct * 4 + j) * 64 + lane];
        ss += ex[12 * 64 + lane];
        const float rs = 1.0f / sqrtf(quad_sum(ss) * (1.0f / 1024.0f) + EPS);
        if (kq == 0) lg[16 * 48 + row] = rs;
#pragma unroll
        for (int ct = 0; ct < 3; ++ct)
#pragma unroll
            for (int j = 0; j < 4; ++j) lg[(4 * kq + j) * 48 + ct * 16 + row] = acc[ct][j];
    }
    LDS_WAIT(); __syncthreads();
    if (hh == 0 && lane < 16) {
        const float rst = lg[16 * 48 + lane]; float l[36];
#pragma unroll
        for (int o = 0; o < 36; ++o) l[o] = lg[lane * 48 + o] * rst + (o < 4 ? F.A->in[16][o] : F.A->in[18][o - 4]);
        int grp = 0; float mg = l[0];
#pragma unroll
        for (int i = 1; i < 4; ++i) if (l[i] > mg) { mg = l[i]; grp = i; }
        float Z = 0.f;
#pragma unroll
        for (int i = 0; i < 4; ++i) Z += expf(l[i] - mg);
        const float pg = 1.0f / Z;
        float le[8];
#pragma unroll
        for (int i = 0; i < 8; ++i) le[i] = grp == 0 ? l[4 + i] : (grp == 1 ? l[12 + i] : (grp == 2 ? l[20 + i] : l[28 + i]));
        int i1 = 0; float v1 = le[0];
#pragma unroll
        for (int i = 1; i < 8; ++i) if (le[i] > v1) { v1 = le[i]; i1 = i; }
        int i2 = -1; float v2 = -3.0e38f;
#pragma unroll
        for (int i = 0; i < 8; ++i) if (i != i1 && le[i] > v2) { v2 = le[i]; i2 = i; }
        const float e2 = expf(v2 - v1); w1 = pg / (1.0f + e2); w2 = pg * e2 / (1.0f + e2);
        ex1 = grp * 8 + i1; ex2 = grp * 8 + i2;
        lr1 = __hip_atomic_fetch_add(lcnt + ex1, 1u, __ATOMIC_RELAXED, __HIP_MEMORY_SCOPE_WORKGROUP); lr2 = __hip_atomic_fetch_add(lcnt + ex2, 1u, __ATOMIC_RELAXED, __HIP_MEMORY_SCOPE_WORKGROUP);
    }
    LDS_WAIT(); __syncthreads();
    if (F.tid < 32) { const unsigned n = lcnt[F.tid]; lcnt[32 + F.tid] = n ? atomicAdd(F.ctl + CW_CNT + F.tid, n) : 0u; }
    LDS_WAIT(); __syncthreads();
    if (hh == 0 && lane < 16) {
        const int t = m0 + lane; v2u* LIST = WSP(v2u, WS_XS);
        LIST[(size_t)ex1 * 16384 + lcnt[32 + ex1] + lr1] = (v2u){(unsigned)(t * 2 + 0), __float_as_uint(w1)};
        LIST[(size_t)ex2 * 16384 + lcnt[32 + ex2] + lr2] = (v2u){(unsigned)(t * 2 + 1), __float_as_uint(w2)};
    }
    { f32x4 w[4]; load_row(F.A->in[14], lane, w);
#pragma unroll 4
      for (int r8 = 0; r8 < 8; ++r8) { const int r = hh * 8 + r8; f32x4 v[4]; load_row(x1 + (size_t)(m0 + r) * 1024, lane, v); const float rst = lg[16 * 48 + r];
#pragma unroll
        for (int j = 0; j < 4; ++j) *(v2u*)(H2 + (size_t)(m0 + r) * 1024 + 4 * lane + 256 * j) = pack4(v[j] * rst * w[j]); } }
    LDS_WAIT(); __syncthreads();
}
DI void p8_moe_weights(Frame& F) {
    LAS float* scr = (LAS float*)(F.lds + F.wave * WAVE_LDS + 4096);
    bf16* WGU = WSP(bf16, WS_MOEW); bf16* WD = WGU + (size_t)32 * 512 * 1024;
    for (int it = F.gw; it < 3 * 4096; it += F.ngw) {
        const int which = it >> 12, r = it & 4095;
        if (which < 2) { const int e = r >> 7, q = r & 127, kb = q >> 3, nb = q & 7; bf16* dstb = WGU + (size_t)e * 512 * 1024 + (which ? 16 * 1024 : 0);
            tr_item((which ? F.A->in[20] : F.A->in[19]) + (size_t)e * 1024 * 256, 256, 256, 64 * kb, 32 * nb, scr, F.lane, [dstb](int n, int w2) { return w2 ? (bf16*)nullptr : dstb + (size_t)moe_row(n) * 1024; }); }
        else { const int e = r >> 7, q = r & 127, kb = q >> 5, nb = q & 31; bf16* dstb = WD + (size_t)e * 1024 * 256;
            tr_item(F.A->in[21] + (size_t)e * 256 * 1024, 1024, 1024, 64 * kb, 32 * nb, scr, F.lane, [dstb](int n, int w2) { return w2 ? (bf16*)nullptr : dstb + (size_t)n * 256; }); }
    }
}
DI void moe_tile_prefix(Frame& F) {
    LAS int* tp = (LAS int*)(F.lds + MOET_OFF);
    if (F.tid == 0) { int a = 0; for (int e = 0; e < 32; ++e) { const unsigned c = __hip_atomic_load(F.ctl + CW_CNT + e, __ATOMIC_RELAXED, __HIP_MEMORY_SCOPE_AGENT); tp[e] = a; tp[34 + e] = (int)c; a += (int)((c + 255u) >> 8); } tp[32] = a; }
    __syncthreads();
}
DI void p12_final(Frame& F) {
    f32x4 w[4]; load_row(F.A->in[22], F.lane, w); const bf16* Y = WSP(const bf16, WS_Y);
#pragma unroll 2
    for (int m = F.gw; m < S; m += F.ngw) {
        f32x4 v[4]; load_row(F.out + (size_t)m * 1024, F.lane, v);
#pragma unroll
        for (int j = 0; j < 4; ++j) { const v2u a = *(const v2u*)(Y + (size_t)m * 1024 + 4 * F.lane + 256 * j), b = *(const v2u*)(Y + ((size_t)S + m) * 1024 + 4 * F.lane + 256 * j);
            v[j][0] += bflo(a.x) + bflo(b.x); v[j][1] += bfhi(a.x) + bfhi(b.x); v[j][2] += bflo(a.y) + bflo(b.y); v[j][3] += bfhi(a.y) + bfhi(b.y); }
        const float rs = row_rstd(v);
#pragma unroll
        for (int j = 0; j < 4; ++j) *(f32x4*)(F.out + (size_t)m * 1024 + 4 * F.lane + 256 * j) = v[j] * rs * w[j];
    }
}

#ifndef MK_PER_PHASE
#define MK_PER_PHASE 0
#endif
constexpr int NPH = 13;
__global__ void __launch_bounds__(NTHR, 2) mk_fwd(Args args) {
    extern __shared__ __attribute__((aligned(16))) unsigned char lds[];
    Frame F;
    F.lds = (LAS unsigned char*)lds;
    F.tid = threadIdx.x; F.lane = F.tid & 63; F.wave = __builtin_amdgcn_readfirstlane(F.tid >> 6);
    F.G = gridDim.x; F.gw = blockIdx.x * NWAVES + F.wave; F.ngw = F.G * NWAVES;
    F.ws = args.ws; F.ctl = (unsigned*)(args.ws + WS_CTL); F.out = args.out;
    F.A = &args;
    for (int u = F.tid; u < (LDS_BYTES - MISC_OFF) / 4; u += NTHR) ((LAS unsigned*)(F.lds + MISC_OFF))[u] = 0u;
    __syncthreads();
    XcdBarrier bar; bar.bar = F.ctl + CW_BAR + args.li * XCD_BAR_WORDS; bar.x = 0; bar.st = nullptr;
    if (!MK_PER_PHASE) bar = xcd_barrier_post(F.ctl + CW_BAR + args.li * XCD_BAR_WORDS, (volatile LAS unsigned*)(F.lds + MISC_OFF) + 8);
    const int lo = args.ph_lo, hi = args.ph_hi;
    const int sub = args.pad ? args.pad : 0xFFFF;
#define IN(k) (lo <= (k) && (k) < hi)
#define SEAM(k) do { if (IN(k) && IN((k) + 1)) xcd_barrier(bar); } while (0)
    LAS unsigned char* ring = F.lds;

    if (IN(0)) { p0_prologue(F); }
    SEAM(0);
    if (IN(1)) {
        pg8::Gemm g{WSP(const bf16, WS_H), WSP(const bf16, WS_WR), 0, 0, 1024}; ProjOrder O{F.G, (int)blockIdx.x};
        EpiProj E{WSP(bf16, WS_QA), WSP(bf16, WS_KCV), WSP(bf16, WS_QR), WSP(bf16, WS_KR), WSP(bf16, WS_GR), WSP(bf16, WS_GA), WSP(bf16, WS_TOUT), (bf16*)F.out};
        pg8::gemm_phase<EpiProj, ProjOrder, true, true>(ring, g, O, E);
    }
    SEAM(1);
    if (IN(2)) {
        if (sub & 32) for (int u = blockIdx.x; u < 512; u += F.G) p2_ret_state_wg(F, u);
        if (sub & 8) { if (F.wave < 4) for (int u = blockIdx.x * 4 + F.wave; u < 1024; u += F.G * 4) p2_cmp_hidden(F, u); }
        if (sub & 16) { if (F.wave == 4) for (int u = blockIdx.x; u < 256; u += F.G) p2_kmax(F, u); }
        asm volatile("s_waitcnt vmcnt(0) lgkmcnt(0)" ::: "memory"); __syncthreads();
    }
    SEAM(2);
    if (IN(3)) {
        if (sub & 64) p3_scan(F);
        if (sub & 128) for (int u = F.gw; u < 256; u += F.ngw) p3_kcvc(F, u);
    }
    SEAM(3);
    if (IN(4)) {
        p4_bias_table(F);
        for (int pp = blockIdx.x; pp < 256; pp += F.G) {
            const int g = pp & 1, c = pp >> 1;
            if (sub & 1) {
                const int us = c * 4 + (F.wave & 3), ul = (255 - c) * 4 + (F.wave & 3);
                const int nS = ((us < 1023 ? us : 1023) + 31) >> 5, nL = ((ul < 1023 ? ul : 1023) + 31) >> 5; const bool moveW = 2 * nL > 2 * nS + 17;
                p4w_wg(F, c, 255 - c, g);
                p4a_unit(F, g, 0, 0, 0, true, F.wave < 4 ? us : ul);
            }
            VM_WAIT(); __syncthreads();
            if (sub & 2) p4b_pass(F.lds, F.ws, F.out, c, 255 - c, g);
        }
        if (sub & 4) for (int u = blockIdx.x; u < 512; u += F.G) p4_ret_wg(F, u);
        asm volatile("s_waitcnt vmcnt(0) lgkmcnt(0)" ::: "memory");
        __syncthreads();
    }
    SEAM(4);
    if (IN(6)) {
        { pg8::Gemm g{WSP(const bf16, WS_QA), WSP(const bf16, WS_WUA), S, 1024, 512}; pg8::StaticOrder O; O.init(S, 1024, F.G, (int)blockIdx.x);
          EpiUp<false> E{(const bf16*)F.out, WSP(bf16, WS_MG), 0};
          pg8::gemm_phase<EpiUp<false>, pg8::StaticOrder, true, true>(ring, g, O, E); }
        if (F.G != 256 && !MK_PER_PHASE) xcd_barrier(bar); else { VM_WAIT(); __syncthreads(); }
        { pg8::Gemm g{WSP(const bf16, WS_GR), WSP(const bf16, WS_WUB), S, 1024, 1024}; pg8::StaticOrder O; O.init(S, 1024, F.G, (int)blockIdx.x);
          EpiUp<true> E{(const bf16*)F.out, WSP(bf16, WS_MG), 1024};
          pg8::gemm_phase<EpiUp<true>, pg8::StaticOrder, true, true>(ring, g, O, E); }
    }
    SEAM(6);
    if (IN(7)) {
        pg8::Gemm g{WSP(const bf16, WS_MG), WSP(const bf16, WS_WO), S, 1024, 1024}; pg8::StaticOrder O; O.init(S, 1024, F.G, (int)blockIdx.x);
        EpiOut E{F.A->in[0], F.out};
        pg8::gemm_phase<EpiOut, pg8::StaticOrder, true, true>(ring, g, O, E);
    }
    SEAM(7);
    if (IN(8)) {
        if (sub & 256) for (int it = blockIdx.x * 4; it < S / 16; it += F.G * 4) p8_route_item(F, it + (F.wave & 3));
        if (sub & 512) p8_moe_weights(F);
    }
    SEAM(8);
    if (IN(10)) {
        moe_tile_prefix(F);
        MoeOrder<2> O{F.G, (int)blockIdx.x, (const LAS int*)(F.lds + MOET_OFF)};
        { LAS unsigned* gtab = (LAS unsigned*)(F.lds + GTAB_OFF); const LAS int* tp = (const LAS int*)(F.lds + MOET_OFF); const v2u* LIST = WSP(const v2u, WS_XS);
          for (int ui = 0; ui < 8; ++ui) { pg8::Unit u; if (!O.next(ui, u)) break;
              if (F.tid < 256) { const int ex = u.pn >> 1, rank = (u.pm - tp[ex]) * 256 + F.tid; gtab[ui * 256 + F.tid] = rank < tp[34 + ex] ? (LIST[(size_t)ex * 16384 + rank].x >> 1) : 0u; } }
          asm volatile("s_waitcnt vmcnt(0) lgkmcnt(0)" ::: "memory"); __syncthreads(); }
        pg8::Gemm g{WSP(const bf16, WS_H), WSP(const bf16, WS_MOEW), 0, 0, 1024};
        EpiMoe1 E{WSP(bf16, WS_HID)};
        pg8::gemm_phase<EpiMoe1, MoeOrder<2>, true, true, true>(ring, g, O, E, (const LAS unsigned*)(F.lds + GTAB_OFF));
    }
    SEAM(10);
    if (IN(11)) {
        moe_tile_prefix(F);
        pg8::Gemm g{WSP(const bf16, WS_HID), WSP(const bf16, WS_MOEW) + (size_t)32 * 512 * 1024, 0, 0, 256}; MoeOrder<4> O{F.G, (int)blockIdx.x, (const LAS int*)(F.lds + MOET_OFF)};
        EpiMoe2 E{WSP(const v2u, WS_XS), WSP(bf16, WS_Y), (const LAS int*)(F.lds + MOET_OFF), (const LAS int*)(F.lds + MOET_OFF) + 34};
        pg8::gemm_phase<EpiMoe2, MoeOrder<4>, true, true>(ring, g, O, E);
    }
    SEAM(11);
    if (IN(12)) p12_final(F);
#undef IN
#undef SEAM
}

extern "C" void kernel_launch(void* const* d_in, const int* in_sizes, int n_in, void* d_out, int out_size, void* d_ws, size_t ws_size, hipStream_t stream) {
    static int grid = 0;
    if (grid == 0) {
        if (n_in != 23 || out_size != S * D || ws_size < WS_END) { fprintf(stderr, "kernel_launch: unexpected problem (n_in %d, out %d, ws %zu)\n", n_in, out_size, ws_size); grid = -1; return; }
        int dev = 0, cus = 0;
        if (hipGetDevice(&dev) != hipSuccess || hipDeviceGetAttribute(&cus, hipDeviceAttributeMultiprocessorCount, dev) != hipSuccess) { grid = -1; return; }
        if (hipFuncSetAttribute((const void*)mk_fwd, hipFuncAttributeMaxDynamicSharedMemorySize, LDS_BYTES) != hipSuccess) { fprintf(stderr, "kernel_launch: hipFuncSetAttribute failed\n"); grid = -1; return; }
        int per_cu = 0;
        if (hipOccupancyMaxActiveBlocksPerMultiprocessor(&per_cu, (const void*)mk_fwd, NTHR, LDS_BYTES) != hipSuccess || per_cu < 1) { fprintf(stderr, "kernel_launch: occupancy query says %d\n", per_cu); }
        (void)hipGetLastError();
        grid = cus > 0 ? cus : 256;
    }
    if (grid < 0) return;
    if (hipMemsetAsync((char*)d_ws + WS_CTL, 0, CTL_ZERO_BYTES, stream) != hipSuccess) return;
    Args a{};
    for (int i = 0; i < 23; ++i) a.in[i] = (const float*)d_in[i];
    a.out = (float*)d_out; a.ws = (unsigned char*)d_ws;
#if MK_PER_PHASE
    for (int p = 0; p < NPH; ++p) { a.ph_lo = p; a.ph_hi = p + 1; hipLaunchKernelGGL(mk_fwd, dim3(grid), dim3(NTHR), LDS_BYTES, stream, a); }
#elif defined(MK_PREFIX_HI)
    a.ph_lo = 0; a.ph_hi = MK_PREFIX_HI; a.li = 0; a.pad = MK_PREFIX_SUB; hipLaunchKernelGGL(mk_fwd, dim3(grid), dim3(NTHR), LDS_BYTES, stream, a);
    (void)hipMemsetAsync((char*)d_ws + WS_CTL, 0, CTL_ZERO_BYTES, stream);
    a.ph_lo = 0; a.ph_hi = NPH; a.li = 1; a.pad = 0; hipLaunchKernelGGL(mk_fwd, dim3(grid), dim3(NTHR), LDS_BYTES, stream, a);
#elif defined(MK_DUP_LO)
    a.ph_lo = 0; a.ph_hi = MK_DUP_HI + 1; a.li = 0; hipLaunchKernelGGL(mk_fwd, dim3(grid), dim3(NTHR), LDS_BYTES, stream, a);
    a.ph_lo = MK_DUP_LO; a.ph_hi = NPH; a.li = 1; hipLaunchKernelGGL(mk_fwd, dim3(grid), dim3(NTHR), LDS_BYTES, stream, a);
#else
    a.ph_lo = 0; a.ph_hi = NPH;
    hipLaunchKernelGGL(mk_fwd, dim3(grid), dim3(NTHR), LDS_BYTES, stream, a);
#endif
}
```

```cpp
#include <hip/hip_runtime.h>
#include <cstdio>
#include <cstdint>
namespace pg8 {
#define PG8_LAS __attribute__((address_space(3)))
typedef unsigned short bf16_t;
typedef short bf16x8 __attribute__((ext_vector_type(8)));
typedef float f32x4 __attribute__((ext_vector_type(4)));
typedef unsigned u32x4 __attribute__((ext_vector_type(4)));
constexpr int BM = 256, BK = 64, HALF = 128, HTB = HALF * BK * 2  , STAGE_BYTES = 8 * HTB, NXCD = 8, WGM = 8;

__host__ __device__ __forceinline__ int lds_byte(int r, int c) { const int st = (r >> 4) * 2 + (c >> 5), rr = r & 15, cc = c & 31, ob = rr * 64 + cc * 2; return st * 1024 + (ob ^ (((ob >> 9) & 1) << 5)); }
__host__ __device__ __forceinline__ void stage_rc(int b, int& R, int& C) { const int st = b / 1024, sb = b % 1024, swz = sb ^ (((sb >> 9) & 1) << 5); R = (st >> 1) * 16 + swz / 64; C = (st & 1) * 32 + (swz % 64) / 2; }
__host__ __device__ __forceinline__ int perm32(int rho) { const int n = rho >> 4, i = rho & 15; return 8 * (i >> 2) + 4 * n + (i & 3); }

struct Unit { int pm, pn; };
struct Gemm { const bf16_t* A; const bf16_t* Bt; int M, N, K; };

struct StaticOrder {
    int nM, nN, nwg, G, c;
    __host__ __device__ void init(int M, int N, int G_, int c_) { nM = M / BM; nN = N / BM; nwg = nM * nN; G = G_; c = c_; }
    __host__ __device__ bool next(int i, Unit& u) const {
        const long L = (long)i * G + c; if (L >= nwg) return false;
        int wgid = (int)L; { const int q = nwg / NXCD, r = nwg % NXCD, xcd = wgid % NXCD, off = wgid / NXCD; wgid = (xcd < r ? xcd * (q + 1) : r * (q + 1) + (xcd - r) * q) + off; }
        const int nig = WGM * nN, gid = wgid / nig, fm = gid * WGM, gsz = (nM - fm) < WGM ? (nM - fm) : WGM;
        u.pm = fm + ((wgid % nig) % gsz); u.pn = (wgid % nig) / gsz; return true;
    }
    __device__ __forceinline__ void a_ready(const Unit&) const {}
    __device__ __forceinline__ void done(const Unit&) const {}
};

__device__ __forceinline__ unsigned cvt_pk_bf16(float lo, float hi) { unsigned r; asm volatile("v_cvt_pk_bf16_f32 %0, %1, %2" : "=v"(r) : "v"(lo), "v"(hi)); return r; }

template <class Epi, class Sched, bool ALIGN_EPI = false, bool SP2 = false, bool GATHER = false>
__device__ __forceinline__ void gemm_phase(PG8_LAS unsigned char* lds, const Gemm g, const Sched& S, const Epi& E, const PG8_LAS unsigned* gtab = nullptr) {
    static_assert(!GATHER || SP2, "GATHER needs SP2");
    const int tid = threadIdx.x, wid = __builtin_amdgcn_readfirstlane(tid >> 6), lane = tid & 63, wr = wid >> 2, wc = wid & 3, fr = lane & 15, fq = lane >> 4;
    const int K = g.K, nt = K / BK;
    unsigned voffA[2], voffB[2];
#pragma unroll
    for (int i = 0; i < 2; ++i) { int R, C; stage_rc(tid * 16 + i * 8192, R, C); const int Rb = Epi::PERM ? ((R & ~31) + perm32(R & 31)) : R;
        voffA[i] = (unsigned)(R * K + C) * 2u; voffB[i] = (unsigned)(Rb * K + C) * 2u; }
    int gR[2], gC[2];
#pragma unroll
    for (int i = 0; i < 2; ++i) stage_rc(tid * 16 + i * 8192, gR[i], gC[i]);
    unsigned gc[2][2], gn[2][2];
#define PG8_GOFF(dst, uidx) do { _Pragma("unroll") for (int _h = 0; _h < 2; ++_h) _Pragma("unroll") for (int _i = 0; _i < 2; ++_i) dst[_h][_i] = (gtab[(uidx) * 256 + _h * 128 + gR[_i]] * (unsigned)K + (unsigned)gC[_i]) * 2u; } while (0)
    const size_t kstep = (size_t)(BK * 2);
    const size_t hstep = (size_t)HALF * K * 2;
    const size_t tstep = 2 * hstep;
    const unsigned ldsw = (unsigned)wid * 1024u;
    const int aoff = lds_byte(wr * 64 + fr, fq * 8), boff = lds_byte(wc * 32 + fr, fq * 8);
#define PG8_SA(b, h) (((b) * 2 + (h)) * HTB)
#define PG8_SB(b, h) ((4 + (b) * 2 + (h)) * HTB)
#define PG8_STAGE(bufoff, gbase, voff) do { _Pragma("unroll") for (int _i = 0; _i < 2; ++_i) \
        __builtin_amdgcn_global_load_lds((const unsigned*)((const char*)(gbase) + (voff)[_i]), (PG8_LAS unsigned*)(lds + (bufoff) + ldsw + _i * 8192), 16, 0, 0); } while (0)
#define PG8_STAGE_A(bufoff, base, half, nxt_) do { if constexpr (GATHER) { _Pragma("unroll") for (int _i = 0; _i < 2; ++_i) \
        __builtin_amdgcn_global_load_lds((const unsigned*)((const char*)(base) + ((nxt_) ? gn[half][_i] : gc[half][_i])), (PG8_LAS unsigned*)(lds + (bufoff) + ldsw + _i * 8192), 16, 0, 0); } \
        else PG8_STAGE(bufoff, (base) + (half) * hstep, voffA); } while (0)
#define PG8_LDA(dst, b, h) do { _Pragma("unroll") for (int m = 0; m < 4; ++m) _Pragma("unroll") for (int k = 0; k < 2; ++k) dst[m][k] = *(const PG8_LAS bf16x8*)(lds + PG8_SA(b, h) + aoff + m * 2048 + k * 1024); } while (0)
#define PG8_LDB(dst, b, h) do { _Pragma("unroll") for (int n = 0; n < 2; ++n) _Pragma("unroll") for (int k = 0; k < 2; ++k) dst[n][k] = *(const PG8_LAS bf16x8*)(lds + PG8_SB(b, h) + boff + n * 2048 + k * 1024); } while (0)
#define PG8_MMA(ai, bj, At, Bt) do { __builtin_amdgcn_s_setprio(1); _Pragma("unroll") for (int m = 0; m < 4; ++m) _Pragma("unroll") for (int n = 0; n < 2; ++n) _Pragma("unroll") for (int k = 0; k < 2; ++k) \
        acc[ai][bj][m][n] = __builtin_amdgcn_mfma_f32_16x16x32_bf16(Bt[n][k], At[m][k], acc[ai][bj][m][n], 0, 0, 0); __builtin_amdgcn_s_setprio(0); } while (0)
#define PG8_WAIT_V(n) asm volatile("s_waitcnt vmcnt(" #n ")" ::: "memory")
#define PG8_WAIT_L(n) asm volatile("s_waitcnt lgkmcnt(" #n ")" ::: "memory")
#define PG8_BAR __builtin_amdgcn_s_barrier()
#define PG8_SCHED __builtin_amdgcn_sched_barrier(0)
    Unit cur, nxt; int ui = 0;
    if (!S.next(0, cur)) return;
    f32x4 acc[2][2][4][2];
#pragma unroll
    for (int a = 0; a < 2; ++a)
#pragma unroll
        for (int b = 0; b < 2; ++b)
#pragma unroll
            for (int m = 0; m < 4; ++m)
#pragma unroll
                for (int n = 0; n < 2; ++n) acc[a][b][m][n] = (f32x4){0.f, 0.f, 0.f, 0.f};
    bf16x8 At[4][2], B0[2][2], B1[2][2];
    const char* cA = GATHER ? (const char*)g.A : (const char*)g.A + (size_t)cur.pm * tstep; const char* cB = (const char*)g.Bt + (size_t)cur.pn * tstep;
    if constexpr (GATHER) { PG8_GOFF(gc, 0); }
    S.a_ready(cur);
    if constexpr (SP2) {
        PG8_STAGE(PG8_SB(0, 0), cB, voffB); PG8_STAGE(PG8_SB(0, 1), cB + hstep, voffB); PG8_STAGE_A(PG8_SA(0, 0), cA, 0, false); PG8_STAGE_A(PG8_SA(0, 1), cA, 1, false);
        if (wr == 1) PG8_BAR;
        PG8_WAIT_V(2); PG8_BAR;
        PG8_STAGE(PG8_SB(1, 0), cB + kstep, voffB); PG8_STAGE_A(PG8_SA(1, 0), cA + kstep, 0, false); PG8_STAGE(PG8_SB(1, 1), cB + hstep + kstep, voffB);
        PG8_WAIT_V(6); PG8_BAR;
    } else {
        PG8_STAGE(PG8_SB(0, 0), cB, voffB); PG8_STAGE(PG8_SA(0, 0), cA, voffA); PG8_STAGE(PG8_SB(0, 1), cB + hstep, voffB); PG8_STAGE(PG8_SA(0, 1), cA + hstep, voffA);
        if (wr == 1) PG8_BAR;
        PG8_WAIT_V(4); PG8_BAR;
        PG8_STAGE(PG8_SB(1, 0), cB + kstep, voffB); PG8_STAGE(PG8_SA(1, 0), cA + kstep, voffA); PG8_STAGE(PG8_SB(1, 1), cB + hstep + kstep, voffB);
        PG8_WAIT_V(6); PG8_BAR;
    }
    for (;;) {
        const bool has_next = S.next(ui + 1, nxt);
        const char* nA = GATHER ? cA : (has_next ? (const char*)g.A + (size_t)nxt.pm * tstep : cA);
        if constexpr (GATHER) { if (has_next) { PG8_GOFF(gn, ui + 1); } else { _Pragma("unroll") for (int _h = 0; _h < 2; ++_h) _Pragma("unroll") for (int _i = 0; _i < 2; ++_i) gn[_h][_i] = gc[_h][_i]; } } const char* nB = has_next ? (const char*)g.Bt + (size_t)nxt.pn * tstep : cB;
#pragma nounroll
        for (int t = 0; t < nt; t += 2) {
            const bool last = (t == nt - 2);
            const char* a1 = cA + (size_t)(t + 1) * kstep;
            const char* a2 = last ? nA : cA + (size_t)(t + 2) * kstep; const char* b2 = last ? nB : cB + (size_t)(t + 2) * kstep;
            const char* a3 = a2 + kstep; const char* b3 = b2 + kstep;
            if (last && has_next) S.a_ready(nxt);
            if constexpr (SP2) {
            PG8_LDB(B0, 0, 0); PG8_LDB(B1, 0, 1); PG8_SCHED; PG8_LDA(At, 0, 0); PG8_STAGE_A(PG8_SA(1, 1), a1, 1, false);
            PG8_WAIT_V(8); PG8_WAIT_L(0); PG8_BAR; PG8_MMA(0, 0, At, B0); PG8_MMA(0, 1, At, B1); PG8_BAR; PG8_SCHED;
            PG8_LDA(At, 0, 1); PG8_STAGE(PG8_SB(0, 0), b2, voffB); PG8_STAGE(PG8_SB(0, 1), b2 + hstep, voffB); PG8_STAGE_A(PG8_SA(0, 0), a2, 0, last);
            PG8_WAIT_V(8); PG8_WAIT_L(0); PG8_BAR; PG8_MMA(1, 0, At, B0); PG8_MMA(1, 1, At, B1); PG8_BAR; PG8_SCHED;
            PG8_LDB(B0, 1, 0); PG8_LDB(B1, 1, 1); PG8_SCHED; PG8_LDA(At, 1, 0); PG8_STAGE_A(PG8_SA(0, 1), a2, 1, last);
            PG8_WAIT_V(8); PG8_WAIT_L(0); PG8_BAR; PG8_MMA(0, 0, At, B0); PG8_MMA(0, 1, At, B1); PG8_BAR; PG8_SCHED;
            PG8_LDA(At, 1, 1); PG8_STAGE(PG8_SB(1, 0), b3, voffB); PG8_STAGE(PG8_SB(1, 1), b3 + hstep, voffB); PG8_STAGE_A(PG8_SA(1, 0), a3, 0, last);
            PG8_WAIT_V(8); PG8_WAIT_L(0); PG8_BAR; PG8_MMA(1, 0, At, B0); PG8_MMA(1, 1, At, B1); PG8_BAR; PG8_SCHED;
            } else {
            PG8_LDB(B0, 0, 0); PG8_SCHED; PG8_LDA(At, 0, 0); PG8_STAGE(PG8_SA(1, 1), a1 + hstep, voffA);
            PG8_WAIT_L(8); PG8_BAR; PG8_WAIT_L(0); PG8_MMA(0, 0, At, B0); PG8_BAR; PG8_SCHED;
            PG8_LDB(B1, 0, 1); PG8_STAGE(PG8_SB(0, 0), b2, voffB);
            PG8_BAR; PG8_WAIT_L(0); PG8_MMA(0, 1, At, B1); PG8_BAR;
            PG8_LDA(At, 0, 1); PG8_STAGE(PG8_SA(0, 0), a2, voffA);
            PG8_BAR; PG8_WAIT_L(0); PG8_MMA(1, 0, At, B0); PG8_BAR; PG8_SCHED;
            PG8_STAGE(PG8_SB(0, 1), b2 + hstep, voffB);
            PG8_WAIT_V(6); PG8_BAR; PG8_MMA(1, 1, At, B1); PG8_BAR;
            PG8_LDB(B0, 1, 0); PG8_SCHED; PG8_LDA(At, 1, 0); PG8_STAGE(PG8_SA(0, 1), a2 + hstep, voffA);
            PG8_WAIT_L(8); PG8_BAR; PG8_WAIT_L(0); PG8_MMA(0, 0, At, B0); PG8_BAR; PG8_SCHED;
            PG8_LDB(B1, 1, 1); PG8_STAGE(PG8_SB(1, 0), b3, voffB);
            PG8_BAR; PG8_WAIT_L(0); PG8_MMA(0, 1, At, B1); PG8_BAR;
            PG8_LDA(At, 1, 1); PG8_STAGE(PG8_SA(1, 0), a3, voffA);
            PG8_BAR; PG8_WAIT_L(0); PG8_MMA(1, 0, At, B0); PG8_BAR; PG8_SCHED;
            PG8_STAGE(PG8_SB(1, 1), b3 + hstep, voffB);
            PG8_WAIT_V(6); PG8_BAR; PG8_MMA(1, 1, At, B1); PG8_BAR;
            }
        }
        if constexpr (ALIGN_EPI) { if (wr == 0) PG8_BAR; }
        if constexpr (!Epi::AFTER_DRAIN) { E(acc, cur, wr, wc, fr, fq); S.done(cur); }
        if (!has_next) break;
#pragma unroll
        for (int a = 0; a < 2; ++a)
#pragma unroll
            for (int b = 0; b < 2; ++b)
#pragma unroll
                for (int m = 0; m < 4; ++m)
#pragma unroll
                    for (int n = 0; n < 2; ++n) acc[a][b][m][n] = (f32x4){0.f, 0.f, 0.f, 0.f};
        cur = nxt; cA = nA; cB = nB; ++ui;
        if constexpr (GATHER) { _Pragma("unroll") for (int _h = 0; _h < 2; ++_h) _Pragma("unroll") for (int _i = 0; _i < 2; ++_i) gc[_h][_i] = gn[_h][_i]; }
        if constexpr (ALIGN_EPI) { if (wr == 1) PG8_BAR; }
    }
    PG8_WAIT_V(0);
    if constexpr (!ALIGN_EPI) { if (wr == 0) PG8_BAR; }
    PG8_BAR;
    if constexpr (Epi::AFTER_DRAIN) { E.fused(acc, cur, wr, wc, fr, fq, lds, wid, lane); S.done(cur); }
#undef PG8_SA
#undef PG8_SB
#undef PG8_STAGE
#undef PG8_STAGE_A
#undef PG8_GOFF
#undef PG8_LDA
#undef PG8_LDB
#undef PG8_MMA
#undef PG8_WAIT_V
#undef PG8_WAIT_L
#undef PG8_BAR
#undef PG8_SCHED
}
}

#define GAS __attribute__((address_space(1)))
#define LAS __attribute__((address_space(3)))
#define DI __device__ __forceinline__
typedef unsigned short bf16;
typedef unsigned v4u __attribute__((ext_vector_type(4)));
typedef unsigned v2u __attribute__((ext_vector_type(2)));
typedef float f32x4 __attribute__((ext_vector_type(4)));
typedef short bf16x8 __attribute__((ext_vector_type(8)));
typedef float f32x2_t __attribute__((ext_vector_type(2)));
typedef __bf16 bf16x2_t __attribute__((ext_vector_type(2)));
#define LDS_WAIT() asm volatile("s_waitcnt lgkmcnt(0)" ::: "memory")
#define VM_WAIT() asm volatile("s_waitcnt vmcnt(0)" ::: "memory")
DI unsigned pk2(float lo, float hi) { f32x2_t v = {lo, hi}; bf16x2_t b = __builtin_convertvector(v, bf16x2_t); return __builtin_bit_cast(unsigned, b); }
DI float bflo(unsigned u) { return __uint_as_float(u << 16); }
DI float bfhi(unsigned u) { return __uint_as_float(u & 0xffff0000u); }
DI float bf1(bf16 b) { return __uint_as_float(((unsigned)b) << 16); }
DI f32x4 mfma16(bf16x8 a, bf16x8 b, f32x4 c) { return __builtin_amdgcn_mfma_f32_16x16x32_bf16(a, b, c, 0, 0, 0); }
DI bf16x8 ld16(const bf16* p) { return *(const bf16x8*)p; }
DI bf16x8 ld8x2(const bf16* p, int off2) { const v2u a = *(const v2u*)p, b = *(const v2u*)(p + off2); v4u r = {a.x, a.y, b.x, b.y}; return __builtin_bit_cast(bf16x8, r); }
DI bf16x8 pack8(f32x4 a, f32x4 b) { v4u r = {pk2(a[0], a[1]), pk2(a[2], a[3]), pk2(b[0], b[1]), pk2(b[2], b[3])}; return __builtin_bit_cast(bf16x8, r); }
DI v2u pack4(f32x4 a) { v2u r = {pk2(a[0], a[1]), pk2(a[2], a[3])}; return r; }
DI float wave_sum(float v) {
#pragma unroll
    for (int o = 1; o < 64; o <<= 1) v += __shfl_xor(v, o);
    return v;
}
DI float quad_sum(float v) { v += __shfl_xor(v, 16); v += __shfl_xor(v, 32); return v; }
DI float quad_sum_l(float v, int lane) { v += __int_as_float(__builtin_amdgcn_ds_bpermute((lane ^ 16) << 2, __float_as_int(v))); v += __int_as_float(__builtin_amdgcn_ds_bpermute((lane ^ 32) << 2, __float_as_int(v))); return v; }
DI float shfl_l(float v, int src) { return __int_as_float(__builtin_amdgcn_ds_bpermute(src << 2, __float_as_int(v))); }
DI float quad_max(float v) { v = fmaxf(v, __shfl_xor(v, 16)); v = fmaxf(v, __shfl_xor(v, 32)); return v; }
DI unsigned wave_max_u32(unsigned v) {
#pragma unroll
    for (int o = 1; o < 64; o <<= 1) { const unsigned w = (unsigned)__shfl_xor((int)v, o); v = w > v ? w : v; }
    return v;
}
DI float sigmoidf_(float x) { return __builtin_amdgcn_rcpf(1.0f + __builtin_amdgcn_exp2f(-x * 1.4426950408889634f)); }
DI float siluf_(float x) { return x * sigmoidf_(x); }
DI float gelu_tanh(float v) { const float z = 0.7978845608028654f * (v + 0.044715f * v * v * v); const float e = __builtin_amdgcn_exp2f(2.0f * 1.4426950408889634f * z); return 0.5f * v * (2.0f - 2.0f * __builtin_amdgcn_rcpf(e + 1.0f)); }

constexpr int S = 16384, D = 1024;
constexpr int TP = S + 2048 + 128;
constexpr int NWAVES = 8, NTHR = 512;
constexpr float EPS = 1e-6f, LOG2E = 1.4426950408889634f, QSCALE = 0.125f * 1.4426950408889634f;
constexpr size_t MiB = 1u << 20;
constexpr size_t WS_CTL = 0, CTL_ZERO_BYTES = MiB;
constexpr size_t WS_MISC = 1 * MiB;
constexpr size_t WS_WR = 2 * MiB;
constexpr size_t WS_H = WS_WR + 3328 * 2048;
constexpr size_t WS_WT = WS_H + 32 * MiB;
constexpr size_t WS_WG = 44 * MiB;
constexpr size_t WS_WC1 = 48 * MiB;
constexpr size_t WS_WUA = 50 * MiB, WS_WUB = 51 * MiB, WS_WO = 53 * MiB;
constexpr size_t WS_SM = 55 * MiB;
constexpr size_t SM_W2T = 0, SM_B1 = 64 * 1024, SM_WRT = 128 * 1024, SM_KC = 512 * 1024, SM_VCT = 768 * 1024;
constexpr size_t WS_QA = 56 * MiB, WS_GR = 72 * MiB, WS_GA = 104 * MiB, WS_KCV = 105 * MiB, WS_QR = 121 * MiB, WS_KR = 137 * MiB, WS_TOUT = 153 * MiB, WS_UR = 217 * MiB, WS_HIDC = 249 * MiB;
constexpr size_t WS_G = 105 * MiB, WS_MG = 169 * MiB;
constexpr size_t WS_MOEW = 56 * MiB;
constexpr size_t WS_HID = 104 * MiB, WS_XS = 188 * MiB  , WS_Y = 124 * MiB, WS_END = 256 * MiB;
static_assert(WS_TOUT + 1792ull * TP * 2 <= WS_UR && WS_WT + 1792 * 2048 <= WS_WG && WS_HIDC + 2 * MiB <= WS_END && WS_Y + 64 * MiB <= WS_XS && WS_XS + 4 * MiB <= WS_END && WS_Y + 64 * MiB <= WS_END, "ws map");
constexpr int CW_BAR = 4096, CW_KMAX = 16384, CW_CNT = 16448, CW_WQ = 16512;
constexpr int XS_ROWS = 40960;
constexpr int WAVE_LDS = 16960;
constexpr int NEAR_OFF = 140288;
constexpr int BIAS_OFF = 157184;
constexpr int MOET_OFF = 161344;
constexpr int GTAB_OFF = 135168;
constexpr int MISC_OFF = 161664;
constexpr int LDS_BYTES = 163840;
#define XB_TMO      128
#define XB_XCNT(j)  (256  + 64 * (j))
#define XB_XSUB(j)  (1280 + 64 * (j))
#define XB_XGEN(j)  (2304 + 64 * (j))
#define XB_TOP      3328
#define XB_TOPGEN   3392
#define XCD_BAR_WORDS 3456
#define XB_SPIN_CAP (1u << 18)

__device__ __forceinline__ unsigned xb_ld(unsigned* p)              { return __hip_atomic_load(p, __ATOMIC_RELAXED, __HIP_MEMORY_SCOPE_AGENT); }
__device__ __forceinline__ unsigned xb_add(unsigned* p, unsigned v) { return __hip_atomic_fetch_add(p, v, __ATOMIC_RELAXED, __HIP_MEMORY_SCOPE_AGENT); }
__device__ __forceinline__ unsigned xb_xcc_id() { return (unsigned)__builtin_amdgcn_s_getreg((3 << 11) | 20) & 0xFu; }
#define XB_SPIN(cond, bar) do { unsigned _sp = 0; while (cond) { __builtin_amdgcn_s_sleep(1); \
    if ((++_sp & 255u) == 0u) { if (xb_ld(&(bar)[XB_TMO])) break; if (_sp > XB_SPIN_CAP) { atomicAdd(&(bar)[XB_TMO], 1u); break; } } } } while (0)

struct XcdBarrier {
    unsigned* bar; unsigned x;
    volatile LAS unsigned* st;
};

__device__ __forceinline__ XcdBarrier xcd_barrier_post(unsigned* bar, volatile LAS unsigned* st) {
    XcdBarrier b; b.bar = bar; b.x = xb_xcc_id(); b.st = st;
    if (threadIdx.x == 0) (void)xb_add(&bar[XB_XCNT(b.x)], 1u);
    return b;
}
__device__ __forceinline__ void xcd_barrier_complete(unsigned* bar, unsigned x, unsigned& nloc, unsigned& nx) {
    const unsigned G = gridDim.x * gridDim.y * gridDim.z;
    unsigned sum, cnt, mine, sp = 0u;
    for (;;) {
        sum = 0u; cnt = 0u; mine = 0u;
#pragma unroll
        for (unsigned j = 0; j < 16; ++j) { const unsigned c = xb_ld(&bar[XB_XCNT(j)]); sum += c; cnt += (c > 0u) ? 1u : 0u; mine = (j == x) ? c : mine; }
        if (sum == G) break;
        __builtin_amdgcn_s_sleep(1);
        if ((++sp & 255u) == 0u) { if (xb_ld(&bar[XB_TMO])) break; if (sp > XB_SPIN_CAP) { atomicAdd(&bar[XB_TMO], 1u); break; } }
    }
    nloc = mine > 0u ? mine : 1u; nx = cnt > 0u ? cnt : 1u;
}

__device__ __forceinline__ void xcd_barrier(const XcdBarrier& b) {
    asm volatile("s_waitcnt vmcnt(0)" ::: "memory");
    __syncthreads();
    if (threadIdx.x == 0) {
        unsigned* bar = b.bar;
        __builtin_amdgcn_s_waitcnt(0);
        unsigned nloc = b.st[0], nx = b.st[1];
        if (nloc == 0u) { xcd_barrier_complete(bar, b.x, nloc, nx); b.st[0] = nloc; b.st[1] = nx; }
        const unsigned old = xb_add(&bar[XB_XSUB(b.x)], 1u);
        const unsigned gen = old / nloc;
        if (old + 1u == (gen + 1u) * nloc) {
            __builtin_amdgcn_fence(__ATOMIC_RELEASE, "agent");
            asm volatile("s_waitcnt vmcnt(0)" ::: "memory");
            const unsigned og = xb_add(&bar[XB_TOP], 1u);
            const unsigned tg = og / nx;
            if (og + 1u == (tg + 1u) * nx) xb_add(&bar[XB_TOPGEN], 1u);
            else XB_SPIN(xb_ld(&bar[XB_TOPGEN]) == tg, bar);
            __builtin_amdgcn_fence(__ATOMIC_ACQUIRE, "agent");
            xb_add(&bar[XB_XGEN(b.x)], 1u);
            asm volatile("s_waitcnt vmcnt(0)" ::: "memory");
        } else {
            XB_SPIN(xb_ld(&bar[XB_XGEN(b.x)]) == gen, bar);
            __builtin_amdgcn_fence(__ATOMIC_ACQUIRE, "agent");
            asm volatile("s_waitcnt vmcnt(0)" ::: "memory");
        }
    }
    __syncthreads();
}

DI void tile_map(int L, int nwg, int nM, int nN, int& pm, int& pn) {
    int wgid = L; { const int q = nwg / 8, r = nwg % 8, xcd = wgid % 8, off = wgid / 8; wgid = (xcd < r ? xcd * (q + 1) : r * (q + 1) + (xcd - r) * q) + off; }
    const int nig = 8 * nN, gid = wgid / nig, fm = gid * 8, gsz = (nM - fm) < 8 ? (nM - fm) : 8;
    pm = fm + ((wgid % nig) % gsz); pn = (wgid % nig) / gsz;
}
constexpr int GATE_PN0 = (int)((WS_WG - WS_WR) / (256 * 1024 * 2));
static_assert((WS_WG - WS_WR) % (256 * 1024 * 2) == 0, "gate weights sit a whole number of B tiles above WR");
struct ProjOrder {
    int G, c;
    DI bool next(int i, pg8::Unit& u) const {
        const int L = i * G + c; if (L >= 1792) return false;
        if (L < 832) tile_map(L, 832, 64, 13, u.pm, u.pn);
        else if (L < 1280) { tile_map(L - 832, 448, 7, 64, u.pm, u.pn); u.pm += 64; u.pn += 13; }
        else { tile_map(L - 1280, 512, 64, 8, u.pm, u.pn); u.pn += GATE_PN0; }
        return true;
    }
    DI void a_ready(const pg8::Unit&) const {}
    DI void done(const pg8::Unit&) const {}
};
template <int NJ> struct MoeOrder {
    int G, c; const LAS int* tp;
    DI bool next(int i, pg8::Unit& u) const {
        const int L = i * G + c, tau = L / NJ, j = L % NJ; const int nt = __builtin_amdgcn_readfirstlane(tp[32]);
        if (tau >= nt) return false;
        int e = 0;
        for (int k = 1; k < 32; ++k) e += (tau >= __builtin_amdgcn_readfirstlane(tp[k])) ? 1 : 0;
        u.pm = tau; u.pn = e * NJ + j; return true;
    }
    DI void a_ready(const pg8::Unit&) const {}
    DI void done(const pg8::Unit&) const {}
};

struct EpiProj {
    static constexpr bool PERM = true, AFTER_DRAIN = false;
    bf16 *QA, *KCV, *QR, *KR, *GR, *GA, *TOUT, *G;
    DI void operator()(const f32x4 (&acc)[2][2][4][2], const pg8::Unit& u, int wr, int wc, int fr_, int fq_) const {
        int fr = fr_, fq = fq_; asm volatile("" : "+v"(fr), "+v"(fq));
        const float L2B = 13.287712379549449f / 64.0f;
        const float INV2PI = 0.15915494309189535f;
        if (u.pm < 64 && u.pn >= GATE_PN0) {
            const int row0 = u.pm * 256 + wr * 64 + fr, col0 = (u.pn - GATE_PN0) * 256 + wc * 32 + 8 * fq;
#pragma unroll
            for (int ai = 0; ai < 2; ++ai)
#pragma unroll
                for (int m = 0; m < 4; ++m) {
                    bf16* rowp = G + (size_t)(row0 + ai * 128 + m * 16) * 2048 + col0;
#pragma unroll
                    for (int bj = 0; bj < 2; ++bj) { f32x4 a = acc[ai][bj][m][0], b = acc[ai][bj][m][1];
#pragma unroll
                        for (int i = 0; i < 4; ++i) { a[i] = sigmoidf_(a[i]); b[i] = sigmoidf_(b[i]); }
                        *(bf16x8*)(rowp + bj * 128) = pack8(a, b); }
                }
        } else if (u.pm < 64) {
            const int pn = u.pn, row0 = u.pm * 256 + wr * 64 + fr;
            if (pn >= 4 && pn < 8) {
                bf16* base = pn < 6 ? QR : KR; const float sc = pn < 6 ? 1.0f : 0.08838834764831845f; const int hd0 = 2 * (pn & 1), d0 = 16 * wc + 4 * fq;
                float invr[4];
#pragma unroll
                for (int i = 0; i < 4; ++i) invr[i] = __builtin_amdgcn_exp2f(-(float)(d0 + i) * L2B) * INV2PI;
#pragma unroll
                for (int ai = 0; ai < 2; ++ai)
#pragma unroll
                    for (int m = 0; m < 4; ++m) {
                        const int tok = row0 + ai * 128 + m * 16; float cs[4], sn[4];
#pragma unroll
                        for (int i = 0; i < 4; ++i) { float rev = (float)tok * invr[i]; rev -= floorf(rev); sn[i] = __builtin_amdgcn_sinf(rev) * sc; cs[i] = __builtin_amdgcn_cosf(rev) * sc; }
#pragma unroll
                        for (int bj = 0; bj < 2; ++bj) {
                            const f32x4 x1 = acc[ai][bj][m][0], x2 = acc[ai][bj][m][1]; f32x4 o1, o2;
#pragma unroll
                            for (int i = 0; i < 4; ++i) { o1[i] = x1[i] * cs[i] - x2[i] * sn[i]; o2[i] = x1[i] * sn[i] + x2[i] * cs[i]; }
                            bf16* p = base + (size_t)tok * 512 + (hd0 + bj) * 128 + d0;
                            *(v2u*)p = pack4(o1); *(v2u*)(p + 64) = pack4(o2);
                        }
                    }
            } else if (pn == 12) {
                if (wc == 0) {
#pragma unroll
                    for (int ai = 0; ai < 2; ++ai)
#pragma unroll
                        for (int m = 0; m < 4; ++m) {
                            const int tok = row0 + ai * 128 + m * 16; f32x4 a = acc[ai][0][m][0], b = acc[ai][0][m][1];
#pragma unroll
                            for (int i = 0; i < 4; ++i) { a[i] = sigmoidf_(a[i]); b[i] = sigmoidf_(b[i]); }
                            *(bf16x8*)(GA + (size_t)tok * 32 + 8 * fq) = pack8(a, b);
                        }
                }
            } else if (pn == 3) {
                const int gg = wc >> 1, d0 = (wc & 1) * 32 + 8 * fq;
#pragma unroll
                for (int ai = 0; ai < 2; ++ai)
#pragma unroll
                    for (int m = 0; m < 4; ++m) { const size_t o = ((size_t)gg * S + (row0 + ai * 128 + m * 16)) * 64 + d0;
                        *(bf16x8*)(KCV + (size_t)8 * MiB / 2 + o) = pack8(acc[ai][0][m][0], acc[ai][0][m][1]);
                        *(bf16x8*)(KCV + (size_t)12 * MiB / 2 + o) = pack8(acc[ai][1][m][0], acc[ai][1][m][1]); }
            } else {
                bf16* dst; int ldc, colt; float sc = 1.0f;
                if (pn < 2) { dst = QA; ldc = 512; colt = 256 * pn; sc = QSCALE; }
                else if (pn == 2) { dst = KCV; ldc = 256; colt = 0; }
                else { dst = GR; ldc = 1024; colt = 256 * (pn - 8); }
                const int col0 = colt + wc * 32 + 8 * fq;
#pragma unroll
                for (int ai = 0; ai < 2; ++ai)
#pragma unroll
                    for (int m = 0; m < 4; ++m) {
                        bf16* rowp = dst + (size_t)(row0 + ai * 128 + m * 16) * ldc + col0;
#pragma unroll
                        for (int bj = 0; bj < 2; ++bj) *(bf16x8*)(rowp + bj * 128) = pack8(acc[ai][bj][m][0] * sc, acc[ai][bj][m][1] * sc);
                    }
            }
        } else {
            const int pmp = u.pm - 64, tok0 = (u.pn - 13) * 256 + wc * 32 + 8 * fq;
            if (pmp == 1 || pmp == 2) {
                const float sc = 0.08838834764831845f;
#pragma unroll
                for (int ai = 0; ai < 2; ++ai) {
                    const int head = 2 * (pmp - 1) + ai;
#pragma unroll
                    for (int m = 0; m < 2; ++m) {
                        const int d = 32 * wr + 16 * m + fr; const float invr = __builtin_amdgcn_exp2f(-(float)d * L2B) * INV2PI;
                        bf16* p1 = TOUT + (size_t)(256 + head * 128 + d) * TP;
#pragma unroll
                        for (int bj = 0; bj < 2; ++bj) {
                            f32x4 o1[2], o2[2];
#pragma unroll
                            for (int n = 0; n < 2; ++n)
#pragma unroll
                                for (int i = 0; i < 4; ++i) {
                                    const int tok = tok0 + bj * 128 + 4 * n + i; float rev = (float)tok * invr; rev -= floorf(rev);
                                    const float sn = __builtin_amdgcn_sinf(rev) * sc, cs = __builtin_amdgcn_cosf(rev) * sc;
                                    const float x1 = acc[ai][bj][m][n][i], x2 = acc[ai][bj][m + 2][n][i];
                                    o1[n][i] = x1 * cs - x2 * sn; o2[n][i] = x1 * sn + x2 * cs;
                                }
                            *(bf16x8*)(p1 + tok0 + bj * 128) = pack8(o1[0], o1[1]);
                            *(bf16x8*)(p1 + (size_t)64 * TP + tok0 + bj * 128) = pack8(o2[0], o2[1]);
                        }
                    }
                }
            } else if (pmp == 0) {
                const int d = 0;
#pragma unroll
                for (int m = 0; m < 4; ++m) { const int dd = m * 16 + fr;
#pragma unroll
                    for (int bj = 0; bj < 2; ++bj) { const int t8 = tok0 + bj * 128;
                        { bf16* pv = TOUT + (((size_t)wr * 256 + (t8 >> 6)) * 64 + dd) * 64 + (t8 & 32) + ((t8 & 15) >> 2) * 8 + ((t8 >> 4) & 1) * 4;
                          *(v2u*)pv = pack4(acc[0][bj][m][0]); *(v2u*)(pv + 8) = pack4(acc[0][bj][m][1]); }
                        *(bf16x8*)(TOUT + (size_t)4 * MiB / 2 + (((size_t)wr * 512 + (t8 >> 5)) * 64 + dd) * 32 + (t8 & 31)) = pack8(acc[1][bj][m][0], acc[1][bj][m][1]); } }
                (void)d;
            } else {
#pragma unroll
                for (int ai = 0; ai < 2; ++ai)
#pragma unroll
                    for (int m = 0; m < 4; ++m) {
                        bf16* rowp = TOUT + (size_t)(pmp * 256 + ai * 128 + wr * 64 + m * 16 + fr) * TP + tok0;
#pragma unroll
                        for (int bj = 0; bj < 2; ++bj) *(bf16x8*)(rowp + bj * 128) = pack8(acc[ai][bj][m][0], acc[ai][bj][m][1]);
                    }
            }
        }
    }
};
struct EpiGate {
    static constexpr bool PERM = true, AFTER_DRAIN = false;
    bf16* G;
    DI void operator()(const f32x4 (&acc)[2][2][4][2], const pg8::Unit& u, int wr, int wc, int fr, int fq) const {
        const int row0 = u.pm * 256 + wr * 64 + fr, col0 = u.pn * 256 + wc * 32 + 8 * fq;
#pragma unroll
        for (int ai = 0; ai < 2; ++ai)
#pragma unroll
            for (int m = 0; m < 4; ++m) {
                bf16* rowp = G + (size_t)(row0 + ai * 128 + m * 16) * 2048 + col0;
#pragma unroll
                for (int bj = 0; bj < 2; ++bj) { f32x4 a = acc[ai][bj][m][0], b = acc[ai][bj][m][1];
#pragma unroll
                    for (int i = 0; i < 4; ++i) { a[i] = sigmoidf_(a[i]); b[i] = sigmoidf_(b[i]); }
                    *(bf16x8*)(rowp + bj * 128) = pack8(a, b); }
            }
    }
};
template <bool ADD> struct EpiUp {
    static constexpr bool PERM = true, AFTER_DRAIN = false;
    const bf16* G; bf16* MG; int goff;
    DI void operator()(const f32x4 (&acc)[2][2][4][2], const pg8::Unit& u, int wr, int wc, int fr, int fq) const {
        const int row0 = u.pm * 256 + wr * 64 + fr, col0 = u.pn * 256 + wc * 32 + 8 * fq;
#pragma unroll
        for (int ai = 0; ai < 2; ++ai)
#pragma unroll
            for (int m = 0; m < 4; ++m) {
                const size_t r = (size_t)(row0 + ai * 128 + m * 16);
#pragma unroll
                for (int bj = 0; bj < 2; ++bj) {
                    const v4u g = *(const v4u*)(G + r * 2048 + goff + col0 + bj * 128);
                    f32x4 a = acc[ai][bj][m][0], b = acc[ai][bj][m][1];
                    a[0] *= bflo(g.x); a[1] *= bfhi(g.x); a[2] *= bflo(g.y); a[3] *= bfhi(g.y); b[0] *= bflo(g.z); b[1] *= bfhi(g.z); b[2] *= bflo(g.w); b[3] *= bfhi(g.w);
                    bf16* op = MG + r * 1024 + col0 + bj * 128;
                    if (ADD) { const v4u o = *(const v4u*)op;
                        a[0] += bflo(o.x); a[1] += bfhi(o.x); a[2] += bflo(o.y); a[3] += bfhi(o.y); b[0] += bflo(o.z); b[1] += bfhi(o.z); b[2] += bflo(o.w); b[3] += bfhi(o.w); }
                    *(bf16x8*)op = pack8(a, b);
                }
            }
    }
};
struct EpiOut {
    static constexpr bool PERM = false, AFTER_DRAIN = false;
    const float* X; float* O;
    DI void operator()(const f32x4 (&acc)[2][2][4][2], const pg8::Unit& u, int wr, int wc, int fr, int fq) const {
        const int row0 = u.pm * 256 + wr * 64 + fr, col0 = u.pn * 256 + wc * 32 + 4 * fq;
#pragma unroll
        for (int ai = 0; ai < 2; ++ai)
#pragma unroll
            for (int m = 0; m < 4; ++m) {
                const size_t off = (size_t)(row0 + ai * 128 + m * 16) * 1024 + col0;
#pragma unroll
                for (int bj = 0; bj < 2; ++bj)
#pragma unroll
                    for (int n = 0; n < 2; ++n) { const size_t o = off + bj * 128 + n * 16; *(f32x4*)(O + o) = *(const f32x4*)(X + o) + acc[ai][bj][m][n]; }
            }
    }
};
struct EpiMoe1 {
    static constexpr bool PERM = false, AFTER_DRAIN = false;
    bf16* HID;
    DI void operator()(const f32x4 (&acc)[2][2][4][2], const pg8::Unit& u, int wr, int wc, int fr, int fq) const {
        const int row0 = u.pm * 256 + wr * 64 + fr, f0 = (u.pn & 1) * 128 + 16 * wc + 4 * fq;
#pragma unroll
        for (int ai = 0; ai < 2; ++ai)
#pragma unroll
            for (int m = 0; m < 4; ++m) {
                bf16* rowp = HID + (size_t)(row0 + ai * 128 + m * 16) * 256 + f0;
#pragma unroll
                for (int bj = 0; bj < 2; ++bj) { const f32x4 g = acc[ai][bj][m][0], up = acc[ai][bj][m][1]; f32x4 h;
#pragma unroll
                    for (int i = 0; i < 4; ++i) h[i] = siluf_(g[i]) * up[i];
                    *(v2u*)(rowp + bj * 64) = pack4(h); }
            }
    }
};
struct EpiMoe2 {
    static constexpr bool PERM = true, AFTER_DRAIN = false;
    const v2u* LIST; bf16* Y; const LAS int* tp; const LAS int* cn;
    DI void operator()(const f32x4 (&acc)[2][2][4][2], const pg8::Unit& u, int wr, int wc, int fr, int fq) const {
        const int ex = u.pn >> 2, rank0 = (u.pm - tp[ex]) * 256 + wr * 64 + fr, cnt = cn[ex], col0 = (u.pn & 3) * 256 + wc * 32 + 8 * fq;
#pragma unroll
        for (int ai = 0; ai < 2; ++ai)
#pragma unroll
            for (int m = 0; m < 4; ++m) {
                const int rank = rank0 + ai * 128 + m * 16;
                if (rank < cnt) {
                    const v2u ri = LIST[(size_t)ex * 16384 + rank]; const float w = __uint_as_float(ri.y);
                    bf16* rowp = Y + ((size_t)(ri.x & 1u) * S + (ri.x >> 1)) * 1024 + col0;
#pragma unroll
                    for (int bj = 0; bj < 2; ++bj) *(bf16x8*)(rowp + bj * 128) = pack8(acc[ai][bj][m][0] * w, acc[ai][bj][m][1] * w);
                }
                asm volatile("" ::: "memory");
            }
    }
};

struct Args { const float* in[23]; float* out; unsigned char* ws; int ph_lo, ph_hi, li, pad; };
struct Frame {
    LAS unsigned char* lds;
    unsigned* ctl;
    int tid, lane, wave, G, gw, ngw;
    const Args* A; float* out; unsigned char* ws;
};
#define WSP(T, off) ((T*)(F.ws + (off)))

template <class DestFn>
DI void tr_item(const float* W, int ldw, int ncols, int k0, int n0, LAS float* scr, int lane, DestFn dest) {
    const int lr = lane >> 3, lc = (lane & 7) * 4;
    if (n0 + 32 <= ncols && (ldw & 3) == 0) {
#pragma unroll
        for (int i = 0; i < 8; ++i) { const int kk = 8 * i + lr; const f32x4 v = *(const f32x4*)(W + (size_t)(k0 + kk) * ldw + n0 + lc); LAS float* d = scr + kk * 33 + lc; d[0] = v[0]; d[1] = v[1]; d[2] = v[2]; d[3] = v[3]; }
    } else {
#pragma unroll
        for (int i = 0; i < 8; ++i) { const int kk = 8 * i + lr;
#pragma unroll
            for (int j = 0; j < 4; ++j) scr[kk * 33 + lc + j] = (n0 + lc + j) < ncols ? W[(size_t)(k0 + kk) * ldw + n0 + lc + j] : 0.0f; }
    }
    LDS_WAIT(); asm volatile("" ::: "memory");
    const int c = lane & 7;
#pragma unroll
    for (int j = 0; j < 4; ++j) {
        const int nl = (lane >> 3) + 8 * j, n = n0 + nl;
        if (n < ncols) {
            const LAS float* s = scr + (8 * c) * 33 + nl;
            v4u o; o.x = pk2(s[0 * 33], s[1 * 33]); o.y = pk2(s[2 * 33], s[3 * 33]); o.z = pk2(s[4 * 33], s[5 * 33]); o.w = pk2(s[6 * 33], s[7 * 33]);
            bf16* r0 = dest(n, 0); if (r0) *(v4u*)(r0 + k0 + 8 * c) = o;
            bf16* r1 = dest(n, 1); if (r1) *(v4u*)(r1 + k0 + 8 * c) = o;
        }
    }
    LDS_WAIT(); asm volatile("" ::: "memory");
}
DI int rot_row_R(int d) { const int n = d >> 6, dd = d & 63; return 32 * (dd >> 4) + 8 * ((dd >> 2) & 3) + 4 * n + (dd & 3); }
DI int rot_row_T(int d) { const int x2 = d >> 6, dd = d & 63; return 64 * (dd >> 5) + 16 * (((dd >> 4) & 1) + 2 * x2) + (dd & 15); }
DI bf16* win_dest(unsigned char* ws, int s, int which) {
    bf16* WR = (bf16*)(ws + WS_WR); bf16* WT = (bf16*)(ws + WS_WT); bf16* WG = (bf16*)(ws + WS_WG);
    int r = -1, t = -1, g = -1;
    if (s < 512) r = s;
    else if (s < 1280) { const int sp = s - 512, j6 = sp >> 7, gd = sp & 127;
        if (j6 == 0) r = 512 + gd; else if (j6 == 1) r = 512 + 128 + gd; else if (j6 == 2) r = 512 + 256 + gd; else if (j6 == 4) r = 512 + 384 + gd;
        else if (j6 == 3) t = gd; else t = 128 + gd; }
    else if (s < 1304) r = 12 * 256 + (s - 1280);
    else if (s < 1816) { const int f = s - 1304, hh = f >> 7, d = f & 127; r = (4 + (hh >> 1)) * 256 + (hh & 1) * 128 + rot_row_R(d); }
    else if (s < 2328) { const int f = s - 1816, hh = f >> 7, d = f & 127; r = (6 + (hh >> 1)) * 256 + (hh & 1) * 128 + rot_row_R(d); t = (1 + (hh >> 1)) * 256 + (hh & 1) * 128 + rot_row_T(d); }
    else if (s < 3352) t = 768 + (s - 2328);
    else if (s < 4376) r = 8 * 256 + (s - 3352);
    else g = s - 4376;
    if (which == 0) { if (r >= 0) return WR + (size_t)r * 1024; if (t >= 0) return WT + (size_t)t * 1024; return WG + (size_t)g * 1024; }
    return (r >= 0 && t >= 0) ? WT + (size_t)t * 1024 : nullptr;
}
DI void load_row(const float* p, int lane, f32x4 (&v)[4]) {
#pragma unroll
    for (int j = 0; j < 4; ++j) v[j] = *(const f32x4*)(p + 4 * lane + 256 * j);
}
DI float row_rstd(const f32x4 (&v)[4]) {
    float s = 0.f;
#pragma unroll
    for (int j = 0; j < 4; ++j) s += (v[j][0] * v[j][0] + v[j][1] * v[j][1]) + (v[j][2] * v[j][2] + v[j][3] * v[j][3]);
    return 1.0f / sqrtf(wave_sum(s) * (1.0f / 1024.0f) + EPS);
}

DI void p0_prologue(Frame& F) {
    LAS float* scr = (LAS float*)(F.lds + F.wave * WAVE_LDS);
    const float* w_in = F.A->in[3];
    constexpr int I_IN = 16 * 201, I_C1 = 512, I_C2 = 16, I_UA = 256, I_UB = 512, I_WO = 512, NIT = I_IN + I_C1 + I_C2 + I_UA + I_UB + I_WO;
    unsigned char* ws = F.ws;
    for (int it = F.gw; it < NIT; it += F.ngw) {
        int r = it;
        if (r < I_IN) { const int kb = r / 201, nb = r % 201; tr_item(w_in, 6424, 6424, 64 * kb, 32 * nb, scr, F.lane, [ws](int n, int which) { return win_dest(ws, n, which); }); continue; } r -= I_IN;
        if (r < I_C1) { const int kind = r >> 8, q = r & 255, kb = q >> 3, nb = q & 7; bf16* dstb = (bf16*)(ws + WS_WC1) + (size_t)kind * 256 * 2048;
            tr_item(F.A->in[kind ? 8 : 5], 256, 256, 64 * kb, 32 * nb, scr, F.lane, [dstb](int n, int which) { return which ? (bf16*)nullptr : dstb + (size_t)n * 2048; }); continue; } r -= I_C1;
        if (r < I_C2) { const int kind = r >> 3, q = r & 7, kb = q >> 1, nb = q & 1; bf16* dstb = (bf16*)(ws + WS_SM + SM_W2T) + (size_t)kind * 64 * 256;
            tr_item(F.A->in[kind ? 9 : 6], 64, 64, 64 * kb, 32 * nb, scr, F.lane, [dstb](int n, int which) { return which ? (bf16*)nullptr : dstb + (size_t)n * 256; }); continue; } r -= I_C2;
        if (r < I_UA) { const int kb = r >> 5, nb = r & 31; bf16* dstb = (bf16*)(ws + WS_WUA);
            tr_item(F.A->in[11], 1024, 1024, 64 * kb, 32 * nb, scr, F.lane, [dstb](int n, int which) { return which ? (bf16*)nullptr : dstb + (size_t)n * 512; }); continue; } r -= I_UA;
        if (r < I_UB) { const int kb = r >> 5, nb = r & 31; bf16* dstb = (bf16*)(ws + WS_WUB);
            tr_item(F.A->in[12], 1024, 1024, 64 * kb, 32 * nb, scr, F.lane, [dstb](int n, int which) { return which ? (bf16*)nullptr : dstb + (size_t)n * 1024; }); continue; } r -= I_UB;
        { const int kb = r >> 5, nb = r & 31; bf16* dstb = (bf16*)(ws + WS_WO);
            tr_item(F.A->in[13], 1024, 1024, 64 * kb, 32 * nb, scr, F.lane, [dstb](int n, int which) { return which ? (bf16*)nullptr : dstb + (size_t)n * 1024; }); }
    }
    for (int o = F.gw; o < 512; o += F.ngw) {
        const int kind = o >> 8, n = o & 255; const float* pos = F.A->in[kind ? 7 : 4]; const float* w1 = F.A->in[kind ? 8 : 5]; float s = 0.f;
        for (int kk = F.lane; kk < 2048; kk += 64) s += pos[kk] * w1[(size_t)kk * 256 + n];
        s = wave_sum(s); if (F.lane == 0) ((float*)(ws + WS_SM + SM_B1))[o] = s;
    }
    { float* wrt = (float*)(ws + WS_SM + SM_WRT); const float* wn = F.A->in[14];
      for (int i = F.gw * 64 + F.lane; i < 48 * 1024; i += F.ngw * 64) { const int o = i >> 10, k = i & 1023; wrt[i] = o < 4 ? wn[k] * F.A->in[15][k * 4 + o] : (o < 36 ? wn[k] * F.A->in[17][k * 32 + (o - 4)] : 0.0f); } }
    { f32x4 w[4]; load_row(F.A->in[2], F.lane, w); bf16* H = (bf16*)(ws + WS_H);
      for (int m = F.gw; m < S; m += F.ngw) { f32x4 v[4]; load_row(F.A->in[0] + (size_t)m * 1024, F.lane, v); const float rs = row_rstd(v);
#pragma unroll
        for (int j = 0; j < 4; ++j) { const f32x4 o = v[j] * rs * w[j]; *(v2u*)(H + (size_t)m * 1024 + 4 * F.lane + 256 * j) = pack4(o); } } }
}

DI void dma_rows256(const bf16* src0, size_t pitch, int nrows, LAS unsigned char* dst, int w, int lane) {
    const int lr = lane >> 4, pc = lane & 15;
#pragma unroll 1
    for (int k = w; k < (nrows >> 2); k += 8) { const int r = k * 4 + lr; const int gc = pc ^ (r & 15);
        __builtin_amdgcn_global_load_lds((const unsigned*)(src0 + (size_t)r * pitch + gc * 8), (LAS unsigned*)(dst + k * 1024), 16, 0, 0); }
}
DI bf16x8 frag256(const LAS unsigned char* base, int row, int chunk) { return *(const LAS bf16x8*)(base + row * 256 + ((chunk ^ (row & 15)) * 16)); }
DI v2u frag256h(const LAS unsigned char* base, int row, int chunk, int half) { return *(const LAS v2u*)(base + row * 256 + ((chunk ^ (row & 15)) * 16) + half * 8); }
DI void p2_ret_state_wg(Frame& F, int u) {
    const int c = u >> 2, h = u & 3, w = F.wave, col = F.lane & 15, kq = F.lane >> 4;
    const float l2g = log2f(1.0f - __builtin_amdgcn_exp2f((float)(-5 - h)));
    const bf16* TOUT = WSP(const bf16, WS_TOUT); LAS unsigned char* L = F.lds;
    asm volatile("s_waitcnt vmcnt(0) lgkmcnt(0)" ::: "memory"); __builtin_amdgcn_s_barrier();
    dma_rows256(TOUT + (size_t)(768 + h * 256) * TP + c * 128, TP, 256, L, w, F.lane);
    dma_rows256(TOUT + (size_t)(256 + h * 128) * TP + c * 128, TP, 128, L + 65536, w, F.lane);
    asm volatile("s_waitcnt vmcnt(0)" ::: "memory"); __builtin_amdgcn_s_barrier(); asm volatile("" ::: "memory");
    f32x4 acc[16];
#pragma unroll
    for (int i = 0; i < 16; ++i) acc[i] = (f32x4){0.f, 0.f, 0.f, 0.f};
#pragma unroll
    for (int ks = 0; ks < 4; ++ks) {
        const v4u kr = __builtin_bit_cast(v4u, frag256(L + 65536, w * 16 + col, ks * 4 + kq)); float kv[8] = {bflo(kr.x), bfhi(kr.x), bflo(kr.y), bfhi(kr.y), bflo(kr.z), bfhi(kr.z), bflo(kr.w), bfhi(kr.w)};
#pragma unroll
        for (int e = 0; e < 8; ++e) kv[e] *= __builtin_amdgcn_exp2f((float)(127 - (ks * 32 + kq * 8 + e)) * l2g);
        v4u ks4 = {pk2(kv[0], kv[1]), pk2(kv[2], kv[3]), pk2(kv[4], kv[5]), pk2(kv[6], kv[7])}; const bf16x8 kf = __builtin_bit_cast(bf16x8, ks4);
#pragma unroll
        for (int dvt = 0; dvt < 16; ++dvt) acc[dvt] = mfma16(kf, frag256(L, dvt * 16 + col, ks * 4 + kq), acc[dvt]);
    }
    bf16* UR = WSP(bf16, WS_UR) + ((size_t)(c * 4 + h) * 256) * 128;
#pragma unroll
    for (int dvt = 0; dvt < 16; ++dvt) *(v2u*)(UR + (size_t)(dvt * 16 + col) * 128 + w * 16 + 4 * kq) = pack4(acc[dvt]);
}
DI void p2_cmp_hidden(Frame& F, int u) {
    const int combo = u >> 8, kind = combo >> 1, g = combo & 1, rt = (u >> 2) & 63, nq = u & 3, col = F.lane & 15, kq = F.lane >> 4;
    const bf16* W1 = WSP(const bf16, WS_WC1) + (size_t)kind * 256 * 2048 + (size_t)(nq * 64 + col) * 2048 + kq * 8;
    int tokb = 16 * (rt * 16 + col); tokb = tokb < S - 32 ? tokb : S - 32;
    const bf16* KCV = WSP(const bf16, WS_KCV) + (size_t)tokb * 256 + kind * 128 + g * 64 + kq * 8;
    f32x4 acc[4];
#pragma unroll
    for (int i = 0; i < 4; ++i) acc[i] = (f32x4){0.f, 0.f, 0.f, 0.f};
#pragma unroll 8
    for (int st = 0; st < 64; ++st) {
        const bf16x8 bfr = ld16(KCV + (size_t)(st >> 1) * 256 + (st & 1) * 32);
#pragma unroll
        for (int nt = 0; nt < 4; ++nt) { const bf16x8 af = ld16(W1 + (size_t)nt * 16 * 2048 + st * 32); acc[nt] = mfma16(af, bfr, acc[nt]); }
    }
    const float* b1 = WSP(const float, WS_SM + SM_B1) + kind * 256; bf16* HC = WSP(bf16, WS_HIDC) + (size_t)combo * 1024 * 256;
#pragma unroll
    for (int nt = 0; nt < 4; ++nt) { const int n0 = nq * 64 + nt * 16 + 4 * kq; const f32x4 bb = *(const f32x4*)(b1 + n0); f32x4 v = acc[nt] + bb;
#pragma unroll
        for (int i = 0; i < 4; ++i) v[i] = gelu_tanh(v[i]);
        *(v2u*)(HC + (size_t)(rt * 16 + col) * 256 + n0) = pack4(v); }
}
DI void p2_kmax(Frame& F, int u) {
    const int tok = u * 64 + F.lane; const bf16* KSW = WSP(const bf16, WS_KCV + 8 * MiB) + (size_t)tok * 64;
#pragma unroll
    for (int q = 0; q < 4; ++q) { float s = 0.f;
#pragma unroll
        for (int j = 0; j < 8; ++j) { const v4u k = *(const v4u*)(KSW + (size_t)q * S * 64 + j * 8);
            const float a0 = bflo(k.x), a1 = bfhi(k.x), a2 = bflo(k.y), a3 = bfhi(k.y), a4 = bflo(k.z), a5 = bfhi(k.z), a6 = bflo(k.w), a7 = bfhi(k.w);
            s += (a0 * a0 + a1 * a1) + (a2 * a2 + a3 * a3) + (a4 * a4 + a5 * a5) + (a6 * a6 + a7 * a7); }
        const unsigned m = wave_max_u32(__float_as_uint(s));
        if (F.lane == 0) atomicMax(F.ctl + CW_KMAX + q, m); }
}
DI void p3_scan(Frame& F) {
    const int idx = blockIdx.x * NTHR + F.tid;
    if (idx < 65536) {
        const int h = idx >> 14; const float cd = __builtin_amdgcn_exp2f(128.0f * log2f(1.0f - __builtin_amdgcn_exp2f((float)(-5 - h))));
        unsigned* UR = WSP(unsigned, WS_UR) + idx; float r0 = 0.f, r1 = 0.f;
#pragma unroll 32
        for (int c = 0; c < 128; ++c) { const unsigned u = UR[(size_t)c * 65536]; UR[(size_t)c * 65536] = pk2(r0, r1); r0 = r0 * cd + bflo(u); r1 = r1 * cd + bfhi(u); }
    }
}
DI void p3_kcvc(Frame& F, int u) {
    const int combo = u >> 6, kind = combo >> 1, g = combo & 1, rt = u & 63, col = F.lane & 15, kq = F.lane >> 4;
    const bf16* HC = WSP(const bf16, WS_HIDC) + (size_t)combo * 1024 * 256 + (size_t)(rt * 16 + col) * 256 + kq * 8;
    const bf16* W2 = WSP(const bf16, WS_SM + SM_W2T) + (size_t)kind * 64 * 256 + (size_t)col * 256 + kq * 8;
    f32x4 acc[4];
#pragma unroll
    for (int i = 0; i < 4; ++i) acc[i] = (f32x4){0.f, 0.f, 0.f, 0.f};
#pragma unroll
    for (int ks = 0; ks < 8; ++ks) { const bf16x8 hf = ld16(HC + ks * 32);
#pragma unroll
        for (int dt = 0; dt < 4; ++dt) { const bf16x8 wf = ld16(W2 + (size_t)dt * 16 * 256 + ks * 32); acc[dt] = kind ? mfma16(hf, wf, acc[dt]) : mfma16(wf, hf, acc[dt]); } }
    if (kind == 0) { bf16* KC = WSP(bf16, WS_SM + SM_KC) + (size_t)g * 1024 * 64;
#pragma unroll
        for (int dt = 0; dt < 4; ++dt) *(v2u*)(KC + (size_t)(rt * 16 + col) * 64 + dt * 16 + 4 * kq) = pack4(acc[dt]);
        float s = 0.f;
#pragma unroll
        for (int dt = 0; dt < 4; ++dt) { const v2u p = pack4(acc[dt]); const float a0 = bflo(p.x), a1 = bfhi(p.x), a2 = bflo(p.y), a3 = bfhi(p.y); s += (a0 * a0 + a1 * a1) + (a2 * a2 + a3 * a3); }
        const unsigned m = wave_max_u32(__float_as_uint(quad_sum(s)));
        if (F.lane == 0) atomicMax(F.ctl + CW_KMAX + 4 + g, m); }
    else { bf16* VCT = WSP(bf16, WS_SM + SM_VCT) + (size_t)g * 64 * 1024;
#pragma unroll
        for (int dt = 0; dt < 4; ++dt) *(v2u*)(VCT + (size_t)(dt * 16 + col) * 1024 + (rt >> 1) * 32 + kq * 8 + (rt & 1) * 4) = pack4(acc[dt]); }
}

DI void p4_bias_table(Frame& F) {
    LAS float* bt = (LAS float*)(F.lds + BIAS_OFF); const float* rb = F.A->in[1];
    for (int i = F.tid; i < 129 * 8; i += NTHR) { const int dist = i >> 3, hd = i & 7; int b = dist;
        if (dist >= 16) { b = 16 + (int)(logf((float)dist / 16.0f) / 2.0794415416798357f * 16.0f); b = b < 31 ? b : 31; }
        bt[i] = rb[b * 8 + hd] * LOG2E; }
    __syncthreads();
    { LAS float* nb = (LAS float*)(F.lds + NEAR_OFF);
      for (int i = F.tid; i < 256 * 8; i += NTHR) { const int dist = (i >> 3) - 64; nb[i] = dist < 0 ? -1e30f : bt[(dist > 128 ? 128 : dist) * 8 + (i & 7)]; } }
    if (F.tid < 64) { float m = 0.f; for (int i = F.tid; i < 129 * 8; i += 64) m = fmaxf(m, fabsf(bt[i]));
#pragma unroll
        for (int o = 1; o < 64; o <<= 1) m = fmaxf(m, __shfl_xor(m, o));
        if (F.tid == 0) bt[129 * 8] = m; }
    __syncthreads();
}
DI void p4w_wg(Frame& F, int tA, int tB, int g) {
    const int lane = F.lane, w = F.wave, col = lane & 15, rq = lane >> 4, th = w >> 2, T0 = (th ? tB : tA) * 64, t0 = T0 + (w & 3) * 16, tq = t0 + col;
    LAS unsigned char* L = F.lds;
    const LAS float* bt = (const LAS float*)(L + BIAS_OFF); const float bmax = bt[129 * 8];
    const bf16* QA = WSP(const bf16, WS_QA); const bf16* KCV = WSP(const bf16, WS_KCV); const bf16* TOUT = WSP(const bf16, WS_TOUT); const bf16* GA = WSP(const bf16, WS_GA);
    const float kmax_win = sqrtf(__uint_as_float(F.ctl[CW_KMAX + 2 + g]));
    bf16x8 qf[4][2]; float bw[4], lw[4];
#pragma unroll
    for (int j = 0; j < 4; ++j) { float s = 0.f; lw[j] = 0.f;
#pragma unroll
        for (int ks = 0; ks < 2; ++ks) { const v4u q = *(const v4u*)(QA + (size_t)tq * 512 + (g * 4 + j) * 64 + ks * 32 + rq * 8); qf[j][ks] = __builtin_bit_cast(bf16x8, q);
            const float a0 = bflo(q.x), a1 = bfhi(q.x), a2 = bflo(q.y), a3 = bfhi(q.y), a4 = bflo(q.z), a5 = bfhi(q.z), a6 = bflo(q.w), a7 = bfhi(q.w);
            s += (a0 * a0 + a1 * a1) + (a2 * a2 + a3 * a3) + (a4 * a4 + a5 * a5) + (a6 * a6 + a7 * a7); }
        bw[j] = sqrtf(quad_sum_l(s, lane)) * kmax_win + bmax; }
    const f32x4 z4 = {0.f, 0.f, 0.f, 0.f};
    f32x4 ACC[4][4];
#pragma unroll
    for (int j = 0; j < 4; ++j)
#pragma unroll
        for (int dt = 0; dt < 4; ++dt) ACC[j][dt] = z4;
    const int kkey = (w & 3) * 8 + (lane >> 3), kch = (lane & 7) ^ (lane >> 3), vd = (w & 3) * 16 + (lane >> 2), vch = (lane & 3) ^ ((lane >> 2) & 3);
    const int pbase = T0 - 544;
    LAS unsigned char* slot0 = L + th * 8192;
#define W_ISSUE(ti, sl) do { int p0_ = pbase + (ti) * 32; p0_ = p0_ < 0 ? 0 : p0_; \
        __builtin_amdgcn_global_load_lds((const unsigned*)(WSP(const bf16, WS_KCV + 12 * MiB) + ((size_t)g * S + p0_ + kkey) * 64 + kch * 8), (LAS unsigned*)(slot0 + (sl) * 16384 + (w & 3) * 1024), 16, 0, 0); \
        __builtin_amdgcn_global_load_lds((const unsigned*)(WSP(const bf16, WS_TOUT + 4 * MiB) + (((size_t)g * 512 + (p0_ >> 5)) * 64 + vd) * 32 + vch * 8), (LAS unsigned*)(slot0 + (sl) * 16384 + 4096 + (w & 3) * 1024), 16, 0, 0); } while (0)
#define W_KFRAG(ring, kt, ks) (*(const LAS bf16x8*)((ring) + ((kt) * 16 + col) * 128 + ((((ks) * 4 + rq) ^ (((kt) * 16 + col) & 7)) * 16)))
#define W_VLO(ring, d) (*(const LAS v2u*)((ring) + 4096 + (d) * 64 + ((((rq >> 1)) ^ ((d) & 3)) * 16) + (rq & 1) * 8))
#define W_VHI(ring, d) (*(const LAS v2u*)((ring) + 4096 + (d) * 64 + ((((rq >> 1) + 2) ^ ((d) & 3)) * 16) + (rq & 1) * 8))
    asm volatile("s_waitcnt vmcnt(0) lgkmcnt(0)" ::: "memory"); __builtin_amdgcn_s_barrier();
    constexpr int NT = 19, DIST = 7;
#pragma unroll 1
    for (int i = 0; i < DIST; ++i) W_ISSUE(i, i);
#pragma unroll 1
    for (int i = 0; i < NT; ++i) {
        const int rem = NT - 1 - i < DIST - 1 ? NT - 1 - i : DIST - 1;
        if (rem >= 6) asm volatile("s_waitcnt vmcnt(12)" ::: "memory"); else if (rem == 5) asm volatile("s_waitcnt vmcnt(10)" ::: "memory"); else if (rem == 4) asm volatile("s_waitcnt vmcnt(8)" ::: "memory");
        else if (rem == 3) asm volatile("s_waitcnt vmcnt(6)" ::: "memory"); else if (rem == 2) asm volatile("s_waitcnt vmcnt(4)" ::: "memory"); else if (rem == 1) asm volatile("s_waitcnt vmcnt(2)" ::: "memory"); else asm volatile("s_waitcnt vmcnt(0)" ::: "memory");
        asm volatile("s_waitcnt lgkmcnt(0)" ::: "memory"); __builtin_amdgcn_s_barrier(); asm volatile("" ::: "memory");
        if (i + DIST < NT) W_ISSUE(i + DIST, (i + DIST) & 7);
        const int p0 = pbase + i * 32;
        if (p0 < 0 || p0 > t0 + 15 || p0 + 31 < t0 - 511) continue;
        const LAS unsigned char* ring = slot0 + (i & 7) * 16384;
        const bool farw = (p0 + 31 <= t0 - 128) && (p0 > t0 + 15 - 512);
        bf16x8 kf[2][2], vf[4];
#pragma unroll
        for (int kt = 0; kt < 2; ++kt)
#pragma unroll
            for (int ks = 0; ks < 2; ++ks) kf[kt][ks] = W_KFRAG(ring, kt, ks);
#pragma unroll
        for (int dt = 0; dt < 4; ++dt) { const v2u lo = W_VLO(ring, dt * 16 + col), hi = W_VHI(ring, dt * 16 + col); v4u v = {lo.x, lo.y, hi.x, hi.y}; vf[dt] = __builtin_bit_cast(bf16x8, v); }
#pragma unroll
        for (int j = 0; j < 4; ++j) {
            f32x4 p[2];
#pragma unroll
            for (int kt = 0; kt < 2; ++kt) { f32x4 s = mfma16(kf[kt][0], qf[j][0], z4); s = mfma16(kf[kt][1], qf[j][1], s);
                if (farw) { const float cf = bt[128 * 8 + g * 4 + j] - bw[j];
#pragma unroll
                    for (int e = 0; e < 4; ++e) { const float v = __builtin_amdgcn_exp2f(s[e] + cf); p[kt][e] = v; lw[j] += v; }
                } else {
#pragma unroll
                    for (int e = 0; e < 4; ++e) { const int dist = tq - (p0 + kt * 16 + 4 * rq + e); const int dc = dist < 0 ? 0 : (dist > 128 ? 128 : dist);
                        const float v = (dist >= 0 && dist < 512) ? __builtin_amdgcn_exp2f(s[e] + bt[dc * 8 + g * 4 + j] - bw[j]) : 0.f; p[kt][e] = v; lw[j] += v; } } }
            const bf16x8 pb = pack8(p[0], p[1]);
#pragma unroll
            for (int dt = 0; dt < 4; ++dt) ACC[j][dt] = mfma16(vf[dt], pb, ACC[j][dt]);
        }
    }
    bf16* PW = WSP(bf16, WS_H) + (size_t)tq * 512 + g * 256;
#pragma unroll
    for (int j = 0; j < 4; ++j) { const float sc = bf1(GA[(size_t)tq * 32 + 16 + g * 4 + j]) / quad_sum_l(lw[j], lane);
#pragma unroll
        for (int dt = 0; dt < 4; ++dt) *(v2u*)(PW + j * 64 + dt * 16 + 4 * rq) = pack4(ACC[j][dt] * sc); }
    asm volatile("s_waitcnt vmcnt(0) lgkmcnt(0)" ::: "memory"); __builtin_amdgcn_s_barrier(); asm volatile("" ::: "memory");
#undef W_ISSUE
#undef W_KFRAG
#undef W_VLO
#undef W_VHI
}
DI void p4a_unit(Frame& F, int g, int nW, int qtW0, int qtW1, bool doC, int qtC) {
    const int lane = F.lane, col = lane & 15, rq = lane >> 4;
    LAS float* wl = (LAS float*)(F.lds + F.wave * WAVE_LDS);
    const LAS float* bt = (const LAS float*)(F.lds + BIAS_OFF);
    const float bmax = bt[129 * 8];
    const bf16* QA = WSP(const bf16, WS_QA); const bf16* KCV = WSP(const bf16, WS_KCV); const bf16* TOUT = WSP(const bf16, WS_TOUT); const bf16* GA = WSP(const bf16, WS_GA);
    const bf16* KC = WSP(const bf16, WS_SM + SM_KC) + (size_t)g * 1024 * 64; const bf16* VCT = WSP(const bf16, WS_SM + SM_VCT) + (size_t)g * 64 * 1024;
    const float kmax_sel = sqrtf(__uint_as_float(F.ctl[CW_KMAX + g])), kmax_win = sqrtf(__uint_as_float(F.ctl[CW_KMAX + 2 + g]));
    const f32x4 z4 = {0.f, 0.f, 0.f, 0.f};
    bf16x8 qf[4][2]; float qn[4]; f32x4 ACC[4][4];
    if (!doC) return;
    const int qt = qtC, t0 = qt * 16, tq = t0 + col;
#pragma unroll
    for (int j = 0; j < 4; ++j) { float s = 0.f;
#pragma unroll
        for (int ks = 0; ks < 2; ++ks) { const v4u q = *(const v4u*)(QA + (size_t)tq * 512 + (g * 4 + j) * 64 + ks * 32 + rq * 8); qf[j][ks] = __builtin_bit_cast(bf16x8, q);
            const float a0 = bflo(q.x), a1 = bfhi(q.x), a2 = bflo(q.y), a3 = bfhi(q.y), a4 = bflo(q.z), a5 = bfhi(q.z), a6 = bflo(q.w), a7 = bfhi(q.w);
            s += (a0 * a0 + a1 * a1) + (a2 * a2 + a3 * a3) + (a4 * a4 + a5 * a5) + (a6 * a6 + a7 * a7); }
        qn[j] = sqrtf(quad_sum_l(s, lane)); }
#pragma unroll
    for (int j = 0; j < 4; ++j)
#pragma unroll
        for (int dt = 0; dt < 4; ++dt) ACC[j][dt] = z4;
    const int nkc = qt < 1023 ? qt : 1023, nst = (nkc + 31) >> 5;
    const float kmax_cmp = sqrtf(__uint_as_float(F.ctl[CW_KMAX + 4 + g]));
    float l1[4], c1[4];
#pragma unroll
    for (int j = 0; j < 4; ++j) { l1[j] = 0.f; c1[j] = -(qn[j] * kmax_cmp + bmax); }
    for (int st = 0; st < nst; ++st) {
        const bool farc = 16 * (st * 32 + 31) + 31 <= t0 - 128;
        bf16x8 kf[2][2]; const int stl = st;
#pragma unroll
        for (int kt = 0; kt < 2; ++kt)
#pragma unroll
            for (int ks = 0; ks < 2; ++ks) kf[kt][ks] = ld16(KC + (size_t)(stl * 32 + kt * 16 + col) * 64 + ks * 32 + rq * 8);
        if (farc) {
#pragma unroll
            for (int j = 0; j < 4; ++j) { const float c0 = bt[128 * 8 + g * 4 + j] + c1[j]; const f32x4 ci = {c0, c0, c0, c0};
                f32x4 s0 = mfma16(kf[0][0], qf[j][0], ci), s1 = mfma16(kf[1][0], qf[j][0], ci); s0 = mfma16(kf[0][1], qf[j][1], s0); s1 = mfma16(kf[1][1], qf[j][1], s1);
#pragma unroll
                for (int e = 0; e < 4; ++e) { s0[e] = __builtin_amdgcn_exp2f(s0[e]); s1[e] = __builtin_amdgcn_exp2f(s1[e]); }
                float la = l1[j]; la += s0[0]; la += s1[0]; la += s0[1]; la += s1[1]; la += s0[2]; la += s1[2]; la += s0[3]; la += s1[3]; l1[j] = la; }
        } else {
#pragma unroll
            for (int j = 0; j < 4; ++j) {
#pragma unroll
                for (int kt = 0; kt < 2; ++kt) { f32x4 s = mfma16(kf[kt][0], qf[j][0], z4); s = mfma16(kf[kt][1], qf[j][1], s);
#pragma unroll
                    for (int e = 0; e < 4; ++e) { const int ci = st * 32 + kt * 16 + 4 * rq + e, dist = tq - (16 * ci + 31); const int dc = dist < 0 ? 0 : (dist > 128 ? 128 : dist);
                        const float v = __builtin_amdgcn_exp2f(s[e] + bt[dc * 8 + g * 4 + j] + c1[j]); l1[j] += dist >= 0 ? v : 0.f; } } }
        }
    }
#pragma unroll
    for (int j = 0; j < 4; ++j) { const float l = quad_sum_l(l1[j], lane); c1[j] = l > 0.f ? c1[j] - __builtin_amdgcn_logf(l) : -1e30f; }
    {
        float xprev = 0.f;
        for (int st = 0; st < nst; ++st) {
            const bool farc = 16 * (st * 32 + 31) + 31 <= t0 - 128;
            bf16x8 kf[2][2], vf[4]; const int stl = st;
#pragma unroll
            for (int kt = 0; kt < 2; ++kt)
#pragma unroll
                for (int ks = 0; ks < 2; ++ks) kf[kt][ks] = ld16(KC + (size_t)(stl * 32 + kt * 16 + col) * 64 + ks * 32 + rq * 8);
#pragma unroll
            for (int dt = 0; dt < 4; ++dt) vf[dt] = ld16(VCT + (size_t)(dt * 16 + col) * 1024 + stl * 32 + 8 * rq);
            f32x4 ps[2] = {z4, z4};
            if (farc) {
#pragma unroll
                for (int j = 0; j < 4; ++j) { const float c0 = bt[128 * 8 + g * 4 + j] + c1[j]; const f32x4 ci = {c0, c0, c0, c0};
                    f32x4 s0 = mfma16(kf[0][0], qf[j][0], ci), s1 = mfma16(kf[1][0], qf[j][0], ci); s0 = mfma16(kf[0][1], qf[j][1], s0); s1 = mfma16(kf[1][1], qf[j][1], s1);
#pragma unroll
                    for (int e = 0; e < 4; ++e) { s0[e] = __builtin_amdgcn_exp2f(s0[e]); s1[e] = __builtin_amdgcn_exp2f(s1[e]); }
#pragma unroll
                    for (int e = 0; e < 4; ++e) { ps[0][e] += s0[e]; ps[1][e] += s1[e]; }
                    const bf16x8 pb = pack8(s0, s1);
#pragma unroll
                    for (int dt = 0; dt < 4; ++dt) ACC[j][dt] = mfma16(vf[dt], pb, ACC[j][dt]); }
            } else {
#pragma unroll
                for (int j = 0; j < 4; ++j) {
                    f32x4 p[2];
#pragma unroll
                    for (int kt = 0; kt < 2; ++kt) { f32x4 s = mfma16(kf[kt][0], qf[j][0], z4); s = mfma16(kf[kt][1], qf[j][1], s);
#pragma unroll
                        for (int e = 0; e < 4; ++e) { const int ci = st * 32 + kt * 16 + 4 * rq + e, dist = tq - (16 * ci + 31); const int dc = dist < 0 ? 0 : (dist > 128 ? 128 : dist);
                            const float v0 = __builtin_amdgcn_exp2f(s[e] + bt[dc * 8 + g * 4 + j] + c1[j]); const float v = dist >= 0 ? v0 : 0.f; ps[kt][e] += v; p[kt][e] = v; } }
                    const bf16x8 pb = pack8(p[0], p[1]);
#pragma unroll
                    for (int dt = 0; dt < 4; ++dt) ACC[j][dt] = mfma16(vf[dt], pb, ACC[j][dt]);
                }
            }
#pragma unroll
            for (int kt = 0; kt < 2; ++kt) {
                const float Gs = (ps[kt][0] + ps[kt][1]) + (ps[kt][2] + ps[kt][3]), X = ps[kt][3];
                const float xa = shfl_l(X, (lane + 48) & 63), xb = shfl_l(xprev, (lane + 48) & 63);
                const float xin = rq > 0 ? xa : xb;
                wl[col * 257 + st * 8 + kt * 4 + rq] = Gs + xin; xprev = X;
            }
        }
#pragma unroll
        for (int j = 0; j < 4; ++j) { const float gc = bf1(GA[(size_t)tq * 32 + g * 4 + j]);
#pragma unroll
            for (int dt = 0; dt < 4; ++dt) ACC[j][dt] *= gc; }
    }
    { bf16* PC = WSP(bf16, WS_H + 16 * MiB) + (size_t)tq * 512 + g * 256;
#pragma unroll
      for (int j = 0; j < 4; ++j)
#pragma unroll
          for (int dt = 0; dt < 4; ++dt) *(v2u*)(PC + j * 64 + dt * 16 + 4 * rq) = pack4(ACC[j][dt]); }
    LDS_WAIT();
    unsigned long long* SELM = (unsigned long long*)(F.ws + WS_WR);
    int lt = lane; asm volatile("" : "+v"(lt));
    for (int i0 = 0; i0 < 16; i0 += 4) {
        const int cur = (t0 + i0) >> 6; unsigned k[4][4], T[4] = {0u, 0u, 0u, 0u};
#pragma unroll
        for (int qq = 0; qq < 4; ++qq)
#pragma unroll
            for (int e = 0; e < 4; ++e) { const int n = lt * 4 + e; const float v = wl[(i0 + qq) * 257 + n];
                k[qq][e] = (n == 0 || (n <= cur && n + 2 > cur)) ? 0x7F000000u : (n <= cur ? __float_as_uint(v) + 1u : 0u); }
#pragma unroll 1
        for (int bit = 30; bit >= 0; --bit) {
#pragma unroll
            for (int qq = 0; qq < 4; ++qq) { const unsigned c = T[qq] | (1u << bit);
                const int cnt = __popcll(__ballot(k[qq][0] >= c)) + __popcll(__ballot(k[qq][1] >= c)) + __popcll(__ballot(k[qq][2] >= c)) + __popcll(__ballot(k[qq][3] >= c));
                if (cnt >= 16) T[qq] = c; } }
#pragma unroll
        for (int qq = 0; qq < 4; ++qq) {
            unsigned long long bsel[4]; int ngt = 0;
#pragma unroll
            for (int e = 0; e < 4; ++e) { bsel[e] = __ballot(k[qq][e] > T[qq] && k[qq][e] != 0u); ngt += __popcll(bsel[e]); }
            if (T[qq] != 0u) {
                int need = 16 - ngt;
                unsigned long long beq[4];
#pragma unroll
                for (int e = 0; e < 4; ++e) beq[e] = __ballot(k[qq][e] == T[qq]);
                while (need > 0) {
                    int bestn = 1 << 30, be = 0;
#pragma unroll
                    for (int e = 0; e < 4; ++e) if (beq[e]) { const int n = 4 * (__ffsll((long long)beq[e]) - 1) + e; if (n < bestn) { bestn = n; be = e; } }
                    if (bestn == (1 << 30)) break;
                    const unsigned long long bitm = 1ull << (bestn >> 2);
                    if (be == 0) { bsel[0] |= bitm; beq[0] &= ~bitm; } else if (be == 1) { bsel[1] |= bitm; beq[1] &= ~bitm; } else if (be == 2) { bsel[2] |= bitm; beq[2] &= ~bitm; } else { bsel[3] |= bitm; beq[3] &= ~bitm; }
                    --need;
                }
            }
            if (lane < 4) SELM[((size_t)(t0 + i0 + qq) * 2 + g) * 4 + lane] = lane == 0 ? bsel[0] : (lane == 1 ? bsel[1] : (lane == 2 ? bsel[2] : bsel[3]));
        }
    }
    LDS_WAIT();
}
DI void p4b_pass(LAS unsigned char* ldsb, unsigned char* ws, float* outp, int tA, int tB, int g, int tid_) {
    Frame F; F.lds = ldsb; F.ws = ws; F.out = outp; F.ctl = (unsigned*)(ws + WS_CTL); F.tid = tid_; F.lane = F.tid & 63; F.wave = __builtin_amdgcn_readfirstlane(F.tid >> 6); F.G = gridDim.x; F.gw = 0; F.ngw = 0; F.A = nullptr;
    const int lane = F.lane, w = F.wave, col = lane & 15, rq = lane >> 4, hj = col & 3;
    LAS unsigned char* L = F.lds;
    const LAS float* bt = (const LAS float*)(L + BIAS_OFF); const float bmax = bt[129 * 8];
    const bf16* QA = WSP(const bf16, WS_QA); const bf16* KCV = WSP(const bf16, WS_KCV); const bf16* TOUT = WSP(const bf16, WS_TOUT); const bf16* GA = WSP(const bf16, WS_GA);
    const float kmax_sel = sqrtf(__uint_as_float(F.ctl[CW_KMAX + g]));
    const unsigned long long* SELM = (const unsigned long long*)(F.ws + WS_WR);
    bf16x8 qb[4][2]; float bnd[4]; int tq[4];
    LAS unsigned long long* PKL = (LAS unsigned long long*)(L + 131072) + w * 64;
#pragma unroll
    for (int ct = 0; ct < 4; ++ct) { const int t = (ct < 2 ? tA : tB) * 64 + w * 8 + (ct & 1) * 4 + (col >> 2); tq[ct] = t; float s = 0.f;
#pragma unroll
        for (int ks = 0; ks < 2; ++ks) { const v4u q = *(const v4u*)(QA + (size_t)t * 512 + (g * 4 + hj) * 64 + ks * 32 + rq * 8); qb[ct][ks] = __builtin_bit_cast(bf16x8, q);
            const float a0 = bflo(q.x), a1 = bfhi(q.x), a2 = bflo(q.y), a3 = bfhi(q.y), a4 = bflo(q.z), a5 = bfhi(q.z), a6 = bflo(q.w), a7 = bfhi(q.w);
            s += (a0 * a0 + a1 * a1) + (a2 * a2 + a3 * a3) + (a4 * a4 + a5 * a5) + (a6 * a6 + a7 * a7); }
        bnd[ct] = sqrtf(quad_sum_l(s, lane)) * kmax_sel + bmax; }
    { const int q = lane >> 2, e = lane & 3; const int t = ((q >> 3) ? tB : tA) * 64 + w * 8 + (q & 7); const unsigned long long wv = SELM[((size_t)t * 2 + g) * 4 + e];
      LAS unsigned* P2 = (LAS unsigned*)PKL; P2[q * 8 + e] = (unsigned)wv; P2[q * 8 + 4 + e] = (unsigned)(wv >> 32); }
    asm volatile("s_waitcnt vmcnt(0) lgkmcnt(0)" ::: "memory");
    const f32x4 z4 = {0.f, 0.f, 0.f, 0.f};
    f32x4 O[4][4], Ls[4] = {z4, z4, z4, z4};
    const v4u onesu = {0x3F803F80u, 0x3F803F80u, 0x3F803F80u, 0x3F803F80u}; const bf16x8 ones = __builtin_bit_cast(bf16x8, onesu);
#pragma unroll
    for (int ct = 0; ct < 4; ++ct)
#pragma unroll
        for (int dt = 0; dt < 4; ++dt) O[ct][dt] = z4;
    const float bfar = bt[128 * 8 + g * 4 + hj];
    const int dr = lane >> 3, dc = (lane & 7) ^ dr, nb = tB + 1;
    const bf16* kbase = WSP(const bf16, WS_KCV + 8 * MiB) + ((size_t)g * S + w * 8 + dr) * 64 + dc * 8;
    const bf16* vbase = TOUT + (((size_t)g * 256) * 64 + w * 8 + dr) * 64 + dc * 8;
#define P4B_ISSUE(blk_, slot) do { \
        __builtin_amdgcn_global_load_lds((const unsigned*)(kbase + (size_t)(blk_) * 4096), (LAS unsigned*)(L + (slot) * 16384 + w * 1024), 16, 0, 0); \
        __builtin_amdgcn_global_load_lds((const unsigned*)(vbase + (size_t)(blk_) * 4096), (LAS unsigned*)(L + (slot) * 16384 + 8192 + w * 1024), 16, 0, 0); } while (0)
    asm volatile("s_waitcnt vmcnt(0)" ::: "memory");
    __builtin_amdgcn_s_barrier();
    const int ngrp = (nb + 3) >> 2;
#pragma unroll 1
    for (int b4 = 0; b4 < 4; ++b4) if (b4 < nb) P4B_ISSUE(b4, b4);
#pragma unroll 1
    for (int gi = 0; gi < ngrp; ++gi) {
        asm volatile("s_waitcnt vmcnt(0)" ::: "memory");
        asm volatile("s_waitcnt lgkmcnt(0)" ::: "memory"); __builtin_amdgcn_s_barrier(); asm volatile("" ::: "memory");
#pragma unroll 1
        for (int b4 = 0; b4 < 4; ++b4) { const int nblk = (gi + 1) * 4 + b4; if (nblk < nb) P4B_ISSUE(nblk, ((gi + 1) & 1) * 4 + b4); }
        unsigned pm = 0u;
        { const int hsel = (gi >> 5) * 4, sh = gi & 31;
#pragma unroll
          for (int ct = 0; ct < 4; ++ct) { const v4u x = *(const LAS v4u*)((const LAS unsigned*)PKL + (ct * 4 + (col >> 2)) * 8 + hsel);
              pm |= (((x.x >> sh) & 1u) | (((x.y >> sh) & 1u) << 1) | (((x.z >> sh) & 1u) << 2) | (((x.w >> sh) & 1u) << 3)) << (ct * 4); } }
        const unsigned am = (unsigned)__builtin_amdgcn_readlane((int)pm, 0) | (unsigned)__builtin_amdgcn_readlane((int)pm, 4) | (unsigned)__builtin_amdgcn_readlane((int)pm, 8) | (unsigned)__builtin_amdgcn_readlane((int)pm, 12);
#pragma unroll 1
      for (int b4 = 0; b4 < 4; ++b4) {
        const int blk = gi * 4 + b4; if (blk >= nb) break;
        const LAS unsigned char* ring = L + ((gi & 1) * 4 + b4) * 16384;
#pragma unroll
        for (int ct = 0; ct < 4; ++ct) {
            if (!((am >> (ct * 4 + b4)) & 1u)) continue;
            const bool pick = (pm >> (ct * 4 + b4)) & 1u;
            const int cur = ct < 2 ? tA : tB;
            const bool farb = blk + 3 <= cur;
            const float binit = pick ? (farb ? bfar - bnd[ct] : -bnd[ct]) : -1e30f; const f32x4 cinit = {binit, binit, binit, binit};
            bf16x8 kf[4][2];
#pragma unroll
            for (int kt = 0; kt < 4; ++kt) { const int key = kt * 16 + col;
                kf[kt][0] = *(const LAS bf16x8*)(ring + key * 128 + ((rq ^ (key & 7)) * 16)); kf[kt][1] = *(const LAS bf16x8*)(ring + key * 128 + (((4 + rq) ^ (key & 7)) * 16)); }
            bf16x8 vf[4][2];
#pragma unroll
            for (int dt = 0; dt < 4; ++dt) { const int d = dt * 16 + col; const LAS unsigned char* vr = ring + 8192 + d * 128; const int sw = d & 7;
                vf[dt][0] = *(const LAS bf16x8*)(vr + ((rq ^ sw) * 16)); vf[dt][1] = *(const LAS bf16x8*)(vr + (((4 + rq) ^ sw) * 16)); }
            __builtin_amdgcn_sched_barrier(0);
            f32x4 sacc[4];
#pragma unroll
            for (int kt = 0; kt < 4; ++kt) sacc[kt] = mfma16(kf[kt][0], qb[ct][0], cinit);
#pragma unroll
            for (int kt = 0; kt < 4; ++kt) sacc[kt] = mfma16(kf[kt][1], qb[ct][1], sacc[kt]);
            if (farb) {
#pragma unroll
                for (int kt = 0; kt < 4; ++kt)
#pragma unroll
                    for (int e = 0; e < 4; ++e) sacc[kt][e] = __builtin_amdgcn_exp2f(sacc[kt][e]);
            } else {
                const LAS float* nbp = (const LAS float*)(L + NEAR_OFF) + (tq[ct] + 64 - blk * 64 - 4 * rq) * 8 + g * 4 + hj;
#pragma unroll
                for (int kt = 0; kt < 4; ++kt)
#pragma unroll
                    for (int e = 0; e < 4; ++e) sacc[kt][e] = __builtin_amdgcn_exp2f(sacc[kt][e] + nbp[-(kt * 16 + e) * 8]);
            }
            const bf16x8 pb0 = pack8(sacc[0], sacc[1]), pb1 = pack8(sacc[2], sacc[3]);
#pragma unroll
            for (int dt = 0; dt < 4; ++dt) O[ct][dt] = mfma16(vf[dt][0], pb0, O[ct][dt]);
#pragma unroll
            for (int dt = 0; dt < 4; ++dt) O[ct][dt] = mfma16(vf[dt][1], pb1, O[ct][dt]);
            Ls[ct] = mfma16(ones, pb0, Ls[ct]); Ls[ct] = mfma16(ones, pb1, Ls[ct]);
        }
      }
    }
#pragma unroll
    for (int ct = 0; ct < 4; ++ct) { const int t = tq[ct]; const float sc = bf1(GA[(size_t)t * 32 + 8 + g * 4 + hj]) / Ls[ct][0];
        const bf16* pw = WSP(const bf16, WS_H) + (size_t)t * 512 + g * 256 + hj * 64; const bf16* pc = WSP(const bf16, WS_H + 16 * MiB) + (size_t)t * 512 + g * 256 + hj * 64; bf16* ya = WSP(bf16, WS_QA) + (size_t)t * 512 + (g * 4 + hj) * 64;
#pragma unroll
        for (int dt = 0; dt < 4; ++dt) { const v2u a = *(const v2u*)(pw + dt * 16 + 4 * rq), b = *(const v2u*)(pc + dt * 16 + 4 * rq);
            f32x4 o = O[ct][dt] * sc; o[0] += bflo(a.x) + bflo(b.x); o[1] += bfhi(a.x) + bfhi(b.x); o[2] += bflo(a.y) + bflo(b.y); o[3] += bfhi(a.y) + bfhi(b.y); *(v2u*)(ya + dt * 16 + 4 * rq) = pack4(o); } }
    asm volatile("s_waitcnt vmcnt(0) lgkmcnt(0)" ::: "memory");
#undef P4B_ISSUE
}
DI void p4_ret_wg(Frame& F, int u) {
    const int c = u >> 2, h = u & 3, q8 = F.wave, lane = F.lane, col = lane & 15, rq = lane >> 4;
    const int il = q8 * 16 + col, tq = c * 128 + il;
    const float l2g = log2f(1.0f - __builtin_amdgcn_exp2f((float)(-5 - h)));
    const bf16* QR = WSP(const bf16, WS_QR); const bf16* KR = WSP(const bf16, WS_KR); const bf16* TOUT = WSP(const bf16, WS_TOUT); LAS unsigned char* L = F.lds;
    const bf16* RT = WSP(const bf16, WS_UR) + ((size_t)(c * 4 + h) * 256) * 128;
    asm volatile("s_waitcnt vmcnt(0) lgkmcnt(0)" ::: "memory"); __builtin_amdgcn_s_barrier();
    dma_rows256(RT, 128, 256, L, F.wave, lane);
    bf16x8 qf[4];
#pragma unroll
    for (int ks = 0; ks < 4; ++ks) qf[ks] = ld16(QR + (size_t)tq * 512 + h * 128 + ks * 32 + rq * 8);
    asm volatile("s_waitcnt vmcnt(0)" ::: "memory"); __builtin_amdgcn_s_barrier(); asm volatile("" ::: "memory");
    f32x4 ACC[16]; const f32x4 z4 = {0.f, 0.f, 0.f, 0.f};
#pragma unroll
    for (int i = 0; i < 16; ++i) ACC[i] = z4;
#pragma unroll
    for (int ks = 0; ks < 4; ++ks)
#pragma unroll
        for (int dvt = 0; dvt < 16; ++dvt) ACC[dvt] = mfma16(frag256(L, dvt * 16 + col, ks * 4 + rq), qf[ks], ACC[dvt]);
    { const float qd = __builtin_amdgcn_exp2f((float)(il + 1) * l2g);
#pragma unroll
      for (int i = 0; i < 16; ++i) ACC[i] = ACC[i] * qd; }
    asm volatile("s_waitcnt lgkmcnt(0)" ::: "memory"); __builtin_amdgcn_s_barrier(); asm volatile("" ::: "memory");
    dma_rows256(TOUT + (size_t)(768 + h * 256) * TP + c * 128, TP, 256, L, F.wave, lane);
    dma_rows256(KR + (size_t)(c * 128) * 512 + h * 128, 512, 128, L + 65536, F.wave, lane);
    asm volatile("s_waitcnt vmcnt(0)" ::: "memory"); __builtin_amdgcn_s_barrier(); asm volatile("" ::: "memory");
    const int nkp = (q8 * 16 + 16 + 31) >> 5;
    for (int kp = 0; kp < nkp; ++kp) {
        f32x4 p[2];
#pragma unroll
        for (int kt = 0; kt < 2; ++kt) { f32x4 s = z4;
#pragma unroll
            for (int ks = 0; ks < 4; ++ks) s = mfma16(frag256(L + 65536, kp * 32 + kt * 16 + col, ks * 4 + rq), qf[ks], s);
#pragma unroll
            for (int e = 0; e < 4; ++e) { const int dj = il - (kp * 32 + kt * 16 + 4 * rq + e); p[kt][e] = dj >= 0 ? s[e] * __builtin_amdgcn_exp2f((float)dj * l2g) : 0.f; } }
        const bf16x8 pb = pack8(p[0], p[1]);
#pragma unroll
        for (int dvt = 0; dvt < 16; ++dvt) { const v2u lo = frag256h(L, dvt * 16 + col, kp * 4 + (rq >> 1), rq & 1), hi = frag256h(L, dvt * 16 + col, kp * 4 + 2 + (rq >> 1), rq & 1);
            v4u v = {lo.x, lo.y, hi.x, hi.y}; ACC[dvt] = mfma16(__builtin_bit_cast(bf16x8, v), pb, ACC[dvt]); }
    }
    float s1 = 0.f;
#pragma unroll
    for (int i = 0; i < 16; ++i) s1 += (ACC[i][0] + ACC[i][1]) + (ACC[i][2] + ACC[i][3]);
    const float mu = quad_sum(s1) * (1.0f / 256.0f); float s2 = 0.f;
#pragma unroll
    for (int i = 0; i < 16; ++i) { ACC[i] = ACC[i] - mu; s2 += (ACC[i][0] * ACC[i][0] + ACC[i][1] * ACC[i][1]) + (ACC[i][2] * ACC[i][2] + ACC[i][3] * ACC[i][3]); }
    const float rs = 1.0f / sqrtf(quad_sum(s2) * (1.0f / 256.0f) + EPS);
    bf16* GR = WSP(bf16, WS_GR) + (size_t)tq * 1024 + h * 256; const float* rn = F.A->in[10] + h * 256;
#pragma unroll
    for (int dvt = 0; dvt < 16; ++dvt) { const int d0 = dvt * 16 + 4 * rq; const v2u gv = *(const v2u*)(GR + d0); const f32x4 w = *(const f32x4*)(rn + d0);
        f32x4 o; o[0] = siluf_(bflo(gv.x)) * ACC[dvt][0] * rs * w[0]; o[1] = siluf_(bfhi(gv.x)) * ACC[dvt][1] * rs * w[1]; o[2] = siluf_(bflo(gv.y)) * ACC[dvt][2] * rs * w[2]; o[3] = siluf_(bfhi(gv.y)) * ACC[dvt][3] * rs * w[3];
        *(v2u*)(GR + d0) = pack4(o); }
}

DI int moe_row(int f) { const int fp = f & 127; return (f >> 7) * 256 + 128 * (fp >> 6) + 32 * ((fp >> 4) & 3) + 4 * ((fp >> 2) & 3) + (fp & 3); }
DI void p8_route_item(Frame& F, int item) {
    const int lane = F.lane, row = lane & 15, kq = lane >> 4, m0 = item * 16, slot = F.wave & 3, hh = F.wave >> 2; const float* x1 = F.out; bf16* H2 = WSP(bf16, WS_H);
    LAS float* lg = (LAS float*)(F.lds + slot * WAVE_LDS);
    LAS float* ex = (LAS float*)(F.lds + slot * WAVE_LDS + 3200);
    const float* WRT = WSP(const float, WS_SM + SM_WRT);
    const float* xr = x1 + (size_t)(m0 + row) * 1024 + 4 * kq + hh * 512; const float* wr = WRT + (size_t)row * 1024 + 4 * kq + hh * 512;
    f32x4 acc[3]; float ss = 0.f;
#pragma unroll
    for (int ct = 0; ct < 3; ++ct) acc[ct] = (f32x4){0.f, 0.f, 0.f, 0.f};
#pragma unroll 8
    for (int c = 0; c < 32; ++c) {
        const f32x4 xa = *(const f32x4*)(xr + 16 * c); ss += (xa[0] * xa[0] + xa[1] * xa[1]) + (xa[2] * xa[2] + xa[3] * xa[3]);
#pragma unroll
        for (int ct = 0; ct < 3; ++ct) { const f32x4 wb = *(const f32x4*)(wr + (size_t)ct * 16 * 1024 + 16 * c);
#pragma unroll
            for (int j = 0; j < 4; ++j) acc[ct] = __builtin_amdgcn_mfma_f32_16x16x4f32(xa[j], wb[j], acc[ct], 0, 0, 0); }
    }
    if (hh == 1) {
#pragma unroll
        for (int ct = 0; ct < 3; ++ct)
#pragma unroll
            for (int j = 0; j < 4; ++j) ex[(ct * 4 + j) * 64 + lane] = acc[ct][j];
        ex[12 * 64 + lane] = ss;
    }
    LDS_WAIT(); __syncthreads();
    LAS unsigned* lcnt = (LAS unsigned*)(F.lds + 4 * WAVE_LDS);
    if (F.tid < 64) lcnt[F.tid] = 0u;
    int ex1 = 0, ex2 = 0; unsigned lr1 = 0u, lr2 = 0u; float w1 = 0.f, w2 = 0.f;
    if (hh == 0) {
#pragma unroll
        for (int ct = 0; ct < 3; ++ct)
#pragma unroll
            for (int j = 0; j < 4; ++j) acc[ct][j] += ex[(ct * 4 + j) * 64 + lane];
        ss += ex[12 * 64 + lane];
        const float rs = 1.0f / sqrtf(quad_sum(ss) * (1.0f / 1024.0f) + EPS);
        if (kq == 0) lg[16 * 48 + row] = rs;
#pragma unroll
        for (int ct = 0; ct < 3; ++ct)
#pragma unroll
            for (int j = 0; j < 4; ++j) lg[(4 * kq + j) * 48 + ct * 16 + row] = acc[ct][j];
    }
    LDS_WAIT(); __syncthreads();
    if (hh == 0 && lane < 16) {
        const float rst = lg[16 * 48 + lane]; float l[36];
#pragma unroll
        for (int o = 0; o < 36; ++o) l[o] = lg[lane * 48 + o] * rst + (o < 4 ? F.A->in[16][o] : F.A->in[18][o - 4]);
        int grp = 0; float mg = l[0];
#pragma unroll
        for (int i = 1; i < 4; ++i) if (l[i] > mg) { mg = l[i]; grp = i; }
        float Z = 0.f;
#pragma unroll
        for (int i = 0; i < 4; ++i) Z += expf(l[i] - mg);
        const float pg = 1.0f / Z;
        float le[8];
#pragma unroll
        for (int i = 0; i < 8; ++i) le[i] = grp == 0 ? l[4 + i] : (grp == 1 ? l[12 + i] : (grp == 2 ? l[20 + i] : l[28 + i]));
        int i1 = 0; float v1 = le[0];
#pragma unroll
        for (int i = 1; i < 8; ++i) if (le[i] > v1) { v1 = le[i]; i1 = i; }
        int i2 = -1; float v2 = -3.0e38f;
#pragma unroll
        for (int i = 0; i < 8; ++i) if (i != i1 && le[i] > v2) { v2 = le[i]; i2 = i; }
        const float e2 = expf(v2 - v1); w1 = pg / (1.0f + e2); w2 = pg * e2 / (1.0f + e2);
        ex1 = grp * 8 + i1; ex2 = grp * 8 + i2;
        lr1 = __hip_atomic_fetch_add(lcnt + ex1, 1u, __ATOMIC_RELAXED, __HIP_MEMORY_SCOPE_WORKGROUP); lr2 = __hip_atomic_fetch_add(lcnt + ex2, 1u, __ATOMIC_RELAXED, __HIP_MEMORY_SCOPE_WORKGROUP);
    }
    LDS_WAIT(); __syncthreads();
    if (F.tid < 32) { const unsigned n = lcnt[F.tid]; lcnt[32 + F.tid] = n ? atomicAdd(F.ctl + CW_CNT + F.tid, n) : 0u; }
    LDS_WAIT(); __syncthreads();
    if (hh == 0 && lane < 16) {
        const int t = m0 + lane; v2u* LIST = WSP(v2u, WS_XS);
        LIST[(size_t)ex1 * 16384 + lcnt[32 + ex1] + lr1] = (v2u){(unsigned)(t * 2 + 0), __float_as_uint(w1)};
        LIST[(size_t)ex2 * 16384 + lcnt[32 + ex2] + lr2] = (v2u){(unsigned)(t * 2 + 1), __float_as_uint(w2)};
    }
    { f32x4 w[4]; load_row(F.A->in[14], lane, w);
#pragma unroll 4
      for (int r8 = 0; r8 < 8; ++r8) { const int r = hh * 8 + r8; f32x4 v[4]; load_row(x1 + (size_t)(m0 + r) * 1024, lane, v); const float rst = lg[16 * 48 + r];
#pragma unroll
        for (int j = 0; j < 4; ++j) *(v2u*)(H2 + (size_t)(m0 + r) * 1024 + 4 * lane + 256 * j) = pack4(v[j] * rst * w[j]); } }
    LDS_WAIT(); __syncthreads();
}
DI void p8_moe_weights(Frame& F) {
    LAS float* scr = (LAS float*)(F.lds + F.wave * WAVE_LDS + 4096);
    bf16* WGU = WSP(bf16, WS_MOEW); bf16* WD = WGU + (size_t)32 * 512 * 1024;
    for (int it = F.gw; it < 3 * 4096; it += F.ngw) {
        const int which = it >> 12, r = it & 4095;
        if (which < 2) { const int e = r >> 7, q = r & 127, kb = q >> 3, nb = q & 7; bf16* dstb = WGU + (size_t)e * 512 * 1024 + (which ? 16 * 1024 : 0);
            tr_item((which ? F.A->in[20] : F.A->in[19]) + (size_t)e * 1024 * 256, 256, 256, 64 * kb, 32 * nb, scr, F.lane, [dstb](int n, int w2) { return w2 ? (bf16*)nullptr : dstb + (size_t)moe_row(n) * 1024; }); }
        else { const int e = r >> 7, q = r & 127, kb = q >> 5, nb = q & 31; bf16* dstb = WD + (size_t)e * 1024 * 256;
            tr_item(F.A->in[21] + (size_t)e * 256 * 1024, 1024, 1024, 64 * kb, 32 * nb, scr, F.lane, [dstb](int n, int w2) { return w2 ? (bf16*)nullptr : dstb + (size_t)n * 256; }); }
    }
}
DI void moe_tile_prefix(Frame& F) {
    LAS int* tp = (LAS int*)(F.lds + MOET_OFF);
    if (F.tid == 0) { int a = 0; for (int e = 0; e < 32; ++e) { const unsigned c = __hip_atomic_load(F.ctl + CW_CNT + e, __ATOMIC_RELAXED, __HIP_MEMORY_SCOPE_AGENT); tp[e] = a; tp[34 + e] = (int)c; a += (int)((c + 255u) >> 8); } tp[32] = a; }
    __syncthreads();
}
DI void p12_final(Frame& F) {
    f32x4 w[4]; load_row(F.A->in[22], F.lane, w); const bf16* Y = WSP(const bf16, WS_Y);
#pragma unroll 2
    for (int m = F.gw; m < S; m += F.ngw) {
        f32x4 v[4]; load_row(F.out + (size_t)m * 1024, F.lane, v);
#pragma unroll
        for (int j = 0; j < 4; ++j) { const v2u a = *(const v2u*)(Y + (size_t)m * 1024 + 4 * F.lane + 256 * j), b = *(const v2u*)(Y + ((size_t)S + m) * 1024 + 4 * F.lane + 256 * j);
            v[j][0] += bflo(a.x) + bflo(b.x); v[j][1] += bfhi(a.x) + bfhi(b.x); v[j][2] += bflo(a.y) + bflo(b.y); v[j][3] += bfhi(a.y) + bfhi(b.y); }
        const float rs = row_rstd(v);
#pragma unroll
        for (int j = 0; j < 4; ++j) *(f32x4*)(F.out + (size_t)m * 1024 + 4 * F.lane + 256 * j) = v[j] * rs * w[j];
    }
}

#ifndef MK_PER_PHASE
#define MK_PER_PHASE 0
#endif
constexpr int NPH = 13;
__global__ void __launch_bounds__(NTHR, 2) mk_fwd(Args args) {
    extern __shared__ __attribute__((aligned(16))) unsigned char lds[];
    Frame F;
    F.lds = (LAS unsigned char*)lds;
    F.tid = threadIdx.x; F.lane = F.tid & 63; F.wave = __builtin_amdgcn_readfirstlane(F.tid >> 6);
    F.G = gridDim.x; F.gw = blockIdx.x * NWAVES + F.wave; F.ngw = F.G * NWAVES;
    F.ws = args.ws; F.ctl = (unsigned*)(args.ws + WS_CTL); F.out = args.out;
    F.A = &args;
    for (int u = F.tid; u < (LDS_BYTES - MISC_OFF) / 4; u += NTHR) ((LAS unsigned*)(F.lds + MISC_OFF))[u] = 0u;
    __syncthreads();
    XcdBarrier bar; bar.bar = F.ctl + CW_BAR + args.li * XCD_BAR_WORDS; bar.x = 0; bar.st = nullptr;
    if (!MK_PER_PHASE) bar = xcd_barrier_post(F.ctl + CW_BAR + args.li * XCD_BAR_WORDS, (volatile LAS unsigned*)(F.lds + MISC_OFF) + 8);
    const int lo = args.ph_lo, hi = args.ph_hi;
    const int sub = args.pad ? args.pad : 0xFFFF;
#define IN(k) (lo <= (k) && (k) < hi)
#define SEAM(k) do { if (IN(k) && IN((k) + 1)) xcd_barrier(bar); } while (0)
    LAS unsigned char* ring = F.lds;

    if (IN(0)) { p0_prologue(F); }
    SEAM(0);
    if (IN(1)) {
        pg8::Gemm g{WSP(const bf16, WS_H), WSP(const bf16, WS_WR), 0, 0, 1024}; ProjOrder O{F.G, (int)blockIdx.x};
        EpiProj E{WSP(bf16, WS_QA), WSP(bf16, WS_KCV), WSP(bf16, WS_QR), WSP(bf16, WS_KR), WSP(bf16, WS_GR), WSP(bf16, WS_GA), WSP(bf16, WS_TOUT), (bf16*)F.out};
        pg8::gemm_phase<EpiProj, ProjOrder, true, true>(ring, g, O, E);
    }
    SEAM(1);
    if (IN(2)) {
        if (sub & 32) for (int u = blockIdx.x; u < 512; u += F.G) p2_ret_state_wg(F, u);
        if (sub & 8) { if (F.wave < 4) for (int u = blockIdx.x * 4 + F.wave; u < 1024; u += F.G * 4) p2_cmp_hidden(F, u); }
        if (sub & 16) { if (F.wave == 4) for (int u = blockIdx.x; u < 256; u += F.G) p2_kmax(F, u); }
        asm volatile("s_waitcnt vmcnt(0) lgkmcnt(0)" ::: "memory"); __syncthreads();
    }
    SEAM(2);
    if (IN(3)) {
        if (sub & 64) p3_scan(F);
        if (sub & 128) for (int u = F.gw; u < 256; u += F.ngw) p3_kcvc(F, u);
    }
    SEAM(3);
    if (IN(4)) {
        p4_bias_table(F);
        for (int pp = blockIdx.x; pp < 256; pp += F.G) {
            const int g = pp & 1, c = pp >> 1;
            { int tl = F.tid; asm volatile("" : "+v"(tl), "+s"(F.ws)); F.tid = tl; F.lane = tl & 63; }
            if (sub & 1) {
                const int us = c * 4 + (F.wave & 3), ul = (255 - c) * 4 + (F.wave & 3);
                const int nS = ((us < 1023 ? us : 1023) + 31) >> 5, nL = ((ul < 1023 ? ul : 1023) + 31) >> 5; const bool moveW = 2 * nL > 2 * nS + 17;
                p4w_wg(F, c, 255 - c, g);
                p4a_unit(F, g, 0, 0, 0, true, F.wave < 4 ? us : ul);
            }
            VM_WAIT(); __syncthreads();
            if (sub & 2) p4b_pass(F.lds, F.ws, F.out, c, 255 - c, g, F.tid);
        }
        if (sub & 4) for (int u = blockIdx.x; u < 512; u += F.G) p4_ret_wg(F, u);
        asm volatile("s_waitcnt vmcnt(0) lgkmcnt(0)" ::: "memory");
        __syncthreads();
    }
    SEAM(4);
    if (IN(6)) {
        { pg8::Gemm g{WSP(const bf16, WS_QA), WSP(const bf16, WS_WUA), S, 1024, 512}; pg8::StaticOrder O; O.init(S, 1024, F.G, (int)blockIdx.x);
          EpiUp<false> E{(const bf16*)F.out, WSP(bf16, WS_MG), 0};
          pg8::gemm_phase<EpiUp<false>, pg8::StaticOrder, true, true>(ring, g, O, E); }
        if (F.G != 256 && !MK_PER_PHASE) xcd_barrier(bar); else { VM_WAIT(); __syncthreads(); }
        { pg8::Gemm g{WSP(const bf16, WS_GR), WSP(const bf16, WS_WUB), S, 1024, 1024}; pg8::StaticOrder O; O.init(S, 1024, F.G, (int)blockIdx.x);
          EpiUp<true> E{(const bf16*)F.out, WSP(bf16, WS_MG), 1024};
          pg8::gemm_phase<EpiUp<true>, pg8::StaticOrder, true, true>(ring, g, O, E); }
    }
    SEAM(6);
    if (IN(7)) {
        pg8::Gemm g{WSP(const bf16, WS_MG), WSP(const bf16, WS_WO), S, 1024, 1024}; pg8::StaticOrder O; O.init(S, 1024, F.G, (int)blockIdx.x);
        EpiOut E{F.A->in[0], F.out};
        pg8::gemm_phase<EpiOut, pg8::StaticOrder, true, true>(ring, g, O, E);
    }
    SEAM(7);
    if (IN(8)) {
        if (sub & 256) for (int it = blockIdx.x * 4; it < S / 16; it += F.G * 4) p8_route_item(F, it + (F.wave & 3));
        if (sub & 512) p8_moe_weights(F);
    }
    SEAM(8);
    if (IN(10)) {
        moe_tile_prefix(F);
        MoeOrder<2> O{F.G, (int)blockIdx.x, (const LAS int*)(F.lds + MOET_OFF)};
        { LAS unsigned* gtab = (LAS unsigned*)(F.lds + GTAB_OFF); const LAS int* tp = (const LAS int*)(F.lds + MOET_OFF); const v2u* LIST = WSP(const v2u, WS_XS);
          for (int ui = 0; ui < 8; ++ui) { pg8::Unit u; if (!O.next(ui, u)) break;
              if (F.tid < 256) { const int ex = u.pn >> 1, rank = (u.pm - tp[ex]) * 256 + F.tid; gtab[ui * 256 + F.tid] = rank < tp[34 + ex] ? (LIST[(size_t)ex * 16384 + rank].x >> 1) : 0u; } }
          asm volatile("s_waitcnt vmcnt(0) lgkmcnt(0)" ::: "memory"); __syncthreads(); }
        pg8::Gemm g{WSP(const bf16, WS_H), WSP(const bf16, WS_MOEW), 0, 0, 1024};
        EpiMoe1 E{WSP(bf16, WS_HID)};
        pg8::gemm_phase<EpiMoe1, MoeOrder<2>, true, true, true>(ring, g, O, E, (const LAS unsigned*)(F.lds + GTAB_OFF));
    }
    SEAM(10);
    if (IN(11)) {
        moe_tile_prefix(F);
        pg8::Gemm g{WSP(const bf16, WS_HID), WSP(const bf16, WS_MOEW) + (size_t)32 * 512 * 1024, 0, 0, 256}; MoeOrder<4> O{F.G, (int)blockIdx.x, (const LAS int*)(F.lds + MOET_OFF)};
        EpiMoe2 E{WSP(const v2u, WS_XS), WSP(bf16, WS_Y), (const LAS int*)(F.lds + MOET_OFF), (const LAS int*)(F.lds + MOET_OFF) + 34};
        pg8::gemm_phase<EpiMoe2, MoeOrder<4>, true, true>(ring, g, O, E);
    }
    SEAM(11);
    if (IN(12)) p12_final(F);
#undef IN
#undef SEAM
}

extern "C" void kernel_launch(void* const* d_in, const int* in_sizes, int n_in, void* d_out, int out_size, void* d_ws, size_t ws_size, hipStream_t stream) {
    static int grid = 0;
    if (grid == 0) {
        if (n_in != 23 || out_size != S * D || ws_size < WS_END) { fprintf(stderr, "kernel_launch: unexpected problem (n_in %d, out %d, ws %zu)\n", n_in, out_size, ws_size); grid = -1; return; }
        int dev = 0, cus = 0;
        if (hipGetDevice(&dev) != hipSuccess || hipDeviceGetAttribute(&cus, hipDeviceAttributeMultiprocessorCount, dev) != hipSuccess) { grid = -1; return; }
        if (hipFuncSetAttribute((const void*)mk_fwd, hipFuncAttributeMaxDynamicSharedMemorySize, LDS_BYTES) != hipSuccess) { fprintf(stderr, "kernel_launch: hipFuncSetAttribute failed\n"); grid = -1; return; }
        int per_cu = 0;
        if (hipOccupancyMaxActiveBlocksPerMultiprocessor(&per_cu, (const void*)mk_fwd, NTHR, LDS_BYTES) != hipSuccess || per_cu < 1) { fprintf(stderr, "kernel_launch: occupancy query says %d\n", per_cu); }
        (void)hipGetLastError();
        grid = cus > 0 ? cus : 256;
    }
    if (grid < 0) return;
    if (hipMemsetAsync((char*)d_ws + WS_CTL, 0, CTL_ZERO_BYTES, stream) != hipSuccess) return;
    Args a{};
    for (int i = 0; i < 23; ++i) a.in[i] = (const float*)d_in[i];
    a.out = (float*)d_out; a.ws = (unsigned char*)d_ws;
#if MK_PER_PHASE
    for (int p = 0; p < NPH; ++p) { a.ph_lo = p; a.ph_hi = p + 1; hipLaunchKernelGGL(mk_fwd, dim3(grid), dim3(NTHR), LDS_BYTES, stream, a); }
#elif defined(MK_PREFIX_HI)
    a.ph_lo = 0; a.ph_hi = MK_PREFIX_HI; a.li = 0; a.pad = MK_PREFIX_SUB; hipLaunchKernelGGL(mk_fwd, dim3(grid), dim3(NTHR), LDS_BYTES, stream, a);
    (void)hipMemsetAsync((char*)d_ws + WS_CTL, 0, CTL_ZERO_BYTES, stream);
    a.ph_lo = 0; a.ph_hi = NPH; a.li = 1; a.pad = 0; hipLaunchKernelGGL(mk_fwd, dim3(grid), dim3(NTHR), LDS_BYTES, stream, a);
#elif defined(MK_DUP_LO)
    a.ph_lo = 0; a.ph_hi = MK_DUP_HI + 1; a.li = 0; hipLaunchKernelGGL(mk_fwd, dim3(grid), dim3(NTHR), LDS_BYTES, stream, a);
    a.ph_lo = MK_DUP_LO; a.ph_hi = NPH; a.li = 1; hipLaunchKernelGGL(mk_fwd, dim3(grid), dim3(NTHR), LDS_BYTES, stream, a);
#else
    a.ph_lo = 0; a.ph_hi = NPH;
    hipLaunchKernelGGL(mk_fwd, dim3(grid), dim3(NTHR), LDS_BYTES, stream, a);
#endif
}
```
